# Optimizing an MI355X kernel written in HIP

```python
import math
import jax
import jax.numpy as jnp
from jax import lax
import numpy as np

D_MODEL = 2048
BATCH = 4
SEQ = 2048
DEPTH = 4

CHUNK = 64
Q_BLOCK = 128
N_MIXERS = 3
DEEPNORM_ALPHA = (2.0 * DEPTH) ** 0.25
DEEPNORM_BETA = (8.0 * DEPTH) ** -0.25
N_MLA_LAYERS = (DEPTH + 2) // 3
N_FOX_LAYERS = (DEPTH + 1) // 3
N_DSA_LAYERS = DEPTH // 3

MLA_HEADS = 16
MLA_NOPE_DIM = 128
MLA_ROPE_DIM = 64
MLA_V_DIM = 128
MLA_Q_RANK = 512
MLA_KV_RANK = 512
ROPE_THETA = 10000.0

FOX_HEADS = 16
FOX_HEAD_DIM = D_MODEL // FOX_HEADS

DSA_HEADS = 16
DSA_HEAD_DIM = D_MODEL // DSA_HEADS
IDX_HEADS = 16
IDX_DIM = 64
IDX_TOPK_MAX = 256

T5_BUCKETS = 32
T5_MAX_DISTANCE = 128

MOE_GROUPS = 4
MOE_EXPERTS_PER_GROUP = 8
MOE_EXPERTS = MOE_GROUPS * MOE_EXPERTS_PER_GROUP
MOE_TOPK = 2
MOE_D_FF = 512

LN_EPS = 1e-5
RMS_EPS = 1e-6
NEG_INF = -1e30

MLA_IN_DIM = MLA_Q_RANK + MLA_KV_RANK + MLA_ROPE_DIM
FOX_IN_DIM = 3 * FOX_HEADS * FOX_HEAD_DIM + FOX_HEADS
DSA_SPLITS = [DSA_HEADS * DSA_HEAD_DIM, DSA_HEAD_DIM, DSA_HEAD_DIM, IDX_HEADS * IDX_DIM, IDX_DIM, IDX_HEADS]
DSA_IN_DIM = sum(DSA_SPLITS)

kernel_name = 'hybrid_chunk_causal_encoder'

F32 = jnp.float32


def _split(h, sizes):
    return jnp.split(h, np.cumsum(sizes)[:-1].tolist(), axis=-1)


def _layernorm(x, g, b):
    xf = x.astype(F32)
    mu = jnp.mean(xf, axis=-1, keepdims=True)
    var = jnp.mean(jnp.square(xf - mu), axis=-1, keepdims=True)
    return ((xf - mu) * lax.rsqrt(var + LN_EPS) * g.astype(F32) + b.astype(F32)).astype(x.dtype)


def _rmsnorm(x, g):
    xf = x.astype(F32)
    return (xf * lax.rsqrt(jnp.mean(xf * xf, axis=-1, keepdims=True) + RMS_EPS) * g.astype(F32)).astype(x.dtype)


def _rope(x, pos):
    half = x.shape[-1] // 2
    inv_freq = ROPE_THETA ** (-jnp.arange(half, dtype=F32) / half)
    ang = pos.astype(F32)[:, None] * inv_freq[None, :]
    cos = jnp.cos(ang)[None, :, None, :]
    sin = jnp.sin(ang)[None, :, None, :]
    xf = x.astype(F32)
    x1, x2 = xf[..., :half], xf[..., half:]
    return jnp.concatenate([x1 * cos - x2 * sin, x2 * cos + x1 * sin], axis=-1).astype(x.dtype)


def _t5_bucket(rel):
    nb = T5_BUCKETS // 2
    max_exact = nb // 2
    ret = jnp.where(rel > 0, nb, 0)
    n = jnp.abs(rel)
    nf = jnp.maximum(n, 1).astype(F32)
    large = max_exact + (jnp.log(nf / max_exact) / math.log(T5_MAX_DISTANCE / max_exact)
                         * (nb - max_exact)).astype(jnp.int32)
    large = jnp.minimum(large, nb - 1)
    return ret + jnp.where(n < max_exact, n, large)


def _block(a):
    b, s = a.shape[:2]
    return jnp.moveaxis(a.reshape(b, s // Q_BLOCK, Q_BLOCK, *a.shape[2:]), 1, 0)


def _unblock(a):
    a = jnp.moveaxis(a, 0, 1)
    return a.reshape(a.shape[0], a.shape[1] * a.shape[2], *a.shape[3:])


def _block_starts(s):
    return jnp.arange(s // Q_BLOCK, dtype=jnp.int32) * Q_BLOCK


def _attend(qb, k, v, bias, mask, scale):
    s = jnp.einsum('bqhd,bkhd->bhqk', qb, k, preferred_element_type=F32) * scale + bias
    s = jnp.where(mask, s, NEG_INF)
    p = jax.nn.softmax(s, axis=-1).astype(v.dtype)
    return jnp.einsum('bhqk,bkhd->bqhd', p, v)


def _mla(x, pos, w_in, q_norm, kv_norm, w_q_up, w_kv_up, w_o):
    B, S, _ = x.shape
    c_q, c_kv, k_rope = _split(x @ w_in, [MLA_Q_RANK, MLA_KV_RANK, MLA_ROPE_DIM])
    c_q = _rmsnorm(c_q, q_norm)
    c_kv = _rmsnorm(c_kv, kv_norm)
    q = (c_q @ w_q_up).reshape(B, S, MLA_HEADS, MLA_NOPE_DIM + MLA_ROPE_DIM)
    kv = (c_kv @ w_kv_up).reshape(B, S, MLA_HEADS, MLA_NOPE_DIM + MLA_V_DIM)
    q = jnp.concatenate([q[..., :MLA_NOPE_DIM], _rope(q[..., MLA_NOPE_DIM:], pos)], axis=-1)
    k_rope = jnp.broadcast_to(_rope(k_rope[:, :, None, :], pos), (B, S, MLA_HEADS, MLA_ROPE_DIM))
    k = jnp.concatenate([kv[..., :MLA_NOPE_DIM], k_rope], axis=-1)
    v = kv[..., MLA_NOPE_DIM:]
    scale = (MLA_NOPE_DIM + MLA_ROPE_DIM) ** -0.5
    kchunk = pos // CHUNK

    def block(args):
        qb, start = args
        qchunk = (start + jnp.arange(Q_BLOCK, dtype=jnp.int32)) // CHUNK
        mask = kchunk[None, :] <= qchunk[:, None]
        return _attend(qb, k, v, 0.0, mask, scale)

    o = _unblock(lax.map(block, (_block(q), _block_starts(S))))
    return o.reshape(B, S, MLA_HEADS * MLA_V_DIM) @ w_o


def _fox(x, pos, w_in, b_f, w_o):
    B, S, _ = x.shape
    hd = FOX_HEADS * FOX_HEAD_DIM
    q, k, v, f_logit = _split(x @ w_in, [hd, hd, hd, FOX_HEADS])
    q = q.reshape(B, S, FOX_HEADS, FOX_HEAD_DIM)
    k = k.reshape(B, S, FOX_HEADS, FOX_HEAD_DIM)
    v = v.reshape(B, S, FOX_HEADS, FOX_HEAD_DIM)
    log_f = jax.nn.log_sigmoid((f_logit + b_f).astype(F32))
    c = jnp.cumsum(log_f, axis=1)
    c_k = jnp.transpose(c, (0, 2, 1))[:, :, None, :]
    scale = FOX_HEAD_DIM ** -0.5

    def block(args):
        qb, cqb, start = args
        qpos = start + jnp.arange(Q_BLOCK, dtype=jnp.int32)
        mask = pos[None, :] <= qpos[:, None]
        bias = jnp.transpose(cqb, (0, 2, 1))[..., None] - c_k
        return _attend(qb, k, v, bias, mask, scale)

    o = _unblock(lax.map(block, (_block(q), _block(c), _block_starts(S))))
    return o.reshape(B, S, hd) @ w_o


def _dsa(x, pos, t5_bias, w_in, w_o):
    B, S, _ = x.shape
    topk = min(IDX_TOPK_MAX, S // 4)
    q, k, v, q_idx, k_idx, w_idx = _split(x @ w_in, DSA_SPLITS)
    q = q.reshape(B, S, DSA_HEADS, DSA_HEAD_DIM)
    q_idx = q_idx.reshape(B, S, IDX_HEADS, IDX_DIM)
    w_idx = w_idx.astype(F32) * (IDX_HEADS * IDX_DIM) ** -0.5
    scale = DSA_HEAD_DIM ** -0.5
    kchunk = pos // CHUNK
    gather = jax.vmap(lambda a, i: a[i])

    def block(args):
        qb, qib, wib, start = args
        qpos = start + jnp.arange(Q_BLOCK, dtype=jnp.int32)
        qchunk = qpos // CHUNK
        idx_logits = jnp.einsum('bqhd,bkd->bqhk', qib, k_idx, preferred_element_type=F32)
        score = jnp.einsum('bqhk,bqh->bqk', jax.nn.relu(idx_logits), wib)
        admissible = kchunk[None, :] <= qchunk[:, None]
        score = jnp.where(admissible[None], score, NEG_INF)
        _, sel = lax.top_k(score, topk)
        valid = (sel // CHUNK) <= qchunk[None, :, None]
        k_sel = gather(k, sel)
        v_sel = gather(v, sel)
        rel_bias = t5_bias[_t5_bucket(sel - qpos[None, :, None])].astype(F32)
        s = (jnp.einsum('bqhd,bqkd->bhqk', qb, k_sel, preferred_element_type=F32) * scale
             + jnp.transpose(rel_bias, (0, 3, 1, 2)))
        s = jnp.where(valid[:, None], s, NEG_INF)
        p = jax.nn.softmax(s, axis=-1).astype(v.dtype)
        return jnp.einsum('bhqk,bqkd->bqhd', p, v_sel)

    o = _unblock(lax.map(block, (_block(q), _block(q_idx), _block(w_idx), _block_starts(S))))
    return o.reshape(B, S, DSA_HEADS * DSA_HEAD_DIM) @ w_o


def _hier_moe(x, w_group, b_group, w_router, b_router, w_gate, w_up, w_down):
    B, S, D = x.shape
    n = B * S
    xf = x.reshape(n, D)
    p_group = jax.nn.softmax((xf @ w_group + b_group).astype(F32), axis=-1)
    g_sel = jnp.argmax(p_group, axis=-1)
    p_g = jnp.take_along_axis(p_group, g_sel[:, None], axis=-1)
    e_logits = (xf @ w_router + b_router).astype(F32).reshape(n, MOE_GROUPS, MOE_EXPERTS_PER_GROUP)
    e_logits = jnp.take_along_axis(e_logits, g_sel[:, None, None], axis=1)[:, 0]
    top_v, top_i = lax.top_k(e_logits, MOE_TOPK)
    top_w = jax.nn.softmax(top_v, axis=-1) * p_g
    gate_in_group = jnp.einsum('nk,nke->ne', top_w, jax.nn.one_hot(top_i, MOE_EXPERTS_PER_GROUP, dtype=F32))
    gates = (gate_in_group[:, None, :] * jax.nn.one_hot(g_sel, MOE_GROUPS, dtype=F32)[:, :, None]).astype(x.dtype)
    y = jnp.zeros_like(xf)
    for g in range(MOE_GROUPS):
        sl = slice(g * MOE_EXPERTS_PER_GROUP, (g + 1) * MOE_EXPERTS_PER_GROUP)
        h_gate = jnp.einsum('nd,edf->nef', xf, w_gate[sl])
        h_up = jnp.einsum('nd,edf->nef', xf, w_up[sl])
        h = jax.nn.silu(h_gate) * h_up * gates[:, g, :, None]
        y = y + jnp.einsum('nef,efd->nd', h, w_down[sl])
    return y.reshape(B, S, D)


def setup_inputs(seed: int = 0) -> dict:
    key = jax.random.key(seed)
    ks = jax.random.split(key, 24)

    def w(k, shape, fan_in, gain=1.0):
        return jax.random.normal(k, shape, F32) * (gain * fan_in ** -0.5)

    def gain_vec(k, shape):
        return 1.0 + 0.02 * jax.random.normal(k, shape, F32)

    D = D_MODEL
    return {
        'x': jax.random.normal(ks[0], (BATCH, SEQ, D), F32),
        't5_rel_bias': 0.1 * jax.random.normal(ks[1], (T5_BUCKETS, DSA_HEADS), F32),
        'mla_w_in': w(ks[2], (N_MLA_LAYERS, D, MLA_IN_DIM), D),
        'mla_q_norm': gain_vec(ks[3], (N_MLA_LAYERS, MLA_Q_RANK)),
        'mla_kv_norm': gain_vec(ks[4], (N_MLA_LAYERS, MLA_KV_RANK)),
        'mla_w_q_up': w(ks[5], (N_MLA_LAYERS, MLA_Q_RANK, MLA_HEADS * (MLA_NOPE_DIM + MLA_ROPE_DIM)), MLA_Q_RANK),
        'mla_w_kv_up': w(ks[6], (N_MLA_LAYERS, MLA_KV_RANK, MLA_HEADS * (MLA_NOPE_DIM + MLA_V_DIM)), MLA_KV_RANK),
        'mla_w_o': w(ks[7], (N_MLA_LAYERS, MLA_HEADS * MLA_V_DIM, D), MLA_HEADS * MLA_V_DIM, DEEPNORM_BETA),
        'fox_w_in': w(ks[8], (N_FOX_LAYERS, D, FOX_IN_DIM), D),
        'fox_b_f': 1.0 + 3.0 * jax.random.uniform(ks[9], (N_FOX_LAYERS, FOX_HEADS), F32),
        'fox_w_o': w(ks[10], (N_FOX_LAYERS, FOX_HEADS * FOX_HEAD_DIM, D), FOX_HEADS * FOX_HEAD_DIM, DEEPNORM_BETA),
        'dsa_w_in': w(ks[11], (N_DSA_LAYERS, D, DSA_IN_DIM), D),
        'dsa_w_o': w(ks[12], (N_DSA_LAYERS, DSA_HEADS * DSA_HEAD_DIM, D), DSA_HEADS * DSA_HEAD_DIM, DEEPNORM_BETA),
        'ln_g': gain_vec(ks[13], (DEPTH, 2, D)),
        'ln_b': 0.02 * jax.random.normal(ks[14], (DEPTH, 2, D), F32),
        'moe_w_group': w(ks[15], (DEPTH, D, MOE_GROUPS), D),
        'moe_b_group': 0.01 * jax.random.normal(ks[16], (DEPTH, MOE_GROUPS), F32),
        'moe_w_router': w(ks[17], (DEPTH, D, MOE_EXPERTS), D),
        'moe_b_router': 0.01 * jax.random.normal(ks[18], (DEPTH, MOE_EXPERTS), F32),
        'moe_w_gate': w(ks[19], (DEPTH, MOE_EXPERTS, D, MOE_D_FF), D),
        'moe_w_up': w(ks[20], (DEPTH, MOE_EXPERTS, D, MOE_D_FF), D),
        'moe_w_down': w(ks[21], (DEPTH, MOE_EXPERTS, MOE_D_FF, D), MOE_D_FF, DEEPNORM_BETA),
    }


def reference(x, t5_rel_bias, mla_w_in, mla_q_norm, mla_kv_norm, mla_w_q_up, mla_w_kv_up, mla_w_o,
              fox_w_in, fox_b_f, fox_w_o, dsa_w_in, dsa_w_o, ln_g, ln_b,
              moe_w_group, moe_b_group, moe_w_router, moe_b_router, moe_w_gate, moe_w_up, moe_w_down):
    pos = jnp.arange(x.shape[1], dtype=jnp.int32)
    for layer in range(DEPTH):
        kind = layer % N_MIXERS
        j = layer // N_MIXERS
        if kind == 0:
            y = _mla(x, pos, mla_w_in[j], mla_q_norm[j], mla_kv_norm[j], mla_w_q_up[j], mla_w_kv_up[j], mla_w_o[j])
        elif kind == 1:
            y = _fox(x, pos, fox_w_in[j], fox_b_f[j], fox_w_o[j])
        else:
            y = _dsa(x, pos, t5_rel_bias, dsa_w_in[j], dsa_w_o[j])
        x = _layernorm(DEEPNORM_ALPHA * x + y, ln_g[layer, 0], ln_b[layer, 0])
        y = _hier_moe(x, moe_w_group[layer], moe_b_group[layer], moe_w_router[layer], moe_b_router[layer],
                      moe_w_gate[layer], moe_w_up[layer], moe_w_down[layer])
        x = _layernorm(DEEPNORM_ALPHA * x + y, ln_g[layer, 1], ln_b[layer, 1])
    return x
```

```cpp
#include <hip/hip_runtime.h>
#include <stdint.h>
#include <math.h>
#include <string.h>
namespace fk {
#define FK_LAS __attribute__((address_space(3)))
typedef unsigned short bf16_t;
typedef short bf16x8 __attribute__((ext_vector_type(8)));
typedef short s16x4 __attribute__((ext_vector_type(4)));
typedef float f32x4 __attribute__((ext_vector_type(4)));
typedef float f32x16 __attribute__((ext_vector_type(16)));
typedef float f32x2 __attribute__((ext_vector_type(2)));
typedef unsigned u32x4 __attribute__((ext_vector_type(4)));
typedef unsigned u32x2 __attribute__((ext_vector_type(2)));
constexpr int NB = 4, S = 2048, D = 2048, NT = NB * S;
constexpr float ALPHA = 1.681792830507429f;
constexpr float LOG2E = 1.4426950408889634f;
__device__ __forceinline__ int fk_tid();
__device__ __forceinline__ int fk_bid();
__device__ __forceinline__ int fk_nblk();
constexpr int BM = 256, BK = 64, HALF = 128, HTB = HALF * BK * 2, STAGE_BYTES = 8 * HTB;

__device__ __forceinline__ unsigned cvt_pk_bf16(float lo, float hi) { unsigned r; asm volatile("v_cvt_pk_bf16_f32 %0, %1, %2" : "=v"(r) : "v"(lo), "v"(hi)); return r; }
__device__ __forceinline__ float bf2f(bf16_t b) { return __uint_as_float(((unsigned)b) << 16); }
__device__ __forceinline__ bf16_t f2bf(float f) { unsigned u = __float_as_uint(f); u += 0x7FFFu + ((u >> 16) & 1u); return (bf16_t)(u >> 16); }

__host__ __device__ __forceinline__ int lds_byte(int r, int c) { const int st = (r >> 4) * 2 + (c >> 5), rr = r & 15, cc = c & 31, ob = rr * 64 + cc * 2; return st * 1024 + (ob ^ (((ob >> 9) & 1) << 5)); }
__host__ __device__ __forceinline__ void stage_rc(int b, int& R, int& C) { const int st = b / 1024, sb = b % 1024, swz = sb ^ (((sb >> 9) & 1) << 5); R = (st >> 1) * 16 + swz / 64; C = (st & 1) * 32 + (swz % 64) / 2; }
__host__ __device__ __forceinline__ int perm32(int rho) { const int n = rho >> 4, i = rho & 15; return 8 * (i >> 2) + 4 * n + (i & 3); }

struct GUnit { const char* A; const char* B; int pm, pn, e, nrows; };

template <class Epi, class Sched>
__device__ __forceinline__ void gemm_phase(FK_LAS unsigned char* lds, const int K, const int ldb, const Sched& S, const Epi& E) {
    const int tid = fk_tid(), wid = __builtin_amdgcn_readfirstlane(tid >> 6), lane = tid & 63, wr = wid >> 2, wc = wid & 3, fr = lane & 15, fq = lane >> 4;
    const int nt = K / BK;
    unsigned voffB[2];
#pragma unroll
    for (int i = 0; i < 2; ++i) { int R_, C_; stage_rc(tid * 16 + i * 8192, R_, C_); const int Rb = Epi::PERM ? ((R_ & ~31) + perm32(R_ & 31)) : R_; voffB[i] = (unsigned)(Rb * ldb + C_) * 2u; }
    const size_t kstep = (size_t)(BK * 2);
    const size_t hstepB = (size_t)HALF * ldb * 2;
    const unsigned ldsw = (unsigned)wid * 1024u;
    const int aoff = lds_byte(wr * 64 + fr, fq * 8), boff = lds_byte(wc * 32 + fr, fq * 8);
#define PG8_SA(b, h) (((b) * 2 + (h)) * HTB)
#define PG8_SB(b, h) ((4 + (b) * 2 + (h)) * HTB)
#define PG8_STAGE2(bufoff, gbase, v0, v1) do { \
        __builtin_amdgcn_global_load_lds((const unsigned*)((const char*)(gbase) + (v0)), (FK_LAS unsigned*)(lds + (bufoff) + ldsw), 16, 0, 0); \
        __builtin_amdgcn_global_load_lds((const unsigned*)((const char*)(gbase) + (v1)), (FK_LAS unsigned*)(lds + (bufoff) + ldsw + 8192), 16, 0, 0); } while (0)
#define PG8_STAGEB(bufoff, gbase) PG8_STAGE2(bufoff, gbase, voffB[0], voffB[1])
#define PG8_LDA(dst, b, h) do { _Pragma("unroll") for (int m = 0; m < 4; ++m) _Pragma("unroll") for (int k = 0; k < 2; ++k) dst[m][k] = *(const FK_LAS bf16x8*)(lds + PG8_SA(b, h) + aoff + m * 2048 + k * 1024); } while (0)
#define PG8_LDB(dst, b, h) do { _Pragma("unroll") for (int n = 0; n < 2; ++n) _Pragma("unroll") for (int k = 0; k < 2; ++k) dst[n][k] = *(const FK_LAS bf16x8*)(lds + PG8_SB(b, h) + boff + n * 2048 + k * 1024); } while (0)
#define PG8_MMA(ai, bj, At, Bt) do { __builtin_amdgcn_s_setprio(1); _Pragma("unroll") for (int m = 0; m < 4; ++m) _Pragma("unroll") for (int n = 0; n < 2; ++n) _Pragma("unroll") for (int k = 0; k < 2; ++k) \
        acc[ai][bj][m][n] = __builtin_amdgcn_mfma_f32_16x16x32_bf16(Bt[n][k], At[m][k], acc[ai][bj][m][n], 0, 0, 0); __builtin_amdgcn_s_setprio(0); } while (0)
#define PG8_WAIT_V(n) asm volatile("s_waitcnt vmcnt(" #n ")" ::: "memory")
#define PG8_WAIT_L(n) asm volatile("s_waitcnt lgkmcnt(" #n ")" ::: "memory")
#define PG8_BAR __builtin_amdgcn_s_barrier()
#define PG8_SCHED __builtin_amdgcn_sched_barrier(0)
    GUnit cur, nxt; int ui = 0;
    if (!S.next(0, cur)) return;
    f32x4 acc[2][2][4][2];
#pragma unroll
    for (int a = 0; a < 2; ++a)
#pragma unroll
        for (int b = 0; b < 2; ++b)
#pragma unroll
            for (int m = 0; m < 4; ++m)
#pragma unroll
                for (int n = 0; n < 2; ++n) acc[a][b][m][n] = (f32x4){0.f, 0.f, 0.f, 0.f};
    bf16x8 At[4][2], B0[2][2], B1[2][2];
    unsigned oc[2][2], on[2][2];
    S.a_offs(cur, tid, oc);
    const char* cA = cur.A; const char* cB = cur.B;
    PG8_STAGEB(PG8_SB(0, 0), cB); PG8_STAGE2(PG8_SA(0, 0), cA, oc[0][0], oc[0][1]); PG8_STAGEB(PG8_SB(0, 1), cB + hstepB); PG8_STAGE2(PG8_SA(0, 1), cA, oc[1][0], oc[1][1]);
    if (wr == 1) PG8_BAR;
    PG8_WAIT_V(4); PG8_BAR;
    PG8_STAGEB(PG8_SB(1, 0), cB + kstep); PG8_STAGE2(PG8_SA(1, 0), cA + kstep, oc[0][0], oc[0][1]); PG8_STAGEB(PG8_SB(1, 1), cB + hstepB + kstep);
    PG8_WAIT_V(6); PG8_BAR;
    for (;;) {
        const bool has_next = S.next(ui + 1, nxt);
        if (has_next) S.a_offs(nxt, tid, on);
        else {
#pragma unroll
            for (int h = 0; h < 2; ++h)
#pragma unroll
                for (int i = 0; i < 2; ++i) on[h][i] = oc[h][i]; }
        const char* nA = has_next ? nxt.A : cA; const char* nB = has_next ? nxt.B : cB;
        for (int t = 0; t < nt; t += 2) {
            const bool last = (t == nt - 2);
            const char* a1 = cA + (size_t)(t + 1) * kstep;
            const char* a2 = last ? nA : cA + (size_t)(t + 2) * kstep; const char* b2 = last ? nB : cB + (size_t)(t + 2) * kstep;
            const char* a3 = a2 + kstep; const char* b3 = b2 + kstep;
            const unsigned o00 = last ? on[0][0] : oc[0][0], o01 = last ? on[0][1] : oc[0][1], o10 = last ? on[1][0] : oc[1][0], o11 = last ? on[1][1] : oc[1][1];
            PG8_LDB(B0, 0, 0); PG8_SCHED; PG8_LDA(At, 0, 0); PG8_STAGE2(PG8_SA(1, 1), a1, oc[1][0], oc[1][1]);
            PG8_WAIT_L(8); PG8_BAR; PG8_WAIT_L(0); PG8_MMA(0, 0, At, B0); PG8_BAR; PG8_SCHED;
            PG8_LDB(B1, 0, 1); PG8_STAGEB(PG8_SB(0, 0), b2);
            PG8_BAR; PG8_WAIT_L(0); PG8_MMA(0, 1, At, B1); PG8_BAR;
            PG8_LDA(At, 0, 1); PG8_STAGE2(PG8_SA(0, 0), a2, o00, o01);
            PG8_BAR; PG8_WAIT_L(0); PG8_MMA(1, 0, At, B0); PG8_BAR; PG8_SCHED;
            PG8_STAGEB(PG8_SB(0, 1), b2 + hstepB);
            PG8_WAIT_V(6); PG8_BAR; PG8_MMA(1, 1, At, B1); PG8_BAR;
            PG8_LDB(B0, 1, 0); PG8_SCHED; PG8_LDA(At, 1, 0); PG8_STAGE2(PG8_SA(0, 1), a2, o10, o11);
            PG8_WAIT_L(8); PG8_BAR; PG8_WAIT_L(0); PG8_MMA(0, 0, At, B0); PG8_BAR; PG8_SCHED;
            PG8_LDB(B1, 1, 1); PG8_STAGEB(PG8_SB(1, 0), b3);
            PG8_BAR; PG8_WAIT_L(0); PG8_MMA(0, 1, At, B1); PG8_BAR;
            PG8_LDA(At, 1, 1); PG8_STAGE2(PG8_SA(1, 0), a3, o00, o01);
            PG8_BAR; PG8_WAIT_L(0); PG8_MMA(1, 0, At, B0); PG8_BAR; PG8_SCHED;
            PG8_STAGEB(PG8_SB(1, 1), b3 + hstepB);
            PG8_WAIT_V(6); PG8_BAR; PG8_MMA(1, 1, At, B1); PG8_BAR;
        }
        E(acc, cur, wr, wc, fr, fq);
        if (!has_next) break;
#pragma unroll
        for (int a = 0; a < 2; ++a)
#pragma unroll
            for (int b = 0; b < 2; ++b)
#pragma unroll
                for (int m = 0; m < 4; ++m)
#pragma unroll
                    for (int n = 0; n < 2; ++n) acc[a][b][m][n] = (f32x4){0.f, 0.f, 0.f, 0.f};
        cur = nxt; cA = nA; cB = nB; ++ui;
#pragma unroll
        for (int h = 0; h < 2; ++h)
#pragma unroll
            for (int i = 0; i < 2; ++i) oc[h][i] = on[h][i];
    }
    PG8_WAIT_V(0);
    if (wr == 0) PG8_BAR;
    PG8_BAR;
#undef PG8_SA
#undef PG8_SB
#undef PG8_STAGE2
#undef PG8_STAGEB
#undef PG8_LDA
#undef PG8_LDB
#undef PG8_MMA
#undef PG8_WAIT_V
#undef PG8_WAIT_L
#undef PG8_BAR
#undef PG8_SCHED
}
}
namespace fk {
constexpr int NTHR = 512;
constexpr int LDS_BYTES = 147456;
constexpr int HCAP = 24576;
constexpr float QSCALE_MLA = 0.07216878364870322f * LOG2E;
constexpr float QSCALE_128 = 0.08838834764831845f * LOG2E;

struct FW {
    const float *x_in, *t5, *mla_w_in, *mla_qn, *mla_kvn, *mla_wq, *mla_wkv, *mla_wo, *fox_w_in, *fox_bf, *fox_wo, *dsa_w_in, *dsa_wo, *ln_g, *ln_b, *wgrp, *bgrp, *wrt, *brt, *wgate, *wup, *wdown;
    float* out;
    unsigned* bar; int* moe_cnt;
    bf16_t *mla_win_t, *mla_wq_t, *mla_wkv_t, *mla_wo_t, *fox_win_t, *fox_wo_t, *dsa_win_t, *dsa_wo_t, *moe_gu_t, *moe_d_t;
    float *wr4, *fox_wf4; f32x2* rope_cs;
    float *xA, *xB, *y; bf16_t *xb0, *xb1, *o;
    char* arena;
    float* ss;
    float *flog, *cf2;
    int *te, *tpos, *list; float *tw, *sw; bf16_t *H, *Y2; unsigned char* x1q;
};

struct FWK { const float *x_in, *t5, *mla_w_in, *mla_qn, *mla_kvn, *mla_wq, *mla_wkv, *mla_wo, *fox_w_in, *fox_bf, *fox_wo, *dsa_w_in, *dsa_wo, *ln_g, *ln_b, *wgrp, *bgrp, *wrt, *brt, *wgate, *wup, *wdown; float* out; char* ws; long moe_bias_gu, moe_bias_d; long var; };
constexpr size_t al256(size_t x) { return (x + 255) & ~(size_t)255; }
template <int MOE_LAYERS> struct WsMap {
    static constexpr size_t CTL = 0, CTL_BYTES = 65536;
    static constexpr size_t MLA_WIN_T = CTL + CTL_BYTES, MLA_WQ_T = MLA_WIN_T + al256((size_t)2 * 1280 * D * 2), MLA_WKV_T = MLA_WQ_T + al256((size_t)2 * 3072 * 512 * 2), MLA_WO_T = MLA_WKV_T + al256((size_t)2 * 4096 * 512 * 2);
    static constexpr size_t FOX_WIN_T = MLA_WO_T + al256((size_t)2 * D * D * 2), FOX_WO_T = FOX_WIN_T + al256((size_t)6144 * D * 2), DSA_WIN_T = FOX_WO_T + al256((size_t)D * D * 2), DSA_WO_T = DSA_WIN_T + al256((size_t)3584 * D * 2);
    static constexpr size_t MOE_GU_T = DSA_WO_T + al256((size_t)D * D * 2), MOE_D_T = MOE_GU_T + al256((size_t)MOE_LAYERS * 32 * 1024 * D * 2);
    static constexpr size_t WR4 = MOE_D_T + al256((size_t)MOE_LAYERS * 32 * D * 512 * 2), FOX_WF4 = WR4 + al256((size_t)4 * D * 48 * 4), ROPE = FOX_WF4 + al256((size_t)D * 16 * 4);
    static constexpr size_t XA = ROPE + al256((size_t)S * 32 * 8), XB = XA + al256((size_t)NT * D * 4), Y = XB + al256((size_t)NT * D * 4);
    static constexpr size_t XB0 = Y + al256((size_t)NT * D * 4), XB1 = XB0 + al256((size_t)NT * D * 2), O = XB1 + al256((size_t)NT * D * 2), ARENA = O + al256((size_t)NT * D * 2);
    static constexpr size_t SS = ARENA + al256((size_t)NT * (512 + 512 + 64 + 3072 + 4096) * 2), FLOG = SS + al256((size_t)NT * 2 * 8 * 4), CF2 = FLOG + al256((size_t)NT * 16 * 4);
    static constexpr size_t TE = CF2 + al256((size_t)NB * 16 * S * 4), TPOS = TE + al256((size_t)NT * 2 * 4), LIST = TPOS + al256((size_t)NT * 2 * 4), TW = LIST + al256((size_t)32 * NT * 4), SW = TW + al256((size_t)NT * 2 * 4);
    static constexpr size_t H = SW + al256((size_t)32 * NT * 4), Y2 = H + al256((size_t)HCAP * 512 * 2), X1Q = Y2 + al256((size_t)HCAP * D * 2), END = X1Q + al256((size_t)NT * D);
};
template <int ML> __host__ __device__ __forceinline__ FW make_fw(const FWK& k, char* ws) {
    typedef WsMap<ML> M; FW w;
    w.x_in = k.x_in; w.t5 = k.t5; w.mla_w_in = k.mla_w_in; w.mla_qn = k.mla_qn; w.mla_kvn = k.mla_kvn; w.mla_wq = k.mla_wq; w.mla_wkv = k.mla_wkv; w.mla_wo = k.mla_wo; w.fox_w_in = k.fox_w_in; w.fox_bf = k.fox_bf; w.fox_wo = k.fox_wo;
    w.dsa_w_in = k.dsa_w_in; w.dsa_wo = k.dsa_wo; w.ln_g = k.ln_g; w.ln_b = k.ln_b; w.wgrp = k.wgrp; w.bgrp = k.bgrp; w.wrt = k.wrt; w.brt = k.brt; w.wgate = k.wgate; w.wup = k.wup; w.wdown = k.wdown; w.out = k.out;
    w.bar = (unsigned*)(ws + M::CTL); w.moe_cnt = (int*)(ws + M::CTL + 32768);
    w.mla_win_t = (bf16_t*)(ws + M::MLA_WIN_T); w.mla_wq_t = (bf16_t*)(ws + M::MLA_WQ_T); w.mla_wkv_t = (bf16_t*)(ws + M::MLA_WKV_T); w.mla_wo_t = (bf16_t*)(ws + M::MLA_WO_T);
    w.fox_win_t = (bf16_t*)(ws + M::FOX_WIN_T); w.fox_wo_t = (bf16_t*)(ws + M::FOX_WO_T); w.dsa_win_t = (bf16_t*)(ws + M::DSA_WIN_T); w.dsa_wo_t = (bf16_t*)(ws + M::DSA_WO_T);
    w.moe_gu_t = (bf16_t*)(ws + M::MOE_GU_T) - k.moe_bias_gu; w.moe_d_t = (bf16_t*)(ws + M::MOE_D_T) - k.moe_bias_d;
    w.wr4 = (float*)(ws + M::WR4); w.fox_wf4 = (float*)(ws + M::FOX_WF4); w.rope_cs = (f32x2*)(ws + M::ROPE);
    w.xA = (float*)(ws + M::XA); w.xB = (float*)(ws + M::XB); w.y = (float*)(ws + M::Y); w.xb0 = (bf16_t*)(ws + M::XB0); w.xb1 = (bf16_t*)(ws + M::XB1); w.o = (bf16_t*)(ws + M::O); w.arena = ws + M::ARENA;
    w.ss = (float*)(ws + M::SS); w.flog = (float*)(ws + M::FLOG); w.cf2 = (float*)(ws + M::CF2);
    w.te = (int*)(ws + M::TE); w.tpos = (int*)(ws + M::TPOS); w.list = (int*)(ws + M::LIST); w.tw = (float*)(ws + M::TW); w.sw = (float*)(ws + M::SW); w.H = (bf16_t*)(ws + M::H); w.Y2 = (bf16_t*)(ws + M::Y2); w.x1q = (unsigned char*)(ws + M::X1Q);
    return w;
}
__device__ __forceinline__ int fk_tid() { int t = threadIdx.x; asm volatile("" : "+v"(t)); return t; }
__device__ __forceinline__ int fk_bid() { int t = blockIdx.x; asm volatile("" : "+s"(t)); return t; }
__device__ __forceinline__ int fk_nblk() { int t = gridDim.x; asm volatile("" : "+s"(t)); return t; }

enum { MAP_ID = 0, MAP_MLA_IN = 1, MAP_MLA_Q = 2, MAP_MOE_GU = 3 };
struct CvtJob { const float* src0; const float* src1; const float* scale; bf16_t* dst; long src_bstride, dst_bstride; int K, N, Np, map, nbatch, tile0, wide, pad; };
constexpr int MAXJOBS = 24;
struct CvtTable { CvtJob j[MAXJOBS]; int njobs, ntiles, misc, pad; };

__device__ __forceinline__ int map_col(int map, int np, int N, int& which) {
    which = 0;
    if (map == MAP_ID) return np < N ? np : -1;
    if (map == MAP_MLA_IN) { if (np < 1024) return np; if (np < 1088) { const int i = np - 1024; return 1024 + (i >> 1) + 32 * (i & 1); } return -1; }
    if (map == MAP_MLA_Q) { const int h = np / 192, j = np % 192; if (j < 128) return np; const int i = j - 128; return h * 192 + 128 + (i >> 1) + 32 * (i & 1); }
      { const int q = np >> 5, r = np & 31; which = r >> 4; return 16 * q + (r & 15); }
}
__device__ __forceinline__ void cvt_tile(const CvtJob& J, int lt, FK_LAS float* tile  , const int tid) {
    const int tk = J.K / 64, tn = J.Np / 64, per = tk * tn;
    const int b = lt / per, r = lt % per, tkk = r % tk, tnn = r / tk;
    const int k0 = tkk * 64, n0 = tnn * 64;
    const float* s0 = J.src0 + (size_t)b * J.src_bstride; const float* s1 = J.src1 ? J.src1 + (size_t)b * J.src_bstride : nullptr;
    bf16_t* d = J.dst + (size_t)b * J.dst_bstride;
    { const int np = n0 + (tid & 63); int which; const int sc = map_col(J.map, np, J.N, which); const float* s = which ? s1 : s0;
#pragma unroll
      for (int i = 0; i < 8; ++i) { const int k = (tid >> 6) + 8 * i; float v = 0.f; if (sc >= 0) { v = s[(size_t)(k0 + k) * J.N + sc]; if (J.scale) v *= J.scale[k0 + k]; } tile[k * 65 + (tid & 63)] = v; } }
    __syncthreads();
    { const int np = tid >> 3, kg = (tid & 7) * 8; float v[8];
#pragma unroll
      for (int j = 0; j < 8; ++j) v[j] = tile[(kg + j) * 65 + np];
      u32x4 w; w.x = cvt_pk_bf16(v[0], v[1]); w.y = cvt_pk_bf16(v[2], v[3]); w.z = cvt_pk_bf16(v[4], v[5]); w.w = cvt_pk_bf16(v[6], v[7]);
      *(u32x4*)(d + (size_t)(n0 + np) * J.K + k0 + kg) = w; }
    __syncthreads();
}
__device__ __forceinline__ void cvt_tile_wide(const CvtJob& J, int lt, FK_LAS unsigned char* img, const int tid) {
    const int wid = tid >> 6, lane = tid & 63;
    const int tk = J.K / 128, tn = J.Np / 256, per = tk * tn;
    const int b = lt / per, r = lt % per, tkk = r % tk, tnn = r / tk;
    const int k0 = tkk * 128, n0 = tnn * 256;
    const float* s0 = J.src0 + (size_t)b * J.src_bstride; const float* s1 = J.src1 ? J.src1 + (size_t)b * J.src_bstride : nullptr;
    bf16_t* d = J.dst + (size_t)b * J.dst_bstride;
    const int np = n0 + 4 * lane; int which; const int sc = map_col(J.map, np, J.N, which); const float* s = which ? s1 : s0;
    const bool ok = sc >= 0 && sc + 3 < J.N;
    f32x4 v[16];
#pragma unroll
    for (int i = 0; i < 16; ++i) { const int k = k0 + wid * 16 + i; v[i] = ok ? *(const f32x4*)(s + (size_t)k * J.N + sc) : (f32x4){0.f, 0.f, 0.f, 0.f}; if (J.scale) v[i] = v[i] * J.scale[k]; }
#pragma unroll
    for (int j = 0; j < 4; ++j) { const int n = 4 * lane + j;
#pragma unroll
        for (int h = 0; h < 2; ++h) { u32x4 w; w.x = cvt_pk_bf16(v[8 * h + 0][j], v[8 * h + 1][j]); w.y = cvt_pk_bf16(v[8 * h + 2][j], v[8 * h + 3][j]); w.z = cvt_pk_bf16(v[8 * h + 4][j], v[8 * h + 5][j]); w.w = cvt_pk_bf16(v[8 * h + 6][j], v[8 * h + 7][j]);
            const int c = wid * 2 + h; *(FK_LAS u32x4*)(img + n * 256 + ((c ^ (n & 15)) << 4)) = w; } }
    __syncthreads();
#pragma unroll
    for (int i = 0; i < 8; ++i) { const int idx = tid + 512 * i, n = idx >> 4, c = idx & 15; const u32x4 w = *(FK_LAS const u32x4*)(img + n * 256 + ((c ^ (n & 15)) << 4));
        *(u32x4*)(d + (size_t)(n0 + n) * J.K + k0 + c * 8) = w; }
    __syncthreads();
}
__device__ __forceinline__ void phase_prologue(const FW& w, const CvtTable& T, FK_LAS unsigned char* lds) {
    FK_LAS float* tile = (FK_LAS float*)lds; const int tid0 = fk_tid();
    for (int t = fk_bid(); t < T.ntiles; t += fk_nblk()) {
        int ji = 0;
#pragma unroll 1
        for (int q = 1; q < T.njobs; ++q) if (t >= T.j[q].tile0) ji = q;
        if (T.j[ji].wide) cvt_tile_wide(T.j[ji], t - T.j[ji].tile0, lds, tid0); else cvt_tile(T.j[ji], t - T.j[ji].tile0, tile, tid0);
    }
    if (!T.misc) return;
    const int gt = fk_bid() * NTHR + tid0, gn = fk_nblk() * NTHR;
    for (int i = gt; i < S * 32; i += gn) { const int pos = i >> 5, j = i & 31; const float invf = powf(10000.f, -(float)j / 32.f); const float ang = (float)pos * invf; w.rope_cs[i] = (f32x2){cosf(ang), sinf(ang)}; }
    for (int i = gt; i < 4 * 128 * 3 * 64 * 4; i += gn) { const int ii = i & 3, lane = (i >> 2) & 63, q = i >> 8, nt = q % 3, kg = (q / 3) & 127, layer = q / (3 * 128); const int k = 16 * kg + 4 * (lane >> 4) + ii, n = 16 * nt + (lane & 15);
        float v = 0.f; if (n < 4) v = w.wgrp[((size_t)layer * D + k) * 4 + n]; else if (n < 36) v = w.wrt[((size_t)layer * D + k) * 32 + (n - 4)]; w.wr4[i] = v; }
    for (int i = gt; i < 128 * 64 * 4; i += gn) { const int ii = i & 3, lane = (i >> 2) & 63, kg = i >> 8; const int k = 16 * kg + 4 * (lane >> 4) + ii; w.fox_wf4[i] = w.fox_w_in[(size_t)k * 6160 + 6144 + (lane & 15)]; }
    for (int i = gt; i < NT * D / 4; i += gn) { const f32x4 v = ((const f32x4*)w.x_in)[i]; u32x2 p; p.x = cvt_pk_bf16(v[0], v[1]); p.y = cvt_pk_bf16(v[2], v[3]); ((u32x2*)w.xb0)[i] = p; }
}

struct RectSched {
    const char* A; const char* B; int lda, ldb, nM, nN, nwg, G, c;
    __device__ void init(const bf16_t* A_, int lda_, const bf16_t* B_, int ldb_, int M, int N) { A = (const char*)A_; B = (const char*)B_; lda = lda_; ldb = ldb_; nM = M / BM; nN = N / BM; nwg = nM * nN; G = fk_nblk(); c = fk_bid(); }
    __device__ __forceinline__ bool tile(int i, int& pm, int& pn) const {
        const long L = (long)i * G + c; if (L >= nwg) return false;
        int wgid = (int)L; { const int q = nwg / 8, r = nwg % 8, xcd = wgid % 8, off = wgid / 8; wgid = (xcd < r ? xcd * (q + 1) : r * (q + 1) + (xcd - r) * q) + off; }
        const int nig = 8 * nN, gid = wgid / nig, fm = gid * 8, gsz = (nM - fm) < 8 ? (nM - fm) : 8;
        pm = fm + ((wgid % nig) % gsz); pn = (wgid % nig) / gsz; return true;
    }
    __device__ __forceinline__ bool next(int i, GUnit& u) const { int pm, pn; if (!tile(i, pm, pn)) return false; u.pm = pm; u.pn = pn; u.e = 0; u.nrows = BM; u.A = A + (size_t)pm * BM * lda * 2; u.B = B + (size_t)pn * BM * ldb * 2; return true; }
    __device__ __forceinline__ void a_offs(const GUnit&, int tid, unsigned (&o)[2][2]) const { int R0, C0, R1, C1; stage_rc(tid * 16, R0, C0); stage_rc(tid * 16 + 8192, R1, C1);
        o[0][0] = (unsigned)(R0 * lda + C0) * 2u; o[0][1] = (unsigned)(R1 * lda + C1) * 2u; o[1][0] = o[0][0] + (unsigned)(HALF * lda * 2); o[1][1] = o[0][1] + (unsigned)(HALF * lda * 2); }
};
struct Rect2Sched {
    RectSched s0, s1; int n0;
    __device__ __forceinline__ bool next(int i, GUnit& u) const {
        const long L = (long)i * s0.G + s0.c; const int tot = s0.nwg + s1.nwg; if (L >= tot) return false;
        if (L < s0.nwg) { const int pm = (int)L % s0.nM, pn = (int)L / s0.nM; u.pm = pm; u.pn = pn; u.e = 0; u.nrows = BM; u.A = s0.A + (size_t)pm * BM * s0.lda * 2; u.B = s0.B + (size_t)pn * BM * s0.ldb * 2; }
        else { const int l = (int)L - s0.nwg; const int pm = l % s1.nM, pn = l / s1.nM; u.pm = pm; u.pn = pn; u.e = 1; u.nrows = BM; u.A = s1.A + (size_t)pm * BM * s1.lda * 2; u.B = s1.B + (size_t)pn * BM * s1.ldb * 2; }
        return true; }
    __device__ __forceinline__ void a_offs(const GUnit& u, int tid, unsigned (&o)[2][2]) const { s0.a_offs(u, tid, o); }
};

struct EpiF32 {
    static constexpr bool PERM = false;
    float* Cp; int ldc;
    __device__ __forceinline__ void operator()(const f32x4 (&acc)[2][2][4][2], const GUnit& u, int wr, int wc, int fr, int fq) const {
        const int row0 = u.pm * BM + wr * 64 + fr, col0 = u.pn * BM + wc * 32 + 4 * fq;
#pragma unroll
        for (int ai = 0; ai < 2; ++ai)
#pragma unroll
            for (int m = 0; m < 4; ++m) { float* rowp = Cp + (size_t)(row0 + ai * HALF + m * 16) * ldc + col0;
#pragma unroll
                for (int bj = 0; bj < 2; ++bj)
#pragma unroll
                    for (int n = 0; n < 2; ++n) *(f32x4*)(rowp + bj * HALF + n * 16) = acc[ai][bj][m][n]; }
    }
};
__device__ __forceinline__ u32x4 pack8(const f32x4& a, const f32x4& b) { u32x4 w; w.x = cvt_pk_bf16(a[0], a[1]); w.y = cvt_pk_bf16(a[2], a[3]); w.z = cvt_pk_bf16(b[0], b[1]); w.w = cvt_pk_bf16(b[2], b[3]); return w; }
__device__ __forceinline__ void rope8(f32x4& v0, f32x4& v1, const f32x2* cs) {
    const f32x4 c01 = *(const f32x4*)cs, c23 = *(const f32x4*)(cs + 2);
    f32x4 r0, r1;
    r0[0] = v0[0] * c01[0] - v0[1] * c01[1]; r0[1] = v0[1] * c01[0] + v0[0] * c01[1]; r0[2] = v0[2] * c01[2] - v0[3] * c01[3]; r0[3] = v0[3] * c01[2] + v0[2] * c01[3];
    r1[0] = v1[0] * c23[0] - v1[1] * c23[1]; r1[1] = v1[1] * c23[0] + v1[0] * c23[1]; r1[2] = v1[2] * c23[2] - v1[3] * c23[3]; r1[3] = v1[3] * c23[2] + v1[2] * c23[3];
    v0 = r0; v1 = r1;
}
struct EpiMlaIn {
    static constexpr bool PERM = true;
    bf16_t *cq, *ckv, *kr; float* ss; const f32x2* cs;
    __device__ __forceinline__ void operator()(const f32x4 (&acc)[2][2][4][2], const GUnit& u, int wr, int wc, int fr, int fq) const {
        const int row0 = u.pm * BM + wr * 64 + fr;
        if (u.pn < 4) {
            bf16_t* dst = (u.pn < 2) ? cq : ckv; const int which = u.pn >> 1; const int col0 = (u.pn & 1) * BM + wc * 32 + 8 * fq;
#pragma unroll
            for (int ai = 0; ai < 2; ++ai)
#pragma unroll
                for (int m = 0; m < 4; ++m) { const int row = row0 + ai * HALF + m * 16; float q = 0.f;
#pragma unroll
                    for (int bj = 0; bj < 2; ++bj) { const f32x4 v0 = acc[ai][bj][m][0], v1 = acc[ai][bj][m][1];
                        q += (v0[0] * v0[0] + v0[1] * v0[1]) + (v0[2] * v0[2] + v0[3] * v0[3]) + (v1[0] * v1[0] + v1[1] * v1[1]) + (v1[2] * v1[2] + v1[3] * v1[3]);
                        *(u32x4*)(dst + (size_t)row * 512 + col0 + bj * HALF) = pack8(v0, v1); }
                    q += __shfl_xor(q, 16); q += __shfl_xor(q, 32);
                    if (fq == 0) ss[((size_t)row * 2 + which) * 8 + (u.pn & 1) * 4 + wc] = q; }
        } else if (wc < 2) {
#pragma unroll
            for (int ai = 0; ai < 2; ++ai) { f32x4 c01[4], c23[4];
#pragma unroll
                for (int m = 0; m < 4; ++m) { const int row = row0 + ai * HALF + m * 16; const f32x2* cp = cs + (size_t)(row & (S - 1)) * 32 + 16 * wc + 4 * fq; c01[m] = *(const f32x4*)cp; c23[m] = *(const f32x4*)(cp + 2); }
#pragma unroll
                for (int m = 0; m < 4; ++m) { const int row = row0 + ai * HALF + m * 16; const f32x4 v0 = acc[ai][0][m][0], v1 = acc[ai][0][m][1]; const f32x4 a = c01[m], b = c23[m]; f32x4 r0, r1;
                    r0[0] = v0[0] * a[0] - v0[1] * a[1]; r0[1] = v0[1] * a[0] + v0[0] * a[1]; r0[2] = v0[2] * a[2] - v0[3] * a[3]; r0[3] = v0[3] * a[2] + v0[2] * a[3];
                    r1[0] = v1[0] * b[0] - v1[1] * b[1]; r1[1] = v1[1] * b[0] + v1[0] * b[1]; r1[2] = v1[2] * b[2] - v1[3] * b[3]; r1[3] = v1[3] * b[2] + v1[2] * b[3];
                    *(u32x4*)(kr + (size_t)row * 64 + wc * 32 + 8 * fq) = pack8(r0, r1); } }
        }
    }
};
struct EpiMlaQKV {
    static constexpr bool PERM = true;
    bf16_t *q, *kv; const float* ss; const f32x2* cs;
    __device__ __forceinline__ void operator()(const f32x4 (&acc)[2][2][4][2], const GUnit& u, int wr, int wc, int fr, int fq) const {
        const int row0 = u.pm * BM + wr * 64 + fr;
#pragma unroll
        for (int ai = 0; ai < 2; ++ai) {
            float rs[4];
            { f32x4 sa[4], sb[4];
#pragma unroll
              for (int m = 0; m < 4; ++m) { const int row = row0 + ai * HALF + m * 16; sa[m] = *(const f32x4*)(ss + ((size_t)row * 2 + u.e) * 8); sb[m] = *(const f32x4*)(ss + ((size_t)row * 2 + u.e) * 8 + 4); }
#pragma unroll
              for (int m = 0; m < 4; ++m) rs[m] = rsqrtf((((sa[m][0] + sa[m][1]) + (sa[m][2] + sa[m][3])) + ((sb[m][0] + sb[m][1]) + (sb[m][2] + sb[m][3]))) * (1.0f / 512.0f) + 1e-6f); }
#pragma unroll
            for (int bj = 0; bj < 2; ++bj) { const int gc = u.pn * BM + bj * HALF + wc * 32 + 8 * fq; const int j = gc % 192; const bool rope = __builtin_amdgcn_readfirstlane((int)((u.e == 0) && (j >= 128))) != 0;
                f32x4 c01[4], c23[4];
                if (rope) {
#pragma unroll
                    for (int m = 0; m < 4; ++m) { const int row = row0 + ai * HALF + m * 16; const f32x2* cp = cs + (size_t)(row & (S - 1)) * 32 + ((j - 128) >> 1); c01[m] = *(const f32x4*)cp; c23[m] = *(const f32x4*)(cp + 2); } }
#pragma unroll
                for (int m = 0; m < 4; ++m) { const int row = row0 + ai * HALF + m * 16; f32x4 v0 = acc[ai][bj][m][0] * rs[m], v1 = acc[ai][bj][m][1] * rs[m];
                    if (u.e == 0) {
                        if (rope) { f32x4 r0, r1; const f32x4 a = c01[m], b = c23[m];
                            r0[0] = v0[0] * a[0] - v0[1] * a[1]; r0[1] = v0[1] * a[0] + v0[0] * a[1]; r0[2] = v0[2] * a[2] - v0[3] * a[3]; r0[3] = v0[3] * a[2] + v0[2] * a[3];
                            r1[0] = v1[0] * b[0] - v1[1] * b[1]; r1[1] = v1[1] * b[0] + v1[0] * b[1]; r1[2] = v1[2] * b[2] - v1[3] * b[3]; r1[3] = v1[3] * b[2] + v1[2] * b[3]; v0 = r0; v1 = r1; }
                        v0 = v0 * QSCALE_MLA; v1 = v1 * QSCALE_MLA; *(u32x4*)(q + (size_t)row * 3072 + gc) = pack8(v0, v1); }
                    else *(u32x4*)(kv + (size_t)row * 4096 + gc) = pack8(v0, v1); } }
        }
    }
};
}
namespace fk {
#define FK_KSWZ(row, colB) ((row) * 256 + ((colB) ^ (((row) & 7) << 4)))
#define FK_KRSWZ(row, ch) ((row) * 128 + ((((ch)) ^ (((row) >> 1) & 7)) << 4))
__device__ __forceinline__ int v_st(int k, int c) { const int kk = (k & ~0xC) | ((k & 4) << 1) | ((k & 8) >> 1); return ((kk >> 3) * 4 + (c >> 5)) * 512 + ((kk & 7) * 32 + (c & 31)) * 2; }
__device__ __forceinline__ int v_rd_base(int lane) { return ((lane & 3) << 3) | (((lane >> 2) & 3) << 6) | (((lane >> 4) & 1) << 5) | (((lane >> 5) & 1) << 8); }
__device__ __forceinline__ int crow(int r, int hi) { return (r & 3) + 8 * (r >> 2) + 4 * hi; }

constexpr int AT_K = 0, AT_V = 32768, AT_KR = 65536, AT_CF = 81920, AT_WS = 90112;

struct AttnPtrs { const bf16_t* Q; const bf16_t* K; const bf16_t* V; const bf16_t* KR; const float* CF; bf16_t* O; int qld, kld; };

template <int MODE>
__device__ __forceinline__ void attn_block(FK_LAS unsigned char* lds, const AttnPtrs P, const int qb, const int var = 0) {
    constexpr int NQ = MODE == 0 ? 12 : 8;
    const int tid = fk_tid(), wid = __builtin_amdgcn_readfirstlane(tid >> 6), lane = tid & 63, r32 = lane & 31, hi = lane >> 5;
    const int q0w = qb * 256 + wid * 32;
    const int nt = 4 * (qb + 1);
    bf16x8 qr[NQ];
    { const bf16_t* qrow = P.Q + (size_t)(q0w + r32) * P.qld;
#pragma unroll
      for (int d0 = 0; d0 < NQ; ++d0) qr[d0] = *(const bf16x8*)(qrow + d0 * 16 + hi * 8); }
    float ct2 = 0.f; if (MODE == 1) ct2 = ((FK_LAS const float*)(lds + AT_CF))[q0w + r32];
    const int sr = tid >> 4, sc = (tid & 15) * 8;
    const int kws = FK_KSWZ(sr, sc * 2), vst0 = v_st(sr, sc), vst1 = v_st(32 + sr, sc);
    const int krr = tid >> 3, krc = tid & 7, krw = FK_KRSWZ(krr, krc);
    const int vb0 = AT_V + v_rd_base(lane);
    FK_LAS float* wsl = (FK_LAS float*)(lds + AT_WS) + wid * 64;
    bf16x8 sk0, sk1, sv0, sv1, skr;
    float m_reg = -1e30f, l_reg = 0.f; f32x16 o[4];
#pragma unroll
    for (int d = 0; d < 4; ++d)
#pragma unroll
        for (int r = 0; r < 16; ++r) o[d][r] = 0.f;
#define AT_LOAD(j) do { const size_t k0_ = (size_t)(j) * 64; \
        sk0 = *(const bf16x8*)(P.K + (k0_ + sr) * P.kld + sc); sk1 = *(const bf16x8*)(P.K + (k0_ + 32 + sr) * P.kld + sc); \
        sv0 = *(const bf16x8*)(P.V + (k0_ + sr) * P.kld + sc); sv1 = *(const bf16x8*)(P.V + (k0_ + 32 + sr) * P.kld + sc); \
        if (MODE == 0) skr = *(const bf16x8*)(P.KR + (k0_ + krr) * 64 + krc * 8); \
        } while (0)
#define AT_WRITE(bf) do { *(FK_LAS bf16x8*)(lds + AT_K + (bf) * 16384 + kws) = sk0; *(FK_LAS bf16x8*)(lds + AT_K + (bf) * 16384 + kws + 32 * 256) = sk1; \
        *(FK_LAS bf16x8*)(lds + AT_V + (bf) * 16384 + vst0) = sv0; *(FK_LAS bf16x8*)(lds + AT_V + (bf) * 16384 + vst1) = sv1; \
        if (MODE == 0) *(FK_LAS bf16x8*)(lds + AT_KR + (bf) * 8192 + krw) = skr; \
        } while (0)
#define AT_TRRD(dst, off) asm volatile("ds_read_b64_tr_b16 %0, %1 offset:%2" : "=&v"(dst) : "v"(vb0), "i"(off) : "memory")
#define AT_PV_D0(KB, d0) do { s16x4 l0, l1, l2, l3, h0, h1, h2, h3; constexpr int b_ = (KB) * 16384 + (d0) * 512; \
        AT_TRRD(l0, b_); AT_TRRD(h0, b_ + 2048); AT_TRRD(l1, b_ + 4096); AT_TRRD(h1, b_ + 6144); AT_TRRD(l2, b_ + 8192); AT_TRRD(h2, b_ + 10240); AT_TRRD(l3, b_ + 12288); AT_TRRD(h3, b_ + 14336); \
        asm volatile("s_waitcnt lgkmcnt(0)" ::: "memory"); __builtin_amdgcn_sched_barrier(0); \
        o[d0] = __builtin_amdgcn_mfma_f32_32x32x16_bf16(pa0, (bf16x8){l0[0], l0[1], l0[2], l0[3], h0[0], h0[1], h0[2], h0[3]}, o[d0], 0, 0, 0); \
        o[d0] = __builtin_amdgcn_mfma_f32_32x32x16_bf16(pa1, (bf16x8){l1[0], l1[1], l1[2], l1[3], h1[0], h1[1], h1[2], h1[3]}, o[d0], 0, 0, 0); \
        o[d0] = __builtin_amdgcn_mfma_f32_32x32x16_bf16(pa2, (bf16x8){l2[0], l2[1], l2[2], l2[3], h2[0], h2[1], h2[2], h2[3]}, o[d0], 0, 0, 0); \
        o[d0] = __builtin_amdgcn_mfma_f32_32x32x16_bf16(pa3, (bf16x8){l3[0], l3[1], l3[2], l3[3], h3[0], h3[1], h3[2], h3[3]}, o[d0], 0, 0, 0); } while (0)
#define AT_PK4(Pv, B_, OUT) do { unsigned a0 = cvt_pk_bf16(Pv[B_ + 0], Pv[B_ + 1]), a1 = cvt_pk_bf16(Pv[B_ + 2], Pv[B_ + 3]); \
        unsigned b0 = cvt_pk_bf16(Pv[B_ + 4], Pv[B_ + 5]), b1 = cvt_pk_bf16(Pv[B_ + 6], Pv[B_ + 7]); \
        auto r0 = __builtin_amdgcn_permlane32_swap(a0, b0, false, false); auto r1 = __builtin_amdgcn_permlane32_swap(a1, b1, false, false); \
        u32x4 w_ = {r0[0], r1[0], r0[1], r1[1]}; OUT = *reinterpret_cast<bf16x8*>(&w_); } while (0)
#define AT_STEP(j, KB) do { \
        if ((j) + 1 < nt && !(var & 512)) AT_LOAD((j) + 1); \
        if ((j) * 64 <= q0w) { \
            f32x16 p0, p1; \
            _Pragma("unroll") for (int r = 0; r < 16; ++r) { p0[r] = 0.f; p1[r] = 0.f; } \
            __builtin_amdgcn_s_setprio(1); \
            if (!(var & 256)) { FK_LAS const unsigned char* kb_ = lds + AT_K + (KB) * 16384; \
              _Pragma("unroll") for (int d0 = 0; d0 < 8; ++d0) { \
                const bf16x8 b0 = *(FK_LAS const bf16x8*)(kb_ + FK_KSWZ(r32, (d0 * 16 + hi * 8) * 2)); \
                const bf16x8 b1 = *(FK_LAS const bf16x8*)(kb_ + FK_KSWZ(r32, (d0 * 16 + hi * 8) * 2) + 32 * 256); \
                p0 = __builtin_amdgcn_mfma_f32_32x32x16_bf16(b0, qr[d0], p0, 0, 0, 0); \
                p1 = __builtin_amdgcn_mfma_f32_32x32x16_bf16(b1, qr[d0], p1, 0, 0, 0); } } \
            if (MODE == 0) { FK_LAS const unsigned char* kr_ = lds + AT_KR + (KB) * 8192; \
              _Pragma("unroll") for (int d0 = 0; d0 < 4; ++d0) { \
                const bf16x8 b0 = *(FK_LAS const bf16x8*)(kr_ + FK_KRSWZ(r32, 2 * d0 + hi)); \
                const bf16x8 b1 = *(FK_LAS const bf16x8*)(kr_ + FK_KRSWZ(r32 + 32, 2 * d0 + hi)); \
                p0 = __builtin_amdgcn_mfma_f32_32x32x16_bf16(b0, qr[(MODE == 0 ? 8 : 0) + d0], p0, 0, 0, 0); \
                p1 = __builtin_amdgcn_mfma_f32_32x32x16_bf16(b1, qr[(MODE == 0 ? 8 : 0) + d0], p1, 0, 0, 0); } } \
            __builtin_amdgcn_s_setprio(0); \
            if (MODE == 1) { FK_LAS const float* cf_ = (FK_LAS const float*)(lds + AT_CF) + (j) * 64; \
              _Pragma("unroll") for (int g = 0; g < 4; ++g) { const f32x4 c0 = *(FK_LAS const f32x4*)(cf_ + 8 * g + 4 * hi), c1 = *(FK_LAS const f32x4*)(cf_ + 32 + 8 * g + 4 * hi); \
                _Pragma("unroll") for (int i = 0; i < 4; ++i) { p0[4 * g + i] += ct2 - c0[i]; p1[4 * g + i] += ct2 - c1[i]; } } \
              if ((j) * 64 + 63 > q0w) { const int dq = q0w + r32 - (j) * 64 - 4 * hi; const float NEG = -__builtin_inff(); \
                _Pragma("unroll") for (int r = 0; r < 16; ++r) { const int c = (r & 3) + 8 * (r >> 2); if (c > dq) p0[r] = NEG; if (c + 32 > dq) p1[r] = NEG; } } } \
            bf16x8 pa0 = qr[0], pa1 = qr[1], pa2 = qr[2], pa3 = qr[3]; \
            if (!(var & 4096)) { \
            float pmax = p0[0]; \
            _Pragma("unroll") for (int r = 1; r < 16; ++r) pmax = fmaxf(pmax, p0[r]); \
            _Pragma("unroll") for (int r = 0; r < 16; ++r) pmax = fmaxf(pmax, p1[r]); \
            { auto rr = __builtin_amdgcn_permlane32_swap(__float_as_uint(pmax), __float_as_uint(pmax), false, false); pmax = fmaxf(__uint_as_float(rr[0]), __uint_as_float(rr[1])); } \
            float mn, alpha; \
            if (__all(pmax - m_reg <= 11.5415603f)) { mn = m_reg; alpha = 1.f; }     \
            else { mn = fmaxf(m_reg, pmax); alpha = __builtin_amdgcn_exp2f(m_reg - mn); m_reg = mn; } \
            float ps = 0.f; \
            if (!(var & 64)) { _Pragma("unroll") for (int r = 0; r < 16; ++r) { p0[r] = __builtin_amdgcn_exp2f(p0[r] - mn); ps += p0[r]; } } \
            if (!(var & 64)) { _Pragma("unroll") for (int r = 0; r < 16; ++r) { p1[r] = __builtin_amdgcn_exp2f(p1[r] - mn); ps += p1[r]; } } \
            { auto rr = __builtin_amdgcn_permlane32_swap(__float_as_uint(ps), __float_as_uint(ps), false, false); ps = __uint_as_float(rr[0]) + __uint_as_float(rr[1]); } \
            l_reg = l_reg * alpha + ps; \
            AT_PK4(p0, 0, pa0); AT_PK4(p0, 8, pa1); AT_PK4(p1, 0, pa2); AT_PK4(p1, 8, pa3); \
            if (__any(alpha < 1.f)) { if (hi == 0) wsl[32 + r32] = alpha; asm volatile("s_waitcnt lgkmcnt(0)" ::: "memory"); \
                _Pragma("unroll") for (int g = 0; g < 4; ++g) { const f32x4 a4 = *(FK_LAS const f32x4*)(wsl + 32 + 8 * g + 4 * hi); \
                    _Pragma("unroll") for (int d_ = 0; d_ < 4; ++d_) _Pragma("unroll") for (int i = 0; i < 4; ++i) o[d_][4 * g + i] *= a4[i]; } } \
            } \
            if (!(var & 128)) { __builtin_amdgcn_s_setprio(1); AT_PV_D0(KB, 0); AT_PV_D0(KB, 1); AT_PV_D0(KB, 2); AT_PV_D0(KB, 3); __builtin_amdgcn_s_setprio(0); } \
        } \
        if ((j) + 1 < nt && !(var & 1024)) AT_WRITE((KB) ^ 1); \
        if (!(var & 2048)) __syncthreads(); } while (0)

    AT_LOAD(0); AT_WRITE(0); __syncthreads();
    for (int j = 0; j < nt; j += 2) { AT_STEP(j, 0); AT_STEP(j + 1, 1); }
    if (hi == 0) wsl[r32] = l_reg; asm volatile("s_waitcnt lgkmcnt(0)" ::: "memory");
    bf16_t* Ow = P.O + (size_t)q0w * D;
#pragma unroll
    for (int g = 0; g < 4; ++g) { const f32x4 l4 = *(FK_LAS const f32x4*)(wsl + 8 * g + 4 * hi);
#pragma unroll
        for (int i = 0; i < 4; ++i) { const int r = 4 * g + i; const int orow = crow(r, hi); const float rl = __builtin_amdgcn_rcpf(l4[i]);
#pragma unroll
            for (int d0 = 0; d0 < 4; ++d0) { const float v = o[d0][r] * rl; const float vn = __shfl_xor(v, 1);
                if ((r32 & 1) == 0) *(unsigned*)(Ow + (size_t)orow * D + d0 * 32 + r32) = cvt_pk_bf16(v, vn); } } }
    __syncthreads();
#undef AT_LOAD
#undef AT_WRITE
#undef AT_TRRD
#undef AT_PV_D0
#undef AT_PK4
#undef AT_STEP
}
}
namespace fk {
constexpr int LN_XS = 2052;
constexpr int TAB_OFF = 143360;

struct LnArgs {
    const float* x; const bf16_t* yb; const bf16_t* Y2; const int* te; const int* tpos; const int* cnt;
    const float *g, *b; float* xo; bf16_t* xbo; float* out2; unsigned char* xqo;
    const f32x4* w4; int ntile;
    const float *bgrp, *brt; int* rcnt; int* ote; int* otpos; float* otw; int* list; float* sw;
    int var;
    float* flog; const float* fbias;
};

__device__ __forceinline__ float wave_sum(float v) { for (int o = 32; o >= 1; o >>= 1) v += __shfl_xor(v, o); return v; }

struct LnRows { f32x4 x[2][8]; u32x2 ya[2][8]; u32x2 yb[2][8]; };
__device__ __forceinline__ void ln_load(const LnArgs& a, FK_LAS const int* hoff, int grp, int wid, int lane, LnRows& R) {
#pragma unroll
    for (int rr = 0; rr < 2; ++rr) { const int t = grp * 16 + 2 * wid + rr;
        const bf16_t *pa, *pb = nullptr;
        if (a.Y2) { const int e0 = a.te[t * 2], e1 = a.te[t * 2 + 1]; pa = a.Y2 + (size_t)(hoff[e0] + a.tpos[t * 2]) * D; pb = a.Y2 + (size_t)(hoff[e1] + a.tpos[t * 2 + 1]) * D; }
        else pa = a.yb + (size_t)t * D;
#pragma unroll
        for (int i = 0; i < 8; ++i) { const int c = 4 * lane + 256 * i; R.x[rr][i] = *(const f32x4*)(a.x + (size_t)t * D + c); R.ya[rr][i] = *(const u32x2*)(pa + c); if (a.Y2) R.yb[rr][i] = *(const u32x2*)(pb + c); else R.yb[rr][i] = (u32x2){0u, 0u}; } }
}
__device__ __forceinline__ void phase_ln(const LnArgs& a, FK_LAS unsigned char* lds) {
    const int tid = fk_tid(), wid = __builtin_amdgcn_readfirstlane(tid >> 6), lane = tid & 63;
    FK_LAS float* xs = (FK_LAS float*)lds;
    FK_LAS float* part = (FK_LAS float*)lds;
    FK_LAS float* logit = (FK_LAS float*)(lds + 32768);
    FK_LAS int* hoff = (FK_LAS int*)(lds + TAB_OFF);
    if (a.Y2) { if (tid < 64) { const int c = lane < 32 ? a.cnt[lane * 32] : 0; const int pc = ((c + 255) >> 8) << 8; int incl = pc;
#pragma unroll
            for (int o = 1; o < 32; o <<= 1) { const int v = __shfl_up(incl, o); if (lane >= o) incl += v; }
            if (lane < 32) hoff[lane] = incl - pc; }
        __syncthreads(); }
    const int nb = fk_nblk(); int grp = fk_bid();
    if (grp >= NT / 16) return;
    LnRows cur; ln_load(a, hoff, grp, wid, lane, cur);
#pragma unroll 1
    for (; grp < NT / 16; grp += nb) {
        const bool has_next = grp + nb < NT / 16;
#pragma unroll
        for (int rr = 0; rr < 2; ++rr) {
            const int lr = 2 * wid + rr, t = grp * 16 + lr;
            f32x4 v[8]; float s = 0.f;
#pragma unroll
            for (int i = 0; i < 8; ++i) { f32x4 xv = cur.x[rr][i] * ALPHA; const u32x2 pa = cur.ya[rr][i], pb = cur.yb[rr][i];
                xv[0] += __uint_as_float(pa.x << 16) + __uint_as_float(pb.x << 16); xv[1] += __uint_as_float(pa.x & 0xffff0000u) + __uint_as_float(pb.x & 0xffff0000u);
                xv[2] += __uint_as_float(pa.y << 16) + __uint_as_float(pb.y << 16); xv[3] += __uint_as_float(pa.y & 0xffff0000u) + __uint_as_float(pb.y & 0xffff0000u);
                v[i] = xv; s += (xv[0] + xv[1]) + (xv[2] + xv[3]); }
            const float mean = wave_sum(s) * (1.0f / D); float q = 0.f;
#pragma unroll
            for (int i = 0; i < 8; ++i) { const f32x4 d = v[i] - mean; q += (d[0] * d[0] + d[1] * d[1]) + (d[2] * d[2] + d[3] * d[3]); }
            const float rs = rsqrtf(wave_sum(q) * (1.0f / D) + 1e-5f);
#pragma unroll
            for (int i = 0; i < 8; ++i) { const int c = 4 * lane + 256 * i; const f32x4 gv = *(const f32x4*)(a.g + c), bv = *(const f32x4*)(a.b + c);
                const f32x4 o = (v[i] - mean) * rs * gv + bv;
                *(f32x4*)(a.xo + (size_t)t * D + c) = o;
                if (a.out2) *(f32x4*)(a.out2 + (size_t)t * D + c) = o;
                u32x2 p; p.x = cvt_pk_bf16(o[0], o[1]); p.y = cvt_pk_bf16(o[2], o[3]); *(u32x2*)(a.xbo + (size_t)t * D + c) = p;
                if (a.w4) *(FK_LAS f32x4*)(xs + lr * LN_XS + c) = o; }
        }
        if (has_next) ln_load(a, hoff, grp + nb, wid, lane, cur);
        if (!a.w4 || (a.var & 8192)) continue;
        __syncthreads();
        f32x4 acc[3];
#pragma unroll
        for (int n = 0; n < 3; ++n) acc[n] = (f32x4){0.f, 0.f, 0.f, 0.f};
        const int row = lane & 15, kq = lane >> 4;
#pragma unroll 8
        for (int j = 0; j < 16; ++j) { const int kg = wid * 16 + j;
            const f32x4 av = *(FK_LAS const f32x4*)(xs + row * LN_XS + 16 * kg + 4 * kq);
#pragma unroll
            for (int n = 0; n < 3; ++n) if (n < a.ntile) { const f32x4 bv = a.w4[(size_t)(kg * a.ntile + n) * 64 + lane];
#pragma unroll
                for (int i = 0; i < 4; ++i) { if (a.var & 32768) acc[n][i] += av[i] * bv[i]; else acc[n] = __builtin_amdgcn_mfma_f32_16x16x4f32(av[i], bv[i], acc[n], 0, 0, 0); } } }
        __syncthreads();
#pragma unroll
        for (int n = 0; n < 3; ++n) if (n < a.ntile) {
#pragma unroll
            for (int r = 0; r < 4; ++r) part[(wid * 16 + 4 * kq + r) * 48 + 16 * n + row] = acc[n][r]; }
        __syncthreads();
        for (int i = tid; i < 16 * 16 * a.ntile; i += NTHR) { const int n = i % (16 * a.ntile), r = i / (16 * a.ntile); float s = 0.f;
#pragma unroll
            for (int w = 0; w < 8; ++w) s += part[(w * 16 + r) * 48 + n]; logit[r * 48 + n] = s; }
        __syncthreads();
        if (a.ntile == 1) { if (tid < 256) { const int r = tid & 15, n = tid >> 4; const int t = grp * 16 + r; const float x = logit[r * 48 + n] + a.fbias[n]; const float ls = fminf(x, 0.f) - 0.6931471805599453f * __builtin_amdgcn_logf(1.0f + __builtin_amdgcn_exp2f(-fabsf(x) * LOG2E));     a.flog[((size_t)((t >> 11) * 16 + n)) * S + (t & (S - 1))] = ls; } }
        else if (tid < 16 && !(a.var & 16384)) { const int t = grp * 16 + tid; FK_LAS const float* lg = logit + tid * 48;
            float g4[4]; float mx = -3e38f; int gs = 0;
            for (int i = 0; i < 4; ++i) { g4[i] = lg[i] + a.bgrp[i]; if (g4[i] > mx) { mx = g4[i]; gs = i; } }
            float den = 0.f; for (int i = 0; i < 4; ++i) den += expf(g4[i] - mx); const float pg = 1.f / den;
            float e[8]; for (int i = 0; i < 8; ++i) e[i] = lg[4 + gs * 8 + i] + a.brt[gs * 8 + i];
            int i1 = 0; for (int i = 1; i < 8; ++i) if (e[i] > e[i1]) i1 = i;
            int i2 = -1; for (int i = 0; i < 8; ++i) if (i != i1 && (i2 < 0 || e[i] > e[i2])) i2 = i;
            const float w1 = 1.f / (1.f + expf(e[i2] - e[i1])), w2 = 1.f - w1;
            const int ea = gs * 8 + i1, eb = gs * 8 + i2;
            const int pa = atomicAdd(a.rcnt + ea * 32, 1), pb = atomicAdd(a.rcnt + eb * 32, 1);
            a.ote[t * 2] = ea; a.ote[t * 2 + 1] = eb; a.otpos[t * 2] = pa; a.otpos[t * 2 + 1] = pb; a.otw[t * 2] = w1 * pg; a.otw[t * 2 + 1] = w2 * pg;
            a.list[ea * NT + pa] = t; a.list[eb * NT + pb] = t; a.sw[ea * NT + pa] = w1 * pg; a.sw[eb * NT + pb] = w2 * pg; }
        __syncthreads();
    }
}

__device__ __forceinline__ void moe_tables(const int* cnt, FK_LAS int* tab) {
    const int tid = fk_tid(), lane = tid & 63;
    __syncthreads();
    if (tid < 64) { const int c = lane < 32 ? cnt[lane * 32] : 0; const int nt = (c + 255) >> 8; int incl = nt;
#pragma unroll
        for (int o = 1; o < 32; o <<= 1) { const int v = __shfl_up(incl, o); if (lane >= o) incl += v; }
        if (lane < 32) { tab[lane] = incl - nt; tab[40 + lane] = (incl - nt) * 256; tab[80 + lane] = c; }
        if (lane == 31) tab[32] = incl; }
    __syncthreads();
}
struct MoeSched1 {
    const char* xb; const char* Bt; const int* list; FK_LAS const int* tab; int G, c;
    __device__ __forceinline__ bool next(int i, GUnit& u) const {
        const int L = i * G + c; const int tot = tab[32] * 4; if (L >= tot) return false;
        int e = 0;
#pragma unroll 1
        for (int q = 1; q < 32; ++q) if (L >= tab[q] * 4) e = q;
        const int r = L - tab[e] * 4, nte = tab[e + 1] - tab[e]; const int mt = r % nte, pn = r / nte;
        u.e = e; u.pm = mt; u.pn = pn; u.nrows = min(256, tab[80 + e] - 256 * mt); u.A = xb; u.B = Bt + ((size_t)e * 1024 + (size_t)pn * 256) * D * 2; return true; }
    __device__ __forceinline__ void a_offs(const GUnit& u, int tid, unsigned (&o)[2][2]) const { int R0, C0, R1, C1; stage_rc(tid * 16, R0, C0); stage_rc(tid * 16 + 8192, R1, C1);
        const int* l = list + (size_t)u.e * NT + u.pm * 256;
        const int r00 = R0 < u.nrows ? R0 : 0, r01 = R1 < u.nrows ? R1 : 0, r10 = R0 + HALF < u.nrows ? R0 + HALF : 0, r11 = R1 + HALF < u.nrows ? R1 + HALF : 0;
        o[0][0] = (unsigned)(l[r00] * D + C0) * 2u; o[0][1] = (unsigned)(l[r01] * D + C1) * 2u; o[1][0] = (unsigned)(l[r10] * D + C0) * 2u; o[1][1] = (unsigned)(l[r11] * D + C1) * 2u; }
};
struct MoeSched2 {
    const char* H; const char* Bt; FK_LAS const int* tab; int G, c;
    __device__ __forceinline__ bool next(int i, GUnit& u) const {
        const int L = i * G + c; const int tot = tab[32] * 8; if (L >= tot) return false;
        int e = 0;
#pragma unroll 1
        for (int q = 1; q < 32; ++q) if (L >= tab[q] * 8) e = q;
        const int r = L - tab[e] * 8, nte = tab[e + 1] - tab[e]; const int mt = r % nte, pn = r / nte;
        u.e = e; u.pm = mt; u.pn = pn; u.nrows = min(256, tab[80 + e] - 256 * mt); u.A = H + (size_t)(tab[40 + e] + 256 * mt) * 512 * 2; u.B = Bt + ((size_t)e * 2048 + (size_t)pn * 256) * 512 * 2; return true; }
    __device__ __forceinline__ void a_offs(const GUnit&, int tid, unsigned (&o)[2][2]) const { int R0, C0, R1, C1; stage_rc(tid * 16, R0, C0); stage_rc(tid * 16 + 8192, R1, C1);
        o[0][0] = (unsigned)(R0 * 512 + C0) * 2u; o[0][1] = (unsigned)(R1 * 512 + C1) * 2u; o[1][0] = o[0][0] + (unsigned)(HALF * 512 * 2); o[1][1] = o[0][1] + (unsigned)(HALF * 512 * 2); }
};
struct EpiMoe1 {
    static constexpr bool PERM = false;
    bf16_t* H; const float* sw; FK_LAS const int* tab;
    __device__ __forceinline__ void operator()(const f32x4 (&acc)[2][2][4][2], const GUnit& u, int wr, int wc, int fr, int fq) const {
        const int hrow0 = tab[40 + u.e] + 256 * u.pm; const float* swe = sw + (size_t)u.e * NT + 256 * u.pm;
#pragma unroll
        for (int ai = 0; ai < 2; ++ai)
#pragma unroll
            for (int m = 0; m < 4; ++m) { const int r = ai * HALF + wr * 64 + m * 16 + fr; if (r < u.nrows) { const float wgt = swe[r];
#pragma unroll
                for (int bj = 0; bj < 2; ++bj) { const f32x4 g = acc[ai][bj][m][0], up = acc[ai][bj][m][1]; f32x4 h;
#pragma unroll
                    for (int j = 0; j < 4; ++j) h[j] = g[j] * __builtin_amdgcn_rcpf(1.0f + __builtin_amdgcn_exp2f(-g[j] * LOG2E)) * up[j] * wgt;
                    u32x2 p; p.x = cvt_pk_bf16(h[0], h[1]); p.y = cvt_pk_bf16(h[2], h[3]);
                    *(u32x2*)(H + (size_t)(hrow0 + r) * 512 + u.pn * 128 + bj * 64 + wc * 16 + 4 * fq) = p; } } }
    }
};
struct EpiMoe2 {
    static constexpr bool PERM = true;
    bf16_t* Y2; FK_LAS const int* tab;
    __device__ __forceinline__ void operator()(const f32x4 (&acc)[2][2][4][2], const GUnit& u, int wr, int wc, int fr, int fq) const {
        const int hrow0 = tab[40 + u.e] + 256 * u.pm;
#pragma unroll
        for (int ai = 0; ai < 2; ++ai)
#pragma unroll
            for (int m = 0; m < 4; ++m) { const int r = ai * HALF + wr * 64 + m * 16 + fr; if (r < u.nrows) {
#pragma unroll
                for (int bj = 0; bj < 2; ++bj) *(u32x4*)(Y2 + (size_t)(hrow0 + r) * D + u.pn * BM + bj * HALF + wc * 32 + 8 * fq) = pack8(acc[ai][bj][m][0], acc[ai][bj][m][1]); } }
    }
};
}
namespace fk {
constexpr int SG_ROWS = 640, SG_ASTG = SG_ROWS * 64, SG_BPITCH = 1040, SG_BSTG = 16 * SG_BPITCH, SG_A = 0, SG_B = 2 * SG_ASTG;
struct SgArgs {
    const char* A; const int* rowlist; int arow0, lda_bytes, nr;
    const float* B0; const float* B1; int ldn, K;
    bf16_t* out; int out_row0, out_ld, out_col0; const float* roww; int var;
};
template <int MODE>
__device__ __forceinline__ void sg_unit(FK_LAS unsigned char* lds, const SgArgs a) {
    const int tid = fk_tid(), wid = __builtin_amdgcn_readfirstlane(tid >> 6), lane = tid & 63, r16 = lane & 15, kq = lane >> 4, wm = wid >> 1, wn = wid & 1;
    const int rpw = ((a.nr + 63) >> 6) << 4, mf = rpw >> 4;
    const int nt = a.K >> 5;
    const char* ap[5];
    { const int kc = (lane & 3) ^ ((lane >> 4) & 3);
#pragma unroll
      for (int i = 0; i < 5; ++i) { int r = 16 * (5 * wid + i) + (lane >> 2); r = r < a.nr ? r : a.nr - 1; if (a.var & 4) r = 0; if (a.var & 32) r &= 63; const int gr = (a.rowlist && !(a.var & 64)) ? a.rowlist[r] : a.arow0 + r; ap[i] = a.A + (size_t)gr * a.lda_bytes + kc * 16; } }
    const float* bp[2];
#pragma unroll
    for (int i = 0; i < 2; ++i) { const int k = 2 * (2 * wid + i) + (lane >> 5), c = lane & 31;
        if (MODE == 1) { const int blk = c >> 3; bp[i] = ((blk & 1) ? a.B1 : a.B0) + (size_t)k * a.ldn + 32 * (blk >> 1) + 4 * (c & 7); }
        else bp[i] = a.B0 + (size_t)k * a.ldn + 4 * c; }
    const unsigned a_rd = (unsigned)(SG_A + (wm * rpw + r16) * 64 + ((kq ^ ((r16 >> 2) & 3)) << 4));
    const unsigned b_rd = (unsigned)(SG_B + 4 * kq * SG_BPITCH + (wn * 64 + r16) * 4);
    f32x4 acc[10][4];
#pragma unroll
    for (int i = 0; i < 10; ++i)
#pragma unroll
        for (int j = 0; j < 4; ++j) acc[i][j] = (f32x4){0.f, 0.f, 0.f, 0.f};
#define SG_ISSUE(t, stg) do {         _Pragma("unroll") for (int i = 0; i < 5; ++i) __builtin_amdgcn_global_load_lds((const unsigned*)(ap[i] + (size_t)(t) * 64), (FK_LAS unsigned*)(lds + SG_A + (stg) * SG_ASTG + (5 * wid + i) * 1024), 16, 0, 0);         _Pragma("unroll") for (int i = 0; i < 2; ++i) __builtin_amdgcn_global_load_lds((const unsigned*)(bp[i] + (size_t)((a.var & 2) ? 0 : (t)) * 32 * a.ldn), (FK_LAS unsigned*)(lds + SG_B + (stg) * SG_BSTG + (2 * wid + i) * SG_BPITCH), 16, 0, 0); } while (0)
    SG_ISSUE(0, 0);
    int stg = 0;
#pragma unroll 1
    for (int t = 0; t < nt; ++t) {
        asm volatile("s_waitcnt vmcnt(0)\n\ts_barrier" ::: "memory");
        if (t + 1 < nt) SG_ISSUE(t + 1, stg ^ 1);
        FK_LAS const unsigned char* ab = lds + a_rd + stg * SG_ASTG; FK_LAS const unsigned char* bb = lds + b_rd + stg * SG_BSTG;
        bf16x8 bf[4];
#pragma unroll
        for (int j = 0; j < 4; ++j) { FK_LAS const float* p = (FK_LAS const float*)(bb + j * 64);
            const float v0 = p[0], v1 = p[128], v2 = p[260], v3 = p[388], v4 = p[520], v5 = p[648], v6 = p[780], v7 = p[908];
            u32x4 w; w.x = cvt_pk_bf16(v0, v1); w.y = cvt_pk_bf16(v2, v3); w.z = cvt_pk_bf16(v4, v5); w.w = cvt_pk_bf16(v6, v7); bf[j] = *reinterpret_cast<bf16x8*>(&w); }
#pragma unroll
        for (int i = 0; i < 10; ++i) if (i < mf && !(a.var & 1)) { const bf16x8 af = *(FK_LAS const bf16x8*)(ab + i * 1024);
#pragma unroll
            for (int j = 0; j < 4; ++j) acc[i][j] = __builtin_amdgcn_mfma_f32_16x16x32_bf16(bf[j], af, acc[i][j], 0, 0, 0); }
        stg ^= 1;
    }
#undef SG_ISSUE
    float wgts[10];
#pragma unroll
    for (int i = 0; i < 10; ++i) { const int r = wm * rpw + 16 * i + r16; wgts[i] = (MODE == 1 && i < mf && r < a.nr) ? a.roww[r] : 0.f; }
#pragma unroll
    for (int i = 0; i < 10; ++i) if (i < mf) { const int r = wm * rpw + 16 * i + r16; if (r < a.nr) {
        if (MODE == 1) { const float wgt = wgts[i]; bf16_t* orow = a.out + (size_t)(a.out_row0 + r) * a.out_ld + a.out_col0 + 32 * wn + 4 * kq;
#pragma unroll
            for (int j = 0; j < 2; ++j) { const f32x4 g = acc[i][j], up = acc[i][j + 2]; f32x4 h;
#pragma unroll
                for (int q = 0; q < 4; ++q) h[q] = g[q] * __builtin_amdgcn_rcpf(1.0f + __builtin_amdgcn_exp2f(-g[q] * LOG2E)) * up[q] * wgt;
                u32x2 p; p.x = cvt_pk_bf16(h[0], h[1]); p.y = cvt_pk_bf16(h[2], h[3]); *(u32x2*)(orow + 16 * j) = p; } }
        else { bf16_t* orow = a.out + (size_t)(a.out_row0 + r) * a.out_ld + a.out_col0 + 64 * wn + 4 * kq;
#pragma unroll
            for (int j = 0; j < 4; ++j) { const f32x4 v = acc[i][j]; u32x2 p; p.x = cvt_pk_bf16(v[0], v[1]); p.y = cvt_pk_bf16(v[2], v[3]); *(u32x2*)(orow + 16 * j) = p; } } } }
    asm volatile("s_waitcnt vmcnt(0)" ::: "memory");
    __syncthreads();
}
__device__ __forceinline__ void phase_moe1(FK_LAS unsigned char* lds, FK_LAS const int* tab, const bf16_t* xb, const int* list, const float* sw, const float* wgate, const float* wup, bf16_t* H, int var, int xcc, int xrank, int xnloc) {
#pragma unroll 1
    for (int q = xrank; q < 32; q += xnloc) { const int e = xcc + 8 * (q >> 3), s = q & 7; if (e >= 32) continue; const int ne = tab[80 + e], hrow0 = tab[40 + e];
        const int rbeg = 0, rend = ne;
#pragma unroll 1
        for (int r0 = rbeg; r0 < rend; r0 += SG_ROWS) { SgArgs a; a.A = (const char*)xb; a.rowlist = list + (size_t)e * NT + r0; a.arow0 = 0; a.lda_bytes = D * 2; a.nr = min(SG_ROWS, rend - r0);
            a.B0 = wgate + (size_t)e * D * 512 + 64 * s; a.B1 = wup + (size_t)e * D * 512 + 64 * s; a.ldn = 512; a.K = D;
            a.out = H; a.out_row0 = hrow0 + r0; a.out_ld = 512; a.out_col0 = 64 * s; a.roww = sw + (size_t)e * NT + r0; a.var = var; sg_unit<1>(lds, a); } }
}
__device__ __forceinline__ void phase_moe2(FK_LAS unsigned char* lds, FK_LAS const int* tab, const bf16_t* H, const float* wdown, bf16_t* Y2, int var, int xcc, int xrank, int xnloc) {
#pragma unroll 1
    for (int q = xrank; q < 64; q += xnloc) { const int e = xcc + 8 * (q >> 4), s = q & 15; if (e >= 32) continue; const int ne = tab[80 + e], hrow0 = tab[40 + e];
        const int rbeg = 0, rend = ne;
#pragma unroll 1
        for (int r0 = rbeg; r0 < rend; r0 += SG_ROWS) { SgArgs a; a.A = (const char*)H; a.rowlist = nullptr; a.arow0 = hrow0 + r0; a.lda_bytes = 512 * 2; a.nr = min(SG_ROWS, rend - r0);
            a.B0 = wdown + (size_t)e * 512 * D + 128 * s; a.B1 = nullptr; a.ldn = D; a.K = 512;
            a.out = Y2; a.out_row0 = hrow0 + r0; a.out_ld = D; a.out_col0 = 128 * s; a.roww = nullptr; a.var = var; sg_unit<2>(lds, a); } }
}
}
namespace fk {
struct EpiBf16Q {
    static constexpr bool PERM = true;
    bf16_t* O; int ldc, qcols; float qscale;
    __device__ __forceinline__ void operator()(const f32x4 (&acc)[2][2][4][2], const GUnit& u, int wr, int wc, int fr, int fq) const {
        const int row0 = u.pm * BM + wr * 64 + fr;
#pragma unroll
        for (int bj = 0; bj < 2; ++bj) { const int gc = u.pn * BM + bj * HALF + wc * 32 + 8 * fq; const float sc = gc < qcols ? qscale : 1.0f;
#pragma unroll
            for (int ai = 0; ai < 2; ++ai)
#pragma unroll
                for (int m = 0; m < 4; ++m) *(u32x4*)(O + (size_t)(row0 + ai * HALF + m * 16) * ldc + gc) = pack8(acc[ai][bj][m][0] * sc, acc[ai][bj][m][1] * sc); }
    }
};
__device__ __forceinline__ void fox_cumsum_lds(const float* lsig, FK_LAS float* cfl, FK_LAS double* wtot, const int b, const int h) {
    const int tid = fk_tid(), lane = tid & 63, wid = tid >> 6;
    __syncthreads();
    const f32x4 v = *(const f32x4*)(lsig + (size_t)(b * 16 + h) * S + 4 * tid);
    const double s0 = (double)v[0], s1 = s0 + (double)v[1], s2 = s1 + (double)v[2], s3 = s2 + (double)v[3];
    double incl = s3;
#pragma unroll
    for (int o = 1; o < 64; o <<= 1) { const double u = __shfl_up(incl, o); if (lane >= o) incl += u; }
    if (lane == 63) wtot[wid] = incl;
    __syncthreads();
    double off = incl - s3;
#pragma unroll
    for (int w = 0; w < 7; ++w) if (w < wid) off += wtot[w];
    f32x4 o4; o4[0] = (float)((off + s0) * 1.4426950408889634); o4[1] = (float)((off + s1) * 1.4426950408889634); o4[2] = (float)((off + s2) * 1.4426950408889634); o4[3] = (float)((off + s3) * 1.4426950408889634);
    *(FK_LAS f32x4*)(cfl + 4 * tid) = o4;
    __syncthreads();
}
struct EpiDsaIn {
    static constexpr bool PERM = true;
    bf16_t *q, *k, *v, *qidx, *kidx; float* widx;
    __device__ __forceinline__ void operator()(const f32x4 (&acc)[2][2][4][2], const GUnit& u, int wr, int wc, int fr, int fq) const {
        const int row0 = u.pm * BM + wr * 64 + fr;
#pragma unroll
        for (int bj = 0; bj < 2; ++bj) { const int gc = u.pn * BM + bj * HALF + wc * 32 + 8 * fq;
            bf16_t* dst; int ld, c; float sc = 1.0f;
            if (gc < 2048) { dst = q; ld = 2048; c = gc; sc = QSCALE_128; } else if (gc < 2176) { dst = k; ld = 128; c = gc - 2048; } else if (gc < 2304) { dst = v; ld = 128; c = gc - 2176; }
            else if (gc < 3328) { dst = qidx; ld = 1024; c = gc - 2304; } else if (gc < 3392) { dst = kidx; ld = 64; c = gc - 3328; } else { dst = nullptr; ld = 0; c = gc - 3392; }
#pragma unroll
            for (int ai = 0; ai < 2; ++ai)
#pragma unroll
                for (int m = 0; m < 4; ++m) { const int row = row0 + ai * HALF + m * 16;
                    if (dst) *(u32x4*)(dst + (size_t)row * ld + c) = pack8(acc[ai][bj][m][0] * sc, acc[ai][bj][m][1] * sc);
                    else if (c < 16) { *(f32x4*)(widx + (size_t)row * 16 + c) = acc[ai][bj][m][0] * 0.03125f; *(f32x4*)(widx + (size_t)row * 16 + c + 4) = acc[ai][bj][m][1] * 0.03125f; } } }
    }
};

__device__ __forceinline__ unsigned ord_u32(float f) { const unsigned b = __float_as_uint(f); return b ^ ((b >> 31) ? 0xFFFFFFFFu : 0x80000000u); }
__device__ __forceinline__ int half_sum(int v) {
    v += __shfl_xor(v, 1); v += __shfl_xor(v, 2); v += __shfl_xor(v, 4); v += __shfl_xor(v, 8); v += __shfl_xor(v, 16); return v; }
__device__ __forceinline__ void dsa_index_unit(FK_LAS unsigned char* lds, const bf16_t* qidx, const bf16_t* kidx, const float* widx, unsigned short* sel, int* nsel, const int b, const int g, const int var = 0) {
    const int tid = fk_tid(), wid = __builtin_amdgcn_readfirstlane(tid >> 6), lane = tid & 63, r32 = lane & 31, hi = lane >> 5;
    const int t0 = 16 * g, ntile = (t0 >> 6) + 1, nk = 64 * ntile;
    const int tq = t0 + 2 * wid;
    bf16x8 qa[4]; float wv[16];
    { const int row = r32, q = row >> 4, h = row & 15; const bf16_t* p = qidx + ((size_t)(b * S + tq + q)) * 1024 + h * 64 + hi * 8;
#pragma unroll
      for (int ks = 0; ks < 4; ++ks) qa[ks] = *(const bf16x8*)(p + ks * 16);
#pragma unroll
      for (int r = 0; r < 16; ++r) { const int rw = crow(r, hi); wv[r] = widx[((size_t)(b * S + tq + (rw >> 4))) * 16 + (rw & 15)]; } }
    const int krr = tid >> 3, krc = tid & 7, krw = FK_KRSWZ(krr, krc);
    unsigned uk[64];
    bf16x8 stg[4];
#define DI_LOAD(T) do { _Pragma("unroll") for (int q_ = 0; q_ < 4; ++q_) stg[q_] = *(const bf16x8*)(kidx + ((size_t)(b * S + (T) * 256 + q_ * 64 + krr)) * 64 + krc * 8); } while (0)
#define DI_WRITE(bf) do { _Pragma("unroll") for (int q_ = 0; q_ < 4; ++q_) *(FK_LAS bf16x8*)(lds + (bf) * 32768 + q_ * 8192 + krw) = stg[q_]; } while (0)
    const int nt256 = (nk + 255) >> 8;
    DI_LOAD(0); DI_WRITE(0); __syncthreads();
#pragma unroll
    for (int i = 0; i < 64; ++i) uk[i] = 0u;
#pragma unroll 1
    for (int it = 0; it < 8; ++it) {
#pragma unroll
        for (int i = 0; i < 56; ++i) uk[i] = uk[i + 8];
        if (it < nt256 && !(var & 16)) {
            if (it + 1 < nt256) DI_LOAD(it + 1);
#pragma unroll
            for (int jj = 0; jj < 4; ++jj) { const int j = 4 * it + jj;
                if (j < ntile) {
                    FK_LAS const unsigned char* kb = lds + (it & 1) * 32768 + jj * 8192;
#pragma unroll
                    for (int sub = 0; sub < 2; ++sub) {
                        f32x16 acc;
#pragma unroll
                        for (int r = 0; r < 16; ++r) acc[r] = 0.f;
#pragma unroll
                        for (int ks = 0; ks < 4; ++ks) { const bf16x8 kf = *(FK_LAS const bf16x8*)(kb + FK_KRSWZ(32 * sub + r32, 2 * ks + hi)); acc = __builtin_amdgcn_mfma_f32_32x32x16_bf16(qa[ks], kf, acc, 0, 0, 0); }
                        float s0 = 0.f, s1 = 0.f;
#pragma unroll
                        for (int r = 0; r < 8; ++r) { s0 += fmaxf(acc[r], 0.f) * wv[r]; s1 += fmaxf(acc[8 + r], 0.f) * wv[8 + r]; }
                        auto rr = __builtin_amdgcn_permlane32_swap(__float_as_uint(s0), __float_as_uint(s1), false, false);
                        uk[56 + 2 * jj + sub] = ord_u32(__uint_as_float(rr[0]) + __uint_as_float(rr[1]));
                    }
                } else { uk[56 + 2 * jj] = 0u; uk[56 + 2 * jj + 1] = 0u; }
            }
            if (it + 1 < nt256) DI_WRITE((it + 1) & 1);
            __syncthreads();
        } else {
#pragma unroll
            for (int q_ = 0; q_ < 8; ++q_) uk[56 + q_] = 0u; }
    }
#undef DI_LOAD
#undef DI_WRITE
    const int t = tq + hi;
    unsigned short* so = sel + ((size_t)(b * S + t)) * 256;
    int base = 0;
    if (nk <= 256 || (var & 8)) {
#pragma unroll
        for (int s = 0; s < 8; ++s) { const int key = 32 * s + r32; so[key] = (unsigned short)(key < nk ? key : 0); }
        base = nk;
    } else {
        unsigned T = 0u; bool done = false;
#pragma unroll 1
        for (int bit = 31; bit >= 0; --bit) { const unsigned cand = T | (1u << bit); int c = 0;
#pragma unroll
            for (int s = 0; s < 64; ++s) c += (uk[s] >= cand) ? 1 : 0;
            c = half_sum(c); if (!done && c >= 256) { T = cand; done = (c == 256); }
            if (__all(done)) break; }
        int cgt = 0;
#pragma unroll
        for (int s = 0; s < 64; ++s) cgt += (uk[s] > T) ? 1 : 0;
        cgt = half_sum(cgt);
        const int need = 256 - cgt; int eqb = 0;
#pragma unroll
        for (int s = 0; s < 64; ++s) { const int key = 32 * s + r32; const unsigned u = uk[s];
            const bool iseq = (u == T);
            const unsigned long long em = __ballot(iseq); const unsigned eh = hi ? (unsigned)(em >> 32) : (unsigned)em; const int erank = eqb + __popc(eh & ((1u << r32) - 1u)); eqb += __popc(eh);
            const bool take = (u > T) || (iseq && erank < need);
            const unsigned long long tm = __ballot(take); const unsigned th = hi ? (unsigned)(tm >> 32) : (unsigned)tm; const int pos = base + __popc(th & ((1u << r32) - 1u)); base += __popc(th);
            if (take) so[pos] = (unsigned short)key; }
    }
    if (r32 == 0) nsel[b * S + t] = base;
}

constexpr int DS_T5 = 131072, DS_LUT = 133120, DS_SEL = 135168;
__device__ __forceinline__ void phase_dsa_attn(FK_LAS unsigned char* lds, const bf16_t* dq, const bf16_t* dk, const bf16_t* dv, const unsigned short* sel, const int* nsel, const float* t5, bf16_t* o) {
    const int tid = fk_tid(), wid = __builtin_amdgcn_readfirstlane(tid >> 6), lane = tid & 63, c16 = lane & 15, g = lane >> 4;
    FK_LAS float* t5l = (FK_LAS float*)(lds + DS_T5); FK_LAS unsigned char* lut = lds + DS_LUT;
    for (int i = tid; i < 512; i += NTHR) t5l[i] = t5[i] * LOG2E;
    for (int n = tid; n < 2048; n += NTHR) { int bk; if (n < 8) bk = n; else { bk = 8 + (int)(logf((float)n / 8.0f) / 2.772588722239781f * 8.0f); if (bk > 15) bk = 15; } lut[n] = (unsigned char)bk; }
    __syncthreads();
    FK_LAS unsigned char* vst = lds + wid * 16384;
    FK_LAS unsigned short* sell = (FK_LAS unsigned short*)(lds + DS_SEL + wid * 512);
    const unsigned vbase = (unsigned)(size_t)vst;
#pragma unroll 1
    for (int tg = fk_bid() * 8 + wid; tg < NT; tg += fk_nblk() * 8) {
        const int b = tg >> 11, t = tg & (S - 1); const int cnt = nsel[tg];
        const bf16_t* kb = dk + (size_t)b * S * 128; const bf16_t* vb = dv + (size_t)b * S * 128;
        { const u32x2 s4 = *(const u32x2*)(sel + (size_t)tg * 256 + lane * 4); *(FK_LAS u32x2*)(sell + lane * 4) = s4; }
        bf16x8 qf[4];
#pragma unroll
        for (int ks = 0; ks < 4; ++ks) qf[ks] = *(const bf16x8*)(dq + (size_t)tg * 2048 + c16 * 128 + ks * 32 + g * 8);
        asm volatile("s_waitcnt lgkmcnt(0)" ::: "memory");
        f32x4 sc[16];
#pragma unroll
        for (int ib = 0; ib < 4; ++ib) {
            bf16x8 kf[4][4];
#pragma unroll
            for (int u = 0; u < 4; ++u) { const int kk = sell[16 * (4 * ib + u) + c16]; const bf16_t* kr = kb + (size_t)kk * 128 + g * 8;
#pragma unroll
                for (int ks = 0; ks < 4; ++ks) kf[u][ks] = *(const bf16x8*)(kr + ks * 32); }
#pragma unroll
            for (int u = 0; u < 4; ++u) { f32x4 a = {0.f, 0.f, 0.f, 0.f};
#pragma unroll
                for (int ks = 0; ks < 4; ++ks) a = __builtin_amdgcn_mfma_f32_16x16x32_bf16(kf[u][ks], qf[ks], a, 0, 0, 0);
                sc[4 * ib + u] = a; }
        }
        float mx = -3.0e38f;
#pragma unroll
        for (int i = 0; i < 16; ++i) { const u32x2 k4 = *(FK_LAS const u32x2*)(sell + 16 * i + 4 * g);
#pragma unroll
            for (int r = 0; r < 4; ++r) { const int kk = (r < 2 ? (k4.x >> (16 * r)) : (k4.y >> (16 * (r - 2)))) & 0xffff; const int rel = kk - t; const int n = rel < 0 ? -rel : rel; const int bk = (rel > 0 ? 16 : 0) + lut[n];
                float v = sc[i][r] + t5l[bk * 16 + c16]; v = (16 * i + 4 * g + r < cnt) ? v : -__builtin_inff(); sc[i][r] = v; mx = fmaxf(mx, v); } }
        mx = fmaxf(mx, __shfl_xor(mx, 16)); mx = fmaxf(mx, __shfl_xor(mx, 32));
        float sum = 0.f;
#pragma unroll
        for (int i = 0; i < 16; ++i)
#pragma unroll
            for (int r = 0; r < 4; ++r) { const float p = __builtin_amdgcn_exp2f(sc[i][r] - mx); sc[i][r] = p; sum += p; }
        sum += __shfl_xor(sum, 16); sum += __shfl_xor(sum, 32);
        const float inv = __builtin_amdgcn_rcpf(sum);
        u32x4 pw[8];
#pragma unroll
        for (int c = 0; c < 8; ++c) pw[c] = pack8(sc[2 * c], sc[2 * c + 1]);
        f32x4 oa[8];
#pragma unroll
        for (int d = 0; d < 8; ++d) oa[d] = (f32x4){0.f, 0.f, 0.f, 0.f};
        bf16x8 vv[2][8];
#define DS_VLOAD(c, B) do { _Pragma("unroll") for (int it = 0; it < 8; ++it) { const int idx = lane + 64 * it, lr = idx >> 4, ch = idx & 15; const int kk = sell[32 * (c) + lr]; vv[B][it] = *(const bf16x8*)(vb + (size_t)kk * 128 + ch * 8); } } while (0)
        DS_VLOAD(0, 0);
#pragma unroll
        for (int c = 0; c < 8; ++c) {
            if (32 * c < cnt) {
                if (c + 1 < 8 && 32 * (c + 1) < cnt) DS_VLOAD(c + 1, (c + 1) & 1);
#pragma unroll
                for (int it = 0; it < 8; ++it) { const int idx = lane + 64 * it, lr = idx >> 4, ch = idx & 15; *(FK_LAS bf16x8*)(vst + lr * 256 + ((ch ^ ((lr & 7) << 1)) << 4)) = vv[c & 1][it]; }
                const bf16x8 pf = *reinterpret_cast<const bf16x8*>(&pw[c]);
                asm volatile("s_waitcnt lgkmcnt(0)" ::: "memory");
                const int q4 = c16 >> 2, p4 = c16 & 3; const int rowA = 4 * g + q4, rowB = 16 + 4 * g + q4;
#pragma unroll
                for (int d = 0; d < 8; ++d) { s16x4 lo, hi4;
                    const unsigned aA = vbase + rowA * 256 + (((2 * d + (p4 >> 1)) ^ ((rowA & 7) << 1)) << 4) + (p4 & 1) * 8;
                    const unsigned aB = vbase + rowB * 256 + (((2 * d + (p4 >> 1)) ^ ((rowB & 7) << 1)) << 4) + (p4 & 1) * 8;
                    asm volatile("ds_read_b64_tr_b16 %0, %1" : "=&v"(lo) : "v"(aA) : "memory");
                    asm volatile("ds_read_b64_tr_b16 %0, %1" : "=&v"(hi4) : "v"(aB) : "memory");
                    asm volatile("s_waitcnt lgkmcnt(0)" ::: "memory"); __builtin_amdgcn_sched_barrier(0);
                    oa[d] = __builtin_amdgcn_mfma_f32_16x16x32_bf16((bf16x8){lo[0], lo[1], lo[2], lo[3], hi4[0], hi4[1], hi4[2], hi4[3]}, pf, oa[d], 0, 0, 0); }
            }
        }
#undef DS_VLOAD
#pragma unroll
        for (int d = 0; d < 8; ++d) { u32x2 p; p.x = cvt_pk_bf16(oa[d][0] * inv, oa[d][1] * inv); p.y = cvt_pk_bf16(oa[d][2] * inv, oa[d][3] * inv);
            *(u32x2*)(o + (size_t)tg * 2048 + c16 * 128 + 16 * d + 4 * g) = p; }
    }
}
}
#define XB_TMO      128
#define XB_XCNT(j)  (256  + 64 * (j))
#define XB_XSUB(j)  (1280 + 64 * (j))
#define XB_XGEN(j)  (2304 + 64 * (j))
#define XB_TOP      3328
#define XB_TOPGEN   3392
#define XCD_BAR_WORDS 3456
#define XB_SPIN_CAP (1u << 18)
#define LAS __attribute__((address_space(3)))

__device__ __forceinline__ unsigned xb_ld(unsigned* p)              { return __hip_atomic_load(p, __ATOMIC_RELAXED, __HIP_MEMORY_SCOPE_AGENT); }
__device__ __forceinline__ unsigned xb_add(unsigned* p, unsigned v) { return __hip_atomic_fetch_add(p, v, __ATOMIC_RELAXED, __HIP_MEMORY_SCOPE_AGENT); }
__device__ __forceinline__ unsigned xb_xcc_id() { return (unsigned)__builtin_amdgcn_s_getreg((3 << 11) | 20) & 0xFu; }
#define XB_SPIN(cond, bar) do { unsigned _sp = 0; while (cond) { __builtin_amdgcn_s_sleep(1); \
    if ((++_sp & 255u) == 0u) { if (xb_ld(&(bar)[XB_TMO])) break; if (_sp > XB_SPIN_CAP) { atomicAdd(&(bar)[XB_TMO], 1u); break; } } } } while (0)

struct XcdBarrier {
    unsigned* bar; unsigned x;
    volatile LAS unsigned* st;
};

__device__ __forceinline__ XcdBarrier xcd_barrier_post(unsigned* bar, volatile LAS unsigned* st) {
    XcdBarrier b; b.bar = bar; b.x = xb_xcc_id(); b.st = st;
    if (threadIdx.x == 0) st[2] = xb_add(&bar[XB_XCNT(b.x)], 1u);
    return b;
}
__device__ __forceinline__ void xcd_barrier_complete(unsigned* bar, unsigned x, unsigned& nloc, unsigned& nx) {
    const unsigned G = gridDim.x * gridDim.y * gridDim.z;
    unsigned sum, cnt, mine, sp = 0u;
    for (;;) {
        sum = 0u; cnt = 0u; mine = 0u;
#pragma unroll
        for (unsigned j = 0; j < 16; ++j) { const unsigned c = xb_ld(&bar[XB_XCNT(j)]); sum += c; cnt += (c > 0u) ? 1u : 0u; mine = (j == x) ? c : mine; }
        if (sum == G) break;
        __builtin_amdgcn_s_sleep(1);
        if ((++sp & 255u) == 0u) { if (xb_ld(&bar[XB_TMO])) break; if (sp > XB_SPIN_CAP) { atomicAdd(&bar[XB_TMO], 1u); break; } }
    }
    nloc = mine > 0u ? mine : 1u; nx = cnt > 0u ? cnt : 1u;
}

__device__ __forceinline__ void xcd_barrier(const XcdBarrier& b) {
    asm volatile("s_waitcnt vmcnt(0)" ::: "memory");
    __syncthreads();
    if (threadIdx.x == 0) {
        unsigned* bar = b.bar;
        __builtin_amdgcn_s_waitcnt(0);
        unsigned nloc = b.st[0], nx = b.st[1];
        if (nloc == 0u) { xcd_barrier_complete(bar, b.x, nloc, nx); b.st[0] = nloc; b.st[1] = nx; }
        const unsigned old = xb_add(&bar[XB_XSUB(b.x)], 1u);
        const unsigned gen = old / nloc;
        if (old + 1u == (gen + 1u) * nloc) {
            __builtin_amdgcn_fence(__ATOMIC_RELEASE, "agent");
            asm volatile("s_waitcnt vmcnt(0)" ::: "memory");
            const unsigned og = xb_add(&bar[XB_TOP], 1u);
            const unsigned tg = og / nx;
            if (og + 1u == (tg + 1u) * nx) xb_add(&bar[XB_TOPGEN], 1u);
            else XB_SPIN(xb_ld(&bar[XB_TOPGEN]) == tg, bar);
            __builtin_amdgcn_fence(__ATOMIC_ACQUIRE, "agent");
            xb_add(&bar[XB_XGEN(b.x)], 1u);
            asm volatile("s_waitcnt vmcnt(0)" ::: "memory");
        } else {
            XB_SPIN(xb_ld(&bar[XB_XGEN(b.x)]) == gen, bar);
            __builtin_amdgcn_fence(__ATOMIC_ACQUIRE, "agent");
            asm volatile("s_waitcnt vmcnt(0)" ::: "memory");
        }
    }
    __syncthreads();
}


__device__ __forceinline__ void xcd_barrier_slim(const XcdBarrier& b) {
    asm volatile("s_waitcnt vmcnt(0)" ::: "memory");
    __syncthreads();
    if (threadIdx.x == 0) {
        unsigned* bar = b.bar;
        __builtin_amdgcn_s_waitcnt(0);
        unsigned nloc = b.st[0], nx = b.st[1];
        if (nloc == 0u) { nloc = 1u; nx = 1u; }
        const unsigned old = xb_add(&bar[XB_XSUB(b.x)], 1u);
        const unsigned gen = old / nloc;
        if (old + 1u == (gen + 1u) * nloc) {
            __builtin_amdgcn_fence(__ATOMIC_RELEASE, "agent");
            asm volatile("s_waitcnt vmcnt(0)" ::: "memory");
            const unsigned og = xb_add(&bar[XB_TOP], 1u);
            const unsigned tg = og / nx;
            if (og + 1u == (tg + 1u) * nx) xb_add(&bar[XB_TOPGEN], 1u);
            else XB_SPIN(xb_ld(&bar[XB_TOPGEN]) == tg, bar);
            __builtin_amdgcn_fence(__ATOMIC_ACQUIRE, "agent");
            xb_add(&bar[XB_XGEN(b.x)], 1u);
            asm volatile("s_waitcnt vmcnt(0)" ::: "memory");
        } else {
            XB_SPIN(xb_ld(&bar[XB_XGEN(b.x)]) == gen, bar);
            __builtin_amdgcn_fence(__ATOMIC_ACQUIRE, "agent");
            asm volatile("s_waitcnt vmcnt(0)" ::: "memory");
        }
    }
    __syncthreads();
}

namespace fk {
template <int FK_PHASE_MASK_, int ML>
__global__ void __launch_bounds__(NTHR, 2) fk_fwd(const FWK kw, const CvtTable T, const int p_lo, const int p_hi) {
    extern __shared__ __attribute__((aligned(16))) unsigned char shm_[];
    FK_LAS unsigned char* lds = (FK_LAS unsigned char*)shm_;
    FK_LAS unsigned* xbw = (FK_LAS unsigned*)(lds + LDS_BYTES - 16);
    if (threadIdx.x == 0) { xbw[0] = 0u; xbw[1] = 0u; xbw[2] = 0u; xbw[3] = 0u; }
    __syncthreads();
#define FWK_FIELDS(X) X(x_in) X(t5) X(mla_w_in) X(mla_qn) X(mla_kvn) X(mla_wq) X(mla_wkv) X(mla_wo) X(fox_w_in) X(fox_bf) X(fox_wo) X(dsa_w_in) X(dsa_wo) X(ln_g) X(ln_b) X(wgrp) X(bgrp) X(wrt) X(brt) X(wgate) X(wup) X(wdown) X(out) X(ws) X(moe_bias_gu) X(moe_bias_d) X(var)
    FK_LAS unsigned long long* kl = (FK_LAS unsigned long long*)(lds + 146944);
    if (threadIdx.x == 0) { int i_ = 0;
#define FWK_PUT(f) kl[i_++] = (unsigned long long)kw.f;
        FWK_FIELDS(FWK_PUT)
#undef FWK_PUT
    }
    __syncthreads();
    XcdBarrier bar = xcd_barrier_post((unsigned*)(kw.ws + WsMap<ML>::CTL), (volatile LAS unsigned*)xbw);
    FK_LAS int* tab = (FK_LAS int*)(lds + TAB_OFF);
    if (p_hi - p_lo > 1) xcd_barrier(bar);
#define PH_ON(k) (((FK_PHASE_MASK_) >> (k)) & 1)
#ifndef FK_REP_MASK
#define FK_REP_MASK 0
#endif
#define PH_REP(k) ((((FK_REP_MASK) >> (k)) & 1) ? 2 : 1)
#define FWK_GET(f) { const unsigned long long v_ = kl[i_++]; const unsigned lo_ = __builtin_amdgcn_readfirstlane((unsigned)v_), hi_ = __builtin_amdgcn_readfirstlane((unsigned)(v_ >> 32)); kq_.f = (decltype(kq_.f))(((unsigned long long)hi_ << 32) | lo_); }
#define PH_BEGIN(id) if ((id) >= p_lo && (id) < p_hi) { if ((id) > p_lo) xcd_barrier_slim(bar); FWK kq_; { int i_ = 0; FWK_FIELDS(FWK_GET) } const FW w = make_fw<ML>(kq_, kq_.ws);
#define PH_END }
#define PH_BEGINR(id, bit) PH_BEGIN(id) for (int rep_ = 0; rep_ < PH_REP(bit); ++rep_)
    if constexpr (PH_ON(8)) { PH_BEGINR(0, 8) phase_prologue(w, T, lds); PH_END }
#pragma unroll 1
    for (int layer = 0; layer < 4; ++layer) {
        const int kind = layer % 3, j = layer / 3, pb = 1 + 8 * layer;
        if (kind == 0) {
#define MLA_PTRS bf16_t* cq = (bf16_t*)w.arena; bf16_t* ckv = cq + (size_t)NT * 512; bf16_t* kr = ckv + (size_t)NT * 512; bf16_t* q = kr + (size_t)NT * 64; bf16_t* kv = q + (size_t)NT * 3072; (void)cq; (void)ckv; (void)kr; (void)q; (void)kv;
            if constexpr (PH_ON(0)) PH_BEGINR(pb + 0, 0) { MLA_PTRS RectSched s; s.init(w.xb0, D, w.mla_win_t + (size_t)j * 1280 * D, D, NT, 1280); EpiMlaIn e{cq, ckv, kr, w.ss, w.rope_cs}; gemm_phase(lds, D, D, s, e); } PH_END
            if constexpr (PH_ON(1)) PH_BEGINR(pb + 1, 1) { MLA_PTRS Rect2Sched s; s.s0.init(cq, 512, w.mla_wq_t + (size_t)j * 3072 * 512, 512, NT, 3072); s.s1.init(ckv, 512, w.mla_wkv_t + (size_t)j * 4096 * 512, 512, NT, 4096); s.n0 = 0;
                EpiMlaQKV e{q, kv, w.ss, w.rope_cs}; gemm_phase(lds, 512, 512, s, e); } PH_END
            if constexpr (PH_ON(2)) PH_BEGINR(pb + 2, 2) { MLA_PTRS
#pragma unroll 1
                for (int p = fk_bid(), np_ = fk_nblk(); p < 256; p += np_) { const int bh = p >> 2, x = p & 3, b = bh >> 4, h = bh & 15;
                    AttnPtrs P; P.Q = q + (size_t)b * S * 3072 + h * 192; P.K = kv + (size_t)b * S * 4096 + h * 256; P.V = P.K + 128; P.KR = kr + (size_t)b * S * 64; P.CF = nullptr; P.O = w.o + (size_t)b * S * D + h * 128; P.qld = 3072; P.kld = 4096;
                    attn_block<0>(lds, P, 7 - x, (int)kq_.var); attn_block<0>(lds, P, x, (int)kq_.var); } } PH_END
        }
        if (kind == 1) {
#define FOX_PTRS bf16_t* qkv = (bf16_t*)w.arena;
            if constexpr (PH_ON(9)) PH_BEGINR(pb + 0, 9) { FOX_PTRS RectSched s; s.init(w.xb0, D, w.fox_win_t, D, NT, 6144); EpiBf16Q e{qkv, 6144, 2048, QSCALE_128}; gemm_phase(lds, D, D, s, e); } PH_END
            if constexpr (PH_ON(10)) PH_BEGINR(pb + 2, 10) { FOX_PTRS
#pragma unroll 1
                for (int p = fk_bid(), np_ = fk_nblk(); p < 256; p += np_) { const int bh = p >> 2, x = p & 3, b = bh >> 4, h = bh & 15;
                    AttnPtrs P; P.Q = qkv + (size_t)b * S * 6144 + h * 128; P.K = P.Q + 2048; P.V = P.Q + 4096; P.KR = nullptr; P.CF = nullptr; P.O = w.o + (size_t)b * S * D + h * 128; P.qld = 6144; P.kld = 6144;
                    fox_cumsum_lds(w.flog, (FK_LAS float*)(lds + AT_CF), (FK_LAS double*)(lds + AT_WS), b, h);
                    attn_block<1>(lds, P, 7 - x, (int)kq_.var); attn_block<1>(lds, P, x, (int)kq_.var); } } PH_END
        }
        if (kind == 2) {
#define DSA_PTRS bf16_t* dq = (bf16_t*)w.arena; bf16_t* dk = dq + (size_t)NT * 2048; bf16_t* dv = dk + (size_t)NT * 128; bf16_t* qidx = dv + (size_t)NT * 128; bf16_t* kidx = qidx + (size_t)NT * 1024; \
            float* widx = (float*)(kidx + (size_t)NT * 64); unsigned short* sel = (unsigned short*)(widx + (size_t)NT * 16); int* nsel = (int*)(sel + (size_t)NT * 256); (void)dq; (void)dk; (void)dv; (void)qidx; (void)kidx; (void)widx; (void)sel; (void)nsel;
            if constexpr (PH_ON(11)) PH_BEGINR(pb + 0, 11) { DSA_PTRS RectSched s; s.init(w.xb0, D, w.dsa_win_t, D, NT, 3584); EpiDsaIn e{dq, dk, dv, qidx, kidx, widx}; gemm_phase(lds, D, D, s, e); } PH_END
            if constexpr (PH_ON(12)) PH_BEGINR(pb + 1, 12) { DSA_PTRS
#pragma unroll 1
                for (int p = fk_bid(), np_ = fk_nblk(); p < 256; p += np_) { const int b = p >> 6, x = p & 63;
                    dsa_index_unit(lds, qidx, kidx, widx, sel, nsel, b, 127 - x, (int)kq_.var); dsa_index_unit(lds, qidx, kidx, widx, sel, nsel, b, x, (int)kq_.var); } } PH_END
            if constexpr (PH_ON(13)) PH_BEGINR(pb + 2, 13) { DSA_PTRS phase_dsa_attn(lds, dq, dk, dv, sel, nsel, w.t5, w.o); } PH_END
        }
        if constexpr (PH_ON(3)) PH_BEGINR(pb + 3, 3) { const bf16_t* wo_t = kind == 0 ? w.mla_wo_t + (size_t)j * D * D : (kind == 1 ? w.fox_wo_t : w.dsa_wo_t); RectSched s; s.init(w.o, D, wo_t, D, NT, D); EpiBf16Q e{(bf16_t*)w.y, D, 0, 1.0f}; gemm_phase(lds, D, D, s, e); } PH_END
        if constexpr (PH_ON(4)) PH_BEGIN(pb + 4) { LnArgs a; a.x = (layer == 0) ? w.x_in : w.xA; a.yb = (const bf16_t*)w.y; a.Y2 = nullptr; a.te = nullptr; a.tpos = nullptr; a.cnt = nullptr; a.g = w.ln_g + (size_t)(layer * 2) * D; a.b = w.ln_b + (size_t)(layer * 2) * D; a.xo = w.xB; a.xbo = w.xb1; a.out2 = nullptr; a.xqo = nullptr;
            a.w4 = (const f32x4*)w.wr4 + (size_t)layer * 128 * 3 * 64; a.ntile = 3; a.bgrp = w.bgrp + layer * 4; a.brt = w.brt + layer * 32; a.rcnt = w.moe_cnt + layer * 1024; a.ote = w.te; a.otpos = w.tpos; a.otw = w.tw; a.list = w.list; a.sw = w.sw; a.flog = nullptr; a.fbias = nullptr; a.var = (int)kq_.var;
            phase_ln(a, lds);
            } PH_END
        if constexpr (PH_ON(5)) PH_BEGINR(pb + 5, 5) { moe_tables(w.moe_cnt + layer * 1024, tab); phase_moe1(lds, tab, w.xb1, w.list, w.sw, w.wgate + (size_t)layer * 32 * D * 512, w.wup + (size_t)layer * 32 * D * 512, w.H, (int)kq_.var, xbw[0] ? (int)bar.x : (fk_bid() & 7), xbw[0] ? (int)xbw[2] : (fk_bid() >> 3), xbw[0] ? (int)xbw[0] : (fk_nblk() >> 3)); } PH_END
        if constexpr (PH_ON(6)) PH_BEGINR(pb + 6, 6) { moe_tables(w.moe_cnt + layer * 1024, tab); phase_moe2(lds, tab, w.H, w.wdown + (size_t)layer * 32 * 512 * D, w.Y2, (int)kq_.var, xbw[0] ? (int)bar.x : (fk_bid() & 7), xbw[0] ? (int)xbw[2] : (fk_bid() >> 3), xbw[0] ? (int)xbw[0] : (fk_nblk() >> 3)); } PH_END
        if constexpr (PH_ON(7)) PH_BEGINR(pb + 7, 7) { LnArgs a; a.x = w.xB; a.yb = nullptr; a.Y2 = w.Y2; a.te = w.te; a.tpos = w.tpos; a.cnt = w.moe_cnt + layer * 1024; a.g = w.ln_g + (size_t)(layer * 2 + 1) * D; a.b = w.ln_b + (size_t)(layer * 2 + 1) * D; a.xo = w.xA; a.xbo = w.xb0; a.xqo = nullptr;
            a.out2 = (layer == 3) ? w.out : nullptr; a.w4 = (layer == 0) ? (const f32x4*)w.fox_wf4 : nullptr; a.ntile = (layer == 0) ? 1 : 0; a.bgrp = nullptr; a.brt = nullptr; a.rcnt = nullptr; a.ote = nullptr; a.otpos = nullptr; a.otw = nullptr; a.list = nullptr; a.sw = nullptr; a.flog = w.flog; a.fbias = w.fox_bf; a.var = 0;
            phase_ln(a, lds); } PH_END
    }
#undef PH_BEGIN
#undef PH_END
}

constexpr size_t CTL_BYTES = 65536;
static FWK make_fwk(void* const* d_in, void* d_out, char* ws) {
    FWK k; memset(&k, 0, sizeof(k));
    k.x_in = (const float*)d_in[0]; k.t5 = (const float*)d_in[1]; k.mla_w_in = (const float*)d_in[2]; k.mla_qn = (const float*)d_in[3]; k.mla_kvn = (const float*)d_in[4]; k.mla_wq = (const float*)d_in[5];
    k.mla_wkv = (const float*)d_in[6]; k.mla_wo = (const float*)d_in[7]; k.fox_w_in = (const float*)d_in[8]; k.fox_bf = (const float*)d_in[9]; k.fox_wo = (const float*)d_in[10]; k.dsa_w_in = (const float*)d_in[11];
    k.dsa_wo = (const float*)d_in[12]; k.ln_g = (const float*)d_in[13]; k.ln_b = (const float*)d_in[14]; k.wgrp = (const float*)d_in[15]; k.bgrp = (const float*)d_in[16]; k.wrt = (const float*)d_in[17];
    k.brt = (const float*)d_in[18]; k.wgate = (const float*)d_in[19]; k.wup = (const float*)d_in[20]; k.wdown = (const float*)d_in[21]; k.out = (float*)d_out; k.ws = ws;
    return k;
}
static void add_job(CvtTable& T, const float* s0, const float* s1, const float* scale, bf16_t* dst, long sbs, long dbs, int K, int N, int Np, int map, int nbatch) {
    CvtJob& J = T.j[T.njobs++]; J.src0 = s0; J.src1 = s1; J.scale = scale; J.dst = dst; J.src_bstride = sbs; J.dst_bstride = dbs; J.K = K; J.N = N; J.Np = Np; J.map = map; J.nbatch = nbatch; J.tile0 = T.ntiles;
    J.wide = ((map == MAP_ID || map == MAP_MOE_GU) && (K % 128 == 0) && (Np % 256 == 0) && (N % 4 == 0)) ? 1 : 0;
    T.ntiles += J.wide ? nbatch * (K / 128) * (Np / 256) : nbatch * (K / 64) * (Np / 64);
}
static void build_table(CvtTable& T, const FW& w, int moe_l0, int moe_l1, bool base) {
    memset(&T, 0, sizeof(T)); T.misc = base ? 1 : 0;
    if (base) {
    for (int j = 0; j < 2; ++j) {
        add_job(T, w.mla_w_in + (size_t)j * D * 1088, nullptr, nullptr, w.mla_win_t + (size_t)j * 1280 * D, 0, 0, D, 1088, 1280, MAP_MLA_IN, 1);
        add_job(T, w.mla_wq + (size_t)j * 512 * 3072, nullptr, w.mla_qn + j * 512, w.mla_wq_t + (size_t)j * 3072 * 512, 0, 0, 512, 3072, 3072, MAP_MLA_Q, 1);
        add_job(T, w.mla_wkv + (size_t)j * 512 * 4096, nullptr, w.mla_kvn + j * 512, w.mla_wkv_t + (size_t)j * 4096 * 512, 0, 0, 512, 4096, 4096, MAP_ID, 1);
        add_job(T, w.mla_wo + (size_t)j * D * D, nullptr, nullptr, w.mla_wo_t + (size_t)j * D * D, 0, 0, D, D, D, MAP_ID, 1);
    }
    add_job(T, w.fox_w_in, nullptr, nullptr, w.fox_win_t, 0, 0, D, 6160, 6144, MAP_ID, 1);
    add_job(T, w.fox_wo, nullptr, nullptr, w.fox_wo_t, 0, 0, D, D, D, MAP_ID, 1);
    add_job(T, w.dsa_w_in, nullptr, nullptr, w.dsa_win_t, 0, 0, D, 3408, 3584, MAP_ID, 1);
    add_job(T, w.dsa_wo, nullptr, nullptr, w.dsa_wo_t, 0, 0, D, D, D, MAP_ID, 1);
    }
    for (int l = moe_l0; l < moe_l1; ++l) {
        add_job(T, w.wgate + (size_t)l * 32 * D * 512, w.wup + (size_t)l * 32 * D * 512, nullptr, w.moe_gu_t + (size_t)l * 32 * 1024 * D, (long)D * 512, (long)1024 * D, D, 512, 1024, MAP_MOE_GU, 32);
        add_job(T, w.wdown + (size_t)l * 32 * 512 * D, nullptr, nullptr, w.moe_d_t + (size_t)l * 32 * D * 512, (long)512 * D, (long)D * 512, 512, D, D, MAP_ID, 32);
    }
}
static int g_grid = 0;
static void setup_once() {
    if (g_grid) return;
    int dev = 0, cus = 0, per_cu = 0;
    (void)hipGetDevice(&dev); (void)hipDeviceGetAttribute(&cus, hipDeviceAttributeMultiprocessorCount, dev);
    (void)per_cu;
    if (cus <= 0) cus = 256;
    g_grid = cus;
}
template <int MASK, int ML> static void launch_mask(const FWK& w, const CvtTable& T, int lo, int hi, hipStream_t st) {
    static bool attr = false; if (!attr) { (void)hipFuncSetAttribute((const void*)fk_fwd<MASK, ML>, hipFuncAttributeMaxDynamicSharedMemorySize, LDS_BYTES); attr = true; }
    hipLaunchKernelGGL((fk_fwd<MASK, ML>), dim3(g_grid), dim3(NTHR), LDS_BYTES, st, w, T, lo, hi);
}
#ifdef FK_DEBUG_BUILD
static void launch_phase(const FWK& w, const CvtTable& T, int p, hipStream_t st) {
    if (p == 0) { launch_mask<(1 << 8), 1>(w, T, p, p + 1, st); return; }
    const int layer = (p - 1) >> 3, k = (p - 1) & 7, kind = layer % 3;
    if (k >= 3) { switch (k) { case 3: launch_mask<(1 << 3), 1>(w, T, p, p + 1, st); break; case 4: launch_mask<(1 << 4), 1>(w, T, p, p + 1, st); break; case 5: launch_mask<(1 << 5), 1>(w, T, p, p + 1, st); break;
                               case 6: launch_mask<(1 << 6), 1>(w, T, p, p + 1, st); break; default: launch_mask<(1 << 7), 1>(w, T, p, p + 1, st); break; } return; }
    if (kind == 0) { if (k == 0) launch_mask<(1 << 0), 1>(w, T, p, p + 1, st); else if (k == 1) launch_mask<(1 << 1), 1>(w, T, p, p + 1, st); else launch_mask<(1 << 2), 1>(w, T, p, p + 1, st); }
    else if (kind == 1) { if (k == 0) launch_mask<(1 << 9), 1>(w, T, p, p + 1, st); else if (k == 2) launch_mask<(1 << 10), 1>(w, T, p, p + 1, st); }
    else { if (k == 0) launch_mask<(1 << 11), 1>(w, T, p, p + 1, st); else if (k == 1) launch_mask<(1 << 12), 1>(w, T, p, p + 1, st); else launch_mask<(1 << 13), 1>(w, T, p, p + 1, st); }
}
#endif
}
#ifndef FK_EXTRA
#define FK_EXTRA {}
#endif
extern "C" void kernel_launch(void* const* d_in, const int* in_sizes, int n_in, void* d_out, int out_size, void* d_ws, size_t ws_size, hipStream_t stream) {
    using namespace fk;
    setup_once();
    const FWK k = make_fwk(d_in, d_out, (char*)d_ws);
    const FW w = make_fw<0>(k, k.ws);
    static CvtTable T; build_table(T, w, 0, 0, true);
    (void)hipMemsetAsync(w.bar, 0, CTL_BYTES, stream);
    launch_mask<0x3FFF, 0>(k, T, 0, 33, stream);
    { static const int extra[] = FK_EXTRA; (void)extra; FWK kv = k;
#ifdef FK_VAR
      kv.var = FK_VAR;
#endif
      for (unsigned i = 0; i < sizeof(extra) / sizeof(int); ++i) launch_mask<0x3FFF, 0>(kv, T, extra[i], extra[i] + 1, stream); }
}
```

```cpp
#include <hip/hip_runtime.h>
#include <stdint.h>
#include <math.h>
#include <string.h>
namespace fk {
#define FK_LAS __attribute__((address_space(3)))
typedef unsigned short bf16_t;
typedef short bf16x8 __attribute__((ext_vector_type(8)));
typedef short s16x4 __attribute__((ext_vector_type(4)));
typedef float f32x4 __attribute__((ext_vector_type(4)));
typedef float f32x16 __attribute__((ext_vector_type(16)));
typedef float f32x2 __attribute__((ext_vector_type(2)));
typedef unsigned u32x4 __attribute__((ext_vector_type(4)));
typedef unsigned u32x2 __attribute__((ext_vector_type(2)));
constexpr int NB = 4, S = 2048, D = 2048, NT = NB * S;
constexpr float ALPHA = 1.681792830507429f;
constexpr float LOG2E = 1.4426950408889634f;
__device__ __forceinline__ int fk_tid();
__device__ __forceinline__ int fk_bid();
__device__ __forceinline__ int fk_nblk();
constexpr int BM = 256, BK = 64, HALF = 128, HTB = HALF * BK * 2, STAGE_BYTES = 8 * HTB;

__device__ __forceinline__ unsigned cvt_pk_bf16(float lo, float hi) { unsigned r; asm volatile("v_cvt_pk_bf16_f32 %0, %1, %2" : "=v"(r) : "v"(lo), "v"(hi)); return r; }
__device__ __forceinline__ float bf2f(bf16_t b) { return __uint_as_float(((unsigned)b) << 16); }
__device__ __forceinline__ bf16_t f2bf(float f) { unsigned u = __float_as_uint(f); u += 0x7FFFu + ((u >> 16) & 1u); return (bf16_t)(u >> 16); }

__host__ __device__ __forceinline__ int lds_byte(int r, int c) { const int st = (r >> 4) * 2 + (c >> 5), rr = r & 15, cc = c & 31, ob = rr * 64 + cc * 2; return st * 1024 + (ob ^ (((ob >> 9) & 1) << 5)); }
__host__ __device__ __forceinline__ void stage_rc(int b, int& R, int& C) { const int st = b / 1024, sb = b % 1024, swz = sb ^ (((sb >> 9) & 1) << 5); R = (st >> 1) * 16 + swz / 64; C = (st & 1) * 32 + (swz % 64) / 2; }
__host__ __device__ __forceinline__ int perm32(int rho) { const int n = rho >> 4, i = rho & 15; return 8 * (i >> 2) + 4 * n + (i & 3); }

struct GUnit { const char* A; const char* B; int pm, pn, e, nrows; };

template <class Epi, class Sched>
__device__ __forceinline__ void gemm_phase(FK_LAS unsigned char* lds, const int K, const int ldb, const Sched& S, const Epi& E) {
    const int tid = fk_tid(), wid = __builtin_amdgcn_readfirstlane(tid >> 6), lane = tid & 63, wr = wid >> 2, wc = wid & 3, fr = lane & 15, fq = lane >> 4;
    const int nt = K / BK;
    unsigned voffB[2];
#pragma unroll
    for (int i = 0; i < 2; ++i) { int R_, C_; stage_rc(tid * 16 + i * 8192, R_, C_); const int Rb = Epi::PERM ? ((R_ & ~31) + perm32(R_ & 31)) : R_; voffB[i] = (unsigned)(Rb * ldb + C_) * 2u; }
    const size_t kstep = (size_t)(BK * 2);
    const size_t hstepB = (size_t)HALF * ldb * 2;
    const unsigned ldsw = (unsigned)wid * 1024u;
    const int aoff = lds_byte(wr * 64 + fr, fq * 8), boff = lds_byte(wc * 32 + fr, fq * 8);
#define PG8_SA(b, h) (((b) * 2 + (h)) * HTB)
#define PG8_SB(b, h) ((4 + (b) * 2 + (h)) * HTB)
#define PG8_STAGE2(bufoff, gbase, v0, v1) do { \
        __builtin_amdgcn_global_load_lds((const unsigned*)((const char*)(gbase) + (v0)), (FK_LAS unsigned*)(lds + (bufoff) + ldsw), 16, 0, 0); \
        __builtin_amdgcn_global_load_lds((const unsigned*)((const char*)(gbase) + (v1)), (FK_LAS unsigned*)(lds + (bufoff) + ldsw + 8192), 16, 0, 0); } while (0)
#define PG8_STAGEB(bufoff, gbase) PG8_STAGE2(bufoff, gbase, voffB[0], voffB[1])
#define PG8_LDA(dst, b, h) do { _Pragma("unroll") for (int m = 0; m < 4; ++m) _Pragma("unroll") for (int k = 0; k < 2; ++k) dst[m][k] = *(const FK_LAS bf16x8*)(lds + PG8_SA(b, h) + aoff + m * 2048 + k * 1024); } while (0)
#define PG8_LDB(dst, b, h) do { _Pragma("unroll") for (int n = 0; n < 2; ++n) _Pragma("unroll") for (int k = 0; k < 2; ++k) dst[n][k] = *(const FK_LAS bf16x8*)(lds + PG8_SB(b, h) + boff + n * 2048 + k * 1024); } while (0)
#define PG8_MMA(ai, bj, At, Bt) do { __builtin_amdgcn_s_setprio(1); _Pragma("unroll") for (int m = 0; m < 4; ++m) _Pragma("unroll") for (int n = 0; n < 2; ++n) _Pragma("unroll") for (int k = 0; k < 2; ++k) \
        acc[ai][bj][m][n] = __builtin_amdgcn_mfma_f32_16x16x32_bf16(Bt[n][k], At[m][k], acc[ai][bj][m][n], 0, 0, 0); __builtin_amdgcn_s_setprio(0); } while (0)
#define PG8_WAIT_V(n) asm volatile("s_waitcnt vmcnt(" #n ")" ::: "memory")
#define PG8_WAIT_L(n) asm volatile("s_waitcnt lgkmcnt(" #n ")" ::: "memory")
#define PG8_BAR __builtin_amdgcn_s_barrier()
#define PG8_SCHED __builtin_amdgcn_sched_barrier(0)
    GUnit cur, nxt; int ui = 0;
    if (!S.next(0, cur)) return;
    f32x4 acc[2][2][4][2];
#pragma unroll
    for (int a = 0; a < 2; ++a)
#pragma unroll
        for (int b = 0; b < 2; ++b)
#pragma unroll
            for (int m = 0; m < 4; ++m)
#pragma unroll
                for (int n = 0; n < 2; ++n) acc[a][b][m][n] = (f32x4){0.f, 0.f, 0.f, 0.f};
    bf16x8 At[4][2], B0[2][2], B1[2][2];
    unsigned oc[2][2], on[2][2];
    S.a_offs(cur, tid, oc);
    const char* cA = cur.A; const char* cB = cur.B;
    PG8_STAGEB(PG8_SB(0, 0), cB); PG8_STAGE2(PG8_SA(0, 0), cA, oc[0][0], oc[0][1]); PG8_STAGEB(PG8_SB(0, 1), cB + hstepB); PG8_STAGE2(PG8_SA(0, 1), cA, oc[1][0], oc[1][1]);
    if (wr == 1) PG8_BAR;
    PG8_WAIT_V(4); PG8_BAR;
    PG8_STAGEB(PG8_SB(1, 0), cB + kstep); PG8_STAGE2(PG8_SA(1, 0), cA + kstep, oc[0][0], oc[0][1]); PG8_STAGEB(PG8_SB(1, 1), cB + hstepB + kstep);
    PG8_WAIT_V(6); PG8_BAR;
    for (;;) {
        const bool has_next = S.next(ui + 1, nxt);
        if (has_next) S.a_offs(nxt, tid, on);
        else {
#pragma unroll
            for (int h = 0; h < 2; ++h)
#pragma unroll
                for (int i = 0; i < 2; ++i) on[h][i] = oc[h][i]; }
        const char* nA = has_next ? nxt.A : cA; const char* nB = has_next ? nxt.B : cB;
        for (int t = 0; t < nt; t += 2) {
            const bool last = (t == nt - 2);
            const char* a1 = cA + (size_t)(t + 1) * kstep;
            const char* a2 = last ? nA : cA + (size_t)(t + 2) * kstep; const char* b2 = last ? nB : cB + (size_t)(t + 2) * kstep;
            const char* a3 = a2 + kstep; const char* b3 = b2 + kstep;
            const unsigned o00 = last ? on[0][0] : oc[0][0], o01 = last ? on[0][1] : oc[0][1], o10 = last ? on[1][0] : oc[1][0], o11 = last ? on[1][1] : oc[1][1];
            PG8_LDB(B0, 0, 0); PG8_SCHED; PG8_LDA(At, 0, 0); PG8_STAGE2(PG8_SA(1, 1), a1, oc[1][0], oc[1][1]);
            PG8_WAIT_L(8); PG8_BAR; PG8_WAIT_L(0); PG8_MMA(0, 0, At, B0); PG8_BAR; PG8_SCHED;
            PG8_LDB(B1, 0, 1); PG8_STAGEB(PG8_SB(0, 0), b2);
            PG8_BAR; PG8_WAIT_L(0); PG8_MMA(0, 1, At, B1); PG8_BAR;
            PG8_LDA(At, 0, 1); PG8_STAGE2(PG8_SA(0, 0), a2, o00, o01);
            PG8_BAR; PG8_WAIT_L(0); PG8_MMA(1, 0, At, B0); PG8_BAR; PG8_SCHED;
            PG8_STAGEB(PG8_SB(0, 1), b2 + hstepB);
            PG8_WAIT_V(6); PG8_BAR; PG8_MMA(1, 1, At, B1); PG8_BAR;
            PG8_LDB(B0, 1, 0); PG8_SCHED; PG8_LDA(At, 1, 0); PG8_STAGE2(PG8_SA(0, 1), a2, o10, o11);
            PG8_WAIT_L(8); PG8_BAR; PG8_WAIT_L(0); PG8_MMA(0, 0, At, B0); PG8_BAR; PG8_SCHED;
            PG8_LDB(B1, 1, 1); PG8_STAGEB(PG8_SB(1, 0), b3);
            PG8_BAR; PG8_WAIT_L(0); PG8_MMA(0, 1, At, B1); PG8_BAR;
            PG8_LDA(At, 1, 1); PG8_STAGE2(PG8_SA(1, 0), a3, o00, o01);
            PG8_BAR; PG8_WAIT_L(0); PG8_MMA(1, 0, At, B0); PG8_BAR; PG8_SCHED;
            PG8_STAGEB(PG8_SB(1, 1), b3 + hstepB);
            PG8_WAIT_V(6); PG8_BAR; PG8_MMA(1, 1, At, B1); PG8_BAR;
        }
        E(acc, cur, wr, wc, fr, fq);
        if (!has_next) break;
#pragma unroll
        for (int a = 0; a < 2; ++a)
#pragma unroll
            for (int b = 0; b < 2; ++b)
#pragma unroll
                for (int m = 0; m < 4; ++m)
#pragma unroll
                    for (int n = 0; n < 2; ++n) acc[a][b][m][n] = (f32x4){0.f, 0.f, 0.f, 0.f};
        cur = nxt; cA = nA; cB = nB; ++ui;
#pragma unroll
        for (int h = 0; h < 2; ++h)
#pragma unroll
            for (int i = 0; i < 2; ++i) oc[h][i] = on[h][i];
    }
    PG8_WAIT_V(0);
    if (wr == 0) PG8_BAR;
    PG8_BAR;
#undef PG8_SA
#undef PG8_SB
#undef PG8_STAGE2
#undef PG8_STAGEB
#undef PG8_LDA
#undef PG8_LDB
#undef PG8_MMA
#undef PG8_WAIT_V
#undef PG8_WAIT_L
#undef PG8_BAR
#undef PG8_SCHED
}
}
namespace fk {
constexpr int NTHR = 512;
constexpr int LDS_BYTES = 147456;
constexpr int HCAP = 24576;
constexpr float QSCALE_MLA = 0.07216878364870322f * LOG2E;
constexpr float QSCALE_128 = 0.08838834764831845f * LOG2E;

struct FW {
    const float *x_in, *t5, *mla_w_in, *mla_qn, *mla_kvn, *mla_wq, *mla_wkv, *mla_wo, *fox_w_in, *fox_bf, *fox_wo, *dsa_w_in, *dsa_wo, *ln_g, *ln_b, *wgrp, *bgrp, *wrt, *brt, *wgate, *wup, *wdown;
    float* out;
    unsigned* bar; int* moe_cnt;
    bf16_t *mla_win_t, *mla_wq_t, *mla_wkv_t, *mla_wo_t, *fox_win_t, *fox_wo_t, *dsa_win_t, *dsa_wo_t, *moe_gu_t, *moe_d_t;
    float *wr4, *fox_wf4; f32x2* rope_cs;
    float *xA, *xB, *y; bf16_t *xb0, *xb1, *o;
    char* arena;
    float* ss;
    float *flog, *cf2;
    int *te, *tpos, *list; float *tw, *sw; bf16_t *H, *Y2; unsigned char* x1q;
};

struct FWK { const float *x_in, *t5, *mla_w_in, *mla_qn, *mla_kvn, *mla_wq, *mla_wkv, *mla_wo, *fox_w_in, *fox_bf, *fox_wo, *dsa_w_in, *dsa_wo, *ln_g, *ln_b, *wgrp, *bgrp, *wrt, *brt, *wgate, *wup, *wdown; float* out; char* ws; long moe_bias_gu, moe_bias_d; long var; };
constexpr size_t al256(size_t x) { return (x + 255) & ~(size_t)255; }
template <int MOE_LAYERS> struct WsMap {
    static constexpr size_t CTL = 0, CTL_BYTES = 65536;
    static constexpr size_t MLA_WIN_T = CTL + CTL_BYTES, MLA_WQ_T = MLA_WIN_T + al256((size_t)2 * 1280 * D * 2), MLA_WKV_T = MLA_WQ_T + al256((size_t)2 * 3072 * 512 * 2), MLA_WO_T = MLA_WKV_T + al256((size_t)2 * 4096 * 512 * 2);
    static constexpr size_t FOX_WIN_T = MLA_WO_T + al256((size_t)2 * D * D * 2), FOX_WO_T = FOX_WIN_T + al256((size_t)6144 * D * 2), DSA_WIN_T = FOX_WO_T + al256((size_t)D * D * 2), DSA_WO_T = DSA_WIN_T + al256((size_t)3584 * D * 2);
    static constexpr size_t MOE_GU_T = DSA_WO_T + al256((size_t)D * D * 2), MOE_D_T = MOE_GU_T + al256((size_t)MOE_LAYERS * 32 * 1024 * D * 2);
    static constexpr size_t WR4 = MOE_D_T + al256((size_t)MOE_LAYERS * 32 * D * 512 * 2), FOX_WF4 = WR4 + al256((size_t)4 * D * 48 * 4), ROPE = FOX_WF4 + al256((size_t)D * 16 * 4);
    static constexpr size_t XA = ROPE + al256((size_t)S * 32 * 8), XB = XA + al256((size_t)NT * D * 4), Y = XB + al256((size_t)NT * D * 4);
    static constexpr size_t XB0 = Y + al256((size_t)NT * D * 4), XB1 = XB0 + al256((size_t)NT * D * 2), O = XB1 + al256((size_t)NT * D * 2), ARENA = O + al256((size_t)NT * D * 2);
    static constexpr size_t SS = ARENA + al256((size_t)NT * (512 + 512 + 64 + 3072 + 4096) * 2), FLOG = SS + al256((size_t)NT * 2 * 8 * 4), CF2 = FLOG + al256((size_t)NT * 16 * 4);
    static constexpr size_t TE = CF2 + al256((size_t)NB * 16 * S * 4), TPOS = TE + al256((size_t)NT * 2 * 4), LIST = TPOS + al256((size_t)NT * 2 * 4), TW = LIST + al256((size_t)32 * NT * 4), SW = TW + al256((size_t)NT * 2 * 4);
    static constexpr size_t H = SW + al256((size_t)32 * NT * 4), Y2 = H + al256((size_t)HCAP * 512 * 2), X1Q = Y2 + al256((size_t)HCAP * D * 2), END = X1Q + al256((size_t)NT * D);
};
template <int ML> __host__ __device__ __forceinline__ FW make_fw(const FWK& k, char* ws) {
    typedef WsMap<ML> M; FW w;
    w.x_in = k.x_in; w.t5 = k.t5; w.mla_w_in = k.mla_w_in; w.mla_qn = k.mla_qn; w.mla_kvn = k.mla_kvn; w.mla_wq = k.mla_wq; w.mla_wkv = k.mla_wkv; w.mla_wo = k.mla_wo; w.fox_w_in = k.fox_w_in; w.fox_bf = k.fox_bf; w.fox_wo = k.fox_wo;
    w.dsa_w_in = k.dsa_w_in; w.dsa_wo = k.dsa_wo; w.ln_g = k.ln_g; w.ln_b = k.ln_b; w.wgrp = k.wgrp; w.bgrp = k.bgrp; w.wrt = k.wrt; w.brt = k.brt; w.wgate = k.wgate; w.wup = k.wup; w.wdown = k.wdown; w.out = k.out;
    w.bar = (unsigned*)(ws + M::CTL); w.moe_cnt = (int*)(ws + M::CTL + 32768);
    w.mla_win_t = (bf16_t*)(ws + M::MLA_WIN_T); w.mla_wq_t = (bf16_t*)(ws + M::MLA_WQ_T); w.mla_wkv_t = (bf16_t*)(ws + M::MLA_WKV_T); w.mla_wo_t = (bf16_t*)(ws + M::MLA_WO_T);
    w.fox_win_t = (bf16_t*)(ws + M::FOX_WIN_T); w.fox_wo_t = (bf16_t*)(ws + M::FOX_WO_T); w.dsa_win_t = (bf16_t*)(ws + M::DSA_WIN_T); w.dsa_wo_t = (bf16_t*)(ws + M::DSA_WO_T);
    w.moe_gu_t = (bf16_t*)(ws + M::MOE_GU_T) - k.moe_bias_gu; w.moe_d_t = (bf16_t*)(ws + M::MOE_D_T) - k.moe_bias_d;
    w.wr4 = (float*)(ws + M::WR4); w.fox_wf4 = (float*)(ws + M::FOX_WF4); w.rope_cs = (f32x2*)(ws + M::ROPE);
    w.xA = (float*)(ws + M::XA); w.xB = (float*)(ws + M::XB); w.y = (float*)(ws + M::Y); w.xb0 = (bf16_t*)(ws + M::XB0); w.xb1 = (bf16_t*)(ws + M::XB1); w.o = (bf16_t*)(ws + M::O); w.arena = ws + M::ARENA;
    w.ss = (float*)(ws + M::SS); w.flog = (float*)(ws + M::FLOG); w.cf2 = (float*)(ws + M::CF2);
    w.te = (int*)(ws + M::TE); w.tpos = (int*)(ws + M::TPOS); w.list = (int*)(ws + M::LIST); w.tw = (float*)(ws + M::TW); w.sw = (float*)(ws + M::SW); w.H = (bf16_t*)(ws + M::H); w.Y2 = (bf16_t*)(ws + M::Y2); w.x1q = (unsigned char*)(ws + M::X1Q);
    return w;
}
__device__ __forceinline__ int fk_tid() { int t = threadIdx.x; asm volatile("" : "+v"(t)); return t; }
__device__ __forceinline__ int fk_bid() { int t = blockIdx.x; asm volatile("" : "+s"(t)); return t; }
__device__ __forceinline__ int fk_nblk() { int t = gridDim.x; asm volatile("" : "+s"(t)); return t; }

enum { MAP_ID = 0, MAP_MLA_IN = 1, MAP_MLA_Q = 2, MAP_MOE_GU = 3 };
struct CvtJob { const float* src0; const float* src1; const float* scale; bf16_t* dst; long src_bstride, dst_bstride; int K, N, Np, map, nbatch, tile0, wide, pad; };
constexpr int MAXJOBS = 24;
struct CvtTable { CvtJob j[MAXJOBS]; int njobs, ntiles, misc, pad; };

__device__ __forceinline__ int map_col(int map, int np, int N, int& which) {
    which = 0;
    if (map == MAP_ID) return np < N ? np : -1;
    if (map == MAP_MLA_IN) { if (np < 1024) return np; if (np < 1088) { const int i = np - 1024; return 1024 + (i >> 1) + 32 * (i & 1); } return -1; }
    if (map == MAP_MLA_Q) { const int h = np / 192, j = np % 192; if (j < 128) return np; const int i = j - 128; return h * 192 + 128 + (i >> 1) + 32 * (i & 1); }
      { const int q = np >> 5, r = np & 31; which = r >> 4; return 16 * q + (r & 15); }
}
__device__ __forceinline__ void cvt_tile(const CvtJob& J, int lt, FK_LAS float* tile  , const int tid) {
    const int tk = J.K / 64, tn = J.Np / 64, per = tk * tn;
    const int b = lt / per, r = lt % per, tkk = r % tk, tnn = r / tk;
    const int k0 = tkk * 64, n0 = tnn * 64;
    const float* s0 = J.src0 + (size_t)b * J.src_bstride; const float* s1 = J.src1 ? J.src1 + (size_t)b * J.src_bstride : nullptr;
    bf16_t* d = J.dst + (size_t)b * J.dst_bstride;
    { const int np = n0 + (tid & 63); int which; const int sc = map_col(J.map, np, J.N, which); const float* s = which ? s1 : s0;
#pragma unroll
      for (int i = 0; i < 8; ++i) { const int k = (tid >> 6) + 8 * i; float v = 0.f; if (sc >= 0) { v = s[(size_t)(k0 + k) * J.N + sc]; if (J.scale) v *= J.scale[k0 + k]; } tile[k * 65 + (tid & 63)] = v; } }
    __syncthreads();
    { const int np = tid >> 3, kg = (tid & 7) * 8; float v[8];
#pragma unroll
      for (int j = 0; j < 8; ++j) v[j] = tile[(kg + j) * 65 + np];
      u32x4 w; w.x = cvt_pk_bf16(v[0], v[1]); w.y = cvt_pk_bf16(v[2], v[3]); w.z = cvt_pk_bf16(v[4], v[5]); w.w = cvt_pk_bf16(v[6], v[7]);
      *(u32x4*)(d + (size_t)(n0 + np) * J.K + k0 + kg) = w; }
    __syncthreads();
}
__device__ __forceinline__ void cvt_tile_wide(const CvtJob& J, int lt, FK_LAS unsigned char* img, const int tid) {
    const int wid = tid >> 6, lane = tid & 63;
    const int tk = J.K / 128, tn = J.Np / 256, per = tk * tn;
    const int b = lt / per, r = lt % per, tkk = r % tk, tnn = r / tk;
    const int k0 = tkk * 128, n0 = tnn * 256;
    const float* s0 = J.src0 + (size_t)b * J.src_bstride; const float* s1 = J.src1 ? J.src1 + (size_t)b * J.src_bstride : nullptr;
    bf16_t* d = J.dst + (size_t)b * J.dst_bstride;
    const int np = n0 + 4 * lane; int which; const int sc = map_col(J.map, np, J.N, which); const float* s = which ? s1 : s0;
    const bool ok = sc >= 0 && sc + 3 < J.N;
    f32x4 v[16];
#pragma unroll
    for (int i = 0; i < 16; ++i) { const int k = k0 + wid * 16 + i; v[i] = ok ? *(const f32x4*)(s + (size_t)k * J.N + sc) : (f32x4){0.f, 0.f, 0.f, 0.f}; if (J.scale) v[i] = v[i] * J.scale[k]; }
#pragma unroll
    for (int j = 0; j < 4; ++j) { const int n = 4 * lane + j;
#pragma unroll
        for (int h = 0; h < 2; ++h) { u32x4 w; w.x = cvt_pk_bf16(v[8 * h + 0][j], v[8 * h + 1][j]); w.y = cvt_pk_bf16(v[8 * h + 2][j], v[8 * h + 3][j]); w.z = cvt_pk_bf16(v[8 * h + 4][j], v[8 * h + 5][j]); w.w = cvt_pk_bf16(v[8 * h + 6][j], v[8 * h + 7][j]);
            const int c = wid * 2 + h; *(FK_LAS u32x4*)(img + n * 256 + ((c ^ (n & 15)) << 4)) = w; } }
    __syncthreads();
#pragma unroll
    for (int i = 0; i < 8; ++i) { const int idx = tid + 512 * i, n = idx >> 4, c = idx & 15; const u32x4 w = *(FK_LAS const u32x4*)(img + n * 256 + ((c ^ (n & 15)) << 4));
        *(u32x4*)(d + (size_t)(n0 + n) * J.K + k0 + c * 8) = w; }
    __syncthreads();
}
__device__ __forceinline__ void phase_prologue(const FW& w, const CvtTable& T, FK_LAS unsigned char* lds) {
    FK_LAS float* tile = (FK_LAS float*)lds; const int tid0 = fk_tid();
    for (int t = fk_bid(); t < T.ntiles; t += fk_nblk()) {
        int ji = 0;
#pragma unroll 1
        for (int q = 1; q < T.njobs; ++q) if (t >= T.j[q].tile0) ji = q;
        if (T.j[ji].wide) cvt_tile_wide(T.j[ji], t - T.j[ji].tile0, lds, tid0); else cvt_tile(T.j[ji], t - T.j[ji].tile0, tile, tid0);
    }
    if (!T.misc) return;
    const int gt = fk_bid() * NTHR + tid0, gn = fk_nblk() * NTHR;
    for (int i = gt; i < S * 32; i += gn) { const int pos = i >> 5, j = i & 31; const float invf = powf(10000.f, -(float)j / 32.f); const float ang = (float)pos * invf; w.rope_cs[i] = (f32x2){cosf(ang), sinf(ang)}; }
    for (int i = gt; i < 4 * 128 * 3 * 64 * 4; i += gn) { const int ii = i & 3, lane = (i >> 2) & 63, q = i >> 8, nt = q % 3, kg = (q / 3) & 127, layer = q / (3 * 128); const int k = 16 * kg + 4 * (lane >> 4) + ii, n = 16 * nt + (lane & 15);
        float v = 0.f; if (n < 4) v = w.wgrp[((size_t)layer * D + k) * 4 + n]; else if (n < 36) v = w.wrt[((size_t)layer * D + k) * 32 + (n - 4)]; w.wr4[i] = v; }
    for (int i = gt; i < 128 * 64 * 4; i += gn) { const int ii = i & 3, lane = (i >> 2) & 63, kg = i >> 8; const int k = 16 * kg + 4 * (lane >> 4) + ii; w.fox_wf4[i] = w.fox_w_in[(size_t)k * 6160 + 6144 + (lane & 15)]; }
    for (int i = gt; i < NT * D / 4; i += gn) { const f32x4 v = ((const f32x4*)w.x_in)[i]; u32x2 p; p.x = cvt_pk_bf16(v[0], v[1]); p.y = cvt_pk_bf16(v[2], v[3]); ((u32x2*)w.xb0)[i] = p; }
}

struct RectSched {
    const char* A; const char* B; int lda, ldb, nM, nN, nwg, G, c;
    __device__ void init(const bf16_t* A_, int lda_, const bf16_t* B_, int ldb_, int M, int N) { A = (const char*)A_; B = (const char*)B_; lda = lda_; ldb = ldb_; nM = M / BM; nN = N / BM; nwg = nM * nN; G = fk_nblk(); c = fk_bid(); }
    __device__ __forceinline__ bool tile(int i, int& pm, int& pn) const {
        const long L = (long)i * G + c; if (L >= nwg) return false;
        int wgid = (int)L; { const int q = nwg / 8, r = nwg % 8, xcd = wgid % 8, off = wgid / 8; wgid = (xcd < r ? xcd * (q + 1) : r * (q + 1) + (xcd - r) * q) + off; }
        const int nig = 8 * nN, gid = wgid / nig, fm = gid * 8, gsz = (nM - fm) < 8 ? (nM - fm) : 8;
        pm = fm + ((wgid % nig) % gsz); pn = (wgid % nig) / gsz; return true;
    }
    __device__ __forceinline__ bool next(int i, GUnit& u) const { int pm, pn; if (!tile(i, pm, pn)) return false; u.pm = pm; u.pn = pn; u.e = 0; u.nrows = BM; u.A = A + (size_t)pm * BM * lda * 2; u.B = B + (size_t)pn * BM * ldb * 2; return true; }
    __device__ __forceinline__ void a_offs(const GUnit&, int tid, unsigned (&o)[2][2]) const { int R0, C0, R1, C1; stage_rc(tid * 16, R0, C0); stage_rc(tid * 16 + 8192, R1, C1);
        o[0][0] = (unsigned)(R0 * lda + C0) * 2u; o[0][1] = (unsigned)(R1 * lda + C1) * 2u; o[1][0] = o[0][0] + (unsigned)(HALF * lda * 2); o[1][1] = o[0][1] + (unsigned)(HALF * lda * 2); }
};
struct Rect2Sched {
    RectSched s0, s1; int n0;
    __device__ __forceinline__ bool next(int i, GUnit& u) const {
        const long L = (long)i * s0.G + s0.c; const int tot = s0.nwg + s1.nwg; if (L >= tot) return false;
        if (L < s0.nwg) { const int pm = (int)L % s0.nM, pn = (int)L / s0.nM; u.pm = pm; u.pn = pn; u.e = 0; u.nrows = BM; u.A = s0.A + (size_t)pm * BM * s0.lda * 2; u.B = s0.B + (size_t)pn * BM * s0.ldb * 2; }
        else { const int l = (int)L - s0.nwg; const int pm = l % s1.nM, pn = l / s1.nM; u.pm = pm; u.pn = pn; u.e = 1; u.nrows = BM; u.A = s1.A + (size_t)pm * BM * s1.lda * 2; u.B = s1.B + (size_t)pn * BM * s1.ldb * 2; }
        return true; }
    __device__ __forceinline__ void a_offs(const GUnit& u, int tid, unsigned (&o)[2][2]) const { s0.a_offs(u, tid, o); }
};

struct EpiF32 {
    static constexpr bool PERM = false;
    float* Cp; int ldc;
    __device__ __forceinline__ void operator()(const f32x4 (&acc)[2][2][4][2], const GUnit& u, int wr, int wc, int fr, int fq) const {
        const int row0 = u.pm * BM + wr * 64 + fr, col0 = u.pn * BM + wc * 32 + 4 * fq;
#pragma unroll
        for (int ai = 0; ai < 2; ++ai)
#pragma unroll
            for (int m = 0; m < 4; ++m) { float* rowp = Cp + (size_t)(row0 + ai * HALF + m * 16) * ldc + col0;
#pragma unroll
                for (int bj = 0; bj < 2; ++bj)
#pragma unroll
                    for (int n = 0; n < 2; ++n) *(f32x4*)(rowp + bj * HALF + n * 16) = acc[ai][bj][m][n]; }
    }
};
__device__ __forceinline__ u32x4 pack8(const f32x4& a, const f32x4& b) { u32x4 w; w.x = cvt_pk_bf16(a[0], a[1]); w.y = cvt_pk_bf16(a[2], a[3]); w.z = cvt_pk_bf16(b[0], b[1]); w.w = cvt_pk_bf16(b[2], b[3]); return w; }
__device__ __forceinline__ void rope8(f32x4& v0, f32x4& v1, const f32x2* cs) {
    const f32x4 c01 = *(const f32x4*)cs, c23 = *(const f32x4*)(cs + 2);
    f32x4 r0, r1;
    r0[0] = v0[0] * c01[0] - v0[1] * c01[1]; r0[1] = v0[1] * c01[0] + v0[0] * c01[1]; r0[2] = v0[2] * c01[2] - v0[3] * c01[3]; r0[3] = v0[3] * c01[2] + v0[2] * c01[3];
    r1[0] = v1[0] * c23[0] - v1[1] * c23[1]; r1[1] = v1[1] * c23[0] + v1[0] * c23[1]; r1[2] = v1[2] * c23[2] - v1[3] * c23[3]; r1[3] = v1[3] * c23[2] + v1[2] * c23[3];
    v0 = r0; v1 = r1;
}
struct EpiMlaIn {
    static constexpr bool PERM = true;
    bf16_t *cq, *ckv, *kr; float* ss; const f32x2* cs;
    __device__ __forceinline__ void operator()(const f32x4 (&acc)[2][2][4][2], const GUnit& u, int wr, int wc, int fr, int fq) const {
        const int row0 = u.pm * BM + wr * 64 + fr;
        if (u.pn < 4) {
            bf16_t* dst = (u.pn < 2) ? cq : ckv; const int which = u.pn >> 1; const int col0 = (u.pn & 1) * BM + wc * 32 + 8 * fq;
#pragma unroll
            for (int ai = 0; ai < 2; ++ai)
#pragma unroll
                for (int m = 0; m < 4; ++m) { const int row = row0 + ai * HALF + m * 16; float q = 0.f;
#pragma unroll
                    for (int bj = 0; bj < 2; ++bj) { const f32x4 v0 = acc[ai][bj][m][0], v1 = acc[ai][bj][m][1];
                        q += (v0[0] * v0[0] + v0[1] * v0[1]) + (v0[2] * v0[2] + v0[3] * v0[3]) + (v1[0] * v1[0] + v1[1] * v1[1]) + (v1[2] * v1[2] + v1[3] * v1[3]);
                        *(u32x4*)(dst + (size_t)row * 512 + col0 + bj * HALF) = pack8(v0, v1); }
                    q += __shfl_xor(q, 16); q += __shfl_xor(q, 32);
                    if (fq == 0) ss[((size_t)row * 2 + which) * 8 + (u.pn & 1) * 4 + wc] = q; }
        } else if (wc < 2) {
#pragma unroll
            for (int ai = 0; ai < 2; ++ai) { f32x4 c01[4], c23[4];
#pragma unroll
                for (int m = 0; m < 4; ++m) { const int row = row0 + ai * HALF + m * 16; const f32x2* cp = cs + (size_t)(row & (S - 1)) * 32 + 16 * wc + 4 * fq; c01[m] = *(const f32x4*)cp; c23[m] = *(const f32x4*)(cp + 2); }
#pragma unroll
                for (int m = 0; m < 4; ++m) { const int row = row0 + ai * HALF + m * 16; const f32x4 v0 = acc[ai][0][m][0], v1 = acc[ai][0][m][1]; const f32x4 a = c01[m], b = c23[m]; f32x4 r0, r1;
                    r0[0] = v0[0] * a[0] - v0[1] * a[1]; r0[1] = v0[1] * a[0] + v0[0] * a[1]; r0[2] = v0[2] * a[2] - v0[3] * a[3]; r0[3] = v0[3] * a[2] + v0[2] * a[3];
                    r1[0] = v1[0] * b[0] - v1[1] * b[1]; r1[1] = v1[1] * b[0] + v1[0] * b[1]; r1[2] = v1[2] * b[2] - v1[3] * b[3]; r1[3] = v1[3] * b[2] + v1[2] * b[3];
                    *(u32x4*)(kr + (size_t)row * 64 + wc * 32 + 8 * fq) = pack8(r0, r1); } }
        }
    }
};
struct EpiMlaQKV {
    static constexpr bool PERM = true;
    bf16_t *q, *kv; const float* ss; const f32x2* cs;
    __device__ __forceinline__ void operator()(const f32x4 (&acc)[2][2][4][2], const GUnit& u, int wr, int wc, int fr, int fq) const {
        const int row0 = u.pm * BM + wr * 64 + fr;
#pragma unroll
        for (int ai = 0; ai < 2; ++ai) {
            float rs[4];
            { f32x4 sa[4], sb[4];
#pragma unroll
              for (int m = 0; m < 4; ++m) { const int row = row0 + ai * HALF + m * 16; sa[m] = *(const f32x4*)(ss + ((size_t)row * 2 + u.e) * 8); sb[m] = *(const f32x4*)(ss + ((size_t)row * 2 + u.e) * 8 + 4); }
#pragma unroll
              for (int m = 0; m < 4; ++m) rs[m] = rsqrtf((((sa[m][0] + sa[m][1]) + (sa[m][2] + sa[m][3])) + ((sb[m][0] + sb[m][1]) + (sb[m][2] + sb[m][3]))) * (1.0f / 512.0f) + 1e-6f); }
#pragma unroll
            for (int bj = 0; bj < 2; ++bj) { const int gc = u.pn * BM + bj * HALF + wc * 32 + 8 * fq; const int j = gc % 192; const bool rope = __builtin_amdgcn_readfirstlane((int)((u.e == 0) && (j >= 128))) != 0;
                f32x4 c01[4], c23[4];
                if (rope) {
#pragma unroll
                    for (int m = 0; m < 4; ++m) { const int row = row0 + ai * HALF + m * 16; const f32x2* cp = cs + (size_t)(row & (S - 1)) * 32 + ((j - 128) >> 1); c01[m] = *(const f32x4*)cp; c23[m] = *(const f32x4*)(cp + 2); } }
#pragma unroll
                for (int m = 0; m < 4; ++m) { const int row = row0 + ai * HALF + m * 16; f32x4 v0 = acc[ai][bj][m][0] * rs[m], v1 = acc[ai][bj][m][1] * rs[m];
                    if (u.e == 0) {
                        if (rope) { f32x4 r0, r1; const f32x4 a = c01[m], b = c23[m];
                            r0[0] = v0[0] * a[0] - v0[1] * a[1]; r0[1] = v0[1] * a[0] + v0[0] * a[1]; r0[2] = v0[2] * a[2] - v0[3] * a[3]; r0[3] = v0[3] * a[2] + v0[2] * a[3];
                            r1[0] = v1[0] * b[0] - v1[1] * b[1]; r1[1] = v1[1] * b[0] + v1[0] * b[1]; r1[2] = v1[2] * b[2] - v1[3] * b[3]; r1[3] = v1[3] * b[2] + v1[2] * b[3]; v0 = r0; v1 = r1; }
                        v0 = v0 * QSCALE_MLA; v1 = v1 * QSCALE_MLA; *(u32x4*)(q + (size_t)row * 3072 + gc) = pack8(v0, v1); }
                    else *(u32x4*)(kv + (size_t)row * 4096 + gc) = pack8(v0, v1); } }
        }
    }
};
}
namespace fk {
#define FK_KSWZ(row, colB) ((row) * 256 + ((colB) ^ (((row) & 7) << 4)))
#define FK_KRSWZ(row, ch) ((row) * 128 + ((((ch)) ^ (((row) >> 1) & 7)) << 4))
__device__ __forceinline__ int v_st(int k, int c) { const int kk = (k & ~0xC) | ((k & 4) << 1) | ((k & 8) >> 1); return ((kk >> 3) * 4 + (c >> 5)) * 512 + ((kk & 7) * 32 + (c & 31)) * 2; }
__device__ __forceinline__ int v_rd_base(int lane) { return ((lane & 3) << 3) | (((lane >> 2) & 3) << 6) | (((lane >> 4) & 1) << 5) | (((lane >> 5) & 1) << 8); }
__device__ __forceinline__ int crow(int r, int hi) { return (r & 3) + 8 * (r >> 2) + 4 * hi; }

constexpr int AT_K = 0, AT_V = 32768, AT_KR = 65536, AT_CF = 81920, AT_WS = 90112;

struct AttnPtrs { const bf16_t* Q; const bf16_t* K; const bf16_t* V; const bf16_t* KR; const float* CF; bf16_t* O; int qld, kld; };

template <int MODE>
__device__ __forceinline__ void attn_block(FK_LAS unsigned char* lds, const AttnPtrs P, const int qb) {
    constexpr int NQ = MODE == 0 ? 12 : 8;
    const int tid = fk_tid(), wid = __builtin_amdgcn_readfirstlane(tid >> 6), lane = tid & 63, r32 = lane & 31, hi = lane >> 5;
    const int q0w = qb * 256 + wid * 32;
    const int nt = 4 * (qb + 1);
    bf16x8 qr[NQ];
    { const bf16_t* qrow = P.Q + (size_t)(q0w + r32) * P.qld;
#pragma unroll
      for (int d0 = 0; d0 < NQ; ++d0) qr[d0] = *(const bf16x8*)(qrow + d0 * 16 + hi * 8); }
    float ct2 = 0.f; if (MODE == 1) ct2 = ((FK_LAS const float*)(lds + AT_CF))[q0w + r32];
    const int sr = tid >> 4, sc = (tid & 15) * 8;
    const int kws = FK_KSWZ(sr, sc * 2), vst0 = v_st(sr, sc), vst1 = v_st(32 + sr, sc);
    const int krr = tid >> 3, krc = tid & 7, krw = FK_KRSWZ(krr, krc);
    const int vb0 = AT_V + v_rd_base(lane);
    FK_LAS float* wsl = (FK_LAS float*)(lds + AT_WS) + wid * 64;
    bf16x8 sk0, sk1, sv0, sv1, skr;
    float m_reg = -1e30f, l_reg = 0.f; f32x16 o[4];
#pragma unroll
    for (int d = 0; d < 4; ++d)
#pragma unroll
        for (int r = 0; r < 16; ++r) o[d][r] = 0.f;
#define AT_LOAD(j) do { const size_t k0_ = (size_t)(j) * 64; \
        sk0 = *(const bf16x8*)(P.K + (k0_ + sr) * P.kld + sc); sk1 = *(const bf16x8*)(P.K + (k0_ + 32 + sr) * P.kld + sc); \
        sv0 = *(const bf16x8*)(P.V + (k0_ + sr) * P.kld + sc); sv1 = *(const bf16x8*)(P.V + (k0_ + 32 + sr) * P.kld + sc); \
        if (MODE == 0) skr = *(const bf16x8*)(P.KR + (k0_ + krr) * 64 + krc * 8); \
        } while (0)
#define AT_WRITE(bf) do { *(FK_LAS bf16x8*)(lds + AT_K + (bf) * 16384 + kws) = sk0; *(FK_LAS bf16x8*)(lds + AT_K + (bf) * 16384 + kws + 32 * 256) = sk1; \
        *(FK_LAS bf16x8*)(lds + AT_V + (bf) * 16384 + vst0) = sv0; *(FK_LAS bf16x8*)(lds + AT_V + (bf) * 16384 + vst1) = sv1; \
        if (MODE == 0) *(FK_LAS bf16x8*)(lds + AT_KR + (bf) * 8192 + krw) = skr; \
        } while (0)
#define AT_TRRD(dst, off) asm volatile("ds_read_b64_tr_b16 %0, %1 offset:%2" : "=&v"(dst) : "v"(vb0), "i"(off) : "memory")
#define AT_PV_D0(KB, d0) do { s16x4 l0, l1, l2, l3, h0, h1, h2, h3; constexpr int b_ = (KB) * 16384 + (d0) * 512; \
        AT_TRRD(l0, b_); AT_TRRD(h0, b_ + 2048); AT_TRRD(l1, b_ + 4096); AT_TRRD(h1, b_ + 6144); AT_TRRD(l2, b_ + 8192); AT_TRRD(h2, b_ + 10240); AT_TRRD(l3, b_ + 12288); AT_TRRD(h3, b_ + 14336); \
        asm volatile("s_waitcnt lgkmcnt(0)" ::: "memory"); __builtin_amdgcn_sched_barrier(0); \
        o[d0] = __builtin_amdgcn_mfma_f32_32x32x16_bf16(pa0, (bf16x8){l0[0], l0[1], l0[2], l0[3], h0[0], h0[1], h0[2], h0[3]}, o[d0], 0, 0, 0); \
        o[d0] = __builtin_amdgcn_mfma_f32_32x32x16_bf16(pa1, (bf16x8){l1[0], l1[1], l1[2], l1[3], h1[0], h1[1], h1[2], h1[3]}, o[d0], 0, 0, 0); \
        o[d0] = __builtin_amdgcn_mfma_f32_32x32x16_bf16(pa2, (bf16x8){l2[0], l2[1], l2[2], l2[3], h2[0], h2[1], h2[2], h2[3]}, o[d0], 0, 0, 0); \
        o[d0] = __builtin_amdgcn_mfma_f32_32x32x16_bf16(pa3, (bf16x8){l3[0], l3[1], l3[2], l3[3], h3[0], h3[1], h3[2], h3[3]}, o[d0], 0, 0, 0); } while (0)
#define AT_PK4(Pv, B_, OUT) do { unsigned a0 = cvt_pk_bf16(Pv[B_ + 0], Pv[B_ + 1]), a1 = cvt_pk_bf16(Pv[B_ + 2], Pv[B_ + 3]); \
        unsigned b0 = cvt_pk_bf16(Pv[B_ + 4], Pv[B_ + 5]), b1 = cvt_pk_bf16(Pv[B_ + 6], Pv[B_ + 7]); \
        auto r0 = __builtin_amdgcn_permlane32_swap(a0, b0, false, false); auto r1 = __builtin_amdgcn_permlane32_swap(a1, b1, false, false); \
        u32x4 w_ = {r0[0], r1[0], r0[1], r1[1]}; OUT = *reinterpret_cast<bf16x8*>(&w_); } while (0)
#define AT_STEP(j, KB) do { \
        if ((j) + 1 < nt) AT_LOAD((j) + 1); \
        if ((j) * 64 <= q0w) { \
            f32x16 p0, p1; \
            _Pragma("unroll") for (int r = 0; r < 16; ++r) { p0[r] = 0.f; p1[r] = 0.f; } \
            __builtin_amdgcn_s_setprio(1); \
            { FK_LAS const unsigned char* kb_ = lds + AT_K + (KB) * 16384; \
              _Pragma("unroll") for (int d0 = 0; d0 < 8; ++d0) { \
                const bf16x8 b0 = *(FK_LAS const bf16x8*)(kb_ + FK_KSWZ(r32, (d0 * 16 + hi * 8) * 2)); \
                const bf16x8 b1 = *(FK_LAS const bf16x8*)(kb_ + FK_KSWZ(r32, (d0 * 16 + hi * 8) * 2) + 32 * 256); \
                p0 = __builtin_amdgcn_mfma_f32_32x32x16_bf16(b0, qr[d0], p0, 0, 0, 0); \
                p1 = __builtin_amdgcn_mfma_f32_32x32x16_bf16(b1, qr[d0], p1, 0, 0, 0); } } \
            if (MODE == 0) { FK_LAS const unsigned char* kr_ = lds + AT_KR + (KB) * 8192; \
              _Pragma("unroll") for (int d0 = 0; d0 < 4; ++d0) { \
                const bf16x8 b0 = *(FK_LAS const bf16x8*)(kr_ + FK_KRSWZ(r32, 2 * d0 + hi)); \
                const bf16x8 b1 = *(FK_LAS const bf16x8*)(kr_ + FK_KRSWZ(r32 + 32, 2 * d0 + hi)); \
                p0 = __builtin_amdgcn_mfma_f32_32x32x16_bf16(b0, qr[(MODE == 0 ? 8 : 0) + d0], p0, 0, 0, 0); \
                p1 = __builtin_amdgcn_mfma_f32_32x32x16_bf16(b1, qr[(MODE == 0 ? 8 : 0) + d0], p1, 0, 0, 0); } } \
            __builtin_amdgcn_s_setprio(0); \
            if (MODE == 1) { FK_LAS const float* cf_ = (FK_LAS const float*)(lds + AT_CF) + (j) * 64; \
              _Pragma("unroll") for (int g = 0; g < 4; ++g) { const f32x4 c0 = *(FK_LAS const f32x4*)(cf_ + 8 * g + 4 * hi), c1 = *(FK_LAS const f32x4*)(cf_ + 32 + 8 * g + 4 * hi); \
                _Pragma("unroll") for (int i = 0; i < 4; ++i) { p0[4 * g + i] += ct2 - c0[i]; p1[4 * g + i] += ct2 - c1[i]; } } \
              if ((j) * 64 + 63 > q0w) { const int dq = q0w + r32 - (j) * 64 - 4 * hi; const float NEG = -__builtin_inff(); \
                _Pragma("unroll") for (int r = 0; r < 16; ++r) { const int c = (r & 3) + 8 * (r >> 2); if (c > dq) p0[r] = NEG; if (c + 32 > dq) p1[r] = NEG; } } } \
            float pmax = p0[0]; \
            _Pragma("unroll") for (int r = 1; r < 16; ++r) pmax = fmaxf(pmax, p0[r]); \
            _Pragma("unroll") for (int r = 0; r < 16; ++r) pmax = fmaxf(pmax, p1[r]); \
            { auto rr = __builtin_amdgcn_permlane32_swap(__float_as_uint(pmax), __float_as_uint(pmax), false, false); pmax = fmaxf(__uint_as_float(rr[0]), __uint_as_float(rr[1])); } \
            float mn, alpha; \
            if (__all(pmax - m_reg <= 11.5415603f)) { mn = m_reg; alpha = 1.f; }     \
            else { mn = fmaxf(m_reg, pmax); alpha = __builtin_amdgcn_exp2f(m_reg - mn); m_reg = mn; } \
            float ps = 0.f; \
            _Pragma("unroll") for (int r = 0; r < 16; ++r) { p0[r] = __builtin_amdgcn_exp2f(p0[r] - mn); ps += p0[r]; } \
            _Pragma("unroll") for (int r = 0; r < 16; ++r) { p1[r] = __builtin_amdgcn_exp2f(p1[r] - mn); ps += p1[r]; } \
            { auto rr = __builtin_amdgcn_permlane32_swap(__float_as_uint(ps), __float_as_uint(ps), false, false); ps = __uint_as_float(rr[0]) + __uint_as_float(rr[1]); } \
            l_reg = l_reg * alpha + ps; \
            bf16x8 pa0, pa1, pa2, pa3; AT_PK4(p0, 0, pa0); AT_PK4(p0, 8, pa1); AT_PK4(p1, 0, pa2); AT_PK4(p1, 8, pa3); \
            if (__any(alpha < 1.f)) { if (hi == 0) wsl[32 + r32] = alpha; asm volatile("s_waitcnt lgkmcnt(0)" ::: "memory"); \
                _Pragma("unroll") for (int g = 0; g < 4; ++g) { const f32x4 a4 = *(FK_LAS const f32x4*)(wsl + 32 + 8 * g + 4 * hi); \
                    _Pragma("unroll") for (int d_ = 0; d_ < 4; ++d_) _Pragma("unroll") for (int i = 0; i < 4; ++i) o[d_][4 * g + i] *= a4[i]; } } \
            __builtin_amdgcn_s_setprio(1); AT_PV_D0(KB, 0); AT_PV_D0(KB, 1); AT_PV_D0(KB, 2); AT_PV_D0(KB, 3); __builtin_amdgcn_s_setprio(0); \
        } \
        if ((j) + 1 < nt) AT_WRITE((KB) ^ 1); \
        __syncthreads(); } while (0)

    AT_LOAD(0); AT_WRITE(0); __syncthreads();
    for (int j = 0; j < nt; j += 2) { AT_STEP(j, 0); AT_STEP(j + 1, 1); }
    if (hi == 0) wsl[r32] = l_reg; asm volatile("s_waitcnt lgkmcnt(0)" ::: "memory");
    bf16_t* Ow = P.O + (size_t)q0w * D;
#pragma unroll
    for (int g = 0; g < 4; ++g) { const f32x4 l4 = *(FK_LAS const f32x4*)(wsl + 8 * g + 4 * hi);
#pragma unroll
        for (int i = 0; i < 4; ++i) { const int r = 4 * g + i; const int orow = crow(r, hi); const float rl = __builtin_amdgcn_rcpf(l4[i]);
#pragma unroll
            for (int d0 = 0; d0 < 4; ++d0) { const float v = o[d0][r] * rl; const float vn = __shfl_xor(v, 1);
                if ((r32 & 1) == 0) *(unsigned*)(Ow + (size_t)orow * D + d0 * 32 + r32) = cvt_pk_bf16(v, vn); } } }
    __syncthreads();
#undef AT_LOAD
#undef AT_WRITE
#undef AT_TRRD
#undef AT_PV_D0
#undef AT_PK4
#undef AT_STEP
}
}
namespace fk {
constexpr int LN_XS = 2052;
constexpr int TAB_OFF = 143360;

struct LnArgs {
    const float* x; const bf16_t* yb; const bf16_t* Y2; const int* te; const int* tpos; const int* cnt;
    const float *g, *b; float* xo; bf16_t* xbo; float* out2; unsigned char* xqo;
    const f32x4* w4; int ntile;
    const float *bgrp, *brt; int* rcnt; int* ote; int* otpos; float* otw; int* list; float* sw;
    float* flog; const float* fbias;
};

__device__ __forceinline__ float wave_sum(float v) { for (int o = 32; o >= 1; o >>= 1) v += __shfl_xor(v, o); return v; }

struct LnRows { f32x4 x[2][8]; u32x2 ya[2][8]; u32x2 yb[2][8]; };
__device__ __forceinline__ void ln_load(const LnArgs& a, FK_LAS const int* hoff, int grp, int wid, int lane, LnRows& R) {
#pragma unroll
    for (int rr = 0; rr < 2; ++rr) { const int t = grp * 16 + 2 * wid + rr;
        const bf16_t *pa, *pb = nullptr;
        if (a.Y2) { const int e0 = a.te[t * 2], e1 = a.te[t * 2 + 1]; pa = a.Y2 + (size_t)(hoff[e0] + a.tpos[t * 2]) * D; pb = a.Y2 + (size_t)(hoff[e1] + a.tpos[t * 2 + 1]) * D; }
        else pa = a.yb + (size_t)t * D;
#pragma unroll
        for (int i = 0; i < 8; ++i) { const int c = 4 * lane + 256 * i; R.x[rr][i] = *(const f32x4*)(a.x + (size_t)t * D + c); R.ya[rr][i] = *(const u32x2*)(pa + c); if (a.Y2) R.yb[rr][i] = *(const u32x2*)(pb + c); else R.yb[rr][i] = (u32x2){0u, 0u}; } }
}
__device__ __forceinline__ void phase_ln(const LnArgs& a, FK_LAS unsigned char* lds) {
    const int tid = fk_tid(), wid = __builtin_amdgcn_readfirstlane(tid >> 6), lane = tid & 63;
    FK_LAS float* xs = (FK_LAS float*)lds;
    FK_LAS float* part = (FK_LAS float*)lds;
    FK_LAS float* logit = (FK_LAS float*)(lds + 32768);
    FK_LAS int* hoff = (FK_LAS int*)(lds + TAB_OFF);
    if (a.Y2) { if (tid < 64) { const int c = lane < 32 ? a.cnt[lane * 32] : 0; const int pc = ((c + 255) >> 8) << 8; int incl = pc;
#pragma unroll
            for (int o = 1; o < 32; o <<= 1) { const int v = __shfl_up(incl, o); if (lane >= o) incl += v; }
            if (lane < 32) hoff[lane] = incl - pc; }
        __syncthreads(); }
    const int nb = fk_nblk(); int grp = fk_bid();
    if (grp >= NT / 16) return;
    LnRows cur; ln_load(a, hoff, grp, wid, lane, cur);
#pragma unroll 1
    for (; grp < NT / 16; grp += nb) {
        const bool has_next = grp + nb < NT / 16;
#pragma unroll
        for (int rr = 0; rr < 2; ++rr) {
            const int lr = 2 * wid + rr, t = grp * 16 + lr;
            f32x4 v[8]; float s = 0.f;
#pragma unroll
            for (int i = 0; i < 8; ++i) { f32x4 xv = cur.x[rr][i] * ALPHA; const u32x2 pa = cur.ya[rr][i], pb = cur.yb[rr][i];
                xv[0] += __uint_as_float(pa.x << 16) + __uint_as_float(pb.x << 16); xv[1] += __uint_as_float(pa.x & 0xffff0000u) + __uint_as_float(pb.x & 0xffff0000u);
                xv[2] += __uint_as_float(pa.y << 16) + __uint_as_float(pb.y << 16); xv[3] += __uint_as_float(pa.y & 0xffff0000u) + __uint_as_float(pb.y & 0xffff0000u);
                v[i] = xv; s += (xv[0] + xv[1]) + (xv[2] + xv[3]); }
            const float mean = wave_sum(s) * (1.0f / D); float q = 0.f;
#pragma unroll
            for (int i = 0; i < 8; ++i) { const f32x4 d = v[i] - mean; q += (d[0] * d[0] + d[1] * d[1]) + (d[2] * d[2] + d[3] * d[3]); }
            const float rs = rsqrtf(wave_sum(q) * (1.0f / D) + 1e-5f);
#pragma unroll
            for (int i = 0; i < 8; ++i) { const int c = 4 * lane + 256 * i; const f32x4 gv = *(const f32x4*)(a.g + c), bv = *(const f32x4*)(a.b + c);
                const f32x4 o = (v[i] - mean) * rs * gv + bv;
                *(f32x4*)(a.xo + (size_t)t * D + c) = o;
                if (a.out2) *(f32x4*)(a.out2 + (size_t)t * D + c) = o;
                u32x2 p; p.x = cvt_pk_bf16(o[0], o[1]); p.y = cvt_pk_bf16(o[2], o[3]); *(u32x2*)(a.xbo + (size_t)t * D + c) = p;
                if (a.w4) *(FK_LAS f32x4*)(xs + lr * LN_XS + c) = o; }
        }
        if (has_next) ln_load(a, hoff, grp + nb, wid, lane, cur);
        if (!a.w4) continue;
        __syncthreads();
        f32x4 acc[3];
#pragma unroll
        for (int n = 0; n < 3; ++n) acc[n] = (f32x4){0.f, 0.f, 0.f, 0.f};
        const int row = lane & 15, kq = lane >> 4;
#pragma unroll 8
        for (int j = 0; j < 16; ++j) { const int kg = wid * 16 + j;
            const f32x4 av = *(FK_LAS const f32x4*)(xs + row * LN_XS + 16 * kg + 4 * kq);
#pragma unroll
            for (int n = 0; n < 3; ++n) if (n < a.ntile) { const f32x4 bv = a.w4[(size_t)(kg * a.ntile + n) * 64 + lane];
#pragma unroll
                for (int i = 0; i < 4; ++i) acc[n] = __builtin_amdgcn_mfma_f32_16x16x4f32(av[i], bv[i], acc[n], 0, 0, 0); } }
        __syncthreads();
#pragma unroll
        for (int n = 0; n < 3; ++n) if (n < a.ntile) {
#pragma unroll
            for (int r = 0; r < 4; ++r) part[(wid * 16 + 4 * kq + r) * 48 + 16 * n + row] = acc[n][r]; }
        __syncthreads();
        for (int i = tid; i < 16 * 16 * a.ntile; i += NTHR) { const int n = i % (16 * a.ntile), r = i / (16 * a.ntile); float s = 0.f;
#pragma unroll
            for (int w = 0; w < 8; ++w) s += part[(w * 16 + r) * 48 + n]; logit[r * 48 + n] = s; }
        __syncthreads();
        if (a.ntile == 1) { if (tid < 256) { const int r = tid & 15, n = tid >> 4; const int t = grp * 16 + r; const float x = logit[r * 48 + n] + a.fbias[n]; const float ls = fminf(x, 0.f) - 0.6931471805599453f * __builtin_amdgcn_logf(1.0f + __builtin_amdgcn_exp2f(-fabsf(x) * LOG2E));     a.flog[((size_t)((t >> 11) * 16 + n)) * S + (t & (S - 1))] = ls; } }
        else if (tid < 16) { const int t = grp * 16 + tid; FK_LAS const float* lg = logit + tid * 48;
            float g4[4]; float mx = -3e38f; int gs = 0;
            for (int i = 0; i < 4; ++i) { g4[i] = lg[i] + a.bgrp[i]; if (g4[i] > mx) { mx = g4[i]; gs = i; } }
            float den = 0.f; for (int i = 0; i < 4; ++i) den += expf(g4[i] - mx); const float pg = 1.f / den;
            float e[8]; for (int i = 0; i < 8; ++i) e[i] = lg[4 + gs * 8 + i] + a.brt[gs * 8 + i];
            int i1 = 0; for (int i = 1; i < 8; ++i) if (e[i] > e[i1]) i1 = i;
            int i2 = -1; for (int i = 0; i < 8; ++i) if (i != i1 && (i2 < 0 || e[i] > e[i2])) i2 = i;
            const float w1 = 1.f / (1.f + expf(e[i2] - e[i1])), w2 = 1.f - w1;
            const int ea = gs * 8 + i1, eb = gs * 8 + i2;
            const int pa = atomicAdd(a.rcnt + ea * 32, 1), pb = atomicAdd(a.rcnt + eb * 32, 1);
            a.ote[t * 2] = ea; a.ote[t * 2 + 1] = eb; a.otpos[t * 2] = pa; a.otpos[t * 2 + 1] = pb; a.otw[t * 2] = w1 * pg; a.otw[t * 2 + 1] = w2 * pg;
            a.list[ea * NT + pa] = t; a.list[eb * NT + pb] = t; a.sw[ea * NT + pa] = w1 * pg; a.sw[eb * NT + pb] = w2 * pg; }
        __syncthreads();
    }
}

__device__ __forceinline__ void moe_tables(const int* cnt, FK_LAS int* tab) {
    const int tid = fk_tid(), lane = tid & 63;
    __syncthreads();
    if (tid < 64) { const int c = lane < 32 ? cnt[lane * 32] : 0; const int nt = (c + 255) >> 8; int incl = nt;
#pragma unroll
        for (int o = 1; o < 32; o <<= 1) { const int v = __shfl_up(incl, o); if (lane >= o) incl += v; }
        if (lane < 32) { tab[lane] = incl - nt; tab[40 + lane] = (incl - nt) * 256; tab[80 + lane] = c; }
        if (lane == 31) tab[32] = incl; }
    __syncthreads();
}
struct MoeSched1 {
    const char* xb; const char* Bt; const int* list; FK_LAS const int* tab; int G, c;
    __device__ __forceinline__ bool next(int i, GUnit& u) const {
        const int L = i * G + c; const int tot = tab[32] * 4; if (L >= tot) return false;
        int e = 0;
#pragma unroll 1
        for (int q = 1; q < 32; ++q) if (L >= tab[q] * 4) e = q;
        const int r = L - tab[e] * 4, nte = tab[e + 1] - tab[e]; const int mt = r % nte, pn = r / nte;
        u.e = e; u.pm = mt; u.pn = pn; u.nrows = min(256, tab[80 + e] - 256 * mt); u.A = xb; u.B = Bt + ((size_t)e * 1024 + (size_t)pn * 256) * D * 2; return true; }
    __device__ __forceinline__ void a_offs(const GUnit& u, int tid, unsigned (&o)[2][2]) const { int R0, C0, R1, C1; stage_rc(tid * 16, R0, C0); stage_rc(tid * 16 + 8192, R1, C1);
        const int* l = list + (size_t)u.e * NT + u.pm * 256;
        const int r00 = R0 < u.nrows ? R0 : 0, r01 = R1 < u.nrows ? R1 : 0, r10 = R0 + HALF < u.nrows ? R0 + HALF : 0, r11 = R1 + HALF < u.nrows ? R1 + HALF : 0;
        o[0][0] = (unsigned)(l[r00] * D + C0) * 2u; o[0][1] = (unsigned)(l[r01] * D + C1) * 2u; o[1][0] = (unsigned)(l[r10] * D + C0) * 2u; o[1][1] = (unsigned)(l[r11] * D + C1) * 2u; }
};
struct MoeSched2 {
    const char* H; const char* Bt; FK_LAS const int* tab; int G, c;
    __device__ __forceinline__ bool next(int i, GUnit& u) const {
        const int L = i * G + c; const int tot = tab[32] * 8; if (L >= tot) return false;
        int e = 0;
#pragma unroll 1
        for (int q = 1; q < 32; ++q) if (L >= tab[q] * 8) e = q;
        const int r = L - tab[e] * 8, nte = tab[e + 1] - tab[e]; const int mt = r % nte, pn = r / nte;
        u.e = e; u.pm = mt; u.pn = pn; u.nrows = min(256, tab[80 + e] - 256 * mt); u.A = H + (size_t)(tab[40 + e] + 256 * mt) * 512 * 2; u.B = Bt + ((size_t)e * 2048 + (size_t)pn * 256) * 512 * 2; return true; }
    __device__ __forceinline__ void a_offs(const GUnit&, int tid, unsigned (&o)[2][2]) const { int R0, C0, R1, C1; stage_rc(tid * 16, R0, C0); stage_rc(tid * 16 + 8192, R1, C1);
        o[0][0] = (unsigned)(R0 * 512 + C0) * 2u; o[0][1] = (unsigned)(R1 * 512 + C1) * 2u; o[1][0] = o[0][0] + (unsigned)(HALF * 512 * 2); o[1][1] = o[0][1] + (unsigned)(HALF * 512 * 2); }
};
struct EpiMoe1 {
    static constexpr bool PERM = false;
    bf16_t* H; const float* sw; FK_LAS const int* tab;
    __device__ __forceinline__ void operator()(const f32x4 (&acc)[2][2][4][2], const GUnit& u, int wr, int wc, int fr, int fq) const {
        const int hrow0 = tab[40 + u.e] + 256 * u.pm; const float* swe = sw + (size_t)u.e * NT + 256 * u.pm;
#pragma unroll
        for (int ai = 0; ai < 2; ++ai)
#pragma unroll
            for (int m = 0; m < 4; ++m) { const int r = ai * HALF + wr * 64 + m * 16 + fr; if (r < u.nrows) { const float wgt = swe[r];
#pragma unroll
                for (int bj = 0; bj < 2; ++bj) { const f32x4 g = acc[ai][bj][m][0], up = acc[ai][bj][m][1]; f32x4 h;
#pragma unroll
                    for (int j = 0; j < 4; ++j) h[j] = g[j] * __builtin_amdgcn_rcpf(1.0f + __builtin_amdgcn_exp2f(-g[j] * LOG2E)) * up[j] * wgt;
                    u32x2 p; p.x = cvt_pk_bf16(h[0], h[1]); p.y = cvt_pk_bf16(h[2], h[3]);
                    *(u32x2*)(H + (size_t)(hrow0 + r) * 512 + u.pn * 128 + bj * 64 + wc * 16 + 4 * fq) = p; } } }
    }
};
struct EpiMoe2 {
    static constexpr bool PERM = true;
    bf16_t* Y2; FK_LAS const int* tab;
    __device__ __forceinline__ void operator()(const f32x4 (&acc)[2][2][4][2], const GUnit& u, int wr, int wc, int fr, int fq) const {
        const int hrow0 = tab[40 + u.e] + 256 * u.pm;
#pragma unroll
        for (int ai = 0; ai < 2; ++ai)
#pragma unroll
            for (int m = 0; m < 4; ++m) { const int r = ai * HALF + wr * 64 + m * 16 + fr; if (r < u.nrows) {
#pragma unroll
                for (int bj = 0; bj < 2; ++bj) *(u32x4*)(Y2 + (size_t)(hrow0 + r) * D + u.pn * BM + bj * HALF + wc * 32 + 8 * fq) = pack8(acc[ai][bj][m][0], acc[ai][bj][m][1]); } }
    }
};
}
namespace fk {
constexpr int SG_ROWS = 640, SG_ASTG = SG_ROWS * 64, SG_BPITCH = 1040, SG_BSTG = 16 * SG_BPITCH, SG_A = 0, SG_B = 2 * SG_ASTG;
struct SgArgs {
    const char* A; const int* rowlist; int arow0, lda_bytes, nr;
    const float* B0; const float* B1; int ldn, K;
    bf16_t* out; int out_row0, out_ld, out_col0; const float* roww; int var;
};
template <int MODE>
__device__ __forceinline__ void sg_unit(FK_LAS unsigned char* lds, const SgArgs a) {
    const int tid = fk_tid(), wid = __builtin_amdgcn_readfirstlane(tid >> 6), lane = tid & 63, r16 = lane & 15, kq = lane >> 4, wm = wid >> 1, wn = wid & 1;
    const int rpw = ((a.nr + 63) >> 6) << 4, mf = rpw >> 4;
    const int nt = a.K >> 5;
    const char* ap[5];
    { const int kc = (lane & 3) ^ ((lane >> 4) & 3);
#pragma unroll
      for (int i = 0; i < 5; ++i) { int r = 16 * (5 * wid + i) + (lane >> 2); r = r < a.nr ? r : a.nr - 1; if (a.var & 4) r = 0; const int gr = a.rowlist ? a.rowlist[r] : a.arow0 + r; ap[i] = a.A + (size_t)gr * a.lda_bytes + kc * 16; } }
    const float* bp[2];
#pragma unroll
    for (int i = 0; i < 2; ++i) { const int k = 2 * (2 * wid + i) + (lane >> 5), c = lane & 31;
        if (MODE == 1) { const int blk = c >> 3; bp[i] = ((blk & 1) ? a.B1 : a.B0) + (size_t)k * a.ldn + 32 * (blk >> 1) + 4 * (c & 7); }
        else bp[i] = a.B0 + (size_t)k * a.ldn + 4 * c; }
    const unsigned a_rd = (unsigned)(SG_A + (wm * rpw + r16) * 64 + ((kq ^ ((r16 >> 2) & 3)) << 4));
    const unsigned b_rd = (unsigned)(SG_B + 4 * kq * SG_BPITCH + (wn * 64 + r16) * 4);
    f32x4 acc[10][4];
#pragma unroll
    for (int i = 0; i < 10; ++i)
#pragma unroll
        for (int j = 0; j < 4; ++j) acc[i][j] = (f32x4){0.f, 0.f, 0.f, 0.f};
#define SG_ISSUE(t, stg) do {         _Pragma("unroll") for (int i = 0; i < 5; ++i) __builtin_amdgcn_global_load_lds((const unsigned*)(ap[i] + (size_t)(t) * 64), (FK_LAS unsigned*)(lds + SG_A + (stg) * SG_ASTG + (5 * wid + i) * 1024), 16, 0, 0);         _Pragma("unroll") for (int i = 0; i < 2; ++i) __builtin_amdgcn_global_load_lds((const unsigned*)(bp[i] + (size_t)((a.var & 2) ? 0 : (t)) * 32 * a.ldn), (FK_LAS unsigned*)(lds + SG_B + (stg) * SG_BSTG + (2 * wid + i) * SG_BPITCH), 16, 0, 0); } while (0)
    SG_ISSUE(0, 0);
    int stg = 0;
#pragma unroll 1
    for (int t = 0; t < nt; ++t) {
        asm volatile("s_waitcnt vmcnt(0)\n\ts_barrier" ::: "memory");
        if (t + 1 < nt) SG_ISSUE(t + 1, stg ^ 1);
        FK_LAS const unsigned char* ab = lds + a_rd + stg * SG_ASTG; FK_LAS const unsigned char* bb = lds + b_rd + stg * SG_BSTG;
        bf16x8 bf[4];
#pragma unroll
        for (int j = 0; j < 4; ++j) { FK_LAS const float* p = (FK_LAS const float*)(bb + j * 64);
            const float v0 = p[0], v1 = p[128], v2 = p[260], v3 = p[388], v4 = p[520], v5 = p[648], v6 = p[780], v7 = p[908];
            u32x4 w; w.x = cvt_pk_bf16(v0, v1); w.y = cvt_pk_bf16(v2, v3); w.z = cvt_pk_bf16(v4, v5); w.w = cvt_pk_bf16(v6, v7); bf[j] = *reinterpret_cast<bf16x8*>(&w); }
#pragma unroll
        for (int i = 0; i < 10; ++i) if (i < mf && !(a.var & 1)) { const bf16x8 af = *(FK_LAS const bf16x8*)(ab + i * 1024);
#pragma unroll
            for (int j = 0; j < 4; ++j) acc[i][j] = __builtin_amdgcn_mfma_f32_16x16x32_bf16(bf[j], af, acc[i][j], 0, 0, 0); }
        stg ^= 1;
    }
#undef SG_ISSUE
    float wgts[10];
#pragma unroll
    for (int i = 0; i < 10; ++i) { const int r = wm * rpw + 16 * i + r16; wgts[i] = (MODE == 1 && i < mf && r < a.nr) ? a.roww[r] : 0.f; }
#pragma unroll
    for (int i = 0; i < 10; ++i) if (i < mf) { const int r = wm * rpw + 16 * i + r16; if (r < a.nr) {
        if (MODE == 1) { const float wgt = wgts[i]; bf16_t* orow = a.out + (size_t)(a.out_row0 + r) * a.out_ld + a.out_col0 + 32 * wn + 4 * kq;
#pragma unroll
            for (int j = 0; j < 2; ++j) { const f32x4 g = acc[i][j], up = acc[i][j + 2]; f32x4 h;
#pragma unroll
                for (int q = 0; q < 4; ++q) h[q] = g[q] * __builtin_amdgcn_rcpf(1.0f + __builtin_amdgcn_exp2f(-g[q] * LOG2E)) * up[q] * wgt;
                u32x2 p; p.x = cvt_pk_bf16(h[0], h[1]); p.y = cvt_pk_bf16(h[2], h[3]); *(u32x2*)(orow + 16 * j) = p; } }
        else { bf16_t* orow = a.out + (size_t)(a.out_row0 + r) * a.out_ld + a.out_col0 + 64 * wn + 4 * kq;
#pragma unroll
            for (int j = 0; j < 4; ++j) { const f32x4 v = acc[i][j]; u32x2 p; p.x = cvt_pk_bf16(v[0], v[1]); p.y = cvt_pk_bf16(v[2], v[3]); *(u32x2*)(orow + 16 * j) = p; } } } }
    asm volatile("s_waitcnt vmcnt(0)" ::: "memory");
    __syncthreads();
}
__device__ __forceinline__ void phase_moe1(FK_LAS unsigned char* lds, FK_LAS const int* tab, const bf16_t* xb, const int* list, const float* sw, const float* wgate, const float* wup, bf16_t* H, int var) {
#pragma unroll 1
    for (int u = fk_bid(), nb = fk_nblk(); u < 256; u += nb) { const int xcd = u & 7, q = u >> 3, e = xcd + 8 * (q >> 3), s = q & 7; const int ne = tab[80 + e], hrow0 = tab[40 + e];
        const int rbeg = 0, rend = ne;
#pragma unroll 1
        for (int r0 = rbeg; r0 < rend; r0 += SG_ROWS) { SgArgs a; a.A = (const char*)xb; a.rowlist = list + (size_t)e * NT + r0; a.arow0 = 0; a.lda_bytes = D * 2; a.nr = min(SG_ROWS, rend - r0);
            a.B0 = wgate + (size_t)e * D * 512 + 64 * s; a.B1 = wup + (size_t)e * D * 512 + 64 * s; a.ldn = 512; a.K = D;
            a.out = H; a.out_row0 = hrow0 + r0; a.out_ld = 512; a.out_col0 = 64 * s; a.roww = sw + (size_t)e * NT + r0; a.var = var; sg_unit<1>(lds, a); } }
}
__device__ __forceinline__ void phase_moe2(FK_LAS unsigned char* lds, FK_LAS const int* tab, const bf16_t* H, const float* wdown, bf16_t* Y2, int var) {
#pragma unroll 1
    for (int u = fk_bid(), nb = fk_nblk(); u < 512; u += nb) { const int xcd = u & 7, q = u >> 3, e = xcd + 8 * (q >> 4), s = q & 15; const int ne = tab[80 + e], hrow0 = tab[40 + e];
        const int rbeg = 0, rend = ne;
#pragma unroll 1
        for (int r0 = rbeg; r0 < rend; r0 += SG_ROWS) { SgArgs a; a.A = (const char*)H; a.rowlist = nullptr; a.arow0 = hrow0 + r0; a.lda_bytes = 512 * 2; a.nr = min(SG_ROWS, rend - r0);
            a.B0 = wdown + (size_t)e * 512 * D + 128 * s; a.B1 = nullptr; a.ldn = D; a.K = 512;
            a.out = Y2; a.out_row0 = hrow0 + r0; a.out_ld = D; a.out_col0 = 128 * s; a.roww = nullptr; a.var = var; sg_unit<2>(lds, a); } }
}
}
namespace fk {
struct EpiBf16Q {
    static constexpr bool PERM = true;
    bf16_t* O; int ldc, qcols; float qscale;
    __device__ __forceinline__ void operator()(const f32x4 (&acc)[2][2][4][2], const GUnit& u, int wr, int wc, int fr, int fq) const {
        const int row0 = u.pm * BM + wr * 64 + fr;
#pragma unroll
        for (int bj = 0; bj < 2; ++bj) { const int gc = u.pn * BM + bj * HALF + wc * 32 + 8 * fq; const float sc = gc < qcols ? qscale : 1.0f;
#pragma unroll
            for (int ai = 0; ai < 2; ++ai)
#pragma unroll
                for (int m = 0; m < 4; ++m) *(u32x4*)(O + (size_t)(row0 + ai * HALF + m * 16) * ldc + gc) = pack8(acc[ai][bj][m][0] * sc, acc[ai][bj][m][1] * sc); }
    }
};
__device__ __forceinline__ void fox_cumsum_lds(const float* lsig, FK_LAS float* cfl, FK_LAS double* wtot, const int b, const int h) {
    const int tid = fk_tid(), lane = tid & 63, wid = tid >> 6;
    __syncthreads();
    const f32x4 v = *(const f32x4*)(lsig + (size_t)(b * 16 + h) * S + 4 * tid);
    const double s0 = (double)v[0], s1 = s0 + (double)v[1], s2 = s1 + (double)v[2], s3 = s2 + (double)v[3];
    double incl = s3;
#pragma unroll
    for (int o = 1; o < 64; o <<= 1) { const double u = __shfl_up(incl, o); if (lane >= o) incl += u; }
    if (lane == 63) wtot[wid] = incl;
    __syncthreads();
    double off = incl - s3;
#pragma unroll
    for (int w = 0; w < 7; ++w) if (w < wid) off += wtot[w];
    f32x4 o4; o4[0] = (float)((off + s0) * 1.4426950408889634); o4[1] = (float)((off + s1) * 1.4426950408889634); o4[2] = (float)((off + s2) * 1.4426950408889634); o4[3] = (float)((off + s3) * 1.4426950408889634);
    *(FK_LAS f32x4*)(cfl + 4 * tid) = o4;
    __syncthreads();
}
struct EpiDsaIn {
    static constexpr bool PERM = true;
    bf16_t *q, *k, *v, *qidx, *kidx; float* widx;
    __device__ __forceinline__ void operator()(const f32x4 (&acc)[2][2][4][2], const GUnit& u, int wr, int wc, int fr, int fq) const {
        const int row0 = u.pm * BM + wr * 64 + fr;
#pragma unroll
        for (int bj = 0; bj < 2; ++bj) { const int gc = u.pn * BM + bj * HALF + wc * 32 + 8 * fq;
            bf16_t* dst; int ld, c; float sc = 1.0f;
            if (gc < 2048) { dst = q; ld = 2048; c = gc; sc = QSCALE_128; } else if (gc < 2176) { dst = k; ld = 128; c = gc - 2048; } else if (gc < 2304) { dst = v; ld = 128; c = gc - 2176; }
            else if (gc < 3328) { dst = qidx; ld = 1024; c = gc - 2304; } else if (gc < 3392) { dst = kidx; ld = 64; c = gc - 3328; } else { dst = nullptr; ld = 0; c = gc - 3392; }
#pragma unroll
            for (int ai = 0; ai < 2; ++ai)
#pragma unroll
                for (int m = 0; m < 4; ++m) { const int row = row0 + ai * HALF + m * 16;
                    if (dst) *(u32x4*)(dst + (size_t)row * ld + c) = pack8(acc[ai][bj][m][0] * sc, acc[ai][bj][m][1] * sc);
                    else if (c < 16) { *(f32x4*)(widx + (size_t)row * 16 + c) = acc[ai][bj][m][0] * 0.03125f; *(f32x4*)(widx + (size_t)row * 16 + c + 4) = acc[ai][bj][m][1] * 0.03125f; } } }
    }
};

__device__ __forceinline__ unsigned ord_u32(float f) { const unsigned b = __float_as_uint(f); return b ^ ((b >> 31) ? 0xFFFFFFFFu : 0x80000000u); }
__device__ __forceinline__ int half_sum(int v) {
    v += __shfl_xor(v, 1); v += __shfl_xor(v, 2); v += __shfl_xor(v, 4); v += __shfl_xor(v, 8); v += __shfl_xor(v, 16); return v; }
__device__ __forceinline__ void dsa_index_unit(FK_LAS unsigned char* lds, const bf16_t* qidx, const bf16_t* kidx, const float* widx, unsigned short* sel, int* nsel, const int b, const int g, const int var = 0) {
    const int tid = fk_tid(), wid = __builtin_amdgcn_readfirstlane(tid >> 6), lane = tid & 63, r32 = lane & 31, hi = lane >> 5;
    const int t0 = 16 * g, ntile = (t0 >> 6) + 1, nk = 64 * ntile;
    const int tq = t0 + 2 * wid;
    bf16x8 qa[4]; float wv[16];
    { const int row = r32, q = row >> 4, h = row & 15; const bf16_t* p = qidx + ((size_t)(b * S + tq + q)) * 1024 + h * 64 + hi * 8;
#pragma unroll
      for (int ks = 0; ks < 4; ++ks) qa[ks] = *(const bf16x8*)(p + ks * 16);
#pragma unroll
      for (int r = 0; r < 16; ++r) { const int rw = crow(r, hi); wv[r] = widx[((size_t)(b * S + tq + (rw >> 4))) * 16 + (rw & 15)]; } }
    const int krr = tid >> 3, krc = tid & 7, krw = FK_KRSWZ(krr, krc);
    unsigned uk[64];
    bf16x8 stg[4];
#define DI_LOAD(T) do { _Pragma("unroll") for (int q_ = 0; q_ < 4; ++q_) stg[q_] = *(const bf16x8*)(kidx + ((size_t)(b * S + (T) * 256 + q_ * 64 + krr)) * 64 + krc * 8); } while (0)
#define DI_WRITE(bf) do { _Pragma("unroll") for (int q_ = 0; q_ < 4; ++q_) *(FK_LAS bf16x8*)(lds + (bf) * 32768 + q_ * 8192 + krw) = stg[q_]; } while (0)
    const int nt256 = (nk + 255) >> 8;
    DI_LOAD(0); DI_WRITE(0); __syncthreads();
#pragma unroll
    for (int i = 0; i < 64; ++i) uk[i] = 0u;
#pragma unroll 1
    for (int it = 0; it < 8; ++it) {
#pragma unroll
        for (int i = 0; i < 56; ++i) uk[i] = uk[i + 8];
        if (it < nt256 && !(var & 16)) {
            if (it + 1 < nt256) DI_LOAD(it + 1);
#pragma unroll
            for (int jj = 0; jj < 4; ++jj) { const int j = 4 * it + jj;
                if (j < ntile) {
                    FK_LAS const unsigned char* kb = lds + (it & 1) * 32768 + jj * 8192;
#pragma unroll
                    for (int sub = 0; sub < 2; ++sub) {
                        f32x16 acc;
#pragma unroll
                        for (int r = 0; r < 16; ++r) acc[r] = 0.f;
#pragma unroll
                        for (int ks = 0; ks < 4; ++ks) { const bf16x8 kf = *(FK_LAS const bf16x8*)(kb + FK_KRSWZ(32 * sub + r32, 2 * ks + hi)); acc = __builtin_amdgcn_mfma_f32_32x32x16_bf16(qa[ks], kf, acc, 0, 0, 0); }
                        float s0 = 0.f, s1 = 0.f;
#pragma unroll
                        for (int r = 0; r < 8; ++r) { s0 += fmaxf(acc[r], 0.f) * wv[r]; s1 += fmaxf(acc[8 + r], 0.f) * wv[8 + r]; }
                        auto rr = __builtin_amdgcn_permlane32_swap(__float_as_uint(s0), __float_as_uint(s1), false, false);
                        uk[56 + 2 * jj + sub] = ord_u32(__uint_as_float(rr[0]) + __uint_as_float(rr[1]));
                    }
                } else { uk[56 + 2 * jj] = 0u; uk[56 + 2 * jj + 1] = 0u; }
            }
            if (it + 1 < nt256) DI_WRITE((it + 1) & 1);
            __syncthreads();
        } else {
#pragma unroll
            for (int q_ = 0; q_ < 8; ++q_) uk[56 + q_] = 0u; }
    }
#undef DI_LOAD
#undef DI_WRITE
    const int t = tq + hi;
    unsigned short* so = sel + ((size_t)(b * S + t)) * 256;
    int base = 0;
    if (nk <= 256 || (var & 8)) {
#pragma unroll
        for (int s = 0; s < 8; ++s) { const int key = 32 * s + r32; so[key] = (unsigned short)(key < nk ? key : 0); }
        base = nk;
    } else {
        unsigned T = 0u; bool done = false;
#pragma unroll 1
        for (int bit = 31; bit >= 0; --bit) { const unsigned cand = T | (1u << bit); int c = 0;
#pragma unroll
            for (int s = 0; s < 64; ++s) c += (uk[s] >= cand) ? 1 : 0;
            c = half_sum(c); if (!done && c >= 256) { T = cand; done = (c == 256); }
            if (__all(done)) break; }
        int cgt = 0;
#pragma unroll
        for (int s = 0; s < 64; ++s) cgt += (uk[s] > T) ? 1 : 0;
        cgt = half_sum(cgt);
        const int need = 256 - cgt; int eqb = 0;
#pragma unroll
        for (int s = 0; s < 64; ++s) { const int key = 32 * s + r32; const unsigned u = uk[s];
            const bool iseq = (u == T);
            const unsigned long long em = __ballot(iseq); const unsigned eh = hi ? (unsigned)(em >> 32) : (unsigned)em; const int erank = eqb + __popc(eh & ((1u << r32) - 1u)); eqb += __popc(eh);
            const bool take = (u > T) || (iseq && erank < need);
            const unsigned long long tm = __ballot(take); const unsigned th = hi ? (unsigned)(tm >> 32) : (unsigned)tm; const int pos = base + __popc(th & ((1u << r32) - 1u)); base += __popc(th);
            if (take) so[pos] = (unsigned short)key; }
    }
    if (r32 == 0) nsel[b * S + t] = base;
}

constexpr int DS_T5 = 131072, DS_LUT = 133120, DS_SEL = 135168;
__device__ __forceinline__ void phase_dsa_attn(FK_LAS unsigned char* lds, const bf16_t* dq, const bf16_t* dk, const bf16_t* dv, const unsigned short* sel, const int* nsel, const float* t5, bf16_t* o) {
    const int tid = fk_tid(), wid = __builtin_amdgcn_readfirstlane(tid >> 6), lane = tid & 63, c16 = lane & 15, g = lane >> 4;
    FK_LAS float* t5l = (FK_LAS float*)(lds + DS_T5); FK_LAS unsigned char* lut = lds + DS_LUT;
    for (int i = tid; i < 512; i += NTHR) t5l[i] = t5[i] * LOG2E;
    for (int n = tid; n < 2048; n += NTHR) { int bk; if (n < 8) bk = n; else { bk = 8 + (int)(logf((float)n / 8.0f) / 2.772588722239781f * 8.0f); if (bk > 15) bk = 15; } lut[n] = (unsigned char)bk; }
    __syncthreads();
    FK_LAS unsigned char* vst = lds + wid * 16384;
    FK_LAS unsigned short* sell = (FK_LAS unsigned short*)(lds + DS_SEL + wid * 512);
    const unsigned vbase = (unsigned)(size_t)vst;
#pragma unroll 1
    for (int tg = fk_bid() * 8 + wid; tg < NT; tg += fk_nblk() * 8) {
        const int b = tg >> 11, t = tg & (S - 1); const int cnt = nsel[tg];
        const bf16_t* kb = dk + (size_t)b * S * 128; const bf16_t* vb = dv + (size_t)b * S * 128;
        { const u32x2 s4 = *(const u32x2*)(sel + (size_t)tg * 256 + lane * 4); *(FK_LAS u32x2*)(sell + lane * 4) = s4; }
        bf16x8 qf[4];
#pragma unroll
        for (int ks = 0; ks < 4; ++ks) qf[ks] = *(const bf16x8*)(dq + (size_t)tg * 2048 + c16 * 128 + ks * 32 + g * 8);
        asm volatile("s_waitcnt lgkmcnt(0)" ::: "memory");
        f32x4 sc[16];
#pragma unroll
        for (int ib = 0; ib < 4; ++ib) {
            bf16x8 kf[4][4];
#pragma unroll
            for (int u = 0; u < 4; ++u) { const int kk = sell[16 * (4 * ib + u) + c16]; const bf16_t* kr = kb + (size_t)kk * 128 + g * 8;
#pragma unroll
                for (int ks = 0; ks < 4; ++ks) kf[u][ks] = *(const bf16x8*)(kr + ks * 32); }
#pragma unroll
            for (int u = 0; u < 4; ++u) { f32x4 a = {0.f, 0.f, 0.f, 0.f};
#pragma unroll
                for (int ks = 0; ks < 4; ++ks) a = __builtin_amdgcn_mfma_f32_16x16x32_bf16(kf[u][ks], qf[ks], a, 0, 0, 0);
                sc[4 * ib + u] = a; }
        }
        float mx = -3.0e38f;
#pragma unroll
        for (int i = 0; i < 16; ++i) { const u32x2 k4 = *(FK_LAS const u32x2*)(sell + 16 * i + 4 * g);
#pragma unroll
            for (int r = 0; r < 4; ++r) { const int kk = (r < 2 ? (k4.x >> (16 * r)) : (k4.y >> (16 * (r - 2)))) & 0xffff; const int rel = kk - t; const int n = rel < 0 ? -rel : rel; const int bk = (rel > 0 ? 16 : 0) + lut[n];
                float v = sc[i][r] + t5l[bk * 16 + c16]; v = (16 * i + 4 * g + r < cnt) ? v : -__builtin_inff(); sc[i][r] = v; mx = fmaxf(mx, v); } }
        mx = fmaxf(mx, __shfl_xor(mx, 16)); mx = fmaxf(mx, __shfl_xor(mx, 32));
        float sum = 0.f;
#pragma unroll
        for (int i = 0; i < 16; ++i)
#pragma unroll
            for (int r = 0; r < 4; ++r) { const float p = __builtin_amdgcn_exp2f(sc[i][r] - mx); sc[i][r] = p; sum += p; }
        sum += __shfl_xor(sum, 16); sum += __shfl_xor(sum, 32);
        const float inv = __builtin_amdgcn_rcpf(sum);
        u32x4 pw[8];
#pragma unroll
        for (int c = 0; c < 8; ++c) pw[c] = pack8(sc[2 * c], sc[2 * c + 1]);
        f32x4 oa[8];
#pragma unroll
        for (int d = 0; d < 8; ++d) oa[d] = (f32x4){0.f, 0.f, 0.f, 0.f};
        bf16x8 vv[2][8];
#define DS_VLOAD(c, B) do { _Pragma("unroll") for (int it = 0; it < 8; ++it) { const int idx = lane + 64 * it, lr = idx >> 4, ch = idx & 15; const int kk = sell[32 * (c) + lr]; vv[B][it] = *(const bf16x8*)(vb + (size_t)kk * 128 + ch * 8); } } while (0)
        DS_VLOAD(0, 0);
#pragma unroll
        for (int c = 0; c < 8; ++c) {
            if (32 * c < cnt) {
                if (c + 1 < 8 && 32 * (c + 1) < cnt) DS_VLOAD(c + 1, (c + 1) & 1);
#pragma unroll
                for (int it = 0; it < 8; ++it) { const int idx = lane + 64 * it, lr = idx >> 4, ch = idx & 15; *(FK_LAS bf16x8*)(vst + lr * 256 + ((ch ^ ((lr & 7) << 1)) << 4)) = vv[c & 1][it]; }
                const bf16x8 pf = *reinterpret_cast<const bf16x8*>(&pw[c]);
                asm volatile("s_waitcnt lgkmcnt(0)" ::: "memory");
                const int q4 = c16 >> 2, p4 = c16 & 3; const int rowA = 4 * g + q4, rowB = 16 + 4 * g + q4;
#pragma unroll
                for (int d = 0; d < 8; ++d) { s16x4 lo, hi4;
                    const unsigned aA = vbase + rowA * 256 + (((2 * d + (p4 >> 1)) ^ ((rowA & 7) << 1)) << 4) + (p4 & 1) * 8;
                    const unsigned aB = vbase + rowB * 256 + (((2 * d + (p4 >> 1)) ^ ((rowB & 7) << 1)) << 4) + (p4 & 1) * 8;
                    asm volatile("ds_read_b64_tr_b16 %0, %1" : "=&v"(lo) : "v"(aA) : "memory");
                    asm volatile("ds_read_b64_tr_b16 %0, %1" : "=&v"(hi4) : "v"(aB) : "memory");
                    asm volatile("s_waitcnt lgkmcnt(0)" ::: "memory"); __builtin_amdgcn_sched_barrier(0);
                    oa[d] = __builtin_amdgcn_mfma_f32_16x16x32_bf16((bf16x8){lo[0], lo[1], lo[2], lo[3], hi4[0], hi4[1], hi4[2], hi4[3]}, pf, oa[d], 0, 0, 0); }
            }
        }
#undef DS_VLOAD
#pragma unroll
        for (int d = 0; d < 8; ++d) { u32x2 p; p.x = cvt_pk_bf16(oa[d][0] * inv, oa[d][1] * inv); p.y = cvt_pk_bf16(oa[d][2] * inv, oa[d][3] * inv);
            *(u32x2*)(o + (size_t)tg * 2048 + c16 * 128 + 16 * d + 4 * g) = p; }
    }
}
}
#define XB_TMO      128
#define XB_XCNT(j)  (256  + 64 * (j))
#define XB_XSUB(j)  (1280 + 64 * (j))
#define XB_XGEN(j)  (2304 + 64 * (j))
#define XB_TOP      3328
#define XB_TOPGEN   3392
#define XCD_BAR_WORDS 3456
#define XB_SPIN_CAP (1u << 18)
#define LAS __attribute__((address_space(3)))

__device__ __forceinline__ unsigned xb_ld(unsigned* p)              { return __hip_atomic_load(p, __ATOMIC_RELAXED, __HIP_MEMORY_SCOPE_AGENT); }
__device__ __forceinline__ unsigned xb_add(unsigned* p, unsigned v) { return __hip_atomic_fetch_add(p, v, __ATOMIC_RELAXED, __HIP_MEMORY_SCOPE_AGENT); }
__device__ __forceinline__ unsigned xb_xcc_id() { return (unsigned)__builtin_amdgcn_s_getreg((3 << 11) | 20) & 0xFu; }
#define XB_SPIN(cond, bar) do { unsigned _sp = 0; while (cond) { __builtin_amdgcn_s_sleep(1); \
    if ((++_sp & 255u) == 0u) { if (xb_ld(&(bar)[XB_TMO])) break; if (_sp > XB_SPIN_CAP) { atomicAdd(&(bar)[XB_TMO], 1u); break; } } } } while (0)

struct XcdBarrier {
    unsigned* bar; unsigned x;
    volatile LAS unsigned* st;
};

__device__ __forceinline__ XcdBarrier xcd_barrier_post(unsigned* bar, volatile LAS unsigned* st) {
    XcdBarrier b; b.bar = bar; b.x = xb_xcc_id(); b.st = st;
    if (threadIdx.x == 0) (void)xb_add(&bar[XB_XCNT(b.x)], 1u);
    return b;
}
__device__ __forceinline__ void xcd_barrier_complete(unsigned* bar, unsigned x, unsigned& nloc, unsigned& nx) {
    const unsigned G = gridDim.x * gridDim.y * gridDim.z;
    unsigned sum, cnt, mine, sp = 0u;
    for (;;) {
        sum = 0u; cnt = 0u; mine = 0u;
#pragma unroll
        for (unsigned j = 0; j < 16; ++j) { const unsigned c = xb_ld(&bar[XB_XCNT(j)]); sum += c; cnt += (c > 0u) ? 1u : 0u; mine = (j == x) ? c : mine; }
        if (sum == G) break;
        __builtin_amdgcn_s_sleep(1);
        if ((++sp & 255u) == 0u) { if (xb_ld(&bar[XB_TMO])) break; if (sp > XB_SPIN_CAP) { atomicAdd(&bar[XB_TMO], 1u); break; } }
    }
    nloc = mine > 0u ? mine : 1u; nx = cnt > 0u ? cnt : 1u;
}

__device__ __forceinline__ void xcd_barrier(const XcdBarrier& b) {
    asm volatile("s_waitcnt vmcnt(0)" ::: "memory");
    __syncthreads();
    if (threadIdx.x == 0) {
        unsigned* bar = b.bar;
        __builtin_amdgcn_s_waitcnt(0);
        unsigned nloc = b.st[0], nx = b.st[1];
        if (nloc == 0u) { xcd_barrier_complete(bar, b.x, nloc, nx); b.st[0] = nloc; b.st[1] = nx; }
        const unsigned old = xb_add(&bar[XB_XSUB(b.x)], 1u);
        const unsigned gen = old / nloc;
        if (old + 1u == (gen + 1u) * nloc) {
            __builtin_amdgcn_fence(__ATOMIC_RELEASE, "agent");
            asm volatile("s_waitcnt vmcnt(0)" ::: "memory");
            const unsigned og = xb_add(&bar[XB_TOP], 1u);
            const unsigned tg = og / nx;
            if (og + 1u == (tg + 1u) * nx) xb_add(&bar[XB_TOPGEN], 1u);
            else XB_SPIN(xb_ld(&bar[XB_TOPGEN]) == tg, bar);
            __builtin_amdgcn_fence(__ATOMIC_ACQUIRE, "agent");
            xb_add(&bar[XB_XGEN(b.x)], 1u);
            asm volatile("s_waitcnt vmcnt(0)" ::: "memory");
        } else {
            XB_SPIN(xb_ld(&bar[XB_XGEN(b.x)]) == gen, bar);
            __builtin_amdgcn_fence(__ATOMIC_ACQUIRE, "agent");
            asm volatile("s_waitcnt vmcnt(0)" ::: "memory");
        }
    }
    __syncthreads();
}


__device__ __forceinline__ void xcd_barrier_slim(const XcdBarrier& b) {
    asm volatile("s_waitcnt vmcnt(0)" ::: "memory");
    __syncthreads();
    if (threadIdx.x == 0) {
        unsigned* bar = b.bar;
        __builtin_amdgcn_s_waitcnt(0);
        unsigned nloc = b.st[0], nx = b.st[1];
        if (nloc == 0u) { nloc = 1u; nx = 1u; }
        const unsigned old = xb_add(&bar[XB_XSUB(b.x)], 1u);
        const unsigned gen = old / nloc;
        if (old + 1u == (gen + 1u) * nloc) {
            __builtin_amdgcn_fence(__ATOMIC_RELEASE, "agent");
            asm volatile("s_waitcnt vmcnt(0)" ::: "memory");
            const unsigned og = xb_add(&bar[XB_TOP], 1u);
            const unsigned tg = og / nx;
            if (og + 1u == (tg + 1u) * nx) xb_add(&bar[XB_TOPGEN], 1u);
            else XB_SPIN(xb_ld(&bar[XB_TOPGEN]) == tg, bar);
            __builtin_amdgcn_fence(__ATOMIC_ACQUIRE, "agent");
            xb_add(&bar[XB_XGEN(b.x)], 1u);
            asm volatile("s_waitcnt vmcnt(0)" ::: "memory");
        } else {
            XB_SPIN(xb_ld(&bar[XB_XGEN(b.x)]) == gen, bar);
            __builtin_amdgcn_fence(__ATOMIC_ACQUIRE, "agent");
            asm volatile("s_waitcnt vmcnt(0)" ::: "memory");
        }
    }
    __syncthreads();
}

namespace fk {
template <int FK_PHASE_MASK_, int ML>
__global__ void __launch_bounds__(NTHR, 2) fk_fwd(const FWK kw, const CvtTable T, const int p_lo, const int p_hi) {
    extern __shared__ __attribute__((aligned(16))) unsigned char shm_[];
    FK_LAS unsigned char* lds = (FK_LAS unsigned char*)shm_;
    FK_LAS unsigned* xbw = (FK_LAS unsigned*)(lds + LDS_BYTES - 16);
    if (threadIdx.x == 0) { xbw[0] = 0u; xbw[1] = 0u; xbw[2] = 0u; xbw[3] = 0u; }
    __syncthreads();
#define FWK_FIELDS(X) X(x_in) X(t5) X(mla_w_in) X(mla_qn) X(mla_kvn) X(mla_wq) X(mla_wkv) X(mla_wo) X(fox_w_in) X(fox_bf) X(fox_wo) X(dsa_w_in) X(dsa_wo) X(ln_g) X(ln_b) X(wgrp) X(bgrp) X(wrt) X(brt) X(wgate) X(wup) X(wdown) X(out) X(ws) X(moe_bias_gu) X(moe_bias_d) X(var)
    FK_LAS unsigned long long* kl = (FK_LAS unsigned long long*)(lds + 146944);
    if (threadIdx.x == 0) { int i_ = 0;
#define FWK_PUT(f) kl[i_++] = (unsigned long long)kw.f;
        FWK_FIELDS(FWK_PUT)
#undef FWK_PUT
    }
    __syncthreads();
    XcdBarrier bar = xcd_barrier_post((unsigned*)(kw.ws + WsMap<ML>::CTL), (volatile LAS unsigned*)xbw);
    FK_LAS int* tab = (FK_LAS int*)(lds + TAB_OFF);
    if (p_hi - p_lo > 1) xcd_barrier(bar);
#define PH_ON(k) (((FK_PHASE_MASK_) >> (k)) & 1)
#ifndef FK_REP_MASK
#define FK_REP_MASK 0
#endif
#define PH_REP(k) ((((FK_REP_MASK) >> (k)) & 1) ? 2 : 1)
#define FWK_GET(f) { const unsigned long long v_ = kl[i_++]; const unsigned lo_ = __builtin_amdgcn_readfirstlane((unsigned)v_), hi_ = __builtin_amdgcn_readfirstlane((unsigned)(v_ >> 32)); kq_.f = (decltype(kq_.f))(((unsigned long long)hi_ << 32) | lo_); }
#define PH_BEGIN(id) if ((id) >= p_lo && (id) < p_hi) { if ((id) > p_lo) xcd_barrier_slim(bar); FWK kq_; { int i_ = 0; FWK_FIELDS(FWK_GET) } const FW w = make_fw<ML>(kq_, kq_.ws);
#define PH_END }
#define PH_BEGINR(id, bit) PH_BEGIN(id) for (int rep_ = 0; rep_ < PH_REP(bit); ++rep_)
    if constexpr (PH_ON(8)) { PH_BEGINR(0, 8) phase_prologue(w, T, lds); PH_END }
#pragma unroll 1
    for (int layer = 0; layer < 4; ++layer) {
        const int kind = layer % 3, j = layer / 3, pb = 1 + 8 * layer;
        if (kind == 0) {
#define MLA_PTRS bf16_t* cq = (bf16_t*)w.arena; bf16_t* ckv = cq + (size_t)NT * 512; bf16_t* kr = ckv + (size_t)NT * 512; bf16_t* q = kr + (size_t)NT * 64; bf16_t* kv = q + (size_t)NT * 3072; (void)cq; (void)ckv; (void)kr; (void)q; (void)kv;
            if constexpr (PH_ON(0)) PH_BEGINR(pb + 0, 0) { MLA_PTRS RectSched s; s.init(w.xb0, D, w.mla_win_t + (size_t)j * 1280 * D, D, NT, 1280); EpiMlaIn e{cq, ckv, kr, w.ss, w.rope_cs}; gemm_phase(lds, D, D, s, e); } PH_END
            if constexpr (PH_ON(1)) PH_BEGINR(pb + 1, 1) { MLA_PTRS Rect2Sched s; s.s0.init(cq, 512, w.mla_wq_t + (size_t)j * 3072 * 512, 512, NT, 3072); s.s1.init(ckv, 512, w.mla_wkv_t + (size_t)j * 4096 * 512, 512, NT, 4096); s.n0 = 0;
                EpiMlaQKV e{q, kv, w.ss, w.rope_cs}; gemm_phase(lds, 512, 512, s, e); } PH_END
            if constexpr (PH_ON(2)) PH_BEGINR(pb + 2, 2) { MLA_PTRS
#pragma unroll 1
                for (int p = fk_bid(), np_ = fk_nblk(); p < 256; p += np_) { const int bh = p >> 2, x = p & 3, b = bh >> 4, h = bh & 15;
                    AttnPtrs P; P.Q = q + (size_t)b * S * 3072 + h * 192; P.K = kv + (size_t)b * S * 4096 + h * 256; P.V = P.K + 128; P.KR = kr + (size_t)b * S * 64; P.CF = nullptr; P.O = w.o + (size_t)b * S * D + h * 128; P.qld = 3072; P.kld = 4096;
                    attn_block<0>(lds, P, 7 - x); attn_block<0>(lds, P, x); } } PH_END
        }
        if (kind == 1) {
#define FOX_PTRS bf16_t* qkv = (bf16_t*)w.arena;
            if constexpr (PH_ON(9)) PH_BEGINR(pb + 0, 9) { FOX_PTRS RectSched s; s.init(w.xb0, D, w.fox_win_t, D, NT, 6144); EpiBf16Q e{qkv, 6144, 2048, QSCALE_128}; gemm_phase(lds, D, D, s, e); } PH_END
            if constexpr (PH_ON(10)) PH_BEGINR(pb + 2, 10) { FOX_PTRS
#pragma unroll 1
                for (int p = fk_bid(), np_ = fk_nblk(); p < 256; p += np_) { const int bh = p >> 2, x = p & 3, b = bh >> 4, h = bh & 15;
                    AttnPtrs P; P.Q = qkv + (size_t)b * S * 6144 + h * 128; P.K = P.Q + 2048; P.V = P.Q + 4096; P.KR = nullptr; P.CF = nullptr; P.O = w.o + (size_t)b * S * D + h * 128; P.qld = 6144; P.kld = 6144;
                    fox_cumsum_lds(w.flog, (FK_LAS float*)(lds + AT_CF), (FK_LAS double*)(lds + AT_WS), b, h);
                    attn_block<1>(lds, P, 7 - x); attn_block<1>(lds, P, x); } } PH_END
        }
        if (kind == 2) {
#define DSA_PTRS bf16_t* dq = (bf16_t*)w.arena; bf16_t* dk = dq + (size_t)NT * 2048; bf16_t* dv = dk + (size_t)NT * 128; bf16_t* qidx = dv + (size_t)NT * 128; bf16_t* kidx = qidx + (size_t)NT * 1024; \
            float* widx = (float*)(kidx + (size_t)NT * 64); unsigned short* sel = (unsigned short*)(widx + (size_t)NT * 16); int* nsel = (int*)(sel + (size_t)NT * 256); (void)dq; (void)dk; (void)dv; (void)qidx; (void)kidx; (void)widx; (void)sel; (void)nsel;
            if constexpr (PH_ON(11)) PH_BEGINR(pb + 0, 11) { DSA_PTRS RectSched s; s.init(w.xb0, D, w.dsa_win_t, D, NT, 3584); EpiDsaIn e{dq, dk, dv, qidx, kidx, widx}; gemm_phase(lds, D, D, s, e); } PH_END
            if constexpr (PH_ON(12)) PH_BEGINR(pb + 1, 12) { DSA_PTRS
#pragma unroll 1
                for (int p = fk_bid(), np_ = fk_nblk(); p < 256; p += np_) { const int b = p >> 6, x = p & 63;
                    dsa_index_unit(lds, qidx, kidx, widx, sel, nsel, b, 127 - x, (int)kq_.var); dsa_index_unit(lds, qidx, kidx, widx, sel, nsel, b, x, (int)kq_.var); } } PH_END
            if constexpr (PH_ON(13)) PH_BEGINR(pb + 2, 13) { DSA_PTRS phase_dsa_attn(lds, dq, dk, dv, sel, nsel, w.t5, w.o); } PH_END
        }
        if constexpr (PH_ON(3)) PH_BEGINR(pb + 3, 3) { const bf16_t* wo_t = kind == 0 ? w.mla_wo_t + (size_t)j * D * D : (kind == 1 ? w.fox_wo_t : w.dsa_wo_t); RectSched s; s.init(w.o, D, wo_t, D, NT, D); EpiBf16Q e{(bf16_t*)w.y, D, 0, 1.0f}; gemm_phase(lds, D, D, s, e); } PH_END
        if constexpr (PH_ON(4)) PH_BEGIN(pb + 4) { LnArgs a; a.x = (layer == 0) ? w.x_in : w.xA; a.yb = (const bf16_t*)w.y; a.Y2 = nullptr; a.te = nullptr; a.tpos = nullptr; a.cnt = nullptr; a.g = w.ln_g + (size_t)(layer * 2) * D; a.b = w.ln_b + (size_t)(layer * 2) * D; a.xo = w.xB; a.xbo = w.xb1; a.out2 = nullptr; a.xqo = nullptr;
            a.w4 = (const f32x4*)w.wr4 + (size_t)layer * 128 * 3 * 64; a.ntile = 3; a.bgrp = w.bgrp + layer * 4; a.brt = w.brt + layer * 32; a.rcnt = w.moe_cnt + layer * 1024; a.ote = w.te; a.otpos = w.tpos; a.otw = w.tw; a.list = w.list; a.sw = w.sw; a.flog = nullptr; a.fbias = nullptr;
            phase_ln(a, lds);
            } PH_END
        if constexpr (PH_ON(5)) PH_BEGINR(pb + 5, 5) { moe_tables(w.moe_cnt + layer * 1024, tab); phase_moe1(lds, tab, w.xb1, w.list, w.sw, w.wgate + (size_t)layer * 32 * D * 512, w.wup + (size_t)layer * 32 * D * 512, w.H, (int)kq_.var); } PH_END
        if constexpr (PH_ON(6)) PH_BEGINR(pb + 6, 6) { moe_tables(w.moe_cnt + layer * 1024, tab); phase_moe2(lds, tab, w.H, w.wdown + (size_t)layer * 32 * 512 * D, w.Y2, (int)kq_.var); } PH_END
        if constexpr (PH_ON(7)) PH_BEGINR(pb + 7, 7) { LnArgs a; a.x = w.xB; a.yb = nullptr; a.Y2 = w.Y2; a.te = w.te; a.tpos = w.tpos; a.cnt = w.moe_cnt + layer * 1024; a.g = w.ln_g + (size_t)(layer * 2 + 1) * D; a.b = w.ln_b + (size_t)(layer * 2 + 1) * D; a.xo = w.xA; a.xbo = w.xb0; a.xqo = nullptr;
            a.out2 = (layer == 3) ? w.out : nullptr; a.w4 = (layer == 0) ? (const f32x4*)w.fox_wf4 : nullptr; a.ntile = (layer == 0) ? 1 : 0; a.bgrp = nullptr; a.brt = nullptr; a.rcnt = nullptr; a.ote = nullptr; a.otpos = nullptr; a.otw = nullptr; a.list = nullptr; a.sw = nullptr; a.flog = w.flog; a.fbias = w.fox_bf;
            phase_ln(a, lds); } PH_END
    }
#undef PH_BEGIN
#undef PH_END
}

constexpr size_t CTL_BYTES = 65536;
static FWK make_fwk(void* const* d_in, void* d_out, char* ws) {
    FWK k; memset(&k, 0, sizeof(k));
    k.x_in = (const float*)d_in[0]; k.t5 = (const float*)d_in[1]; k.mla_w_in = (const float*)d_in[2]; k.mla_qn = (const float*)d_in[3]; k.mla_kvn = (const float*)d_in[4]; k.mla_wq = (const float*)d_in[5];
    k.mla_wkv = (const float*)d_in[6]; k.mla_wo = (const float*)d_in[7]; k.fox_w_in = (const float*)d_in[8]; k.fox_bf = (const float*)d_in[9]; k.fox_wo = (const float*)d_in[10]; k.dsa_w_in = (const float*)d_in[11];
    k.dsa_wo = (const float*)d_in[12]; k.ln_g = (const float*)d_in[13]; k.ln_b = (const float*)d_in[14]; k.wgrp = (const float*)d_in[15]; k.bgrp = (const float*)d_in[16]; k.wrt = (const float*)d_in[17];
    k.brt = (const float*)d_in[18]; k.wgate = (const float*)d_in[19]; k.wup = (const float*)d_in[20]; k.wdown = (const float*)d_in[21]; k.out = (float*)d_out; k.ws = ws;
    return k;
}
static void add_job(CvtTable& T, const float* s0, const float* s1, const float* scale, bf16_t* dst, long sbs, long dbs, int K, int N, int Np, int map, int nbatch) {
    CvtJob& J = T.j[T.njobs++]; J.src0 = s0; J.src1 = s1; J.scale = scale; J.dst = dst; J.src_bstride = sbs; J.dst_bstride = dbs; J.K = K; J.N = N; J.Np = Np; J.map = map; J.nbatch = nbatch; J.tile0 = T.ntiles;
    J.wide = ((map == MAP_ID || map == MAP_MOE_GU) && (K % 128 == 0) && (Np % 256 == 0) && (N % 4 == 0)) ? 1 : 0;
    T.ntiles += J.wide ? nbatch * (K / 128) * (Np / 256) : nbatch * (K / 64) * (Np / 64);
}
static void build_table(CvtTable& T, const FW& w, int moe_l0, int moe_l1, bool base) {
    memset(&T, 0, sizeof(T)); T.misc = base ? 1 : 0;
    if (base) {
    for (int j = 0; j < 2; ++j) {
        add_job(T, w.mla_w_in + (size_t)j * D * 1088, nullptr, nullptr, w.mla_win_t + (size_t)j * 1280 * D, 0, 0, D, 1088, 1280, MAP_MLA_IN, 1);
        add_job(T, w.mla_wq + (size_t)j * 512 * 3072, nullptr, w.mla_qn + j * 512, w.mla_wq_t + (size_t)j * 3072 * 512, 0, 0, 512, 3072, 3072, MAP_MLA_Q, 1);
        add_job(T, w.mla_wkv + (size_t)j * 512 * 4096, nullptr, w.mla_kvn + j * 512, w.mla_wkv_t + (size_t)j * 4096 * 512, 0, 0, 512, 4096, 4096, MAP_ID, 1);
        add_job(T, w.mla_wo + (size_t)j * D * D, nullptr, nullptr, w.mla_wo_t + (size_t)j * D * D, 0, 0, D, D, D, MAP_ID, 1);
    }
    add_job(T, w.fox_w_in, nullptr, nullptr, w.fox_win_t, 0, 0, D, 6160, 6144, MAP_ID, 1);
    add_job(T, w.fox_wo, nullptr, nullptr, w.fox_wo_t, 0, 0, D, D, D, MAP_ID, 1);
    add_job(T, w.dsa_w_in, nullptr, nullptr, w.dsa_win_t, 0, 0, D, 3408, 3584, MAP_ID, 1);
    add_job(T, w.dsa_wo, nullptr, nullptr, w.dsa_wo_t, 0, 0, D, D, D, MAP_ID, 1);
    }
    for (int l = moe_l0; l < moe_l1; ++l) {
        add_job(T, w.wgate + (size_t)l * 32 * D * 512, w.wup + (size_t)l * 32 * D * 512, nullptr, w.moe_gu_t + (size_t)l * 32 * 1024 * D, (long)D * 512, (long)1024 * D, D, 512, 1024, MAP_MOE_GU, 32);
        add_job(T, w.wdown + (size_t)l * 32 * 512 * D, nullptr, nullptr, w.moe_d_t + (size_t)l * 32 * D * 512, (long)512 * D, (long)D * 512, 512, D, D, MAP_ID, 32);
    }
}
static int g_grid = 0;
static void setup_once() {
    if (g_grid) return;
    int dev = 0, cus = 0, per_cu = 0;
    (void)hipGetDevice(&dev); (void)hipDeviceGetAttribute(&cus, hipDeviceAttributeMultiprocessorCount, dev);
    (void)per_cu;
    if (cus <= 0) cus = 256;
    g_grid = cus;
}
template <int MASK, int ML> static void launch_mask(const FWK& w, const CvtTable& T, int lo, int hi, hipStream_t st) {
    static bool attr = false; if (!attr) { (void)hipFuncSetAttribute((const void*)fk_fwd<MASK, ML>, hipFuncAttributeMaxDynamicSharedMemorySize, LDS_BYTES); attr = true; }
    hipLaunchKernelGGL((fk_fwd<MASK, ML>), dim3(g_grid), dim3(NTHR), LDS_BYTES, st, w, T, lo, hi);
}
#ifdef FK_DEBUG_BUILD
static void launch_phase(const FWK& w, const CvtTable& T, int p, hipStream_t st) {
    if (p == 0) { launch_mask<(1 << 8), 1>(w, T, p, p + 1, st); return; }
    const int layer = (p - 1) >> 3, k = (p - 1) & 7, kind = layer % 3;
    if (k >= 3) { switch (k) { case 3: launch_mask<(1 << 3), 1>(w, T, p, p + 1, st); break; case 4: launch_mask<(1 << 4), 1>(w, T, p, p + 1, st); break; case 5: launch_mask<(1 << 5), 1>(w, T, p, p + 1, st); break;
                               case 6: launch_mask<(1 << 6), 1>(w, T, p, p + 1, st); break; default: launch_mask<(1 << 7), 1>(w, T, p, p + 1, st); break; } return; }
    if (kind == 0) { if (k == 0) launch_mask<(1 << 0), 1>(w, T, p, p + 1, st); else if (k == 1) launch_mask<(1 << 1), 1>(w, T, p, p + 1, st); else launch_mask<(1 << 2), 1>(w, T, p, p + 1, st); }
    else if (kind == 1) { if (k == 0) launch_mask<(1 << 9), 1>(w, T, p, p + 1, st); else if (k == 2) launch_mask<(1 << 10), 1>(w, T, p, p + 1, st); }
    else { if (k == 0) launch_mask<(1 << 11), 1>(w, T, p, p + 1, st); else if (k == 1) launch_mask<(1 << 12), 1>(w, T, p, p + 1, st); else launch_mask<(1 << 13), 1>(w, T, p, p + 1, st); }
}
#endif
}
#ifndef FK_EXTRA
#define FK_EXTRA {}
#endif
extern "C" void kernel_launch(void* const* d_in, const int* in_sizes, int n_in, void* d_out, int out_size, void* d_ws, size_t ws_size, hipStream_t stream) {
    using namespace fk;
    setup_once();
    const FWK k = make_fwk(d_in, d_out, (char*)d_ws);
    const FW w = make_fw<0>(k, k.ws);
    static CvtTable T; build_table(T, w, 0, 0, true);
    (void)hipMemsetAsync(w.bar, 0, CTL_BYTES, stream);
    launch_mask<0x3FFF, 0>(k, T, 0, 33, stream);
    { static const int extra[] = FK_EXTRA; (void)extra; FWK kv = k;
#ifdef FK_VAR
      kv.var = FK_VAR;
#endif
      for (unsigned i = 0; i < sizeof(extra) / sizeof(int); ++i) launch_mask<0x3FFF, 0>(kv, T, extra[i], extra[i] + 1, stream); }
}
```

```cpp
#include <hip/hip_runtime.h>
#include <stdint.h>
#include <math.h>
#include <string.h>
namespace fk {
#define FK_LAS __attribute__((address_space(3)))
typedef unsigned short bf16_t;
typedef short bf16x8 __attribute__((ext_vector_type(8)));
typedef short s16x4 __attribute__((ext_vector_type(4)));
typedef float f32x4 __attribute__((ext_vector_type(4)));
typedef float f32x16 __attribute__((ext_vector_type(16)));
typedef float f32x2 __attribute__((ext_vector_type(2)));
typedef unsigned u32x4 __attribute__((ext_vector_type(4)));
typedef unsigned u32x2 __attribute__((ext_vector_type(2)));
constexpr int NB = 4, S = 2048, D = 2048, NT = NB * S;
constexpr float ALPHA = 1.681792830507429f;
constexpr float LOG2E = 1.4426950408889634f;
__device__ __forceinline__ int fk_tid();
__device__ __forceinline__ int fk_bid();
__device__ __forceinline__ int fk_nblk();
constexpr int BM = 256, BK = 64, HALF = 128, HTB = HALF * BK * 2, STAGE_BYTES = 8 * HTB;

__device__ __forceinline__ unsigned cvt_pk_bf16(float lo, float hi) { unsigned r; asm volatile("v_cvt_pk_bf16_f32 %0, %1, %2" : "=v"(r) : "v"(lo), "v"(hi)); return r; }
__device__ __forceinline__ float bf2f(bf16_t b) { return __uint_as_float(((unsigned)b) << 16); }
__device__ __forceinline__ bf16_t f2bf(float f) { unsigned u = __float_as_uint(f); u += 0x7FFFu + ((u >> 16) & 1u); return (bf16_t)(u >> 16); }

__host__ __device__ __forceinline__ int lds_byte(int r, int c) { const int st = (r >> 4) * 2 + (c >> 5), rr = r & 15, cc = c & 31, ob = rr * 64 + cc * 2; return st * 1024 + (ob ^ (((ob >> 9) & 1) << 5)); }
__host__ __device__ __forceinline__ void stage_rc(int b, int& R, int& C) { const int st = b / 1024, sb = b % 1024, swz = sb ^ (((sb >> 9) & 1) << 5); R = (st >> 1) * 16 + swz / 64; C = (st & 1) * 32 + (swz % 64) / 2; }
__host__ __device__ __forceinline__ int perm32(int rho) { const int n = rho >> 4, i = rho & 15; return 8 * (i >> 2) + 4 * n + (i & 3); }

struct GUnit { const char* A; const char* B; int pm, pn, e, nrows; };

template <class Epi, class Sched>
__device__ __forceinline__ void gemm_phase(FK_LAS unsigned char* lds, const int K, const int ldb, const Sched& S, const Epi& E) {
    const int tid = fk_tid(), wid = __builtin_amdgcn_readfirstlane(tid >> 6), lane = tid & 63, wr = wid >> 2, wc = wid & 3, fr = lane & 15, fq = lane >> 4;
    const int nt = K / BK;
    unsigned voffB[2];
#pragma unroll
    for (int i = 0; i < 2; ++i) { int R_, C_; stage_rc(tid * 16 + i * 8192, R_, C_); const int Rb = Epi::PERM ? ((R_ & ~31) + perm32(R_ & 31)) : R_; voffB[i] = (unsigned)(Rb * ldb + C_) * 2u; }
    const size_t kstep = (size_t)(BK * 2);
    const size_t hstepB = (size_t)HALF * ldb * 2;
    const unsigned ldsw = (unsigned)wid * 1024u;
    const int aoff = lds_byte(wr * 64 + fr, fq * 8), boff = lds_byte(wc * 32 + fr, fq * 8);
#define PG8_SA(b, h) (((b) * 2 + (h)) * HTB)
#define PG8_SB(b, h) ((4 + (b) * 2 + (h)) * HTB)
#define PG8_STAGE2(bufoff, gbase, v0, v1) do { \
        __builtin_amdgcn_global_load_lds((const unsigned*)((const char*)(gbase) + (v0)), (FK_LAS unsigned*)(lds + (bufoff) + ldsw), 16, 0, 0); \
        __builtin_amdgcn_global_load_lds((const unsigned*)((const char*)(gbase) + (v1)), (FK_LAS unsigned*)(lds + (bufoff) + ldsw + 8192), 16, 0, 0); } while (0)
#define PG8_STAGEB(bufoff, gbase) PG8_STAGE2(bufoff, gbase, voffB[0], voffB[1])
#define PG8_LDA(dst, b, h) do { _Pragma("unroll") for (int m = 0; m < 4; ++m) _Pragma("unroll") for (int k = 0; k < 2; ++k) dst[m][k] = *(const FK_LAS bf16x8*)(lds + PG8_SA(b, h) + aoff + m * 2048 + k * 1024); } while (0)
#define PG8_LDB(dst, b, h) do { _Pragma("unroll") for (int n = 0; n < 2; ++n) _Pragma("unroll") for (int k = 0; k < 2; ++k) dst[n][k] = *(const FK_LAS bf16x8*)(lds + PG8_SB(b, h) + boff + n * 2048 + k * 1024); } while (0)
#define PG8_MMA(ai, bj, At, Bt) do { __builtin_amdgcn_s_setprio(1); _Pragma("unroll") for (int m = 0; m < 4; ++m) _Pragma("unroll") for (int n = 0; n < 2; ++n) _Pragma("unroll") for (int k = 0; k < 2; ++k) \
        acc[ai][bj][m][n] = __builtin_amdgcn_mfma_f32_16x16x32_bf16(Bt[n][k], At[m][k], acc[ai][bj][m][n], 0, 0, 0); __builtin_amdgcn_s_setprio(0); } while (0)
#define PG8_WAIT_V(n) asm volatile("s_waitcnt vmcnt(" #n ")" ::: "memory")
#define PG8_WAIT_L(n) asm volatile("s_waitcnt lgkmcnt(" #n ")" ::: "memory")
#define PG8_BAR __builtin_amdgcn_s_barrier()
#define PG8_SCHED __builtin_amdgcn_sched_barrier(0)
    GUnit cur, nxt; int ui = 0;
    if (!S.next(0, cur)) return;
    f32x4 acc[2][2][4][2];
#pragma unroll
    for (int a = 0; a < 2; ++a)
#pragma unroll
        for (int b = 0; b < 2; ++b)
#pragma unroll
            for (int m = 0; m < 4; ++m)
#pragma unroll
                for (int n = 0; n < 2; ++n) acc[a][b][m][n] = (f32x4){0.f, 0.f, 0.f, 0.f};
    bf16x8 At[4][2], B0[2][2], B1[2][2];
    unsigned oc[2][2], on[2][2];
    S.a_offs(cur, tid, oc);
    const char* cA = cur.A; const char* cB = cur.B;
    PG8_STAGEB(PG8_SB(0, 0), cB); PG8_STAGE2(PG8_SA(0, 0), cA, oc[0][0], oc[0][1]); PG8_STAGEB(PG8_SB(0, 1), cB + hstepB); PG8_STAGE2(PG8_SA(0, 1), cA, oc[1][0], oc[1][1]);
    if (wr == 1) PG8_BAR;
    PG8_WAIT_V(4); PG8_BAR;
    PG8_STAGEB(PG8_SB(1, 0), cB + kstep); PG8_STAGE2(PG8_SA(1, 0), cA + kstep, oc[0][0], oc[0][1]); PG8_STAGEB(PG8_SB(1, 1), cB + hstepB + kstep);
    PG8_WAIT_V(6); PG8_BAR;
    for (;;) {
        const bool has_next = S.next(ui + 1, nxt);
        if (has_next) S.a_offs(nxt, tid, on);
        else {
#pragma unroll
            for (int h = 0; h < 2; ++h)
#pragma unroll
                for (int i = 0; i < 2; ++i) on[h][i] = oc[h][i]; }
        const char* nA = has_next ? nxt.A : cA; const char* nB = has_next ? nxt.B : cB;
        for (int t = 0; t < nt; t += 2) {
            const bool last = (t == nt - 2);
            const char* a1 = cA + (size_t)(t + 1) * kstep;
            const char* a2 = last ? nA : cA + (size_t)(t + 2) * kstep; const char* b2 = last ? nB : cB + (size_t)(t + 2) * kstep;
            const char* a3 = a2 + kstep; const char* b3 = b2 + kstep;
            const unsigned o00 = last ? on[0][0] : oc[0][0], o01 = last ? on[0][1] : oc[0][1], o10 = last ? on[1][0] : oc[1][0], o11 = last ? on[1][1] : oc[1][1];
            PG8_LDB(B0, 0, 0); PG8_SCHED; PG8_LDA(At, 0, 0); PG8_STAGE2(PG8_SA(1, 1), a1, oc[1][0], oc[1][1]);
            PG8_WAIT_L(8); PG8_BAR; PG8_WAIT_L(0); PG8_MMA(0, 0, At, B0); PG8_BAR; PG8_SCHED;
            PG8_LDB(B1, 0, 1); PG8_STAGEB(PG8_SB(0, 0), b2);
            PG8_BAR; PG8_WAIT_L(0); PG8_MMA(0, 1, At, B1); PG8_BAR;
            PG8_LDA(At, 0, 1); PG8_STAGE2(PG8_SA(0, 0), a2, o00, o01);
            PG8_BAR; PG8_WAIT_L(0); PG8_MMA(1, 0, At, B0); PG8_BAR; PG8_SCHED;
            PG8_STAGEB(PG8_SB(0, 1), b2 + hstepB);
            PG8_WAIT_V(6); PG8_BAR; PG8_MMA(1, 1, At, B1); PG8_BAR;
            PG8_LDB(B0, 1, 0); PG8_SCHED; PG8_LDA(At, 1, 0); PG8_STAGE2(PG8_SA(0, 1), a2, o10, o11);
            PG8_WAIT_L(8); PG8_BAR; PG8_WAIT_L(0); PG8_MMA(0, 0, At, B0); PG8_BAR; PG8_SCHED;
            PG8_LDB(B1, 1, 1); PG8_STAGEB(PG8_SB(1, 0), b3);
            PG8_BAR; PG8_WAIT_L(0); PG8_MMA(0, 1, At, B1); PG8_BAR;
            PG8_LDA(At, 1, 1); PG8_STAGE2(PG8_SA(1, 0), a3, o00, o01);
            PG8_BAR; PG8_WAIT_L(0); PG8_MMA(1, 0, At, B0); PG8_BAR; PG8_SCHED;
            PG8_STAGEB(PG8_SB(1, 1), b3 + hstepB);
            PG8_WAIT_V(6); PG8_BAR; PG8_MMA(1, 1, At, B1); PG8_BAR;
        }
        E(acc, cur, wr, wc, fr, fq);
        if (!has_next) break;
#pragma unroll
        for (int a = 0; a < 2; ++a)
#pragma unroll
            for (int b = 0; b < 2; ++b)
#pragma unroll
                for (int m = 0; m < 4; ++m)
#pragma unroll
                    for (int n = 0; n < 2; ++n) acc[a][b][m][n] = (f32x4){0.f, 0.f, 0.f, 0.f};
        cur = nxt; cA = nA; cB = nB; ++ui;
#pragma unroll
        for (int h = 0; h < 2; ++h)
#pragma unroll
            for (int i = 0; i < 2; ++i) oc[h][i] = on[h][i];
    }
    PG8_WAIT_V(0);
    if (wr == 0) PG8_BAR;
    PG8_BAR;
#undef PG8_SA
#undef PG8_SB
#undef PG8_STAGE2
#undef PG8_STAGEB
#undef PG8_LDA
#undef PG8_LDB
#undef PG8_MMA
#undef PG8_WAIT_V
#undef PG8_WAIT_L
#undef PG8_BAR
#undef PG8_SCHED
}
}
namespace fk {
constexpr int NTHR = 512;
constexpr int LDS_BYTES = 147456;
constexpr int HCAP = 24576;
constexpr float QSCALE_MLA = 0.07216878364870322f * LOG2E;
constexpr float QSCALE_128 = 0.08838834764831845f * LOG2E;

struct FW {
    const float *x_in, *t5, *mla_w_in, *mla_qn, *mla_kvn, *mla_wq, *mla_wkv, *mla_wo, *fox_w_in, *fox_bf, *fox_wo, *dsa_w_in, *dsa_wo, *ln_g, *ln_b, *wgrp, *bgrp, *wrt, *brt, *wgate, *wup, *wdown;
    float* out;
    unsigned* bar; int* moe_cnt;
    bf16_t *mla_win_t, *mla_wq_t, *mla_wkv_t, *mla_wo_t, *fox_win_t, *fox_wo_t, *dsa_win_t, *dsa_wo_t, *moe_gu_t, *moe_d_t;
    float *wr4, *fox_wf4; f32x2* rope_cs;
    float *xA, *xB, *y; bf16_t *xb0, *xb1, *o;
    char* arena;
    float* ss;
    float *flog, *cf2;
    int *te, *tpos, *list; float *tw, *sw; bf16_t *H, *Y2; unsigned char* x1q;
};

struct FWK { const float *x_in, *t5, *mla_w_in, *mla_qn, *mla_kvn, *mla_wq, *mla_wkv, *mla_wo, *fox_w_in, *fox_bf, *fox_wo, *dsa_w_in, *dsa_wo, *ln_g, *ln_b, *wgrp, *bgrp, *wrt, *brt, *wgate, *wup, *wdown; float* out; char* ws; long moe_bias_gu, moe_bias_d; long var; };
constexpr size_t al256(size_t x) { return (x + 255) & ~(size_t)255; }
template <int MOE_LAYERS> struct WsMap {
    static constexpr size_t CTL = 0, CTL_BYTES = 65536;
    static constexpr size_t MLA_WIN_T = CTL + CTL_BYTES, MLA_WQ_T = MLA_WIN_T + al256((size_t)2 * 1280 * D * 2), MLA_WKV_T = MLA_WQ_T + al256((size_t)2 * 3072 * 512 * 2), MLA_WO_T = MLA_WKV_T + al256((size_t)2 * 4096 * 512 * 2);
    static constexpr size_t FOX_WIN_T = MLA_WO_T + al256((size_t)2 * D * D * 2), FOX_WO_T = FOX_WIN_T + al256((size_t)6144 * D * 2), DSA_WIN_T = FOX_WO_T + al256((size_t)D * D * 2), DSA_WO_T = DSA_WIN_T + al256((size_t)3584 * D * 2);
    static constexpr size_t MOE_GU_T = DSA_WO_T + al256((size_t)D * D * 2), MOE_D_T = MOE_GU_T + al256((size_t)MOE_LAYERS * 32 * 1024 * D * 2);
    static constexpr size_t WR4 = MOE_D_T + al256((size_t)MOE_LAYERS * 32 * D * 512 * 2), FOX_WF4 = WR4 + al256((size_t)4 * D * 48 * 4), ROPE = FOX_WF4 + al256((size_t)D * 16 * 4);
    static constexpr size_t XA = ROPE + al256((size_t)S * 32 * 8), XB = XA + al256((size_t)NT * D * 4), Y = XB + al256((size_t)NT * D * 4);
    static constexpr size_t XB0 = Y + al256((size_t)NT * D * 4), XB1 = XB0 + al256((size_t)NT * D * 2), O = XB1 + al256((size_t)NT * D * 2), ARENA = O + al256((size_t)NT * D * 2);
    static constexpr size_t SS = ARENA + al256((size_t)NT * (512 + 512 + 64 + 3072 + 4096) * 2), FLOG = SS + al256((size_t)NT * 2 * 8 * 4), CF2 = FLOG + al256((size_t)NT * 16 * 4);
    static constexpr size_t TE = CF2 + al256((size_t)NB * 16 * S * 4), TPOS = TE + al256((size_t)NT * 2 * 4), LIST = TPOS + al256((size_t)NT * 2 * 4), TW = LIST + al256((size_t)32 * NT * 4), SW = TW + al256((size_t)NT * 2 * 4);
    static constexpr size_t H = SW + al256((size_t)32 * NT * 4), Y2 = H + al256((size_t)HCAP * 512 * 2), X1Q = Y2 + al256((size_t)HCAP * D * 2), END = X1Q + al256((size_t)NT * D);
};
template <int ML> __host__ __device__ __forceinline__ FW make_fw(const FWK& k, char* ws) {
    typedef WsMap<ML> M; FW w;
    w.x_in = k.x_in; w.t5 = k.t5; w.mla_w_in = k.mla_w_in; w.mla_qn = k.mla_qn; w.mla_kvn = k.mla_kvn; w.mla_wq = k.mla_wq; w.mla_wkv = k.mla_wkv; w.mla_wo = k.mla_wo; w.fox_w_in = k.fox_w_in; w.fox_bf = k.fox_bf; w.fox_wo = k.fox_wo;
    w.dsa_w_in = k.dsa_w_in; w.dsa_wo = k.dsa_wo; w.ln_g = k.ln_g; w.ln_b = k.ln_b; w.wgrp = k.wgrp; w.bgrp = k.bgrp; w.wrt = k.wrt; w.brt = k.brt; w.wgate = k.wgate; w.wup = k.wup; w.wdown = k.wdown; w.out = k.out;
    w.bar = (unsigned*)(ws + M::CTL); w.moe_cnt = (int*)(ws + M::CTL + 32768);
    w.mla_win_t = (bf16_t*)(ws + M::MLA_WIN_T); w.mla_wq_t = (bf16_t*)(ws + M::MLA_WQ_T); w.mla_wkv_t = (bf16_t*)(ws + M::MLA_WKV_T); w.mla_wo_t = (bf16_t*)(ws + M::MLA_WO_T);
    w.fox_win_t = (bf16_t*)(ws + M::FOX_WIN_T); w.fox_wo_t = (bf16_t*)(ws + M::FOX_WO_T); w.dsa_win_t = (bf16_t*)(ws + M::DSA_WIN_T); w.dsa_wo_t = (bf16_t*)(ws + M::DSA_WO_T);
    w.moe_gu_t = (bf16_t*)(ws + M::MOE_GU_T) - k.moe_bias_gu; w.moe_d_t = (bf16_t*)(ws + M::MOE_D_T) - k.moe_bias_d;
    w.wr4 = (float*)(ws + M::WR4); w.fox_wf4 = (float*)(ws + M::FOX_WF4); w.rope_cs = (f32x2*)(ws + M::ROPE);
    w.xA = (float*)(ws + M::XA); w.xB = (float*)(ws + M::XB); w.y = (float*)(ws + M::Y); w.xb0 = (bf16_t*)(ws + M::XB0); w.xb1 = (bf16_t*)(ws + M::XB1); w.o = (bf16_t*)(ws + M::O); w.arena = ws + M::ARENA;
    w.ss = (float*)(ws + M::SS); w.flog = (float*)(ws + M::FLOG); w.cf2 = (float*)(ws + M::CF2);
    w.te = (int*)(ws + M::TE); w.tpos = (int*)(ws + M::TPOS); w.list = (int*)(ws + M::LIST); w.tw = (float*)(ws + M::TW); w.sw = (float*)(ws + M::SW); w.H = (bf16_t*)(ws + M::H); w.Y2 = (bf16_t*)(ws + M::Y2); w.x1q = (unsigned char*)(ws + M::X1Q);
    return w;
}
__device__ __forceinline__ int fk_tid() { int t = threadIdx.x; asm volatile("" : "+v"(t)); return t; }
__device__ __forceinline__ int fk_bid() { int t = blockIdx.x; asm volatile("" : "+s"(t)); return t; }
__device__ __forceinline__ int fk_nblk() { int t = gridDim.x; asm volatile("" : "+s"(t)); return t; }

enum { MAP_ID = 0, MAP_MLA_IN = 1, MAP_MLA_Q = 2, MAP_MOE_GU = 3 };
struct CvtJob { const float* src0; const float* src1; const float* scale; bf16_t* dst; long src_bstride, dst_bstride; int K, N, Np, map, nbatch, tile0, wide, pad; };
constexpr int MAXJOBS = 24;
struct CvtTable { CvtJob j[MAXJOBS]; int njobs, ntiles, misc, pad; };

__device__ __forceinline__ int map_col(int map, int np, int N, int& which) {
    which = 0;
    if (map == MAP_ID) return np < N ? np : -1;
    if (map == MAP_MLA_IN) { if (np < 1024) return np; if (np < 1088) { const int i = np - 1024; return 1024 + (i >> 1) + 32 * (i & 1); } return -1; }
    if (map == MAP_MLA_Q) { const int h = np / 192, j = np % 192; if (j < 128) return np; const int i = j - 128; return h * 192 + 128 + (i >> 1) + 32 * (i & 1); }
      { const int q = np >> 5, r = np & 31; which = r >> 4; return 16 * q + (r & 15); }
}
__device__ __forceinline__ void cvt_tile(const CvtJob& J, int lt, FK_LAS float* tile  , const int tid) {
    const int tk = J.K / 64, tn = J.Np / 64, per = tk * tn;
    const int b = lt / per, r = lt % per, tkk = r % tk, tnn = r / tk;
    const int k0 = tkk * 64, n0 = tnn * 64;
    const float* s0 = J.src0 + (size_t)b * J.src_bstride; const float* s1 = J.src1 ? J.src1 + (size_t)b * J.src_bstride : nullptr;
    bf16_t* d = J.dst + (size_t)b * J.dst_bstride;
    { const int np = n0 + (tid & 63); int which; const int sc = map_col(J.map, np, J.N, which); const float* s = which ? s1 : s0;
#pragma unroll
      for (int i = 0; i < 8; ++i) { const int k = (tid >> 6) + 8 * i; float v = 0.f; if (sc >= 0) { v = s[(size_t)(k0 + k) * J.N + sc]; if (J.scale) v *= J.scale[k0 + k]; } tile[k * 65 + (tid & 63)] = v; } }
    __syncthreads();
    { const int np = tid >> 3, kg = (tid & 7) * 8; float v[8];
#pragma unroll
      for (int j = 0; j < 8; ++j) v[j] = tile[(kg + j) * 65 + np];
      u32x4 w; w.x = cvt_pk_bf16(v[0], v[1]); w.y = cvt_pk_bf16(v[2], v[3]); w.z = cvt_pk_bf16(v[4], v[5]); w.w = cvt_pk_bf16(v[6], v[7]);
      *(u32x4*)(d + (size_t)(n0 + np) * J.K + k0 + kg) = w; }
    __syncthreads();
}
__device__ __forceinline__ void cvt_tile_wide(const CvtJob& J, int lt, FK_LAS unsigned char* img, const int tid) {
    const int wid = tid >> 6, lane = tid & 63;
    const int tk = J.K / 128, tn = J.Np / 256, per = tk * tn;
    const int b = lt / per, r = lt % per, tkk = r % tk, tnn = r / tk;
    const int k0 = tkk * 128, n0 = tnn * 256;
    const float* s0 = J.src0 + (size_t)b * J.src_bstride; const float* s1 = J.src1 ? J.src1 + (size_t)b * J.src_bstride : nullptr;
    bf16_t* d = J.dst + (size_t)b * J.dst_bstride;
    const int np = n0 + 4 * lane; int which; const int sc = map_col(J.map, np, J.N, which); const float* s = which ? s1 : s0;
    const bool ok = sc >= 0 && sc + 3 < J.N;
    f32x4 v[16];
#pragma unroll
    for (int i = 0; i < 16; ++i) { const int k = k0 + wid * 16 + i; v[i] = ok ? *(const f32x4*)(s + (size_t)k * J.N + sc) : (f32x4){0.f, 0.f, 0.f, 0.f}; if (J.scale) v[i] = v[i] * J.scale[k]; }
#pragma unroll
    for (int j = 0; j < 4; ++j) { const int n = 4 * lane + j;
#pragma unroll
        for (int h = 0; h < 2; ++h) { u32x4 w; w.x = cvt_pk_bf16(v[8 * h + 0][j], v[8 * h + 1][j]); w.y = cvt_pk_bf16(v[8 * h + 2][j], v[8 * h + 3][j]); w.z = cvt_pk_bf16(v[8 * h + 4][j], v[8 * h + 5][j]); w.w = cvt_pk_bf16(v[8 * h + 6][j], v[8 * h + 7][j]);
            const int c = wid * 2 + h; *(FK_LAS u32x4*)(img + n * 256 + ((c ^ (n & 15)) << 4)) = w; } }
    __syncthreads();
#pragma unroll
    for (int i = 0; i < 8; ++i) { const int idx = tid + 512 * i, n = idx >> 4, c = idx & 15; const u32x4 w = *(FK_LAS const u32x4*)(img + n * 256 + ((c ^ (n & 15)) << 4));
        *(u32x4*)(d + (size_t)(n0 + n) * J.K + k0 + c * 8) = w; }
    __syncthreads();
}
__device__ __forceinline__ void phase_prologue(const FW& w, const CvtTable& T, FK_LAS unsigned char* lds) {
    FK_LAS float* tile = (FK_LAS float*)lds; const int tid0 = fk_tid();
    for (int t = fk_bid(); t < T.ntiles; t += fk_nblk()) {
        int ji = 0;
#pragma unroll 1
        for (int q = 1; q < T.njobs; ++q) if (t >= T.j[q].tile0) ji = q;
        if (T.j[ji].wide) cvt_tile_wide(T.j[ji], t - T.j[ji].tile0, lds, tid0); else cvt_tile(T.j[ji], t - T.j[ji].tile0, tile, tid0);
    }
    if (!T.misc) return;
    const int gt = fk_bid() * NTHR + tid0, gn = fk_nblk() * NTHR;
    for (int i = gt; i < S * 32; i += gn) { const int pos = i >> 5, j = i & 31; const float invf = powf(10000.f, -(float)j / 32.f); const float ang = (float)pos * invf; w.rope_cs[i] = (f32x2){cosf(ang), sinf(ang)}; }
    for (int i = gt; i < 4 * 128 * 3 * 64 * 4; i += gn) { const int ii = i & 3, lane = (i >> 2) & 63, q = i >> 8, nt = q % 3, kg = (q / 3) & 127, layer = q / (3 * 128); const int k = 16 * kg + 4 * (lane >> 4) + ii, n = 16 * nt + (lane & 15);
        float v = 0.f; if (n < 4) v = w.wgrp[((size_t)layer * D + k) * 4 + n]; else if (n < 36) v = w.wrt[((size_t)layer * D + k) * 32 + (n - 4)]; w.wr4[i] = v; }
    for (int i = gt; i < 128 * 64 * 4; i += gn) { const int ii = i & 3, lane = (i >> 2) & 63, kg = i >> 8; const int k = 16 * kg + 4 * (lane >> 4) + ii; w.fox_wf4[i] = w.fox_w_in[(size_t)k * 6160 + 6144 + (lane & 15)]; }
    for (int i = gt; i < NT * D / 4; i += gn) { const f32x4 v = ((const f32x4*)w.x_in)[i]; u32x2 p; p.x = cvt_pk_bf16(v[0], v[1]); p.y = cvt_pk_bf16(v[2], v[3]); ((u32x2*)w.xb0)[i] = p; }
}

struct RectSched {
    const char* A; const char* B; int lda, ldb, nM, nN, nwg, G, c;
    __device__ void init(const bf16_t* A_, int lda_, const bf16_t* B_, int ldb_, int M, int N) { A = (const char*)A_; B = (const char*)B_; lda = lda_; ldb = ldb_; nM = M / BM; nN = N / BM; nwg = nM * nN; G = fk_nblk(); c = fk_bid(); }
    __device__ __forceinline__ bool tile(int i, int& pm, int& pn) const {
        const long L = (long)i * G + c; if (L >= nwg) return false;
        int wgid = (int)L; { const int q = nwg / 8, r = nwg % 8, xcd = wgid % 8, off = wgid / 8; wgid = (xcd < r ? xcd * (q + 1) : r * (q + 1) + (xcd - r) * q) + off; }
        const int nig = 8 * nN, gid = wgid / nig, fm = gid * 8, gsz = (nM - fm) < 8 ? (nM - fm) : 8;
        pm = fm + ((wgid % nig) % gsz); pn = (wgid % nig) / gsz; return true;
    }
    __device__ __forceinline__ bool next(int i, GUnit& u) const { int pm, pn; if (!tile(i, pm, pn)) return false; u.pm = pm; u.pn = pn; u.e = 0; u.nrows = BM; u.A = A + (size_t)pm * BM * lda * 2; u.B = B + (size_t)pn * BM * ldb * 2; return true; }
    __device__ __forceinline__ void a_offs(const GUnit&, int tid, unsigned (&o)[2][2]) const { int R0, C0, R1, C1; stage_rc(tid * 16, R0, C0); stage_rc(tid * 16 + 8192, R1, C1);
        o[0][0] = (unsigned)(R0 * lda + C0) * 2u; o[0][1] = (unsigned)(R1 * lda + C1) * 2u; o[1][0] = o[0][0] + (unsigned)(HALF * lda * 2); o[1][1] = o[0][1] + (unsigned)(HALF * lda * 2); }
};
struct Rect2Sched {
    RectSched s0, s1; int n0;
    __device__ __forceinline__ bool next(int i, GUnit& u) const {
        const long L = (long)i * s0.G + s0.c; const int tot = s0.nwg + s1.nwg; if (L >= tot) return false;
        if (L < s0.nwg) { const int pm = (int)L % s0.nM, pn = (int)L / s0.nM; u.pm = pm; u.pn = pn; u.e = 0; u.nrows = BM; u.A = s0.A + (size_t)pm * BM * s0.lda * 2; u.B = s0.B + (size_t)pn * BM * s0.ldb * 2; }
        else { const int l = (int)L - s0.nwg; const int pm = l % s1.nM, pn = l / s1.nM; u.pm = pm; u.pn = pn; u.e = 1; u.nrows = BM; u.A = s1.A + (size_t)pm * BM * s1.lda * 2; u.B = s1.B + (size_t)pn * BM * s1.ldb * 2; }
        return true; }
    __device__ __forceinline__ void a_offs(const GUnit& u, int tid, unsigned (&o)[2][2]) const { s0.a_offs(u, tid, o); }
};

struct EpiF32 {
    static constexpr bool PERM = false;
    float* Cp; int ldc;
    __device__ __forceinline__ void operator()(const f32x4 (&acc)[2][2][4][2], const GUnit& u, int wr, int wc, int fr, int fq) const {
        const int row0 = u.pm * BM + wr * 64 + fr, col0 = u.pn * BM + wc * 32 + 4 * fq;
#pragma unroll
        for (int ai = 0; ai < 2; ++ai)
#pragma unroll
            for (int m = 0; m < 4; ++m) { float* rowp = Cp + (size_t)(row0 + ai * HALF + m * 16) * ldc + col0;
#pragma unroll
                for (int bj = 0; bj < 2; ++bj)
#pragma unroll
                    for (int n = 0; n < 2; ++n) *(f32x4*)(rowp + bj * HALF + n * 16) = acc[ai][bj][m][n]; }
    }
};
__device__ __forceinline__ u32x4 pack8(const f32x4& a, const f32x4& b) { u32x4 w; w.x = cvt_pk_bf16(a[0], a[1]); w.y = cvt_pk_bf16(a[2], a[3]); w.z = cvt_pk_bf16(b[0], b[1]); w.w = cvt_pk_bf16(b[2], b[3]); return w; }
__device__ __forceinline__ void rope8(f32x4& v0, f32x4& v1, const f32x2* cs) {
    const f32x4 c01 = *(const f32x4*)cs, c23 = *(const f32x4*)(cs + 2);
    f32x4 r0, r1;
    r0[0] = v0[0] * c01[0] - v0[1] * c01[1]; r0[1] = v0[1] * c01[0] + v0[0] * c01[1]; r0[2] = v0[2] * c01[2] - v0[3] * c01[3]; r0[3] = v0[3] * c01[2] + v0[2] * c01[3];
    r1[0] = v1[0] * c23[0] - v1[1] * c23[1]; r1[1] = v1[1] * c23[0] + v1[0] * c23[1]; r1[2] = v1[2] * c23[2] - v1[3] * c23[3]; r1[3] = v1[3] * c23[2] + v1[2] * c23[3];
    v0 = r0; v1 = r1;
}
struct EpiMlaIn {
    static constexpr bool PERM = true;
    bf16_t *cq, *ckv, *kr; float* ss; const f32x2* cs;
    __device__ __forceinline__ void operator()(const f32x4 (&acc)[2][2][4][2], const GUnit& u, int wr, int wc, int fr, int fq) const {
        const int row0 = u.pm * BM + wr * 64 + fr;
        if (u.pn < 4) {
            bf16_t* dst = (u.pn < 2) ? cq : ckv; const int which = u.pn >> 1; const int col0 = (u.pn & 1) * BM + wc * 32 + 8 * fq;
#pragma unroll
            for (int ai = 0; ai < 2; ++ai)
#pragma unroll
                for (int m = 0; m < 4; ++m) { const int row = row0 + ai * HALF + m * 16; float q = 0.f;
#pragma unroll
                    for (int bj = 0; bj < 2; ++bj) { const f32x4 v0 = acc[ai][bj][m][0], v1 = acc[ai][bj][m][1];
                        q += (v0[0] * v0[0] + v0[1] * v0[1]) + (v0[2] * v0[2] + v0[3] * v0[3]) + (v1[0] * v1[0] + v1[1] * v1[1]) + (v1[2] * v1[2] + v1[3] * v1[3]);
                        *(u32x4*)(dst + (size_t)row * 512 + col0 + bj * HALF) = pack8(v0, v1); }
                    q += __shfl_xor(q, 16); q += __shfl_xor(q, 32);
                    if (fq == 0) ss[((size_t)row * 2 + which) * 8 + (u.pn & 1) * 4 + wc] = q; }
        } else if (wc < 2) {
#pragma unroll
            for (int ai = 0; ai < 2; ++ai) { f32x4 c01[4], c23[4];
#pragma unroll
                for (int m = 0; m < 4; ++m) { const int row = row0 + ai * HALF + m * 16; const f32x2* cp = cs + (size_t)(row & (S - 1)) * 32 + 16 * wc + 4 * fq; c01[m] = *(const f32x4*)cp; c23[m] = *(const f32x4*)(cp + 2); }
#pragma unroll
                for (int m = 0; m < 4; ++m) { const int row = row0 + ai * HALF + m * 16; const f32x4 v0 = acc[ai][0][m][0], v1 = acc[ai][0][m][1]; const f32x4 a = c01[m], b = c23[m]; f32x4 r0, r1;
                    r0[0] = v0[0] * a[0] - v0[1] * a[1]; r0[1] = v0[1] * a[0] + v0[0] * a[1]; r0[2] = v0[2] * a[2] - v0[3] * a[3]; r0[3] = v0[3] * a[2] + v0[2] * a[3];
                    r1[0] = v1[0] * b[0] - v1[1] * b[1]; r1[1] = v1[1] * b[0] + v1[0] * b[1]; r1[2] = v1[2] * b[2] - v1[3] * b[3]; r1[3] = v1[3] * b[2] + v1[2] * b[3];
                    *(u32x4*)(kr + (size_t)row * 64 + wc * 32 + 8 * fq) = pack8(r0, r1); } }
        }
    }
};
struct EpiMlaQKV {
    static constexpr bool PERM = true;
    bf16_t *q, *kv; const float* ss; const f32x2* cs;
    __device__ __forceinline__ void operator()(const f32x4 (&acc)[2][2][4][2], const GUnit& u, int wr, int wc, int fr, int fq) const {
        const int row0 = u.pm * BM + wr * 64 + fr;
#pragma unroll
        for (int ai = 0; ai < 2; ++ai) {
            float rs[4];
            { f32x4 sa[4], sb[4];
#pragma unroll
              for (int m = 0; m < 4; ++m) { const int row = row0 + ai * HALF + m * 16; sa[m] = *(const f32x4*)(ss + ((size_t)row * 2 + u.e) * 8); sb[m] = *(const f32x4*)(ss + ((size_t)row * 2 + u.e) * 8 + 4); }
#pragma unroll
              for (int m = 0; m < 4; ++m) rs[m] = rsqrtf((((sa[m][0] + sa[m][1]) + (sa[m][2] + sa[m][3])) + ((sb[m][0] + sb[m][1]) + (sb[m][2] + sb[m][3]))) * (1.0f / 512.0f) + 1e-6f); }
#pragma unroll
            for (int bj = 0; bj < 2; ++bj) { const int gc = u.pn * BM + bj * HALF + wc * 32 + 8 * fq; const int j = gc % 192; const bool rope = __builtin_amdgcn_readfirstlane((int)((u.e == 0) && (j >= 128))) != 0;
                f32x4 c01[4], c23[4];
                if (rope) {
#pragma unroll
                    for (int m = 0; m < 4; ++m) { const int row = row0 + ai * HALF + m * 16; const f32x2* cp = cs + (size_t)(row & (S - 1)) * 32 + ((j - 128) >> 1); c01[m] = *(const f32x4*)cp; c23[m] = *(const f32x4*)(cp + 2); } }
#pragma unroll
                for (int m = 0; m < 4; ++m) { const int row = row0 + ai * HALF + m * 16; f32x4 v0 = acc[ai][bj][m][0] * rs[m], v1 = acc[ai][bj][m][1] * rs[m];
                    if (u.e == 0) {
                        if (rope) { f32x4 r0, r1; const f32x4 a = c01[m], b = c23[m];
                            r0[0] = v0[0] * a[0] - v0[1] * a[1]; r0[1] = v0[1] * a[0] + v0[0] * a[1]; r0[2] = v0[2] * a[2] - v0[3] * a[3]; r0[3] = v0[3] * a[2] + v0[2] * a[3];
                            r1[0] = v1[0] * b[0] - v1[1] * b[1]; r1[1] = v1[1] * b[0] + v1[0] * b[1]; r1[2] = v1[2] * b[2] - v1[3] * b[3]; r1[3] = v1[3] * b[2] + v1[2] * b[3]; v0 = r0; v1 = r1; }
                        v0 = v0 * QSCALE_MLA; v1 = v1 * QSCALE_MLA; *(u32x4*)(q + (size_t)row * 3072 + gc) = pack8(v0, v1); }
                    else *(u32x4*)(kv + (size_t)row * 4096 + gc) = pack8(v0, v1); } }
        }
    }
};
}
namespace fk {
#define FK_KSWZ(row, colB) ((row) * 256 + ((colB) ^ (((row) & 7) << 4)))
#define FK_KRSWZ(row, ch) ((row) * 128 + ((((ch)) ^ (((row) >> 1) & 7)) << 4))
__device__ __forceinline__ int v_st(int k, int c) { const int kk = (k & ~0xC) | ((k & 4) << 1) | ((k & 8) >> 1); return ((kk >> 3) * 4 + (c >> 5)) * 512 + ((kk & 7) * 32 + (c & 31)) * 2; }
__device__ __forceinline__ int v_rd_base(int lane) { return ((lane & 3) << 3) | (((lane >> 2) & 3) << 6) | (((lane >> 4) & 1) << 5) | (((lane >> 5) & 1) << 8); }
__device__ __forceinline__ int crow(int r, int hi) { return (r & 3) + 8 * (r >> 2) + 4 * hi; }

constexpr int AT_K = 0, AT_V = 32768, AT_KR = 65536, AT_CF = 81920, AT_WS = 90112;

struct AttnPtrs { const bf16_t* Q; const bf16_t* K; const bf16_t* V; const bf16_t* KR; const float* CF; bf16_t* O; int qld, kld; };

template <int MODE>
__device__ __forceinline__ void attn_block(FK_LAS unsigned char* lds, const AttnPtrs P, const int qb) {
    constexpr int NQ = MODE == 0 ? 12 : 8;
    const int tid = fk_tid(), wid = __builtin_amdgcn_readfirstlane(tid >> 6), lane = tid & 63, r32 = lane & 31, hi = lane >> 5;
    const int q0w = qb * 256 + wid * 32;
    const int nt = 4 * (qb + 1);
    bf16x8 qr[NQ];
    { const bf16_t* qrow = P.Q + (size_t)(q0w + r32) * P.qld;
#pragma unroll
      for (int d0 = 0; d0 < NQ; ++d0) qr[d0] = *(const bf16x8*)(qrow + d0 * 16 + hi * 8); }
    float ct2 = 0.f; if (MODE == 1) ct2 = ((FK_LAS const float*)(lds + AT_CF))[q0w + r32];
    const int sr = tid >> 4, sc = (tid & 15) * 8;
    const int kws = FK_KSWZ(sr, sc * 2), vst0 = v_st(sr, sc), vst1 = v_st(32 + sr, sc);
    const int krr = tid >> 3, krc = tid & 7, krw = FK_KRSWZ(krr, krc);
    const int vb0 = AT_V + v_rd_base(lane);
    FK_LAS float* wsl = (FK_LAS float*)(lds + AT_WS) + wid * 64;
    bf16x8 sk0, sk1, sv0, sv1, skr;
    float m_reg = -1e30f, l_reg = 0.f; f32x16 o[4];
#pragma unroll
    for (int d = 0; d < 4; ++d)
#pragma unroll
        for (int r = 0; r < 16; ++r) o[d][r] = 0.f;
#define AT_LOAD(j) do { const size_t k0_ = (size_t)(j) * 64; \
        sk0 = *(const bf16x8*)(P.K + (k0_ + sr) * P.kld + sc); sk1 = *(const bf16x8*)(P.K + (k0_ + 32 + sr) * P.kld + sc); \
        sv0 = *(const bf16x8*)(P.V + (k0_ + sr) * P.kld + sc); sv1 = *(const bf16x8*)(P.V + (k0_ + 32 + sr) * P.kld + sc); \
        if (MODE == 0) skr = *(const bf16x8*)(P.KR + (k0_ + krr) * 64 + krc * 8); \
        } while (0)
#define AT_WRITE(bf) do { *(FK_LAS bf16x8*)(lds + AT_K + (bf) * 16384 + kws) = sk0; *(FK_LAS bf16x8*)(lds + AT_K + (bf) * 16384 + kws + 32 * 256) = sk1; \
        *(FK_LAS bf16x8*)(lds + AT_V + (bf) * 16384 + vst0) = sv0; *(FK_LAS bf16x8*)(lds + AT_V + (bf) * 16384 + vst1) = sv1; \
        if (MODE == 0) *(FK_LAS bf16x8*)(lds + AT_KR + (bf) * 8192 + krw) = skr; \
        } while (0)
#define AT_TRRD(dst, off) asm volatile("ds_read_b64_tr_b16 %0, %1 offset:%2" : "=&v"(dst) : "v"(vb0), "i"(off) : "memory")
#define AT_PV_D0(KB, d0) do { s16x4 l0, l1, l2, l3, h0, h1, h2, h3; constexpr int b_ = (KB) * 16384 + (d0) * 512; \
        AT_TRRD(l0, b_); AT_TRRD(h0, b_ + 2048); AT_TRRD(l1, b_ + 4096); AT_TRRD(h1, b_ + 6144); AT_TRRD(l2, b_ + 8192); AT_TRRD(h2, b_ + 10240); AT_TRRD(l3, b_ + 12288); AT_TRRD(h3, b_ + 14336); \
        asm volatile("s_waitcnt lgkmcnt(0)" ::: "memory"); __builtin_amdgcn_sched_barrier(0); \
        o[d0] = __builtin_amdgcn_mfma_f32_32x32x16_bf16(pa0, (bf16x8){l0[0], l0[1], l0[2], l0[3], h0[0], h0[1], h0[2], h0[3]}, o[d0], 0, 0, 0); \
        o[d0] = __builtin_amdgcn_mfma_f32_32x32x16_bf16(pa1, (bf16x8){l1[0], l1[1], l1[2], l1[3], h1[0], h1[1], h1[2], h1[3]}, o[d0], 0, 0, 0); \
        o[d0] = __builtin_amdgcn_mfma_f32_32x32x16_bf16(pa2, (bf16x8){l2[0], l2[1], l2[2], l2[3], h2[0], h2[1], h2[2], h2[3]}, o[d0], 0, 0, 0); \
        o[d0] = __builtin_amdgcn_mfma_f32_32x32x16_bf16(pa3, (bf16x8){l3[0], l3[1], l3[2], l3[3], h3[0], h3[1], h3[2], h3[3]}, o[d0], 0, 0, 0); } while (0)
#define AT_PK4(Pv, B_, OUT) do { unsigned a0 = cvt_pk_bf16(Pv[B_ + 0], Pv[B_ + 1]), a1 = cvt_pk_bf16(Pv[B_ + 2], Pv[B_ + 3]); \
        unsigned b0 = cvt_pk_bf16(Pv[B_ + 4], Pv[B_ + 5]), b1 = cvt_pk_bf16(Pv[B_ + 6], Pv[B_ + 7]); \
        auto r0 = __builtin_amdgcn_permlane32_swap(a0, b0, false, false); auto r1 = __builtin_amdgcn_permlane32_swap(a1, b1, false, false); \
        u32x4 w_ = {r0[0], r1[0], r0[1], r1[1]}; OUT = *reinterpret_cast<bf16x8*>(&w_); } while (0)
#define AT_STEP(j, KB) do { \
        if ((j) + 1 < nt) AT_LOAD((j) + 1); \
        if ((j) * 64 <= q0w) { \
            f32x16 p0, p1; \
            _Pragma("unroll") for (int r = 0; r < 16; ++r) { p0[r] = 0.f; p1[r] = 0.f; } \
            __builtin_amdgcn_s_setprio(1); \
            { FK_LAS const unsigned char* kb_ = lds + AT_K + (KB) * 16384; \
              _Pragma("unroll") for (int d0 = 0; d0 < 8; ++d0) { \
                const bf16x8 b0 = *(FK_LAS const bf16x8*)(kb_ + FK_KSWZ(r32, (d0 * 16 + hi * 8) * 2)); \
                const bf16x8 b1 = *(FK_LAS const bf16x8*)(kb_ + FK_KSWZ(r32, (d0 * 16 + hi * 8) * 2) + 32 * 256); \
                p0 = __builtin_amdgcn_mfma_f32_32x32x16_bf16(b0, qr[d0], p0, 0, 0, 0); \
                p1 = __builtin_amdgcn_mfma_f32_32x32x16_bf16(b1, qr[d0], p1, 0, 0, 0); } } \
            if (MODE == 0) { FK_LAS const unsigned char* kr_ = lds + AT_KR + (KB) * 8192; \
              _Pragma("unroll") for (int d0 = 0; d0 < 4; ++d0) { \
                const bf16x8 b0 = *(FK_LAS const bf16x8*)(kr_ + FK_KRSWZ(r32, 2 * d0 + hi)); \
                const bf16x8 b1 = *(FK_LAS const bf16x8*)(kr_ + FK_KRSWZ(r32 + 32, 2 * d0 + hi)); \
                p0 = __builtin_amdgcn_mfma_f32_32x32x16_bf16(b0, qr[(MODE == 0 ? 8 : 0) + d0], p0, 0, 0, 0); \
                p1 = __builtin_amdgcn_mfma_f32_32x32x16_bf16(b1, qr[(MODE == 0 ? 8 : 0) + d0], p1, 0, 0, 0); } } \
            __builtin_amdgcn_s_setprio(0); \
            if (MODE == 1) { FK_LAS const float* cf_ = (FK_LAS const float*)(lds + AT_CF) + (j) * 64; \
              _Pragma("unroll") for (int g = 0; g < 4; ++g) { const f32x4 c0 = *(FK_LAS const f32x4*)(cf_ + 8 * g + 4 * hi), c1 = *(FK_LAS const f32x4*)(cf_ + 32 + 8 * g + 4 * hi); \
                _Pragma("unroll") for (int i = 0; i < 4; ++i) { p0[4 * g + i] += ct2 - c0[i]; p1[4 * g + i] += ct2 - c1[i]; } } \
              if ((j) * 64 + 63 > q0w) { const int dq = q0w + r32 - (j) * 64 - 4 * hi; const float NEG = -__builtin_inff(); \
                _Pragma("unroll") for (int r = 0; r < 16; ++r) { const int c = (r & 3) + 8 * (r >> 2); if (c > dq) p0[r] = NEG; if (c + 32 > dq) p1[r] = NEG; } } } \
            float pmax = p0[0]; \
            _Pragma("unroll") for (int r = 1; r < 16; ++r) pmax = fmaxf(pmax, p0[r]); \
            _Pragma("unroll") for (int r = 0; r < 16; ++r) pmax = fmaxf(pmax, p1[r]); \
            { auto rr = __builtin_amdgcn_permlane32_swap(__float_as_uint(pmax), __float_as_uint(pmax), false, false); pmax = fmaxf(__uint_as_float(rr[0]), __uint_as_float(rr[1])); } \
            float mn, alpha; \
            if (__all(pmax - m_reg <= 11.5415603f)) { mn = m_reg; alpha = 1.f; }     \
            else { mn = fmaxf(m_reg, pmax); alpha = __builtin_amdgcn_exp2f(m_reg - mn); m_reg = mn; } \
            float ps = 0.f; \
            _Pragma("unroll") for (int r = 0; r < 16; ++r) { p0[r] = __builtin_amdgcn_exp2f(p0[r] - mn); ps += p0[r]; } \
            _Pragma("unroll") for (int r = 0; r < 16; ++r) { p1[r] = __builtin_amdgcn_exp2f(p1[r] - mn); ps += p1[r]; } \
            { auto rr = __builtin_amdgcn_permlane32_swap(__float_as_uint(ps), __float_as_uint(ps), false, false); ps = __uint_as_float(rr[0]) + __uint_as_float(rr[1]); } \
            l_reg = l_reg * alpha + ps; \
            bf16x8 pa0, pa1, pa2, pa3; AT_PK4(p0, 0, pa0); AT_PK4(p0, 8, pa1); AT_PK4(p1, 0, pa2); AT_PK4(p1, 8, pa3); \
            if (__any(alpha < 1.f)) { if (hi == 0) wsl[32 + r32] = alpha; asm volatile("s_waitcnt lgkmcnt(0)" ::: "memory"); \
                _Pragma("unroll") for (int g = 0; g < 4; ++g) { const f32x4 a4 = *(FK_LAS const f32x4*)(wsl + 32 + 8 * g + 4 * hi); \
                    _Pragma("unroll") for (int d_ = 0; d_ < 4; ++d_) _Pragma("unroll") for (int i = 0; i < 4; ++i) o[d_][4 * g + i] *= a4[i]; } } \
            __builtin_amdgcn_s_setprio(1); AT_PV_D0(KB, 0); AT_PV_D0(KB, 1); AT_PV_D0(KB, 2); AT_PV_D0(KB, 3); __builtin_amdgcn_s_setprio(0); \
        } \
        if ((j) + 1 < nt) AT_WRITE((KB) ^ 1); \
        __syncthreads(); } while (0)

    AT_LOAD(0); AT_WRITE(0); __syncthreads();
    for (int j = 0; j < nt; j += 2) { AT_STEP(j, 0); AT_STEP(j + 1, 1); }
    if (hi == 0) wsl[r32] = l_reg; asm volatile("s_waitcnt lgkmcnt(0)" ::: "memory");
    bf16_t* Ow = P.O + (size_t)q0w * D;
#pragma unroll
    for (int g = 0; g < 4; ++g) { const f32x4 l4 = *(FK_LAS const f32x4*)(wsl + 8 * g + 4 * hi);
#pragma unroll
        for (int i = 0; i < 4; ++i) { const int r = 4 * g + i; const int orow = crow(r, hi); const float rl = __builtin_amdgcn_rcpf(l4[i]);
#pragma unroll
            for (int d0 = 0; d0 < 4; ++d0) { const float v = o[d0][r] * rl; const float vn = __shfl_xor(v, 1);
                if ((r32 & 1) == 0) *(unsigned*)(Ow + (size_t)orow * D + d0 * 32 + r32) = cvt_pk_bf16(v, vn); } } }
    __syncthreads();
#undef AT_LOAD
#undef AT_WRITE
#undef AT_TRRD
#undef AT_PV_D0
#undef AT_PK4
#undef AT_STEP
}
}
namespace fk {
constexpr int LN_XS = 2052;
constexpr int TAB_OFF = 143360;

struct LnArgs {
    const float* x; const bf16_t* yb; const bf16_t* Y2; const int* te; const int* tpos; const int* cnt;
    const float *g, *b; float* xo; bf16_t* xbo; float* out2; unsigned char* xqo;
    const f32x4* w4; int ntile;
    const float *bgrp, *brt; int* rcnt; int* ote; int* otpos; float* otw; int* list; float* sw;
    float* flog; const float* fbias;
};

__device__ __forceinline__ float wave_sum(float v) { for (int o = 32; o >= 1; o >>= 1) v += __shfl_xor(v, o); return v; }

struct LnRows { f32x4 x[2][8]; u32x2 ya[2][8]; u32x2 yb[2][8]; };
__device__ __forceinline__ void ln_load(const LnArgs& a, FK_LAS const int* hoff, int grp, int wid, int lane, LnRows& R) {
#pragma unroll
    for (int rr = 0; rr < 2; ++rr) { const int t = grp * 16 + 2 * wid + rr;
        const bf16_t *pa, *pb = nullptr;
        if (a.Y2) { const int e0 = a.te[t * 2], e1 = a.te[t * 2 + 1]; pa = a.Y2 + (size_t)(hoff[e0] + a.tpos[t * 2]) * D; pb = a.Y2 + (size_t)(hoff[e1] + a.tpos[t * 2 + 1]) * D; }
        else pa = a.yb + (size_t)t * D;
#pragma unroll
        for (int i = 0; i < 8; ++i) { const int c = 4 * lane + 256 * i; R.x[rr][i] = *(const f32x4*)(a.x + (size_t)t * D + c); R.ya[rr][i] = *(const u32x2*)(pa + c); if (a.Y2) R.yb[rr][i] = *(const u32x2*)(pb + c); else R.yb[rr][i] = (u32x2){0u, 0u}; } }
}
__device__ __forceinline__ void phase_ln(const LnArgs& a, FK_LAS unsigned char* lds) {
    const int tid = fk_tid(), wid = __builtin_amdgcn_readfirstlane(tid >> 6), lane = tid & 63;
    FK_LAS float* part = (FK_LAS float*)lds;
    FK_LAS float* logit = (FK_LAS float*)(lds + 65536);
    FK_LAS int* hoff = (FK_LAS int*)(lds + TAB_OFF);
    if (a.Y2) { if (tid < 64) { const int c = lane < 32 ? a.cnt[lane * 32] : 0; const int pc = ((c + 255) >> 8) << 8; int incl = pc;
#pragma unroll
            for (int o = 1; o < 32; o <<= 1) { const int v = __shfl_up(incl, o); if (lane >= o) incl += v; }
            if (lane < 32) hoff[lane] = incl - pc; }
        __syncthreads(); }
    const int nb = fk_nblk(); int grp = fk_bid();
    if (grp >= NT / 16) return;
    LnRows cur; ln_load(a, hoff, grp, wid, lane, cur);
#pragma unroll 1
    for (; grp < NT / 16; grp += nb) {
        const bool has_next = grp + nb < NT / 16;
#pragma unroll
        for (int rr = 0; rr < 2; ++rr) {
            const int lr = 2 * wid + rr, t = grp * 16 + lr;
            f32x4 v[8]; float s = 0.f;
#pragma unroll
            for (int i = 0; i < 8; ++i) { f32x4 xv = cur.x[rr][i] * ALPHA; const u32x2 pa = cur.ya[rr][i], pb = cur.yb[rr][i];
                xv[0] += __uint_as_float(pa.x << 16) + __uint_as_float(pb.x << 16); xv[1] += __uint_as_float(pa.x & 0xffff0000u) + __uint_as_float(pb.x & 0xffff0000u);
                xv[2] += __uint_as_float(pa.y << 16) + __uint_as_float(pb.y << 16); xv[3] += __uint_as_float(pa.y & 0xffff0000u) + __uint_as_float(pb.y & 0xffff0000u);
                v[i] = xv; s += (xv[0] + xv[1]) + (xv[2] + xv[3]); }
            const float mean = wave_sum(s) * (1.0f / D); float q = 0.f;
#pragma unroll
            for (int i = 0; i < 8; ++i) { const f32x4 d = v[i] - mean; q += (d[0] * d[0] + d[1] * d[1]) + (d[2] * d[2] + d[3] * d[3]); }
            const float rs = rsqrtf(wave_sum(q) * (1.0f / D) + 1e-5f);
#pragma unroll
            for (int i = 0; i < 8; ++i) { const int c = 4 * lane + 256 * i; const f32x4 gv = *(const f32x4*)(a.g + c), bv = *(const f32x4*)(a.b + c);
                const f32x4 o = (v[i] - mean) * rs * gv + bv;
                *(f32x4*)(a.xo + (size_t)t * D + c) = o;
                if (a.out2) *(f32x4*)(a.out2 + (size_t)t * D + c) = o;
                u32x2 p; p.x = cvt_pk_bf16(o[0], o[1]); p.y = cvt_pk_bf16(o[2], o[3]); *(u32x2*)(a.xbo + (size_t)t * D + c) = p; }
        }
        if (has_next) ln_load(a, hoff, grp + nb, wid, lane, cur);
    }
    if (!a.w4) return;
    __syncthreads();
    const int row = lane & 15, kq = lane >> 4;
#pragma unroll 1
    for (int g0 = fk_bid(); g0 < NT / 16; g0 += 2 * nb) {
        const int g1 = g0 + nb; const bool two = g1 < NT / 16;
        const float* xp0 = a.xo + (size_t)(g0 * 16 + row) * D + 4 * kq + 256 * wid;
        const float* xp1 = a.xo + (size_t)((two ? g1 : g0) * 16 + row) * D + 4 * kq + 256 * wid;
        const f32x4* wp = a.w4 + (size_t)(wid * 16 * a.ntile) * 64 + lane;
        f32x4 acc[2][3];
#pragma unroll
        for (int g = 0; g < 2; ++g)
#pragma unroll
            for (int n = 0; n < 3; ++n) acc[g][n] = (f32x4){0.f, 0.f, 0.f, 0.f};
#pragma unroll 4
        for (int j = 0; j < 16; ++j) {
            const f32x4 a0 = *(const f32x4*)(xp0 + 16 * j), a1 = *(const f32x4*)(xp1 + 16 * j);
#pragma unroll
            for (int n = 0; n < 3; ++n) if (n < a.ntile) { const f32x4 bv = wp[(size_t)(j * a.ntile + n) * 64];
#pragma unroll
                for (int i = 0; i < 4; ++i) { acc[0][n] = __builtin_amdgcn_mfma_f32_16x16x4f32(a0[i], bv[i], acc[0][n], 0, 0, 0); acc[1][n] = __builtin_amdgcn_mfma_f32_16x16x4f32(a1[i], bv[i], acc[1][n], 0, 0, 0); } } }
#pragma unroll
        for (int g = 0; g < 2; ++g)
#pragma unroll
            for (int n = 0; n < 3; ++n) if (n < a.ntile) {
#pragma unroll
                for (int r = 0; r < 4; ++r) part[(wid * 32 + 16 * g + 4 * kq + r) * 48 + 16 * n + row] = acc[g][n][r]; }
        __syncthreads();
        for (int i = tid; i < 32 * 16 * a.ntile; i += NTHR) { const int n = i % (16 * a.ntile), r = i / (16 * a.ntile); float s = 0.f;
#pragma unroll
            for (int w = 0; w < 8; ++w) s += part[(w * 32 + r) * 48 + n]; logit[r * 48 + n] = s; }
        __syncthreads();
        if (a.ntile == 1) { const int r = tid & 31, n = tid >> 5; if (r < 16 || two) { const int t = (r < 16 ? g0 : g1) * 16 + (r & 15); const float x = logit[r * 48 + n] + a.fbias[n]; const float ls = fminf(x, 0.f) - 0.6931471805599453f * __builtin_amdgcn_logf(1.0f + __builtin_amdgcn_exp2f(-fabsf(x) * LOG2E));     a.flog[((size_t)((t >> 11) * 16 + n)) * S + (t & (S - 1))] = ls; } }
        else if (tid < 16 || (tid < 32 && two)) { const int t = (tid < 16 ? g0 : g1) * 16 + (tid & 15); FK_LAS const float* lg = logit + tid * 48;
            float g4[4]; float mx = -3e38f; int gs = 0;
            for (int i = 0; i < 4; ++i) { g4[i] = lg[i] + a.bgrp[i]; if (g4[i] > mx) { mx = g4[i]; gs = i; } }
            float den = 0.f; for (int i = 0; i < 4; ++i) den += expf(g4[i] - mx); const float pg = 1.f / den;
            float e[8]; for (int i = 0; i < 8; ++i) e[i] = lg[4 + gs * 8 + i] + a.brt[gs * 8 + i];
            int i1 = 0; for (int i = 1; i < 8; ++i) if (e[i] > e[i1]) i1 = i;
            int i2 = -1; for (int i = 0; i < 8; ++i) if (i != i1 && (i2 < 0 || e[i] > e[i2])) i2 = i;
            const float w1 = 1.f / (1.f + expf(e[i2] - e[i1])), w2 = 1.f - w1;
            const int ea = gs * 8 + i1, eb = gs * 8 + i2;
            const int pa = atomicAdd(a.rcnt + ea * 32, 1), pb = atomicAdd(a.rcnt + eb * 32, 1);
            a.ote[t * 2] = ea; a.ote[t * 2 + 1] = eb; a.otpos[t * 2] = pa; a.otpos[t * 2 + 1] = pb; a.otw[t * 2] = w1 * pg; a.otw[t * 2 + 1] = w2 * pg;
            a.list[ea * NT + pa] = t; a.list[eb * NT + pb] = t; a.sw[ea * NT + pa] = w1 * pg; a.sw[eb * NT + pb] = w2 * pg; }
        __syncthreads();
    }
}

__device__ __forceinline__ void moe_tables(const int* cnt, FK_LAS int* tab) {
    const int tid = fk_tid(), lane = tid & 63;
    __syncthreads();
    if (tid < 64) { const int c = lane < 32 ? cnt[lane * 32] : 0; const int nt = (c + 255) >> 8; int incl = nt;
#pragma unroll
        for (int o = 1; o < 32; o <<= 1) { const int v = __shfl_up(incl, o); if (lane >= o) incl += v; }
        if (lane < 32) { tab[lane] = incl - nt; tab[40 + lane] = (incl - nt) * 256; tab[80 + lane] = c; }
        if (lane == 31) tab[32] = incl; }
    __syncthreads();
}
struct MoeSched1 {
    const char* xb; const char* Bt; const int* list; FK_LAS const int* tab; int G, c;
    __device__ __forceinline__ bool next(int i, GUnit& u) const {
        const int L = i * G + c; const int tot = tab[32] * 4; if (L >= tot) return false;
        int e = 0;
#pragma unroll 1
        for (int q = 1; q < 32; ++q) if (L >= tab[q] * 4) e = q;
        const int r = L - tab[e] * 4, nte = tab[e + 1] - tab[e]; const int mt = r % nte, pn = r / nte;
        u.e = e; u.pm = mt; u.pn = pn; u.nrows = min(256, tab[80 + e] - 256 * mt); u.A = xb; u.B = Bt + ((size_t)e * 1024 + (size_t)pn * 256) * D * 2; return true; }
    __device__ __forceinline__ void a_offs(const GUnit& u, int tid, unsigned (&o)[2][2]) const { int R0, C0, R1, C1; stage_rc(tid * 16, R0, C0); stage_rc(tid * 16 + 8192, R1, C1);
        const int* l = list + (size_t)u.e * NT + u.pm * 256;
        const int r00 = R0 < u.nrows ? R0 : 0, r01 = R1 < u.nrows ? R1 : 0, r10 = R0 + HALF < u.nrows ? R0 + HALF : 0, r11 = R1 + HALF < u.nrows ? R1 + HALF : 0;
        o[0][0] = (unsigned)(l[r00] * D + C0) * 2u; o[0][1] = (unsigned)(l[r01] * D + C1) * 2u; o[1][0] = (unsigned)(l[r10] * D + C0) * 2u; o[1][1] = (unsigned)(l[r11] * D + C1) * 2u; }
};
struct MoeSched2 {
    const char* H; const char* Bt; FK_LAS const int* tab; int G, c;
    __device__ __forceinline__ bool next(int i, GUnit& u) const {
        const int L = i * G + c; const int tot = tab[32] * 8; if (L >= tot) return false;
        int e = 0;
#pragma unroll 1
        for (int q = 1; q < 32; ++q) if (L >= tab[q] * 8) e = q;
        const int r = L - tab[e] * 8, nte = tab[e + 1] - tab[e]; const int mt = r % nte, pn = r / nte;
        u.e = e; u.pm = mt; u.pn = pn; u.nrows = min(256, tab[80 + e] - 256 * mt); u.A = H + (size_t)(tab[40 + e] + 256 * mt) * 512 * 2; u.B = Bt + ((size_t)e * 2048 + (size_t)pn * 256) * 512 * 2; return true; }
    __device__ __forceinline__ void a_offs(const GUnit&, int tid, unsigned (&o)[2][2]) const { int R0, C0, R1, C1; stage_rc(tid * 16, R0, C0); stage_rc(tid * 16 + 8192, R1, C1);
        o[0][0] = (unsigned)(R0 * 512 + C0) * 2u; o[0][1] = (unsigned)(R1 * 512 + C1) * 2u; o[1][0] = o[0][0] + (unsigned)(HALF * 512 * 2); o[1][1] = o[0][1] + (unsigned)(HALF * 512 * 2); }
};
struct EpiMoe1 {
    static constexpr bool PERM = false;
    bf16_t* H; const float* sw; FK_LAS const int* tab;
    __device__ __forceinline__ void operator()(const f32x4 (&acc)[2][2][4][2], const GUnit& u, int wr, int wc, int fr, int fq) const {
        const int hrow0 = tab[40 + u.e] + 256 * u.pm; const float* swe = sw + (size_t)u.e * NT + 256 * u.pm;
#pragma unroll
        for (int ai = 0; ai < 2; ++ai)
#pragma unroll
            for (int m = 0; m < 4; ++m) { const int r = ai * HALF + wr * 64 + m * 16 + fr; if (r < u.nrows) { const float wgt = swe[r];
#pragma unroll
                for (int bj = 0; bj < 2; ++bj) { const f32x4 g = acc[ai][bj][m][0], up = acc[ai][bj][m][1]; f32x4 h;
#pragma unroll
                    for (int j = 0; j < 4; ++j) h[j] = g[j] * __builtin_amdgcn_rcpf(1.0f + __builtin_amdgcn_exp2f(-g[j] * LOG2E)) * up[j] * wgt;
                    u32x2 p; p.x = cvt_pk_bf16(h[0], h[1]); p.y = cvt_pk_bf16(h[2], h[3]);
                    *(u32x2*)(H + (size_t)(hrow0 + r) * 512 + u.pn * 128 + bj * 64 + wc * 16 + 4 * fq) = p; } } }
    }
};
struct EpiMoe2 {
    static constexpr bool PERM = true;
    bf16_t* Y2; FK_LAS const int* tab;
    __device__ __forceinline__ void operator()(const f32x4 (&acc)[2][2][4][2], const GUnit& u, int wr, int wc, int fr, int fq) const {
        const int hrow0 = tab[40 + u.e] + 256 * u.pm;
#pragma unroll
        for (int ai = 0; ai < 2; ++ai)
#pragma unroll
            for (int m = 0; m < 4; ++m) { const int r = ai * HALF + wr * 64 + m * 16 + fr; if (r < u.nrows) {
#pragma unroll
                for (int bj = 0; bj < 2; ++bj) *(u32x4*)(Y2 + (size_t)(hrow0 + r) * D + u.pn * BM + bj * HALF + wc * 32 + 8 * fq) = pack8(acc[ai][bj][m][0], acc[ai][bj][m][1]); } }
    }
};
}
namespace fk {
constexpr int SG_ROWS = 640, SG_ASTG = SG_ROWS * 64, SG_BPITCH = 1040, SG_BSTG = 16 * SG_BPITCH, SG_A = 0, SG_B = 2 * SG_ASTG;
struct SgArgs {
    const char* A; const int* rowlist; int arow0, lda_bytes, nr;
    const float* B0; const float* B1; int ldn, K;
    bf16_t* out; int out_row0, out_ld, out_col0; const float* roww; int var;
};
template <int MODE>
__device__ __forceinline__ void sg_unit(FK_LAS unsigned char* lds, const SgArgs a) {
    const int tid = fk_tid(), wid = __builtin_amdgcn_readfirstlane(tid >> 6), lane = tid & 63, r16 = lane & 15, kq = lane >> 4, wm = wid >> 1, wn = wid & 1;
    const int rpw = ((a.nr + 63) >> 6) << 4, mf = rpw >> 4;
    const int nt = a.K >> 5;
    const char* ap[5];
    { const int kc = (lane & 3) ^ ((lane >> 4) & 3);
#pragma unroll
      for (int i = 0; i < 5; ++i) { int r = 16 * (5 * wid + i) + (lane >> 2); r = r < a.nr ? r : a.nr - 1; if (a.var & 4) r = 0; const int gr = a.rowlist ? a.rowlist[r] : a.arow0 + r; ap[i] = a.A + (size_t)gr * a.lda_bytes + kc * 16; } }
    const float* bp[2];
#pragma unroll
    for (int i = 0; i < 2; ++i) { const int k = 2 * (2 * wid + i) + (lane >> 5), c = lane & 31;
        if (MODE == 1) { const int blk = c >> 3; bp[i] = ((blk & 1) ? a.B1 : a.B0) + (size_t)k * a.ldn + 32 * (blk >> 1) + 4 * (c & 7); }
        else bp[i] = a.B0 + (size_t)k * a.ldn + 4 * c; }
    const unsigned a_rd = (unsigned)(SG_A + (wm * rpw + r16) * 64 + ((kq ^ ((r16 >> 2) & 3)) << 4));
    const unsigned b_rd = (unsigned)(SG_B + 4 * kq * SG_BPITCH + (wn * 64 + r16) * 4);
    f32x4 acc[10][4];
#pragma unroll
    for (int i = 0; i < 10; ++i)
#pragma unroll
        for (int j = 0; j < 4; ++j) acc[i][j] = (f32x4){0.f, 0.f, 0.f, 0.f};
#define SG_ISSUE(t, stg) do {         _Pragma("unroll") for (int i = 0; i < 5; ++i) __builtin_amdgcn_global_load_lds((const unsigned*)(ap[i] + (size_t)(t) * 64), (FK_LAS unsigned*)(lds + SG_A + (stg) * SG_ASTG + (5 * wid + i) * 1024), 16, 0, 0);         _Pragma("unroll") for (int i = 0; i < 2; ++i) __builtin_amdgcn_global_load_lds((const unsigned*)(bp[i] + (size_t)((a.var & 2) ? 0 : (t)) * 32 * a.ldn), (FK_LAS unsigned*)(lds + SG_B + (stg) * SG_BSTG + (2 * wid + i) * SG_BPITCH), 16, 0, 0); } while (0)
    SG_ISSUE(0, 0);
    int stg = 0;
#pragma unroll 1
    for (int t = 0; t < nt; ++t) {
        asm volatile("s_waitcnt vmcnt(0)\n\ts_barrier" ::: "memory");
        if (t + 1 < nt) SG_ISSUE(t + 1, stg ^ 1);
        FK_LAS const unsigned char* ab = lds + a_rd + stg * SG_ASTG; FK_LAS const unsigned char* bb = lds + b_rd + stg * SG_BSTG;
        bf16x8 bf[4];
#pragma unroll
        for (int j = 0; j < 4; ++j) { FK_LAS const float* p = (FK_LAS const float*)(bb + j * 64);
            const float v0 = p[0], v1 = p[128], v2 = p[260], v3 = p[388], v4 = p[520], v5 = p[648], v6 = p[780], v7 = p[908];
            u32x4 w; w.x = cvt_pk_bf16(v0, v1); w.y = cvt_pk_bf16(v2, v3); w.z = cvt_pk_bf16(v4, v5); w.w = cvt_pk_bf16(v6, v7); bf[j] = *reinterpret_cast<bf16x8*>(&w); }
#pragma unroll
        for (int i = 0; i < 10; ++i) if (i < mf && !(a.var & 1)) { const bf16x8 af = *(FK_LAS const bf16x8*)(ab + i * 1024);
#pragma unroll
            for (int j = 0; j < 4; ++j) acc[i][j] = __builtin_amdgcn_mfma_f32_16x16x32_bf16(bf[j], af, acc[i][j], 0, 0, 0); }
        stg ^= 1;
    }
#undef SG_ISSUE
    float wgts[10];
#pragma unroll
    for (int i = 0; i < 10; ++i) { const int r = wm * rpw + 16 * i + r16; wgts[i] = (MODE == 1 && i < mf && r < a.nr) ? a.roww[r] : 0.f; }
#pragma unroll
    for (int i = 0; i < 10; ++i) if (i < mf) { const int r = wm * rpw + 16 * i + r16; if (r < a.nr) {
        if (MODE == 1) { const float wgt = wgts[i]; bf16_t* orow = a.out + (size_t)(a.out_row0 + r) * a.out_ld + a.out_col0 + 32 * wn + 4 * kq;
#pragma unroll
            for (int j = 0; j < 2; ++j) { const f32x4 g = acc[i][j], up = acc[i][j + 2]; f32x4 h;
#pragma unroll
                for (int q = 0; q < 4; ++q) h[q] = g[q] * __builtin_amdgcn_rcpf(1.0f + __builtin_amdgcn_exp2f(-g[q] * LOG2E)) * up[q] * wgt;
                u32x2 p; p.x = cvt_pk_bf16(h[0], h[1]); p.y = cvt_pk_bf16(h[2], h[3]); *(u32x2*)(orow + 16 * j) = p; } }
        else { bf16_t* orow = a.out + (size_t)(a.out_row0 + r) * a.out_ld + a.out_col0 + 64 * wn + 4 * kq;
#pragma unroll
            for (int j = 0; j < 4; ++j) { const f32x4 v = acc[i][j]; u32x2 p; p.x = cvt_pk_bf16(v[0], v[1]); p.y = cvt_pk_bf16(v[2], v[3]); *(u32x2*)(orow + 16 * j) = p; } } } }
    asm volatile("s_waitcnt vmcnt(0)" ::: "memory");
    __syncthreads();
}
__device__ __forceinline__ void phase_moe1(FK_LAS unsigned char* lds, FK_LAS const int* tab, const bf16_t* xb, const int* list, const float* sw, const float* wgate, const float* wup, bf16_t* H, int var) {
#pragma unroll 1
    for (int u = fk_bid(), nb = fk_nblk(); u < 256; u += nb) { const int xcd = u & 7, q = u >> 3, e = xcd + 8 * (q >> 3), s = q & 7; const int ne = tab[80 + e], hrow0 = tab[40 + e];
        const int rbeg = 0, rend = ne;
#pragma unroll 1
        for (int r0 = rbeg; r0 < rend; r0 += SG_ROWS) { SgArgs a; a.A = (const char*)xb; a.rowlist = list + (size_t)e * NT + r0; a.arow0 = 0; a.lda_bytes = D * 2; a.nr = min(SG_ROWS, rend - r0);
            a.B0 = wgate + (size_t)e * D * 512 + 64 * s; a.B1 = wup + (size_t)e * D * 512 + 64 * s; a.ldn = 512; a.K = D;
            a.out = H; a.out_row0 = hrow0 + r0; a.out_ld = 512; a.out_col0 = 64 * s; a.roww = sw + (size_t)e * NT + r0; a.var = var; sg_unit<1>(lds, a); } }
}
__device__ __forceinline__ void phase_moe2(FK_LAS unsigned char* lds, FK_LAS const int* tab, const bf16_t* H, const float* wdown, bf16_t* Y2, int var) {
#pragma unroll 1
    for (int u = fk_bid(), nb = fk_nblk(); u < 512; u += nb) { const int xcd = u & 7, q = u >> 3, e = xcd + 8 * (q >> 4), s = q & 15; const int ne = tab[80 + e], hrow0 = tab[40 + e];
        const int rbeg = 0, rend = ne;
#pragma unroll 1
        for (int r0 = rbeg; r0 < rend; r0 += SG_ROWS) { SgArgs a; a.A = (const char*)H; a.rowlist = nullptr; a.arow0 = hrow0 + r0; a.lda_bytes = 512 * 2; a.nr = min(SG_ROWS, rend - r0);
            a.B0 = wdown + (size_t)e * 512 * D + 128 * s; a.B1 = nullptr; a.ldn = D; a.K = 512;
            a.out = Y2; a.out_row0 = hrow0 + r0; a.out_ld = D; a.out_col0 = 128 * s; a.roww = nullptr; a.var = var; sg_unit<2>(lds, a); } }
}
}
namespace fk {
struct EpiBf16Q {
    static constexpr bool PERM = true;
    bf16_t* O; int ldc, qcols; float qscale;
    __device__ __forceinline__ void operator()(const f32x4 (&acc)[2][2][4][2], const GUnit& u, int wr, int wc, int fr, int fq) const {
        const int row0 = u.pm * BM + wr * 64 + fr;
#pragma unroll
        for (int bj = 0; bj < 2; ++bj) { const int gc = u.pn * BM + bj * HALF + wc * 32 + 8 * fq; const float sc = gc < qcols ? qscale : 1.0f;
#pragma unroll
            for (int ai = 0; ai < 2; ++ai)
#pragma unroll
                for (int m = 0; m < 4; ++m) *(u32x4*)(O + (size_t)(row0 + ai * HALF + m * 16) * ldc + gc) = pack8(acc[ai][bj][m][0] * sc, acc[ai][bj][m][1] * sc); }
    }
};
__device__ __forceinline__ void fox_cumsum_lds(const float* lsig, FK_LAS float* cfl, FK_LAS double* wtot, const int b, const int h) {
    const int tid = fk_tid(), lane = tid & 63, wid = tid >> 6;
    __syncthreads();
    const f32x4 v = *(const f32x4*)(lsig + (size_t)(b * 16 + h) * S + 4 * tid);
    const double s0 = (double)v[0], s1 = s0 + (double)v[1], s2 = s1 + (double)v[2], s3 = s2 + (double)v[3];
    double incl = s3;
#pragma unroll
    for (int o = 1; o < 64; o <<= 1) { const double u = __shfl_up(incl, o); if (lane >= o) incl += u; }
    if (lane == 63) wtot[wid] = incl;
    __syncthreads();
    double off = incl - s3;
#pragma unroll
    for (int w = 0; w < 7; ++w) if (w < wid) off += wtot[w];
    f32x4 o4; o4[0] = (float)((off + s0) * 1.4426950408889634); o4[1] = (float)((off + s1) * 1.4426950408889634); o4[2] = (float)((off + s2) * 1.4426950408889634); o4[3] = (float)((off + s3) * 1.4426950408889634);
    *(FK_LAS f32x4*)(cfl + 4 * tid) = o4;
    __syncthreads();
}
struct EpiDsaIn {
    static constexpr bool PERM = true;
    bf16_t *q, *k, *v, *qidx, *kidx; float* widx;
    __device__ __forceinline__ void operator()(const f32x4 (&acc)[2][2][4][2], const GUnit& u, int wr, int wc, int fr, int fq) const {
        const int row0 = u.pm * BM + wr * 64 + fr;
#pragma unroll
        for (int bj = 0; bj < 2; ++bj) { const int gc = u.pn * BM + bj * HALF + wc * 32 + 8 * fq;
            bf16_t* dst; int ld, c; float sc = 1.0f;
            if (gc < 2048) { dst = q; ld = 2048; c = gc; sc = QSCALE_128; } else if (gc < 2176) { dst = k; ld = 128; c = gc - 2048; } else if (gc < 2304) { dst = v; ld = 128; c = gc - 2176; }
            else if (gc < 3328) { dst = qidx; ld = 1024; c = gc - 2304; } else if (gc < 3392) { dst = kidx; ld = 64; c = gc - 3328; } else { dst = nullptr; ld = 0; c = gc - 3392; }
#pragma unroll
            for (int ai = 0; ai < 2; ++ai)
#pragma unroll
                for (int m = 0; m < 4; ++m) { const int row = row0 + ai * HALF + m * 16;
                    if (dst) *(u32x4*)(dst + (size_t)row * ld + c) = pack8(acc[ai][bj][m][0] * sc, acc[ai][bj][m][1] * sc);
                    else if (c < 16) { *(f32x4*)(widx + (size_t)row * 16 + c) = acc[ai][bj][m][0] * 0.03125f; *(f32x4*)(widx + (size_t)row * 16 + c + 4) = acc[ai][bj][m][1] * 0.03125f; } } }
    }
};

__device__ __forceinline__ unsigned ord_u32(float f) { const unsigned b = __float_as_uint(f); return b ^ ((b >> 31) ? 0xFFFFFFFFu : 0x80000000u); }
__device__ __forceinline__ int half_sum(int v) {
    v += __shfl_xor(v, 1); v += __shfl_xor(v, 2); v += __shfl_xor(v, 4); v += __shfl_xor(v, 8); v += __shfl_xor(v, 16); return v; }
__device__ __forceinline__ void dsa_index_unit(FK_LAS unsigned char* lds, const bf16_t* qidx, const bf16_t* kidx, const float* widx, unsigned short* sel, int* nsel, const int b, const int g, const int var = 0) {
    const int tid = fk_tid(), wid = __builtin_amdgcn_readfirstlane(tid >> 6), lane = tid & 63, r32 = lane & 31, hi = lane >> 5;
    const int t0 = 16 * g, ntile = (t0 >> 6) + 1, nk = 64 * ntile;
    const int tq = t0 + 2 * wid;
    bf16x8 qa[4]; float wv[16];
    { const int row = r32, q = row >> 4, h = row & 15; const bf16_t* p = qidx + ((size_t)(b * S + tq + q)) * 1024 + h * 64 + hi * 8;
#pragma unroll
      for (int ks = 0; ks < 4; ++ks) qa[ks] = *(const bf16x8*)(p + ks * 16);
#pragma unroll
      for (int r = 0; r < 16; ++r) { const int rw = crow(r, hi); wv[r] = widx[((size_t)(b * S + tq + (rw >> 4))) * 16 + (rw & 15)]; } }
    const int krr = tid >> 3, krc = tid & 7, krw = FK_KRSWZ(krr, krc);
    unsigned uk[64];
    bf16x8 stg[4];
#define DI_LOAD(T) do { _Pragma("unroll") for (int q_ = 0; q_ < 4; ++q_) stg[q_] = *(const bf16x8*)(kidx + ((size_t)(b * S + (T) * 256 + q_ * 64 + krr)) * 64 + krc * 8); } while (0)
#define DI_WRITE(bf) do { _Pragma("unroll") for (int q_ = 0; q_ < 4; ++q_) *(FK_LAS bf16x8*)(lds + (bf) * 32768 + q_ * 8192 + krw) = stg[q_]; } while (0)
    const int nt256 = (nk + 255) >> 8;
    DI_LOAD(0); DI_WRITE(0); __syncthreads();
#pragma unroll
    for (int i = 0; i < 64; ++i) uk[i] = 0u;
#pragma unroll 1
    for (int it = 0; it < 8; ++it) {
#pragma unroll
        for (int i = 0; i < 56; ++i) uk[i] = uk[i + 8];
        if (it < nt256 && !(var & 16)) {
            if (it + 1 < nt256) DI_LOAD(it + 1);
#pragma unroll
            for (int jj = 0; jj < 4; ++jj) { const int j = 4 * it + jj;
                if (j < ntile) {
                    FK_LAS const unsigned char* kb = lds + (it & 1) * 32768 + jj * 8192;
#pragma unroll
                    for (int sub = 0; sub < 2; ++sub) {
                        f32x16 acc;
#pragma unroll
                        for (int r = 0; r < 16; ++r) acc[r] = 0.f;
#pragma unroll
                        for (int ks = 0; ks < 4; ++ks) { const bf16x8 kf = *(FK_LAS const bf16x8*)(kb + FK_KRSWZ(32 * sub + r32, 2 * ks + hi)); acc = __builtin_amdgcn_mfma_f32_32x32x16_bf16(qa[ks], kf, acc, 0, 0, 0); }
                        float s0 = 0.f, s1 = 0.f;
#pragma unroll
                        for (int r = 0; r < 8; ++r) { s0 += fmaxf(acc[r], 0.f) * wv[r]; s1 += fmaxf(acc[8 + r], 0.f) * wv[8 + r]; }
                        auto rr = __builtin_amdgcn_permlane32_swap(__float_as_uint(s0), __float_as_uint(s1), false, false);
                        uk[56 + 2 * jj + sub] = ord_u32(__uint_as_float(rr[0]) + __uint_as_float(rr[1]));
                    }
                } else { uk[56 + 2 * jj] = 0u; uk[56 + 2 * jj + 1] = 0u; }
            }
            if (it + 1 < nt256) DI_WRITE((it + 1) & 1);
            __syncthreads();
        } else {
#pragma unroll
            for (int q_ = 0; q_ < 8; ++q_) uk[56 + q_] = 0u; }
    }
#undef DI_LOAD
#undef DI_WRITE
    const int t = tq + hi;
    unsigned short* so = sel + ((size_t)(b * S + t)) * 256;
    int base = 0;
    if (nk <= 256 || (var & 8)) {
#pragma unroll
        for (int s = 0; s < 8; ++s) { const int key = 32 * s + r32; so[key] = (unsigned short)(key < nk ? key : 0); }
        base = nk;
    } else {
        unsigned T = 0u; bool done = false;
#pragma unroll 1
        for (int bit = 31; bit >= 0; --bit) { const unsigned cand = T | (1u << bit); int c = 0;
#pragma unroll
            for (int s = 0; s < 64; ++s) c += (uk[s] >= cand) ? 1 : 0;
            c = half_sum(c); if (!done && c >= 256) { T = cand; done = (c == 256); }
            if (__all(done)) break; }
        int cgt = 0;
#pragma unroll
        for (int s = 0; s < 64; ++s) cgt += (uk[s] > T) ? 1 : 0;
        cgt = half_sum(cgt);
        const int need = 256 - cgt; int eqb = 0;
#pragma unroll
        for (int s = 0; s < 64; ++s) { const int key = 32 * s + r32; const unsigned u = uk[s];
            const bool iseq = (u == T);
            const unsigned long long em = __ballot(iseq); const unsigned eh = hi ? (unsigned)(em >> 32) : (unsigned)em; const int erank = eqb + __popc(eh & ((1u << r32) - 1u)); eqb += __popc(eh);
            const bool take = (u > T) || (iseq && erank < need);
            const unsigned long long tm = __ballot(take); const unsigned th = hi ? (unsigned)(tm >> 32) : (unsigned)tm; const int pos = base + __popc(th & ((1u << r32) - 1u)); base += __popc(th);
            if (take) so[pos] = (unsigned short)key; }
    }
    if (r32 == 0) nsel[b * S + t] = base;
}

constexpr int DS_T5 = 131072, DS_LUT = 133120, DS_SEL = 135168;
__device__ __forceinline__ void phase_dsa_attn(FK_LAS unsigned char* lds, const bf16_t* dq, const bf16_t* dk, const bf16_t* dv, const unsigned short* sel, const int* nsel, const float* t5, bf16_t* o) {
    const int tid = fk_tid(), wid = __builtin_amdgcn_readfirstlane(tid >> 6), lane = tid & 63, c16 = lane & 15, g = lane >> 4;
    FK_LAS float* t5l = (FK_LAS float*)(lds + DS_T5); FK_LAS unsigned char* lut = lds + DS_LUT;
    for (int i = tid; i < 512; i += NTHR) t5l[i] = t5[i] * LOG2E;
    for (int n = tid; n < 2048; n += NTHR) { int bk; if (n < 8) bk = n; else { bk = 8 + (int)(logf((float)n / 8.0f) / 2.772588722239781f * 8.0f); if (bk > 15) bk = 15; } lut[n] = (unsigned char)bk; }
    __syncthreads();
    FK_LAS unsigned char* vst = lds + wid * 16384;
    FK_LAS unsigned short* sell = (FK_LAS unsigned short*)(lds + DS_SEL + wid * 512);
    const unsigned vbase = (unsigned)(size_t)vst;
#pragma unroll 1
    for (int tg = fk_bid() * 8 + wid; tg < NT; tg += fk_nblk() * 8) {
        const int b = tg >> 11, t = tg & (S - 1); const int cnt = nsel[tg];
        const bf16_t* kb = dk + (size_t)b * S * 128; const bf16_t* vb = dv + (size_t)b * S * 128;
        { const u32x2 s4 = *(const u32x2*)(sel + (size_t)tg * 256 + lane * 4); *(FK_LAS u32x2*)(sell + lane * 4) = s4; }
        bf16x8 qf[4];
#pragma unroll
        for (int ks = 0; ks < 4; ++ks) qf[ks] = *(const bf16x8*)(dq + (size_t)tg * 2048 + c16 * 128 + ks * 32 + g * 8);
        asm volatile("s_waitcnt lgkmcnt(0)" ::: "memory");
        f32x4 sc[16];
#pragma unroll
        for (int ib = 0; ib < 4; ++ib) {
            bf16x8 kf[4][4];
#pragma unroll
            for (int u = 0; u < 4; ++u) { const int kk = sell[16 * (4 * ib + u) + c16]; const bf16_t* kr = kb + (size_t)kk * 128 + g * 8;
#pragma unroll
                for (int ks = 0; ks < 4; ++ks) kf[u][ks] = *(const bf16x8*)(kr + ks * 32); }
#pragma unroll
            for (int u = 0; u < 4; ++u) { f32x4 a = {0.f, 0.f, 0.f, 0.f};
#pragma unroll
                for (int ks = 0; ks < 4; ++ks) a = __builtin_amdgcn_mfma_f32_16x16x32_bf16(kf[u][ks], qf[ks], a, 0, 0, 0);
                sc[4 * ib + u] = a; }
        }
        float mx = -3.0e38f;
#pragma unroll
        for (int i = 0; i < 16; ++i) { const u32x2 k4 = *(FK_LAS const u32x2*)(sell + 16 * i + 4 * g);
#pragma unroll
            for (int r = 0; r < 4; ++r) { const int kk = (r < 2 ? (k4.x >> (16 * r)) : (k4.y >> (16 * (r - 2)))) & 0xffff; const int rel = kk - t; const int n = rel < 0 ? -rel : rel; const int bk = (rel > 0 ? 16 : 0) + lut[n];
                float v = sc[i][r] + t5l[bk * 16 + c16]; v = (16 * i + 4 * g + r < cnt) ? v : -__builtin_inff(); sc[i][r] = v; mx = fmaxf(mx, v); } }
        mx = fmaxf(mx, __shfl_xor(mx, 16)); mx = fmaxf(mx, __shfl_xor(mx, 32));
        float sum = 0.f;
#pragma unroll
        for (int i = 0; i < 16; ++i)
#pragma unroll
            for (int r = 0; r < 4; ++r) { const float p = __builtin_amdgcn_exp2f(sc[i][r] - mx); sc[i][r] = p; sum += p; }
        sum += __shfl_xor(sum, 16); sum += __shfl_xor(sum, 32);
        const float inv = __builtin_amdgcn_rcpf(sum);
        u32x4 pw[8];
#pragma unroll
        for (int c = 0; c < 8; ++c) pw[c] = pack8(sc[2 * c], sc[2 * c + 1]);
        f32x4 oa[8];
#pragma unroll
        for (int d = 0; d < 8; ++d) oa[d] = (f32x4){0.f, 0.f, 0.f, 0.f};
        bf16x8 vv[2][8];
#define DS_VLOAD(c, B) do { _Pragma("unroll") for (int it = 0; it < 8; ++it) { const int idx = lane + 64 * it, lr = idx >> 4, ch = idx & 15; const int kk = sell[32 * (c) + lr]; vv[B][it] = *(const bf16x8*)(vb + (size_t)kk * 128 + ch * 8); } } while (0)
        DS_VLOAD(0, 0);
#pragma unroll
        for (int c = 0; c < 8; ++c) {
            if (32 * c < cnt) {
                if (c + 1 < 8 && 32 * (c + 1) < cnt) DS_VLOAD(c + 1, (c + 1) & 1);
#pragma unroll
                for (int it = 0; it < 8; ++it) { const int idx = lane + 64 * it, lr = idx >> 4, ch = idx & 15; *(FK_LAS bf16x8*)(vst + lr * 256 + ((ch ^ ((lr & 7) << 1)) << 4)) = vv[c & 1][it]; }
                const bf16x8 pf = *reinterpret_cast<const bf16x8*>(&pw[c]);
                asm volatile("s_waitcnt lgkmcnt(0)" ::: "memory");
                const int q4 = c16 >> 2, p4 = c16 & 3; const int rowA = 4 * g + q4, rowB = 16 + 4 * g + q4;
#pragma unroll
                for (int d = 0; d < 8; ++d) { s16x4 lo, hi4;
                    const unsigned aA = vbase + rowA * 256 + (((2 * d + (p4 >> 1)) ^ ((rowA & 7) << 1)) << 4) + (p4 & 1) * 8;
                    const unsigned aB = vbase + rowB * 256 + (((2 * d + (p4 >> 1)) ^ ((rowB & 7) << 1)) << 4) + (p4 & 1) * 8;
                    asm volatile("ds_read_b64_tr_b16 %0, %1" : "=&v"(lo) : "v"(aA) : "memory");
                    asm volatile("ds_read_b64_tr_b16 %0, %1" : "=&v"(hi4) : "v"(aB) : "memory");
                    asm volatile("s_waitcnt lgkmcnt(0)" ::: "memory"); __builtin_amdgcn_sched_barrier(0);
                    oa[d] = __builtin_amdgcn_mfma_f32_16x16x32_bf16((bf16x8){lo[0], lo[1], lo[2], lo[3], hi4[0], hi4[1], hi4[2], hi4[3]}, pf, oa[d], 0, 0, 0); }
            }
        }
#undef DS_VLOAD
#pragma unroll
        for (int d = 0; d < 8; ++d) { u32x2 p; p.x = cvt_pk_bf16(oa[d][0] * inv, oa[d][1] * inv); p.y = cvt_pk_bf16(oa[d][2] * inv, oa[d][3] * inv);
            *(u32x2*)(o + (size_t)tg * 2048 + c16 * 128 + 16 * d + 4 * g) = p; }
    }
}
}
#define XB_TMO      128
#define XB_XCNT(j)  (256  + 64 * (j))
#define XB_XSUB(j)  (1280 + 64 * (j))
#define XB_XGEN(j)  (2304 + 64 * (j))
#define XB_TOP      3328
#define XB_TOPGEN   3392
#define XCD_BAR_WORDS 3456
#define XB_SPIN_CAP (1u << 18)
#define LAS __attribute__((address_space(3)))

__device__ __forceinline__ unsigned xb_ld(unsigned* p)              { return __hip_atomic_load(p, __ATOMIC_RELAXED, __HIP_MEMORY_SCOPE_AGENT); }
__device__ __forceinline__ unsigned xb_add(unsigned* p, unsigned v) { return __hip_atomic_fetch_add(p, v, __ATOMIC_RELAXED, __HIP_MEMORY_SCOPE_AGENT); }
__device__ __forceinline__ unsigned xb_xcc_id() { return (unsigned)__builtin_amdgcn_s_getreg((3 << 11) | 20) & 0xFu; }
#define XB_SPIN(cond, bar) do { unsigned _sp = 0; while (cond) { __builtin_amdgcn_s_sleep(1); \
    if ((++_sp & 255u) == 0u) { if (xb_ld(&(bar)[XB_TMO])) break; if (_sp > XB_SPIN_CAP) { atomicAdd(&(bar)[XB_TMO], 1u); break; } } } } while (0)

struct XcdBarrier {
    unsigned* bar; unsigned x;
    volatile LAS unsigned* st;
};

__device__ __forceinline__ XcdBarrier xcd_barrier_post(unsigned* bar, volatile LAS unsigned* st) {
    XcdBarrier b; b.bar = bar; b.x = xb_xcc_id(); b.st = st;
    if (threadIdx.x == 0) (void)xb_add(&bar[XB_XCNT(b.x)], 1u);
    return b;
}
__device__ __forceinline__ void xcd_barrier_complete(unsigned* bar, unsigned x, unsigned& nloc, unsigned& nx) {
    const unsigned G = gridDim.x * gridDim.y * gridDim.z;
    unsigned sum, cnt, mine, sp = 0u;
    for (;;) {
        sum = 0u; cnt = 0u; mine = 0u;
#pragma unroll
        for (unsigned j = 0; j < 16; ++j) { const unsigned c = xb_ld(&bar[XB_XCNT(j)]); sum += c; cnt += (c > 0u) ? 1u : 0u; mine = (j == x) ? c : mine; }
        if (sum == G) break;
        __builtin_amdgcn_s_sleep(1);
        if ((++sp & 255u) == 0u) { if (xb_ld(&bar[XB_TMO])) break; if (sp > XB_SPIN_CAP) { atomicAdd(&bar[XB_TMO], 1u); break; } }
    }
    nloc = mine > 0u ? mine : 1u; nx = cnt > 0u ? cnt : 1u;
}

__device__ __forceinline__ void xcd_barrier(const XcdBarrier& b) {
    asm volatile("s_waitcnt vmcnt(0)" ::: "memory");
    __syncthreads();
    if (threadIdx.x == 0) {
        unsigned* bar = b.bar;
        __builtin_amdgcn_s_waitcnt(0);
        unsigned nloc = b.st[0], nx = b.st[1];
        if (nloc == 0u) { xcd_barrier_complete(bar, b.x, nloc, nx); b.st[0] = nloc; b.st[1] = nx; }
        const unsigned old = xb_add(&bar[XB_XSUB(b.x)], 1u);
        const unsigned gen = old / nloc;
        if (old + 1u == (gen + 1u) * nloc) {
            __builtin_amdgcn_fence(__ATOMIC_RELEASE, "agent");
            asm volatile("s_waitcnt vmcnt(0)" ::: "memory");
            const unsigned og = xb_add(&bar[XB_TOP], 1u);
            const unsigned tg = og / nx;
            if (og + 1u == (tg + 1u) * nx) xb_add(&bar[XB_TOPGEN], 1u);
            else XB_SPIN(xb_ld(&bar[XB_TOPGEN]) == tg, bar);
            __builtin_amdgcn_fence(__ATOMIC_ACQUIRE, "agent");
            xb_add(&bar[XB_XGEN(b.x)], 1u);
            asm volatile("s_waitcnt vmcnt(0)" ::: "memory");
        } else {
            XB_SPIN(xb_ld(&bar[XB_XGEN(b.x)]) == gen, bar);
            __builtin_amdgcn_fence(__ATOMIC_ACQUIRE, "agent");
            asm volatile("s_waitcnt vmcnt(0)" ::: "memory");
        }
    }
    __syncthreads();
}


__device__ __forceinline__ void xcd_barrier_slim(const XcdBarrier& b) {
    asm volatile("s_waitcnt vmcnt(0)" ::: "memory");
    __syncthreads();
    if (threadIdx.x == 0) {
        unsigned* bar = b.bar;
        __builtin_amdgcn_s_waitcnt(0);
        unsigned nloc = b.st[0], nx = b.st[1];
        if (nloc == 0u) { nloc = 1u; nx = 1u; }
        const unsigned old = xb_add(&bar[XB_XSUB(b.x)], 1u);
        const unsigned gen = old / nloc;
        if (old + 1u == (gen + 1u) * nloc) {
            __builtin_amdgcn_fence(__ATOMIC_RELEASE, "agent");
            asm volatile("s_waitcnt vmcnt(0)" ::: "memory");
            const unsigned og = xb_add(&bar[XB_TOP], 1u);
            const unsigned tg = og / nx;
            if (og + 1u == (tg + 1u) * nx) xb_add(&bar[XB_TOPGEN], 1u);
            else XB_SPIN(xb_ld(&bar[XB_TOPGEN]) == tg, bar);
            __builtin_amdgcn_fence(__ATOMIC_ACQUIRE, "agent");
            xb_add(&bar[XB_XGEN(b.x)], 1u);
            asm volatile("s_waitcnt vmcnt(0)" ::: "memory");
        } else {
            XB_SPIN(xb_ld(&bar[XB_XGEN(b.x)]) == gen, bar);
            __builtin_amdgcn_fence(__ATOMIC_ACQUIRE, "agent");
            asm volatile("s_waitcnt vmcnt(0)" ::: "memory");
        }
    }
    __syncthreads();
}

namespace fk {
template <int FK_PHASE_MASK_, int ML>
__global__ void __launch_bounds__(NTHR, 2) fk_fwd(const FWK kw, const CvtTable T, const int p_lo, const int p_hi) {
    extern __shared__ __attribute__((aligned(16))) unsigned char shm_[];
    FK_LAS unsigned char* lds = (FK_LAS unsigned char*)shm_;
    FK_LAS unsigned* xbw = (FK_LAS unsigned*)(lds + LDS_BYTES - 16);
    if (threadIdx.x == 0) { xbw[0] = 0u; xbw[1] = 0u; xbw[2] = 0u; xbw[3] = 0u; }
    __syncthreads();
#define FWK_FIELDS(X) X(x_in) X(t5) X(mla_w_in) X(mla_qn) X(mla_kvn) X(mla_wq) X(mla_wkv) X(mla_wo) X(fox_w_in) X(fox_bf) X(fox_wo) X(dsa_w_in) X(dsa_wo) X(ln_g) X(ln_b) X(wgrp) X(bgrp) X(wrt) X(brt) X(wgate) X(wup) X(wdown) X(out) X(ws) X(moe_bias_gu) X(moe_bias_d) X(var)
    FK_LAS unsigned long long* kl = (FK_LAS unsigned long long*)(lds + 146944);
    if (threadIdx.x == 0) { int i_ = 0;
#define FWK_PUT(f) kl[i_++] = (unsigned long long)kw.f;
        FWK_FIELDS(FWK_PUT)
#undef FWK_PUT
    }
    __syncthreads();
    XcdBarrier bar = xcd_barrier_post((unsigned*)(kw.ws + WsMap<ML>::CTL), (volatile LAS unsigned*)xbw);
    FK_LAS int* tab = (FK_LAS int*)(lds + TAB_OFF);
    if (p_hi - p_lo > 1) xcd_barrier(bar);
#define PH_ON(k) (((FK_PHASE_MASK_) >> (k)) & 1)
#ifndef FK_REP_MASK
#define FK_REP_MASK 0
#endif
#define PH_REP(k) ((((FK_REP_MASK) >> (k)) & 1) ? 2 : 1)
#define FWK_GET(f) { const unsigned long long v_ = kl[i_++]; const unsigned lo_ = __builtin_amdgcn_readfirstlane((unsigned)v_), hi_ = __builtin_amdgcn_readfirstlane((unsigned)(v_ >> 32)); kq_.f = (decltype(kq_.f))(((unsigned long long)hi_ << 32) | lo_); }
#define PH_BEGIN(id) if ((id) >= p_lo && (id) < p_hi) { if ((id) > p_lo) xcd_barrier_slim(bar); FWK kq_; { int i_ = 0; FWK_FIELDS(FWK_GET) } const FW w = make_fw<ML>(kq_, kq_.ws);
#define PH_END }
#define PH_BEGINR(id, bit) PH_BEGIN(id) for (int rep_ = 0; rep_ < PH_REP(bit); ++rep_)
    if constexpr (PH_ON(8)) { PH_BEGINR(0, 8) phase_prologue(w, T, lds); PH_END }
#pragma unroll 1
    for (int layer = 0; layer < 4; ++layer) {
        const int kind = layer % 3, j = layer / 3, pb = 1 + 8 * layer;
        if (kind == 0) {
#define MLA_PTRS bf16_t* cq = (bf16_t*)w.arena; bf16_t* ckv = cq + (size_t)NT * 512; bf16_t* kr = ckv + (size_t)NT * 512; bf16_t* q = kr + (size_t)NT * 64; bf16_t* kv = q + (size_t)NT * 3072; (void)cq; (void)ckv; (void)kr; (void)q; (void)kv;
            if constexpr (PH_ON(0)) PH_BEGINR(pb + 0, 0) { MLA_PTRS RectSched s; s.init(w.xb0, D, w.mla_win_t + (size_t)j * 1280 * D, D, NT, 1280); EpiMlaIn e{cq, ckv, kr, w.ss, w.rope_cs}; gemm_phase(lds, D, D, s, e); } PH_END
            if constexpr (PH_ON(1)) PH_BEGINR(pb + 1, 1) { MLA_PTRS Rect2Sched s; s.s0.init(cq, 512, w.mla_wq_t + (size_t)j * 3072 * 512, 512, NT, 3072); s.s1.init(ckv, 512, w.mla_wkv_t + (size_t)j * 4096 * 512, 512, NT, 4096); s.n0 = 0;
                EpiMlaQKV e{q, kv, w.ss, w.rope_cs}; gemm_phase(lds, 512, 512, s, e); } PH_END
            if constexpr (PH_ON(2)) PH_BEGINR(pb + 2, 2) { MLA_PTRS
#pragma unroll 1
                for (int p = fk_bid(), np_ = fk_nblk(); p < 256; p += np_) { const int bh = p >> 2, x = p & 3, b = bh >> 4, h = bh & 15;
                    AttnPtrs P; P.Q = q + (size_t)b * S * 3072 + h * 192; P.K = kv + (size_t)b * S * 4096 + h * 256; P.V = P.K + 128; P.KR = kr + (size_t)b * S * 64; P.CF = nullptr; P.O = w.o + (size_t)b * S * D + h * 128; P.qld = 3072; P.kld = 4096;
                    attn_block<0>(lds, P, 7 - x); attn_block<0>(lds, P, x); } } PH_END
        }
        if (kind == 1) {
#define FOX_PTRS bf16_t* qkv = (bf16_t*)w.arena;
            if constexpr (PH_ON(9)) PH_BEGINR(pb + 0, 9) { FOX_PTRS RectSched s; s.init(w.xb0, D, w.fox_win_t, D, NT, 6144); EpiBf16Q e{qkv, 6144, 2048, QSCALE_128}; gemm_phase(lds, D, D, s, e); } PH_END
            if constexpr (PH_ON(10)) PH_BEGINR(pb + 2, 10) { FOX_PTRS
#pragma unroll 1
                for (int p = fk_bid(), np_ = fk_nblk(); p < 256; p += np_) { const int bh = p >> 2, x = p & 3, b = bh >> 4, h = bh & 15;
                    AttnPtrs P; P.Q = qkv + (size_t)b * S * 6144 + h * 128; P.K = P.Q + 2048; P.V = P.Q + 4096; P.KR = nullptr; P.CF = nullptr; P.O = w.o + (size_t)b * S * D + h * 128; P.qld = 6144; P.kld = 6144;
                    fox_cumsum_lds(w.flog, (FK_LAS float*)(lds + AT_CF), (FK_LAS double*)(lds + AT_WS), b, h);
                    attn_block<1>(lds, P, 7 - x); attn_block<1>(lds, P, x); } } PH_END
        }
        if (kind == 2) {
#define DSA_PTRS bf16_t* dq = (bf16_t*)w.arena; bf16_t* dk = dq + (size_t)NT * 2048; bf16_t* dv = dk + (size_t)NT * 128; bf16_t* qidx = dv + (size_t)NT * 128; bf16_t* kidx = qidx + (size_t)NT * 1024; \
            float* widx = (float*)(kidx + (size_t)NT * 64); unsigned short* sel = (unsigned short*)(widx + (size_t)NT * 16); int* nsel = (int*)(sel + (size_t)NT * 256); (void)dq; (void)dk; (void)dv; (void)qidx; (void)kidx; (void)widx; (void)sel; (void)nsel;
            if constexpr (PH_ON(11)) PH_BEGINR(pb + 0, 11) { DSA_PTRS RectSched s; s.init(w.xb0, D, w.dsa_win_t, D, NT, 3584); EpiDsaIn e{dq, dk, dv, qidx, kidx, widx}; gemm_phase(lds, D, D, s, e); } PH_END
            if constexpr (PH_ON(12)) PH_BEGINR(pb + 1, 12) { DSA_PTRS
#pragma unroll 1
                for (int p = fk_bid(), np_ = fk_nblk(); p < 256; p += np_) { const int b = p >> 6, x = p & 63;
                    dsa_index_unit(lds, qidx, kidx, widx, sel, nsel, b, 127 - x, (int)kq_.var); dsa_index_unit(lds, qidx, kidx, widx, sel, nsel, b, x, (int)kq_.var); } } PH_END
            if constexpr (PH_ON(13)) PH_BEGINR(pb + 2, 13) { DSA_PTRS phase_dsa_attn(lds, dq, dk, dv, sel, nsel, w.t5, w.o); } PH_END
        }
        if constexpr (PH_ON(3)) PH_BEGINR(pb + 3, 3) { const bf16_t* wo_t = kind == 0 ? w.mla_wo_t + (size_t)j * D * D : (kind == 1 ? w.fox_wo_t : w.dsa_wo_t); RectSched s; s.init(w.o, D, wo_t, D, NT, D); EpiBf16Q e{(bf16_t*)w.y, D, 0, 1.0f}; gemm_phase(lds, D, D, s, e); } PH_END
        if constexpr (PH_ON(4)) PH_BEGIN(pb + 4) { LnArgs a; a.x = (layer == 0) ? w.x_in : w.xA; a.yb = (const bf16_t*)w.y; a.Y2 = nullptr; a.te = nullptr; a.tpos = nullptr; a.cnt = nullptr; a.g = w.ln_g + (size_t)(layer * 2) * D; a.b = w.ln_b + (size_t)(layer * 2) * D; a.xo = w.xB; a.xbo = w.xb1; a.out2 = nullptr; a.xqo = nullptr;
            a.w4 = (const f32x4*)w.wr4 + (size_t)layer * 128 * 3 * 64; a.ntile = 3; a.bgrp = w.bgrp + layer * 4; a.brt = w.brt + layer * 32; a.rcnt = w.moe_cnt + layer * 1024; a.ote = w.te; a.otpos = w.tpos; a.otw = w.tw; a.list = w.list; a.sw = w.sw; a.flog = nullptr; a.fbias = nullptr;
            phase_ln(a, lds);
            } PH_END
        if constexpr (PH_ON(5)) PH_BEGINR(pb + 5, 5) { moe_tables(w.moe_cnt + layer * 1024, tab); phase_moe1(lds, tab, w.xb1, w.list, w.sw, w.wgate + (size_t)layer * 32 * D * 512, w.wup + (size_t)layer * 32 * D * 512, w.H, (int)kq_.var); } PH_END
        if constexpr (PH_ON(6)) PH_BEGINR(pb + 6, 6) { moe_tables(w.moe_cnt + layer * 1024, tab); phase_moe2(lds, tab, w.H, w.wdown + (size_t)layer * 32 * 512 * D, w.Y2, (int)kq_.var); } PH_END
        if constexpr (PH_ON(7)) PH_BEGINR(pb + 7, 7) { LnArgs a; a.x = w.xB; a.yb = nullptr; a.Y2 = w.Y2; a.te = w.te; a.tpos = w.tpos; a.cnt = w.moe_cnt + layer * 1024; a.g = w.ln_g + (size_t)(layer * 2 + 1) * D; a.b = w.ln_b + (size_t)(layer * 2 + 1) * D; a.xo = w.xA; a.xbo = w.xb0; a.xqo = nullptr;
            a.out2 = (layer == 3) ? w.out : nullptr; a.w4 = (layer == 0) ? (const f32x4*)w.fox_wf4 : nullptr; a.ntile = (layer == 0) ? 1 : 0; a.bgrp = nullptr; a.brt = nullptr; a.rcnt = nullptr; a.ote = nullptr; a.otpos = nullptr; a.otw = nullptr; a.list = nullptr; a.sw = nullptr; a.flog = w.flog; a.fbias = w.fox_bf;
            phase_ln(a, lds); } PH_END
    }
#undef PH_BEGIN
#undef PH_END
}

constexpr size_t CTL_BYTES = 65536;
static FWK make_fwk(void* const* d_in, void* d_out, char* ws) {
    FWK k; memset(&k, 0, sizeof(k));
    k.x_in = (const float*)d_in[0]; k.t5 = (const float*)d_in[1]; k.mla_w_in = (const float*)d_in[2]; k.mla_qn = (const float*)d_in[3]; k.mla_kvn = (const float*)d_in[4]; k.mla_wq = (const float*)d_in[5];
    k.mla_wkv = (const float*)d_in[6]; k.mla_wo = (const float*)d_in[7]; k.fox_w_in = (const float*)d_in[8]; k.fox_bf = (const float*)d_in[9]; k.fox_wo = (const float*)d_in[10]; k.dsa_w_in = (const float*)d_in[11];
    k.dsa_wo = (const float*)d_in[12]; k.ln_g = (const float*)d_in[13]; k.ln_b = (const float*)d_in[14]; k.wgrp = (const float*)d_in[15]; k.bgrp = (const float*)d_in[16]; k.wrt = (const float*)d_in[17];
    k.brt = (const float*)d_in[18]; k.wgate = (const float*)d_in[19]; k.wup = (const float*)d_in[20]; k.wdown = (const float*)d_in[21]; k.out = (float*)d_out; k.ws = ws;
    return k;
}
static void add_job(CvtTable& T, const float* s0, const float* s1, const float* scale, bf16_t* dst, long sbs, long dbs, int K, int N, int Np, int map, int nbatch) {
    CvtJob& J = T.j[T.njobs++]; J.src0 = s0; J.src1 = s1; J.scale = scale; J.dst = dst; J.src_bstride = sbs; J.dst_bstride = dbs; J.K = K; J.N = N; J.Np = Np; J.map = map; J.nbatch = nbatch; J.tile0 = T.ntiles;
    J.wide = ((map == MAP_ID || map == MAP_MOE_GU) && (K % 128 == 0) && (Np % 256 == 0) && (N % 4 == 0)) ? 1 : 0;
    T.ntiles += J.wide ? nbatch * (K / 128) * (Np / 256) : nbatch * (K / 64) * (Np / 64);
}
static void build_table(CvtTable& T, const FW& w, int moe_l0, int moe_l1, bool base) {
    memset(&T, 0, sizeof(T)); T.misc = base ? 1 : 0;
    if (base) {
    for (int j = 0; j < 2; ++j) {
        add_job(T, w.mla_w_in + (size_t)j * D * 1088, nullptr, nullptr, w.mla_win_t + (size_t)j * 1280 * D, 0, 0, D, 1088, 1280, MAP_MLA_IN, 1);
        add_job(T, w.mla_wq + (size_t)j * 512 * 3072, nullptr, w.mla_qn + j * 512, w.mla_wq_t + (size_t)j * 3072 * 512, 0, 0, 512, 3072, 3072, MAP_MLA_Q, 1);
        add_job(T, w.mla_wkv + (size_t)j * 512 * 4096, nullptr, w.mla_kvn + j * 512, w.mla_wkv_t + (size_t)j * 4096 * 512, 0, 0, 512, 4096, 4096, MAP_ID, 1);
        add_job(T, w.mla_wo + (size_t)j * D * D, nullptr, nullptr, w.mla_wo_t + (size_t)j * D * D, 0, 0, D, D, D, MAP_ID, 1);
    }
    add_job(T, w.fox_w_in, nullptr, nullptr, w.fox_win_t, 0, 0, D, 6160, 6144, MAP_ID, 1);
    add_job(T, w.fox_wo, nullptr, nullptr, w.fox_wo_t, 0, 0, D, D, D, MAP_ID, 1);
    add_job(T, w.dsa_w_in, nullptr, nullptr, w.dsa_win_t, 0, 0, D, 3408, 3584, MAP_ID, 1);
    add_job(T, w.dsa_wo, nullptr, nullptr, w.dsa_wo_t, 0, 0, D, D, D, MAP_ID, 1);
    }
    for (int l = moe_l0; l < moe_l1; ++l) {
        add_job(T, w.wgate + (size_t)l * 32 * D * 512, w.wup + (size_t)l * 32 * D * 512, nullptr, w.moe_gu_t + (size_t)l * 32 * 1024 * D, (long)D * 512, (long)1024 * D, D, 512, 1024, MAP_MOE_GU, 32);
        add_job(T, w.wdown + (size_t)l * 32 * 512 * D, nullptr, nullptr, w.moe_d_t + (size_t)l * 32 * D * 512, (long)512 * D, (long)D * 512, 512, D, D, MAP_ID, 32);
    }
}
static int g_grid = 0;
static void setup_once() {
    if (g_grid) return;
    int dev = 0, cus = 0, per_cu = 0;
    (void)hipGetDevice(&dev); (void)hipDeviceGetAttribute(&cus, hipDeviceAttributeMultiprocessorCount, dev);
    (void)per_cu;
    if (cus <= 0) cus = 256;
    g_grid = cus;
}
template <int MASK, int ML> static void launch_mask(const FWK& w, const CvtTable& T, int lo, int hi, hipStream_t st) {
    static bool attr = false; if (!attr) { (void)hipFuncSetAttribute((const void*)fk_fwd<MASK, ML>, hipFuncAttributeMaxDynamicSharedMemorySize, LDS_BYTES); attr = true; }
    hipLaunchKernelGGL((fk_fwd<MASK, ML>), dim3(g_grid), dim3(NTHR), LDS_BYTES, st, w, T, lo, hi);
}
#ifdef FK_DEBUG_BUILD
static void launch_phase(const FWK& w, const CvtTable& T, int p, hipStream_t st) {
    if (p == 0) { launch_mask<(1 << 8), 1>(w, T, p, p + 1, st); return; }
    const int layer = (p - 1) >> 3, k = (p - 1) & 7, kind = layer % 3;
    if (k >= 3) { switch (k) { case 3: launch_mask<(1 << 3), 1>(w, T, p, p + 1, st); break; case 4: launch_mask<(1 << 4), 1>(w, T, p, p + 1, st); break; case 5: launch_mask<(1 << 5), 1>(w, T, p, p + 1, st); break;
                               case 6: launch_mask<(1 << 6), 1>(w, T, p, p + 1, st); break; default: launch_mask<(1 << 7), 1>(w, T, p, p + 1, st); break; } return; }
    if (kind == 0) { if (k == 0) launch_mask<(1 << 0), 1>(w, T, p, p + 1, st); else if (k == 1) launch_mask<(1 << 1), 1>(w, T, p, p + 1, st); else launch_mask<(1 << 2), 1>(w, T, p, p + 1, st); }
    else if (kind == 1) { if (k == 0) launch_mask<(1 << 9), 1>(w, T, p, p + 1, st); else if (k == 2) launch_mask<(1 << 10), 1>(w, T, p, p + 1, st); }
    else { if (k == 0) launch_mask<(1 << 11), 1>(w, T, p, p + 1, st); else if (k == 1) launch_mask<(1 << 12), 1>(w, T, p, p + 1, st); else launch_mask<(1 << 13), 1>(w, T, p, p + 1, st); }
}
#endif
}
#ifndef FK_EXTRA
#define FK_EXTRA {}
#endif
extern "C" void kernel_launch(void* const* d_in, const int* in_sizes, int n_in, void* d_out, int out_size, void* d_ws, size_t ws_size, hipStream_t stream) {
    using namespace fk;
    setup_once();
    const FWK k = make_fwk(d_in, d_out, (char*)d_ws);
    const FW w = make_fw<0>(k, k.ws);
    static CvtTable T; build_table(T, w, 0, 0, true);
    (void)hipMemsetAsync(w.bar, 0, CTL_BYTES, stream);
    launch_mask<0x3FFF, 0>(k, T, 0, 33, stream);
    { static const int extra[] = FK_EXTRA; (void)extra; FWK kv = k;
#ifdef FK_VAR
      kv.var = FK_VAR;
#endif
      for (unsigned i = 0; i < sizeof(extra) / sizeof(int); ++i) launch_mask<0x3FFF, 0>(kv, T, extra[i], extra[i] + 1, stream); }
}
```

```cpp
#include <hip/hip_runtime.h>
#include <stdint.h>
#include <math.h>
#include <string.h>
namespace fk {
#define FK_LAS __attribute__((address_space(3)))
typedef unsigned short bf16_t;
typedef short bf16x8 __attribute__((ext_vector_type(8)));
typedef short s16x4 __attribute__((ext_vector_type(4)));
typedef float f32x4 __attribute__((ext_vector_type(4)));
typedef float f32x16 __attribute__((ext_vector_type(16)));
typedef float f32x2 __attribute__((ext_vector_type(2)));
typedef unsigned u32x4 __attribute__((ext_vector_type(4)));
typedef unsigned u32x2 __attribute__((ext_vector_type(2)));
constexpr int NB = 4, S = 2048, D = 2048, NT = NB * S;
constexpr float ALPHA = 1.681792830507429f;
constexpr float LOG2E = 1.4426950408889634f;
__device__ __forceinline__ int fk_tid();
__device__ __forceinline__ int fk_bid();
__device__ __forceinline__ int fk_nblk();
constexpr int BM = 256, BK = 64, HALF = 128, HTB = HALF * BK * 2, STAGE_BYTES = 8 * HTB;

__device__ __forceinline__ unsigned cvt_pk_bf16(float lo, float hi) { unsigned r; asm volatile("v_cvt_pk_bf16_f32 %0, %1, %2" : "=v"(r) : "v"(lo), "v"(hi)); return r; }
__device__ __forceinline__ float bf2f(bf16_t b) { return __uint_as_float(((unsigned)b) << 16); }
__device__ __forceinline__ bf16_t f2bf(float f) { unsigned u = __float_as_uint(f); u += 0x7FFFu + ((u >> 16) & 1u); return (bf16_t)(u >> 16); }

__host__ __device__ __forceinline__ int lds_byte(int r, int c) { const int st = (r >> 4) * 2 + (c >> 5), rr = r & 15, cc = c & 31, ob = rr * 64 + cc * 2; return st * 1024 + (ob ^ (((ob >> 9) & 1) << 5)); }
__host__ __device__ __forceinline__ void stage_rc(int b, int& R, int& C) { const int st = b / 1024, sb = b % 1024, swz = sb ^ (((sb >> 9) & 1) << 5); R = (st >> 1) * 16 + swz / 64; C = (st & 1) * 32 + (swz % 64) / 2; }
__host__ __device__ __forceinline__ int perm32(int rho) { const int n = rho >> 4, i = rho & 15; return 8 * (i >> 2) + 4 * n + (i & 3); }

struct GUnit { const char* A; const char* B; int pm, pn, e, nrows; };

template <class Epi, class Sched>
__device__ __forceinline__ void gemm_phase(FK_LAS unsigned char* lds, const int K, const int ldb, const Sched& S, const Epi& E) {
    const int tid = fk_tid(), wid = __builtin_amdgcn_readfirstlane(tid >> 6), lane = tid & 63, wr = wid >> 2, wc = wid & 3, fr = lane & 15, fq = lane >> 4;
    const int nt = K / BK;
    unsigned voffB[2];
#pragma unroll
    for (int i = 0; i < 2; ++i) { int R_, C_; stage_rc(tid * 16 + i * 8192, R_, C_); const int Rb = Epi::PERM ? ((R_ & ~31) + perm32(R_ & 31)) : R_; voffB[i] = (unsigned)(Rb * ldb + C_) * 2u; }
    const size_t kstep = (size_t)(BK * 2);
    const size_t hstepB = (size_t)HALF * ldb * 2;
    const unsigned ldsw = (unsigned)wid * 1024u;
    const int aoff = lds_byte(wr * 64 + fr, fq * 8), boff = lds_byte(wc * 32 + fr, fq * 8);
#define PG8_SA(b, h) (((b) * 2 + (h)) * HTB)
#define PG8_SB(b, h) ((4 + (b) * 2 + (h)) * HTB)
#define PG8_STAGE2(bufoff, gbase, v0, v1) do { \
        __builtin_amdgcn_global_load_lds((const unsigned*)((const char*)(gbase) + (v0)), (FK_LAS unsigned*)(lds + (bufoff) + ldsw), 16, 0, 0); \
        __builtin_amdgcn_global_load_lds((const unsigned*)((const char*)(gbase) + (v1)), (FK_LAS unsigned*)(lds + (bufoff) + ldsw + 8192), 16, 0, 0); } while (0)
#define PG8_STAGEB(bufoff, gbase) PG8_STAGE2(bufoff, gbase, voffB[0], voffB[1])
#define PG8_LDA(dst, b, h) do { _Pragma("unroll") for (int m = 0; m < 4; ++m) _Pragma("unroll") for (int k = 0; k < 2; ++k) dst[m][k] = *(const FK_LAS bf16x8*)(lds + PG8_SA(b, h) + aoff + m * 2048 + k * 1024); } while (0)
#define PG8_LDB(dst, b, h) do { _Pragma("unroll") for (int n = 0; n < 2; ++n) _Pragma("unroll") for (int k = 0; k < 2; ++k) dst[n][k] = *(const FK_LAS bf16x8*)(lds + PG8_SB(b, h) + boff + n * 2048 + k * 1024); } while (0)
#define PG8_MMA(ai, bj, At, Bt) do { __builtin_amdgcn_s_setprio(1); _Pragma("unroll") for (int m = 0; m < 4; ++m) _Pragma("unroll") for (int n = 0; n < 2; ++n) _Pragma("unroll") for (int k = 0; k < 2; ++k) \
        acc[ai][bj][m][n] = __builtin_amdgcn_mfma_f32_16x16x32_bf16(Bt[n][k], At[m][k], acc[ai][bj][m][n], 0, 0, 0); __builtin_amdgcn_s_setprio(0); } while (0)
#define PG8_WAIT_V(n) asm volatile("s_waitcnt vmcnt(" #n ")" ::: "memory")
#define PG8_WAIT_L(n) asm volatile("s_waitcnt lgkmcnt(" #n ")" ::: "memory")
#define PG8_BAR __builtin_amdgcn_s_barrier()
#define PG8_SCHED __builtin_amdgcn_sched_barrier(0)
    GUnit cur, nxt; int ui = 0;
    if (!S.next(0, cur)) return;
    f32x4 acc[2][2][4][2];
#pragma unroll
    for (int a = 0; a < 2; ++a)
#pragma unroll
        for (int b = 0; b < 2; ++b)
#pragma unroll
            for (int m = 0; m < 4; ++m)
#pragma unroll
                for (int n = 0; n < 2; ++n) acc[a][b][m][n] = (f32x4){0.f, 0.f, 0.f, 0.f};
    bf16x8 At[4][2], B0[2][2], B1[2][2];
    unsigned oc[2][2], on[2][2];
    S.a_offs(cur, tid, oc);
    const char* cA = cur.A; const char* cB = cur.B;
    PG8_STAGEB(PG8_SB(0, 0), cB); PG8_STAGE2(PG8_SA(0, 0), cA, oc[0][0], oc[0][1]); PG8_STAGEB(PG8_SB(0, 1), cB + hstepB); PG8_STAGE2(PG8_SA(0, 1), cA, oc[1][0], oc[1][1]);
    if (wr == 1) PG8_BAR;
    PG8_WAIT_V(4); PG8_BAR;
    PG8_STAGEB(PG8_SB(1, 0), cB + kstep); PG8_STAGE2(PG8_SA(1, 0), cA + kstep, oc[0][0], oc[0][1]); PG8_STAGEB(PG8_SB(1, 1), cB + hstepB + kstep);
    PG8_WAIT_V(6); PG8_BAR;
    for (;;) {
        const bool has_next = S.next(ui + 1, nxt);
        if (has_next) S.a_offs(nxt, tid, on);
        else {
#pragma unroll
            for (int h = 0; h < 2; ++h)
#pragma unroll
                for (int i = 0; i < 2; ++i) on[h][i] = oc[h][i]; }
        const char* nA = has_next ? nxt.A : cA; const char* nB = has_next ? nxt.B : cB;
        for (int t = 0; t < nt; t += 2) {
            const bool last = (t == nt - 2);
            const char* a1 = cA + (size_t)(t + 1) * kstep;
            const char* a2 = last ? nA : cA + (size_t)(t + 2) * kstep; const char* b2 = last ? nB : cB + (size_t)(t + 2) * kstep;
            const char* a3 = a2 + kstep; const char* b3 = b2 + kstep;
            const unsigned o00 = last ? on[0][0] : oc[0][0], o01 = last ? on[0][1] : oc[0][1], o10 = last ? on[1][0] : oc[1][0], o11 = last ? on[1][1] : oc[1][1];
            PG8_LDB(B0, 0, 0); PG8_SCHED; PG8_LDA(At, 0, 0); PG8_STAGE2(PG8_SA(1, 1), a1, oc[1][0], oc[1][1]);
            PG8_WAIT_L(8); PG8_BAR; PG8_WAIT_L(0); PG8_MMA(0, 0, At, B0); PG8_BAR; PG8_SCHED;
            PG8_LDB(B1, 0, 1); PG8_STAGEB(PG8_SB(0, 0), b2);
            PG8_BAR; PG8_WAIT_L(0); PG8_MMA(0, 1, At, B1); PG8_BAR;
            PG8_LDA(At, 0, 1); PG8_STAGE2(PG8_SA(0, 0), a2, o00, o01);
            PG8_BAR; PG8_WAIT_L(0); PG8_MMA(1, 0, At, B0); PG8_BAR; PG8_SCHED;
            PG8_STAGEB(PG8_SB(0, 1), b2 + hstepB);
            PG8_WAIT_V(6); PG8_BAR; PG8_MMA(1, 1, At, B1); PG8_BAR;
            PG8_LDB(B0, 1, 0); PG8_SCHED; PG8_LDA(At, 1, 0); PG8_STAGE2(PG8_SA(0, 1), a2, o10, o11);
            PG8_WAIT_L(8); PG8_BAR; PG8_WAIT_L(0); PG8_MMA(0, 0, At, B0); PG8_BAR; PG8_SCHED;
            PG8_LDB(B1, 1, 1); PG8_STAGEB(PG8_SB(1, 0), b3);
            PG8_BAR; PG8_WAIT_L(0); PG8_MMA(0, 1, At, B1); PG8_BAR;
            PG8_LDA(At, 1, 1); PG8_STAGE2(PG8_SA(1, 0), a3, o00, o01);
            PG8_BAR; PG8_WAIT_L(0); PG8_MMA(1, 0, At, B0); PG8_BAR; PG8_SCHED;
            PG8_STAGEB(PG8_SB(1, 1), b3 + hstepB);
            PG8_WAIT_V(6); PG8_BAR; PG8_MMA(1, 1, At, B1); PG8_BAR;
        }
        E(acc, cur, wr, wc, fr, fq);
        if (!has_next) break;
#pragma unroll
        for (int a = 0; a < 2; ++a)
#pragma unroll
            for (int b = 0; b < 2; ++b)
#pragma unroll
                for (int m = 0; m < 4; ++m)
#pragma unroll
                    for (int n = 0; n < 2; ++n) acc[a][b][m][n] = (f32x4){0.f, 0.f, 0.f, 0.f};
        cur = nxt; cA = nA; cB = nB; ++ui;
#pragma unroll
        for (int h = 0; h < 2; ++h)
#pragma unroll
            for (int i = 0; i < 2; ++i) oc[h][i] = on[h][i];
    }
    PG8_WAIT_V(0);
    if (wr == 0) PG8_BAR;
    PG8_BAR;
#undef PG8_SA
#undef PG8_SB
#undef PG8_STAGE2
#undef PG8_STAGEB
#undef PG8_LDA
#undef PG8_LDB
#undef PG8_MMA
#undef PG8_WAIT_V
#undef PG8_WAIT_L
#undef PG8_BAR
#undef PG8_SCHED
}
}
namespace fk {
constexpr int NTHR = 512;
constexpr int LDS_BYTES = 147456;
constexpr int HCAP = 24576;
constexpr float QSCALE_MLA = 0.07216878364870322f * LOG2E;
constexpr float QSCALE_128 = 0.08838834764831845f * LOG2E;

struct FW {
    const float *x_in, *t5, *mla_w_in, *mla_qn, *mla_kvn, *mla_wq, *mla_wkv, *mla_wo, *fox_w_in, *fox_bf, *fox_wo, *dsa_w_in, *dsa_wo, *ln_g, *ln_b, *wgrp, *bgrp, *wrt, *brt, *wgate, *wup, *wdown;
    float* out;
    unsigned* bar; int* moe_cnt;
    bf16_t *mla_win_t, *mla_wq_t, *mla_wkv_t, *mla_wo_t, *fox_win_t, *fox_wo_t, *dsa_win_t, *dsa_wo_t, *moe_gu_t, *moe_d_t;
    float *wr4, *fox_wf4; f32x2* rope_cs;
    float *xA, *xB, *y; bf16_t *xb0, *xb1, *o;
    char* arena;
    float* ss;
    float *flog, *cf2;
    int *te, *tpos, *list; float *tw, *sw; bf16_t *H, *Y2; unsigned char* x1q;
};

struct FWK { const float *x_in, *t5, *mla_w_in, *mla_qn, *mla_kvn, *mla_wq, *mla_wkv, *mla_wo, *fox_w_in, *fox_bf, *fox_wo, *dsa_w_in, *dsa_wo, *ln_g, *ln_b, *wgrp, *bgrp, *wrt, *brt, *wgate, *wup, *wdown; float* out; char* ws; long moe_bias_gu, moe_bias_d; long var; };
constexpr size_t al256(size_t x) { return (x + 255) & ~(size_t)255; }
template <int MOE_LAYERS> struct WsMap {
    static constexpr size_t CTL = 0, CTL_BYTES = 65536;
    static constexpr size_t MLA_WIN_T = CTL + CTL_BYTES, MLA_WQ_T = MLA_WIN_T + al256((size_t)2 * 1280 * D * 2), MLA_WKV_T = MLA_WQ_T + al256((size_t)2 * 3072 * 512 * 2), MLA_WO_T = MLA_WKV_T + al256((size_t)2 * 4096 * 512 * 2);
    static constexpr size_t FOX_WIN_T = MLA_WO_T + al256((size_t)2 * D * D * 2), FOX_WO_T = FOX_WIN_T + al256((size_t)6144 * D * 2), DSA_WIN_T = FOX_WO_T + al256((size_t)D * D * 2), DSA_WO_T = DSA_WIN_T + al256((size_t)3584 * D * 2);
    static constexpr size_t MOE_GU_T = DSA_WO_T + al256((size_t)D * D * 2), MOE_D_T = MOE_GU_T + al256((size_t)MOE_LAYERS * 32 * 1024 * D * 2);
    static constexpr size_t WR4 = MOE_D_T + al256((size_t)MOE_LAYERS * 32 * D * 512 * 2), FOX_WF4 = WR4 + al256((size_t)4 * D * 48 * 4), ROPE = FOX_WF4 + al256((size_t)D * 16 * 4);
    static constexpr size_t XA = ROPE + al256((size_t)S * 32 * 8), XB = XA + al256((size_t)NT * D * 4), Y = XB + al256((size_t)NT * D * 4);
    static constexpr size_t XB0 = Y + al256((size_t)NT * D * 4), XB1 = XB0 + al256((size_t)NT * D * 2), O = XB1 + al256((size_t)NT * D * 2), ARENA = O + al256((size_t)NT * D * 2);
    static constexpr size_t SS = ARENA + al256((size_t)NT * (512 + 512 + 64 + 3072 + 4096) * 2), FLOG = SS + al256((size_t)NT * 2 * 8 * 4), CF2 = FLOG + al256((size_t)NT * 16 * 4);
    static constexpr size_t TE = CF2 + al256((size_t)NB * 16 * S * 4), TPOS = TE + al256((size_t)NT * 2 * 4), LIST = TPOS + al256((size_t)NT * 2 * 4), TW = LIST + al256((size_t)32 * NT * 4), SW = TW + al256((size_t)NT * 2 * 4);
    static constexpr size_t H = SW + al256((size_t)32 * NT * 4), Y2 = H + al256((size_t)HCAP * 512 * 2), X1Q = Y2 + al256((size_t)HCAP * D * 2), END = X1Q + al256((size_t)NT * D);
};
template <int ML> __host__ __device__ __forceinline__ FW make_fw(const FWK& k, char* ws) {
    typedef WsMap<ML> M; FW w;
    w.x_in = k.x_in; w.t5 = k.t5; w.mla_w_in = k.mla_w_in; w.mla_qn = k.mla_qn; w.mla_kvn = k.mla_kvn; w.mla_wq = k.mla_wq; w.mla_wkv = k.mla_wkv; w.mla_wo = k.mla_wo; w.fox_w_in = k.fox_w_in; w.fox_bf = k.fox_bf; w.fox_wo = k.fox_wo;
    w.dsa_w_in = k.dsa_w_in; w.dsa_wo = k.dsa_wo; w.ln_g = k.ln_g; w.ln_b = k.ln_b; w.wgrp = k.wgrp; w.bgrp = k.bgrp; w.wrt = k.wrt; w.brt = k.brt; w.wgate = k.wgate; w.wup = k.wup; w.wdown = k.wdown; w.out = k.out;
    w.bar = (unsigned*)(ws + M::CTL); w.moe_cnt = (int*)(ws + M::CTL + 32768);
    w.mla_win_t = (bf16_t*)(ws + M::MLA_WIN_T); w.mla_wq_t = (bf16_t*)(ws + M::MLA_WQ_T); w.mla_wkv_t = (bf16_t*)(ws + M::MLA_WKV_T); w.mla_wo_t = (bf16_t*)(ws + M::MLA_WO_T);
    w.fox_win_t = (bf16_t*)(ws + M::FOX_WIN_T); w.fox_wo_t = (bf16_t*)(ws + M::FOX_WO_T); w.dsa_win_t = (bf16_t*)(ws + M::DSA_WIN_T); w.dsa_wo_t = (bf16_t*)(ws + M::DSA_WO_T);
    w.moe_gu_t = (bf16_t*)(ws + M::MOE_GU_T) - k.moe_bias_gu; w.moe_d_t = (bf16_t*)(ws + M::MOE_D_T) - k.moe_bias_d;
    w.wr4 = (float*)(ws + M::WR4); w.fox_wf4 = (float*)(ws + M::FOX_WF4); w.rope_cs = (f32x2*)(ws + M::ROPE);
    w.xA = (float*)(ws + M::XA); w.xB = (float*)(ws + M::XB); w.y = (float*)(ws + M::Y); w.xb0 = (bf16_t*)(ws + M::XB0); w.xb1 = (bf16_t*)(ws + M::XB1); w.o = (bf16_t*)(ws + M::O); w.arena = ws + M::ARENA;
    w.ss = (float*)(ws + M::SS); w.flog = (float*)(ws + M::FLOG); w.cf2 = (float*)(ws + M::CF2);
    w.te = (int*)(ws + M::TE); w.tpos = (int*)(ws + M::TPOS); w.list = (int*)(ws + M::LIST); w.tw = (float*)(ws + M::TW); w.sw = (float*)(ws + M::SW); w.H = (bf16_t*)(ws + M::H); w.Y2 = (bf16_t*)(ws + M::Y2); w.x1q = (unsigned char*)(ws + M::X1Q);
    return w;
}
__device__ __forceinline__ int fk_tid() { int t = threadIdx.x; asm volatile("" : "+v"(t)); return t; }
__device__ __forceinline__ int fk_bid() { int t = blockIdx.x; asm volatile("" : "+s"(t)); return t; }
__device__ __forceinline__ int fk_nblk() { int t = gridDim.x; asm volatile("" : "+s"(t)); return t; }

enum { MAP_ID = 0, MAP_MLA_IN = 1, MAP_MLA_Q = 2, MAP_MOE_GU = 3 };
struct CvtJob { const float* src0; const float* src1; const float* scale; bf16_t* dst; long src_bstride, dst_bstride; int K, N, Np, map, nbatch, tile0, wide, pad; };
constexpr int MAXJOBS = 24;
struct CvtTable { CvtJob j[MAXJOBS]; int njobs, ntiles, misc, pad; };

__device__ __forceinline__ int map_col(int map, int np, int N, int& which) {
    which = 0;
    if (map == MAP_ID) return np < N ? np : -1;
    if (map == MAP_MLA_IN) { if (np < 1024) return np; if (np < 1088) { const int i = np - 1024; return 1024 + (i >> 1) + 32 * (i & 1); } return -1; }
    if (map == MAP_MLA_Q) { const int h = np / 192, j = np % 192; if (j < 128) return np; const int i = j - 128; return h * 192 + 128 + (i >> 1) + 32 * (i & 1); }
      { const int q = np >> 5, r = np & 31; which = r >> 4; return 16 * q + (r & 15); }
}
__device__ __forceinline__ void cvt_tile(const CvtJob& J, int lt, FK_LAS float* tile  , const int tid) {
    const int tk = J.K / 64, tn = J.Np / 64, per = tk * tn;
    const int b = lt / per, r = lt % per, tkk = r % tk, tnn = r / tk;
    const int k0 = tkk * 64, n0 = tnn * 64;
    const float* s0 = J.src0 + (size_t)b * J.src_bstride; const float* s1 = J.src1 ? J.src1 + (size_t)b * J.src_bstride : nullptr;
    bf16_t* d = J.dst + (size_t)b * J.dst_bstride;
    { const int np = n0 + (tid & 63); int which; const int sc = map_col(J.map, np, J.N, which); const float* s = which ? s1 : s0;
#pragma unroll
      for (int i = 0; i < 8; ++i) { const int k = (tid >> 6) + 8 * i; float v = 0.f; if (sc >= 0) { v = s[(size_t)(k0 + k) * J.N + sc]; if (J.scale) v *= J.scale[k0 + k]; } tile[k * 65 + (tid & 63)] = v; } }
    __syncthreads();
    { const int np = tid >> 3, kg = (tid & 7) * 8; float v[8];
#pragma unroll
      for (int j = 0; j < 8; ++j) v[j] = tile[(kg + j) * 65 + np];
      u32x4 w; w.x = cvt_pk_bf16(v[0], v[1]); w.y = cvt_pk_bf16(v[2], v[3]); w.z = cvt_pk_bf16(v[4], v[5]); w.w = cvt_pk_bf16(v[6], v[7]);
      *(u32x4*)(d + (size_t)(n0 + np) * J.K + k0 + kg) = w; }
    __syncthreads();
}
__device__ __forceinline__ void cvt_tile_wide(const CvtJob& J, int lt, FK_LAS unsigned char* img, const int tid) {
    const int wid = tid >> 6, lane = tid & 63;
    const int tk = J.K / 128, tn = J.Np / 256, per = tk * tn;
    const int b = lt / per, r = lt % per, tkk = r % tk, tnn = r / tk;
    const int k0 = tkk * 128, n0 = tnn * 256;
    const float* s0 = J.src0 + (size_t)b * J.src_bstride; const float* s1 = J.src1 ? J.src1 + (size_t)b * J.src_bstride : nullptr;
    bf16_t* d = J.dst + (size_t)b * J.dst_bstride;
    const int np = n0 + 4 * lane; int which; const int sc = map_col(J.map, np, J.N, which); const float* s = which ? s1 : s0;
    const bool ok = sc >= 0 && sc + 3 < J.N;
    f32x4 v[16];
#pragma unroll
    for (int i = 0; i < 16; ++i) { const int k = k0 + wid * 16 + i; v[i] = ok ? *(const f32x4*)(s + (size_t)k * J.N + sc) : (f32x4){0.f, 0.f, 0.f, 0.f}; if (J.scale) v[i] = v[i] * J.scale[k]; }
#pragma unroll
    for (int j = 0; j < 4; ++j) { const int n = 4 * lane + j;
#pragma unroll
        for (int h = 0; h < 2; ++h) { u32x4 w; w.x = cvt_pk_bf16(v[8 * h + 0][j], v[8 * h + 1][j]); w.y = cvt_pk_bf16(v[8 * h + 2][j], v[8 * h + 3][j]); w.z = cvt_pk_bf16(v[8 * h + 4][j], v[8 * h + 5][j]); w.w = cvt_pk_bf16(v[8 * h + 6][j], v[8 * h + 7][j]);
            const int c = wid * 2 + h; *(FK_LAS u32x4*)(img + n * 256 + ((c ^ (n & 15)) << 4)) = w; } }
    __syncthreads();
#pragma unroll
    for (int i = 0; i < 8; ++i) { const int idx = tid + 512 * i, n = idx >> 4, c = idx & 15; const u32x4 w = *(FK_LAS const u32x4*)(img + n * 256 + ((c ^ (n & 15)) << 4));
        *(u32x4*)(d + (size_t)(n0 + n) * J.K + k0 + c * 8) = w; }
    __syncthreads();
}
__device__ __forceinline__ void phase_prologue(const FW& w, const CvtTable& T, FK_LAS unsigned char* lds) {
    FK_LAS float* tile = (FK_LAS float*)lds; const int tid0 = fk_tid();
    for (int t = fk_bid(); t < T.ntiles; t += fk_nblk()) {
        int ji = 0;
#pragma unroll 1
        for (int q = 1; q < T.njobs; ++q) if (t >= T.j[q].tile0) ji = q;
        if (T.j[ji].wide) cvt_tile_wide(T.j[ji], t - T.j[ji].tile0, lds, tid0); else cvt_tile(T.j[ji], t - T.j[ji].tile0, tile, tid0);
    }
    if (!T.misc) return;
    const int gt = fk_bid() * NTHR + tid0, gn = fk_nblk() * NTHR;
    for (int i = gt; i < S * 32; i += gn) { const int pos = i >> 5, j = i & 31; const float invf = powf(10000.f, -(float)j / 32.f); const float ang = (float)pos * invf; w.rope_cs[i] = (f32x2){cosf(ang), sinf(ang)}; }
    for (int i = gt; i < 4 * 128 * 3 * 64 * 4; i += gn) { const int ii = i & 3, lane = (i >> 2) & 63, q = i >> 8, nt = q % 3, kg = (q / 3) & 127, layer = q / (3 * 128); const int k = 16 * kg + 4 * (lane >> 4) + ii, n = 16 * nt + (lane & 15);
        float v = 0.f; if (n < 4) v = w.wgrp[((size_t)layer * D + k) * 4 + n]; else if (n < 36) v = w.wrt[((size_t)layer * D + k) * 32 + (n - 4)]; w.wr4[i] = v; }
    for (int i = gt; i < 128 * 64 * 4; i += gn) { const int ii = i & 3, lane = (i >> 2) & 63, kg = i >> 8; const int k = 16 * kg + 4 * (lane >> 4) + ii; w.fox_wf4[i] = w.fox_w_in[(size_t)k * 6160 + 6144 + (lane & 15)]; }
    for (int i = gt; i < NT * D / 4; i += gn) { const f32x4 v = ((const f32x4*)w.x_in)[i]; u32x2 p; p.x = cvt_pk_bf16(v[0], v[1]); p.y = cvt_pk_bf16(v[2], v[3]); ((u32x2*)w.xb0)[i] = p; }
}

struct RectSched {
    const char* A; const char* B; int lda, ldb, nM, nN, nwg, G, c;
    __device__ void init(const bf16_t* A_, int lda_, const bf16_t* B_, int ldb_, int M, int N) { A = (const char*)A_; B = (const char*)B_; lda = lda_; ldb = ldb_; nM = M / BM; nN = N / BM; nwg = nM * nN; G = fk_nblk(); c = fk_bid(); }
    __device__ __forceinline__ bool tile(int i, int& pm, int& pn) const {
        const long L = (long)i * G + c; if (L >= nwg) return false;
        int wgid = (int)L; { const int q = nwg / 8, r = nwg % 8, xcd = wgid % 8, off = wgid / 8; wgid = (xcd < r ? xcd * (q + 1) : r * (q + 1) + (xcd - r) * q) + off; }
        const int nig = 8 * nN, gid = wgid / nig, fm = gid * 8, gsz = (nM - fm) < 8 ? (nM - fm) : 8;
        pm = fm + ((wgid % nig) % gsz); pn = (wgid % nig) / gsz; return true;
    }
    __device__ __forceinline__ bool next(int i, GUnit& u) const { int pm, pn; if (!tile(i, pm, pn)) return false; u.pm = pm; u.pn = pn; u.e = 0; u.nrows = BM; u.A = A + (size_t)pm * BM * lda * 2; u.B = B + (size_t)pn * BM * ldb * 2; return true; }
    __device__ __forceinline__ void a_offs(const GUnit&, int tid, unsigned (&o)[2][2]) const { int R0, C0, R1, C1; stage_rc(tid * 16, R0, C0); stage_rc(tid * 16 + 8192, R1, C1);
        o[0][0] = (unsigned)(R0 * lda + C0) * 2u; o[0][1] = (unsigned)(R1 * lda + C1) * 2u; o[1][0] = o[0][0] + (unsigned)(HALF * lda * 2); o[1][1] = o[0][1] + (unsigned)(HALF * lda * 2); }
};
struct Rect2Sched {
    RectSched s0, s1; int n0;
    __device__ __forceinline__ bool next(int i, GUnit& u) const {
        const long L = (long)i * s0.G + s0.c; const int tot = s0.nwg + s1.nwg; if (L >= tot) return false;
        if (L < s0.nwg) { const int pm = (int)L % s0.nM, pn = (int)L / s0.nM; u.pm = pm; u.pn = pn; u.e = 0; u.nrows = BM; u.A = s0.A + (size_t)pm * BM * s0.lda * 2; u.B = s0.B + (size_t)pn * BM * s0.ldb * 2; }
        else { const int l = (int)L - s0.nwg; const int pm = l % s1.nM, pn = l / s1.nM; u.pm = pm; u.pn = pn; u.e = 1; u.nrows = BM; u.A = s1.A + (size_t)pm * BM * s1.lda * 2; u.B = s1.B + (size_t)pn * BM * s1.ldb * 2; }
        return true; }
    __device__ __forceinline__ void a_offs(const GUnit& u, int tid, unsigned (&o)[2][2]) const { s0.a_offs(u, tid, o); }
};

struct EpiF32 {
    static constexpr bool PERM = false;
    float* Cp; int ldc;
    __device__ __forceinline__ void operator()(const f32x4 (&acc)[2][2][4][2], const GUnit& u, int wr, int wc, int fr, int fq) const {
        const int row0 = u.pm * BM + wr * 64 + fr, col0 = u.pn * BM + wc * 32 + 4 * fq;
#pragma unroll
        for (int ai = 0; ai < 2; ++ai)
#pragma unroll
            for (int m = 0; m < 4; ++m) { float* rowp = Cp + (size_t)(row0 + ai * HALF + m * 16) * ldc + col0;
#pragma unroll
                for (int bj = 0; bj < 2; ++bj)
#pragma unroll
                    for (int n = 0; n < 2; ++n) *(f32x4*)(rowp + bj * HALF + n * 16) = acc[ai][bj][m][n]; }
    }
};
__device__ __forceinline__ u32x4 pack8(const f32x4& a, const f32x4& b) { u32x4 w; w.x = cvt_pk_bf16(a[0], a[1]); w.y = cvt_pk_bf16(a[2], a[3]); w.z = cvt_pk_bf16(b[0], b[1]); w.w = cvt_pk_bf16(b[2], b[3]); return w; }
__device__ __forceinline__ void rope8(f32x4& v0, f32x4& v1, const f32x2* cs) {
    const f32x4 c01 = *(const f32x4*)cs, c23 = *(const f32x4*)(cs + 2);
    f32x4 r0, r1;
    r0[0] = v0[0] * c01[0] - v0[1] * c01[1]; r0[1] = v0[1] * c01[0] + v0[0] * c01[1]; r0[2] = v0[2] * c01[2] - v0[3] * c01[3]; r0[3] = v0[3] * c01[2] + v0[2] * c01[3];
    r1[0] = v1[0] * c23[0] - v1[1] * c23[1]; r1[1] = v1[1] * c23[0] + v1[0] * c23[1]; r1[2] = v1[2] * c23[2] - v1[3] * c23[3]; r1[3] = v1[3] * c23[2] + v1[2] * c23[3];
    v0 = r0; v1 = r1;
}
struct EpiMlaIn {
    static constexpr bool PERM = true;
    bf16_t *cq, *ckv, *kr; float* ss; const f32x2* cs;
    __device__ __forceinline__ void operator()(const f32x4 (&acc)[2][2][4][2], const GUnit& u, int wr, int wc, int fr, int fq) const {
        const int row0 = u.pm * BM + wr * 64 + fr;
        if (u.pn < 4) {
            bf16_t* dst = (u.pn < 2) ? cq : ckv; const int which = u.pn >> 1; const int col0 = (u.pn & 1) * BM + wc * 32 + 8 * fq;
#pragma unroll
            for (int ai = 0; ai < 2; ++ai)
#pragma unroll
                for (int m = 0; m < 4; ++m) { const int row = row0 + ai * HALF + m * 16; float q = 0.f;
#pragma unroll
                    for (int bj = 0; bj < 2; ++bj) { const f32x4 v0 = acc[ai][bj][m][0], v1 = acc[ai][bj][m][1];
                        q += (v0[0] * v0[0] + v0[1] * v0[1]) + (v0[2] * v0[2] + v0[3] * v0[3]) + (v1[0] * v1[0] + v1[1] * v1[1]) + (v1[2] * v1[2] + v1[3] * v1[3]);
                        *(u32x4*)(dst + (size_t)row * 512 + col0 + bj * HALF) = pack8(v0, v1); }
                    q += __shfl_xor(q, 16); q += __shfl_xor(q, 32);
                    if (fq == 0) ss[((size_t)row * 2 + which) * 8 + (u.pn & 1) * 4 + wc] = q; }
        } else if (wc < 2) {
#pragma unroll
            for (int ai = 0; ai < 2; ++ai) { f32x4 c01[4], c23[4];
#pragma unroll
                for (int m = 0; m < 4; ++m) { const int row = row0 + ai * HALF + m * 16; const f32x2* cp = cs + (size_t)(row & (S - 1)) * 32 + 16 * wc + 4 * fq; c01[m] = *(const f32x4*)cp; c23[m] = *(const f32x4*)(cp + 2); }
#pragma unroll
                for (int m = 0; m < 4; ++m) { const int row = row0 + ai * HALF + m * 16; const f32x4 v0 = acc[ai][0][m][0], v1 = acc[ai][0][m][1]; const f32x4 a = c01[m], b = c23[m]; f32x4 r0, r1;
                    r0[0] = v0[0] * a[0] - v0[1] * a[1]; r0[1] = v0[1] * a[0] + v0[0] * a[1]; r0[2] = v0[2] * a[2] - v0[3] * a[3]; r0[3] = v0[3] * a[2] + v0[2] * a[3];
                    r1[0] = v1[0] * b[0] - v1[1] * b[1]; r1[1] = v1[1] * b[0] + v1[0] * b[1]; r1[2] = v1[2] * b[2] - v1[3] * b[3]; r1[3] = v1[3] * b[2] + v1[2] * b[3];
                    *(u32x4*)(kr + (size_t)row * 64 + wc * 32 + 8 * fq) = pack8(r0, r1); } }
        }
    }
};
struct EpiMlaQKV {
    static constexpr bool PERM = true;
    bf16_t *q, *kv; const float* ss; const f32x2* cs;
    __device__ __forceinline__ void operator()(const f32x4 (&acc)[2][2][4][2], const GUnit& u, int wr, int wc, int fr, int fq) const {
        const int row0 = u.pm * BM + wr * 64 + fr;
#pragma unroll
        for (int ai = 0; ai < 2; ++ai) {
            float rs[4];
            { f32x4 sa[4], sb[4];
#pragma unroll
              for (int m = 0; m < 4; ++m) { const int row = row0 + ai * HALF + m * 16; sa[m] = *(const f32x4*)(ss + ((size_t)row * 2 + u.e) * 8); sb[m] = *(const f32x4*)(ss + ((size_t)row * 2 + u.e) * 8 + 4); }
#pragma unroll
              for (int m = 0; m < 4; ++m) rs[m] = rsqrtf((((sa[m][0] + sa[m][1]) + (sa[m][2] + sa[m][3])) + ((sb[m][0] + sb[m][1]) + (sb[m][2] + sb[m][3]))) * (1.0f / 512.0f) + 1e-6f); }
#pragma unroll
            for (int bj = 0; bj < 2; ++bj) { const int gc = u.pn * BM + bj * HALF + wc * 32 + 8 * fq; const int j = gc % 192; const bool rope = __builtin_amdgcn_readfirstlane((int)((u.e == 0) && (j >= 128))) != 0;
                f32x4 c01[4], c23[4];
                if (rope) {
#pragma unroll
                    for (int m = 0; m < 4; ++m) { const int row = row0 + ai * HALF + m * 16; const f32x2* cp = cs + (size_t)(row & (S - 1)) * 32 + ((j - 128) >> 1); c01[m] = *(const f32x4*)cp; c23[m] = *(const f32x4*)(cp + 2); } }
#pragma unroll
                for (int m = 0; m < 4; ++m) { const int row = row0 + ai * HALF + m * 16; f32x4 v0 = acc[ai][bj][m][0] * rs[m], v1 = acc[ai][bj][m][1] * rs[m];
                    if (u.e == 0) {
                        if (rope) { f32x4 r0, r1; const f32x4 a = c01[m], b = c23[m];
                            r0[0] = v0[0] * a[0] - v0[1] * a[1]; r0[1] = v0[1] * a[0] + v0[0] * a[1]; r0[2] = v0[2] * a[2] - v0[3] * a[3]; r0[3] = v0[3] * a[2] + v0[2] * a[3];
                            r1[0] = v1[0] * b[0] - v1[1] * b[1]; r1[1] = v1[1] * b[0] + v1[0] * b[1]; r1[2] = v1[2] * b[2] - v1[3] * b[3]; r1[3] = v1[3] * b[2] + v1[2] * b[3]; v0 = r0; v1 = r1; }
                        v0 = v0 * QSCALE_MLA; v1 = v1 * QSCALE_MLA; *(u32x4*)(q + (size_t)row * 3072 + gc) = pack8(v0, v1); }
                    else *(u32x4*)(kv + (size_t)row * 4096 + gc) = pack8(v0, v1); } }
        }
    }
};
}
namespace fk {
#define FK_KSWZ(row, colB) ((row) * 256 + ((colB) ^ (((row) & 7) << 4)))
#define FK_KRSWZ(row, ch) ((row) * 128 + ((((ch)) ^ (((row) >> 1) & 7)) << 4))
__device__ __forceinline__ int v_st(int k, int c) { const int kk = (k & ~0xC) | ((k & 4) << 1) | ((k & 8) >> 1); return ((kk >> 3) * 4 + (c >> 5)) * 512 + ((kk & 7) * 32 + (c & 31)) * 2; }
__device__ __forceinline__ int v_rd_base(int lane) { return ((lane & 3) << 3) | (((lane >> 2) & 3) << 6) | (((lane >> 4) & 1) << 5) | (((lane >> 5) & 1) << 8); }
__device__ __forceinline__ int crow(int r, int hi) { return (r & 3) + 8 * (r >> 2) + 4 * hi; }

constexpr int AT_K = 0, AT_V = 32768, AT_KR = 65536, AT_CF = 81920, AT_WS = 90112;

struct AttnPtrs { const bf16_t* Q; const bf16_t* K; const bf16_t* V; const bf16_t* KR; const float* CF; bf16_t* O; int qld, kld; };

template <int MODE>
__device__ __forceinline__ void attn_block(FK_LAS unsigned char* lds, const AttnPtrs P, const int qb) {
    constexpr int NQ = MODE == 0 ? 12 : 8;
    const int tid = fk_tid(), wid = __builtin_amdgcn_readfirstlane(tid >> 6), lane = tid & 63, r32 = lane & 31, hi = lane >> 5;
    const int q0w = qb * 256 + wid * 32;
    const int nt = 4 * (qb + 1);
    bf16x8 qr[NQ];
    { const bf16_t* qrow = P.Q + (size_t)(q0w + r32) * P.qld;
#pragma unroll
      for (int d0 = 0; d0 < NQ; ++d0) qr[d0] = *(const bf16x8*)(qrow + d0 * 16 + hi * 8); }
    float ct2 = 0.f; if (MODE == 1) ct2 = ((FK_LAS const float*)(lds + AT_CF))[q0w + r32];
    const int sr = tid >> 4, sc = (tid & 15) * 8;
    const int kws = FK_KSWZ(sr, sc * 2), vst0 = v_st(sr, sc), vst1 = v_st(32 + sr, sc);
    const int krr = tid >> 3, krc = tid & 7, krw = FK_KRSWZ(krr, krc);
    const int vb0 = AT_V + v_rd_base(lane);
    FK_LAS float* wsl = (FK_LAS float*)(lds + AT_WS) + wid * 64;
    bf16x8 sk0, sk1, sv0, sv1, skr;
    float m_reg = -1e30f, l_reg = 0.f; f32x16 o[4];
#pragma unroll
    for (int d = 0; d < 4; ++d)
#pragma unroll
        for (int r = 0; r < 16; ++r) o[d][r] = 0.f;
#define AT_LOAD(j) do { const size_t k0_ = (size_t)(j) * 64; \
        sk0 = *(const bf16x8*)(P.K + (k0_ + sr) * P.kld + sc); sk1 = *(const bf16x8*)(P.K + (k0_ + 32 + sr) * P.kld + sc); \
        sv0 = *(const bf16x8*)(P.V + (k0_ + sr) * P.kld + sc); sv1 = *(const bf16x8*)(P.V + (k0_ + 32 + sr) * P.kld + sc); \
        if (MODE == 0) skr = *(const bf16x8*)(P.KR + (k0_ + krr) * 64 + krc * 8); \
        } while (0)
#define AT_WRITE(bf) do { *(FK_LAS bf16x8*)(lds + AT_K + (bf) * 16384 + kws) = sk0; *(FK_LAS bf16x8*)(lds + AT_K + (bf) * 16384 + kws + 32 * 256) = sk1; \
        *(FK_LAS bf16x8*)(lds + AT_V + (bf) * 16384 + vst0) = sv0; *(FK_LAS bf16x8*)(lds + AT_V + (bf) * 16384 + vst1) = sv1; \
        if (MODE == 0) *(FK_LAS bf16x8*)(lds + AT_KR + (bf) * 8192 + krw) = skr; \
        } while (0)
#define AT_TRRD(dst, off) asm volatile("ds_read_b64_tr_b16 %0, %1 offset:%2" : "=&v"(dst) : "v"(vb0), "i"(off) : "memory")
#define AT_PV_D0(KB, d0) do { s16x4 l0, l1, l2, l3, h0, h1, h2, h3; constexpr int b_ = (KB) * 16384 + (d0) * 512; \
        AT_TRRD(l0, b_); AT_TRRD(h0, b_ + 2048); AT_TRRD(l1, b_ + 4096); AT_TRRD(h1, b_ + 6144); AT_TRRD(l2, b_ + 8192); AT_TRRD(h2, b_ + 10240); AT_TRRD(l3, b_ + 12288); AT_TRRD(h3, b_ + 14336); \
        asm volatile("s_waitcnt lgkmcnt(0)" ::: "memory"); __builtin_amdgcn_sched_barrier(0); \
        o[d0] = __builtin_amdgcn_mfma_f32_32x32x16_bf16(pa0, (bf16x8){l0[0], l0[1], l0[2], l0[3], h0[0], h0[1], h0[2], h0[3]}, o[d0], 0, 0, 0); \
        o[d0] = __builtin_amdgcn_mfma_f32_32x32x16_bf16(pa1, (bf16x8){l1[0], l1[1], l1[2], l1[3], h1[0], h1[1], h1[2], h1[3]}, o[d0], 0, 0, 0); \
        o[d0] = __builtin_amdgcn_mfma_f32_32x32x16_bf16(pa2, (bf16x8){l2[0], l2[1], l2[2], l2[3], h2[0], h2[1], h2[2], h2[3]}, o[d0], 0, 0, 0); \
        o[d0] = __builtin_amdgcn_mfma_f32_32x32x16_bf16(pa3, (bf16x8){l3[0], l3[1], l3[2], l3[3], h3[0], h3[1], h3[2], h3[3]}, o[d0], 0, 0, 0); } while (0)
#define AT_PK4(Pv, B_, OUT) do { unsigned a0 = cvt_pk_bf16(Pv[B_ + 0], Pv[B_ + 1]), a1 = cvt_pk_bf16(Pv[B_ + 2], Pv[B_ + 3]); \
        unsigned b0 = cvt_pk_bf16(Pv[B_ + 4], Pv[B_ + 5]), b1 = cvt_pk_bf16(Pv[B_ + 6], Pv[B_ + 7]); \
        auto r0 = __builtin_amdgcn_permlane32_swap(a0, b0, false, false); auto r1 = __builtin_amdgcn_permlane32_swap(a1, b1, false, false); \
        u32x4 w_ = {r0[0], r1[0], r0[1], r1[1]}; OUT = *reinterpret_cast<bf16x8*>(&w_); } while (0)
#define AT_STEP(j, KB) do { \
        if ((j) + 1 < nt) AT_LOAD((j) + 1); \
        if ((j) * 64 <= q0w) { \
            f32x16 p0, p1; \
            _Pragma("unroll") for (int r = 0; r < 16; ++r) { p0[r] = 0.f; p1[r] = 0.f; } \
            __builtin_amdgcn_s_setprio(1); \
            { FK_LAS const unsigned char* kb_ = lds + AT_K + (KB) * 16384; \
              _Pragma("unroll") for (int d0 = 0; d0 < 8; ++d0) { \
                const bf16x8 b0 = *(FK_LAS const bf16x8*)(kb_ + FK_KSWZ(r32, (d0 * 16 + hi * 8) * 2)); \
                const bf16x8 b1 = *(FK_LAS const bf16x8*)(kb_ + FK_KSWZ(r32, (d0 * 16 + hi * 8) * 2) + 32 * 256); \
                p0 = __builtin_amdgcn_mfma_f32_32x32x16_bf16(b0, qr[d0], p0, 0, 0, 0); \
                p1 = __builtin_amdgcn_mfma_f32_32x32x16_bf16(b1, qr[d0], p1, 0, 0, 0); } } \
            if (MODE == 0) { FK_LAS const unsigned char* kr_ = lds + AT_KR + (KB) * 8192; \
              _Pragma("unroll") for (int d0 = 0; d0 < 4; ++d0) { \
                const bf16x8 b0 = *(FK_LAS const bf16x8*)(kr_ + FK_KRSWZ(r32, 2 * d0 + hi)); \
                const bf16x8 b1 = *(FK_LAS const bf16x8*)(kr_ + FK_KRSWZ(r32 + 32, 2 * d0 + hi)); \
                p0 = __builtin_amdgcn_mfma_f32_32x32x16_bf16(b0, qr[(MODE == 0 ? 8 : 0) + d0], p0, 0, 0, 0); \
                p1 = __builtin_amdgcn_mfma_f32_32x32x16_bf16(b1, qr[(MODE == 0 ? 8 : 0) + d0], p1, 0, 0, 0); } } \
            __builtin_amdgcn_s_setprio(0); \
            if (MODE == 1) { FK_LAS const float* cf_ = (FK_LAS const float*)(lds + AT_CF) + (j) * 64; \
              _Pragma("unroll") for (int g = 0; g < 4; ++g) { const f32x4 c0 = *(FK_LAS const f32x4*)(cf_ + 8 * g + 4 * hi), c1 = *(FK_LAS const f32x4*)(cf_ + 32 + 8 * g + 4 * hi); \
                _Pragma("unroll") for (int i = 0; i < 4; ++i) { p0[4 * g + i] += ct2 - c0[i]; p1[4 * g + i] += ct2 - c1[i]; } } \
              if ((j) * 64 + 63 > q0w) { const int dq = q0w + r32 - (j) * 64 - 4 * hi; const float NEG = -__builtin_inff(); \
                _Pragma("unroll") for (int r = 0; r < 16; ++r) { const int c = (r & 3) + 8 * (r >> 2); if (c > dq) p0[r] = NEG; if (c + 32 > dq) p1[r] = NEG; } } } \
            float pmax = p0[0]; \
            _Pragma("unroll") for (int r = 1; r < 16; ++r) pmax = fmaxf(pmax, p0[r]); \
            _Pragma("unroll") for (int r = 0; r < 16; ++r) pmax = fmaxf(pmax, p1[r]); \
            { auto rr = __builtin_amdgcn_permlane32_swap(__float_as_uint(pmax), __float_as_uint(pmax), false, false); pmax = fmaxf(__uint_as_float(rr[0]), __uint_as_float(rr[1])); } \
            float mn, alpha; \
            if (__all(pmax - m_reg <= 11.5415603f)) { mn = m_reg; alpha = 1.f; }     \
            else { mn = fmaxf(m_reg, pmax); alpha = __builtin_amdgcn_exp2f(m_reg - mn); m_reg = mn; } \
            float ps = 0.f; \
            _Pragma("unroll") for (int r = 0; r < 16; ++r) { p0[r] = __builtin_amdgcn_exp2f(p0[r] - mn); ps += p0[r]; } \
            _Pragma("unroll") for (int r = 0; r < 16; ++r) { p1[r] = __builtin_amdgcn_exp2f(p1[r] - mn); ps += p1[r]; } \
            { auto rr = __builtin_amdgcn_permlane32_swap(__float_as_uint(ps), __float_as_uint(ps), false, false); ps = __uint_as_float(rr[0]) + __uint_as_float(rr[1]); } \
            l_reg = l_reg * alpha + ps; \
            bf16x8 pa0, pa1, pa2, pa3; AT_PK4(p0, 0, pa0); AT_PK4(p0, 8, pa1); AT_PK4(p1, 0, pa2); AT_PK4(p1, 8, pa3); \
            if (__any(alpha < 1.f)) { if (hi == 0) wsl[32 + r32] = alpha; asm volatile("s_waitcnt lgkmcnt(0)" ::: "memory"); \
                _Pragma("unroll") for (int g = 0; g < 4; ++g) { const f32x4 a4 = *(FK_LAS const f32x4*)(wsl + 32 + 8 * g + 4 * hi); \
                    _Pragma("unroll") for (int d_ = 0; d_ < 4; ++d_) _Pragma("unroll") for (int i = 0; i < 4; ++i) o[d_][4 * g + i] *= a4[i]; } } \
            __builtin_amdgcn_s_setprio(1); AT_PV_D0(KB, 0); AT_PV_D0(KB, 1); AT_PV_D0(KB, 2); AT_PV_D0(KB, 3); __builtin_amdgcn_s_setprio(0); \
        } \
        if ((j) + 1 < nt) AT_WRITE((KB) ^ 1); \
        __syncthreads(); } while (0)

    AT_LOAD(0); AT_WRITE(0); __syncthreads();
    for (int j = 0; j < nt; j += 2) { AT_STEP(j, 0); AT_STEP(j + 1, 1); }
    if (hi == 0) wsl[r32] = l_reg; asm volatile("s_waitcnt lgkmcnt(0)" ::: "memory");
    bf16_t* Ow = P.O + (size_t)q0w * D;
#pragma unroll
    for (int g = 0; g < 4; ++g) { const f32x4 l4 = *(FK_LAS const f32x4*)(wsl + 8 * g + 4 * hi);
#pragma unroll
        for (int i = 0; i < 4; ++i) { const int r = 4 * g + i; const int orow = crow(r, hi); const float rl = __builtin_amdgcn_rcpf(l4[i]);
#pragma unroll
            for (int d0 = 0; d0 < 4; ++d0) { const float v = o[d0][r] * rl; const float vn = __shfl_xor(v, 1);
                if ((r32 & 1) == 0) *(unsigned*)(Ow + (size_t)orow * D + d0 * 32 + r32) = cvt_pk_bf16(v, vn); } } }
    __syncthreads();
#undef AT_LOAD
#undef AT_WRITE
#undef AT_TRRD
#undef AT_PV_D0
#undef AT_PK4
#undef AT_STEP
}
}
namespace fk {
constexpr int LN_XS = 2052;
constexpr int TAB_OFF = 143360;

struct LnArgs {
    const float* x; const bf16_t* yb; const bf16_t* Y2; const int* te; const int* tpos; const int* cnt;
    const float *g, *b; float* xo; bf16_t* xbo; float* out2; unsigned char* xqo;
    const f32x4* w4; int ntile;
    const float *bgrp, *brt; int* rcnt; int* ote; int* otpos; float* otw; int* list; float* sw;
    float* flog; const float* fbias;
};

__device__ __forceinline__ float wave_sum(float v) { for (int o = 32; o >= 1; o >>= 1) v += __shfl_xor(v, o); return v; }

struct LnRows { f32x4 x[2][8]; u32x2 ya[2][8]; u32x2 yb[2][8]; };
__device__ __forceinline__ void ln_load(const LnArgs& a, FK_LAS const int* hoff, int grp, int wid, int lane, LnRows& R) {
#pragma unroll
    for (int rr = 0; rr < 2; ++rr) { const int t = grp * 16 + 2 * wid + rr;
        const bf16_t *pa, *pb = nullptr;
        if (a.Y2) { const int e0 = a.te[t * 2], e1 = a.te[t * 2 + 1]; pa = a.Y2 + (size_t)(hoff[e0] + a.tpos[t * 2]) * D; pb = a.Y2 + (size_t)(hoff[e1] + a.tpos[t * 2 + 1]) * D; }
        else pa = a.yb + (size_t)t * D;
#pragma unroll
        for (int i = 0; i < 8; ++i) { const int c = 4 * lane + 256 * i; R.x[rr][i] = *(const f32x4*)(a.x + (size_t)t * D + c); R.ya[rr][i] = *(const u32x2*)(pa + c); if (a.Y2) R.yb[rr][i] = *(const u32x2*)(pb + c); else R.yb[rr][i] = (u32x2){0u, 0u}; } }
}
__device__ __forceinline__ void phase_ln(const LnArgs& a, FK_LAS unsigned char* lds) {
    const int tid = fk_tid(), wid = __builtin_amdgcn_readfirstlane(tid >> 6), lane = tid & 63;
    FK_LAS float* part = (FK_LAS float*)lds;
    FK_LAS float* logit = (FK_LAS float*)(lds + 65536);
    FK_LAS int* hoff = (FK_LAS int*)(lds + TAB_OFF);
    if (a.Y2) { if (tid < 64) { const int c = lane < 32 ? a.cnt[lane * 32] : 0; const int pc = ((c + 255) >> 8) << 8; int incl = pc;
#pragma unroll
            for (int o = 1; o < 32; o <<= 1) { const int v = __shfl_up(incl, o); if (lane >= o) incl += v; }
            if (lane < 32) hoff[lane] = incl - pc; }
        __syncthreads(); }
    const int nb = fk_nblk(); int grp = fk_bid();
    if (grp >= NT / 16) return;
    LnRows cur; ln_load(a, hoff, grp, wid, lane, cur);
#pragma unroll 1
    for (; grp < NT / 16; grp += nb) {
        const bool has_next = grp + nb < NT / 16;
#pragma unroll
        for (int rr = 0; rr < 2; ++rr) {
            const int lr = 2 * wid + rr, t = grp * 16 + lr;
            f32x4 v[8]; float s = 0.f;
#pragma unroll
            for (int i = 0; i < 8; ++i) { f32x4 xv = cur.x[rr][i] * ALPHA; const u32x2 pa = cur.ya[rr][i], pb = cur.yb[rr][i];
                xv[0] += __uint_as_float(pa.x << 16) + __uint_as_float(pb.x << 16); xv[1] += __uint_as_float(pa.x & 0xffff0000u) + __uint_as_float(pb.x & 0xffff0000u);
                xv[2] += __uint_as_float(pa.y << 16) + __uint_as_float(pb.y << 16); xv[3] += __uint_as_float(pa.y & 0xffff0000u) + __uint_as_float(pb.y & 0xffff0000u);
                v[i] = xv; s += (xv[0] + xv[1]) + (xv[2] + xv[3]); }
            const float mean = wave_sum(s) * (1.0f / D); float q = 0.f;
#pragma unroll
            for (int i = 0; i < 8; ++i) { const f32x4 d = v[i] - mean; q += (d[0] * d[0] + d[1] * d[1]) + (d[2] * d[2] + d[3] * d[3]); }
            const float rs = rsqrtf(wave_sum(q) * (1.0f / D) + 1e-5f);
#pragma unroll
            for (int i = 0; i < 8; ++i) { const int c = 4 * lane + 256 * i; const f32x4 gv = *(const f32x4*)(a.g + c), bv = *(const f32x4*)(a.b + c);
                const f32x4 o = (v[i] - mean) * rs * gv + bv;
                *(f32x4*)(a.xo + (size_t)t * D + c) = o;
                if (a.out2) *(f32x4*)(a.out2 + (size_t)t * D + c) = o;
                u32x2 p; p.x = cvt_pk_bf16(o[0], o[1]); p.y = cvt_pk_bf16(o[2], o[3]); *(u32x2*)(a.xbo + (size_t)t * D + c) = p; }
        }
        if (has_next) ln_load(a, hoff, grp + nb, wid, lane, cur);
    }
    if (!a.w4) return;
    __syncthreads();
    const int row = lane & 15, kq = lane >> 4;
#pragma unroll 1
    for (int g0 = fk_bid(); g0 < NT / 16; g0 += 2 * nb) {
        const int g1 = g0 + nb; const bool two = g1 < NT / 16;
        const int ks = (wid + (fk_bid() >> 3)) & 7, jrot = 4 * ((fk_bid() >> 6) & 3);
        const float* xp0 = a.xo + (size_t)(g0 * 16 + row) * D + 4 * kq + 256 * ks;
        const float* xp1 = a.xo + (size_t)((two ? g1 : g0) * 16 + row) * D + 4 * kq + 256 * ks;
        const f32x4* wp = a.w4 + (size_t)(ks * 16 * a.ntile) * 64 + lane;
        f32x4 acc[2][3];
#pragma unroll
        for (int g = 0; g < 2; ++g)
#pragma unroll
            for (int n = 0; n < 3; ++n) acc[g][n] = (f32x4){0.f, 0.f, 0.f, 0.f};
#pragma unroll 4
        for (int j0 = 0; j0 < 16; ++j0) { const int j = (j0 + jrot) & 15;
            const f32x4 a0 = *(const f32x4*)(xp0 + 16 * j), a1 = *(const f32x4*)(xp1 + 16 * j);
#pragma unroll
            for (int n = 0; n < 3; ++n) if (n < a.ntile) { const f32x4 bv = wp[(size_t)(j * a.ntile + n) * 64];
#pragma unroll
                for (int i = 0; i < 4; ++i) { acc[0][n] = __builtin_amdgcn_mfma_f32_16x16x4f32(a0[i], bv[i], acc[0][n], 0, 0, 0); acc[1][n] = __builtin_amdgcn_mfma_f32_16x16x4f32(a1[i], bv[i], acc[1][n], 0, 0, 0); } } }
#pragma unroll
        for (int g = 0; g < 2; ++g)
#pragma unroll
            for (int n = 0; n < 3; ++n) if (n < a.ntile) {
#pragma unroll
                for (int r = 0; r < 4; ++r) part[(wid * 32 + 16 * g + 4 * kq + r) * 48 + 16 * n + row] = acc[g][n][r]; }
        __syncthreads();
        for (int i = tid; i < 32 * 16 * a.ntile; i += NTHR) { const int n = i % (16 * a.ntile), r = i / (16 * a.ntile); float s = 0.f;
#pragma unroll
            for (int w = 0; w < 8; ++w) s += part[(w * 32 + r) * 48 + n]; logit[r * 48 + n] = s; }
        __syncthreads();
        if (a.ntile == 1) { const int r = tid & 31, n = tid >> 5; if (r < 16 || two) { const int t = (r < 16 ? g0 : g1) * 16 + (r & 15); const float x = logit[r * 48 + n] + a.fbias[n]; const float ls = fminf(x, 0.f) - 0.6931471805599453f * __builtin_amdgcn_logf(1.0f + __builtin_amdgcn_exp2f(-fabsf(x) * LOG2E));     a.flog[((size_t)((t >> 11) * 16 + n)) * S + (t & (S - 1))] = ls; } }
        else if (tid < 16 || (tid < 32 && two)) { const int t = (tid < 16 ? g0 : g1) * 16 + (tid & 15); FK_LAS const float* lg = logit + tid * 48;
            float g4[4]; float mx = -3e38f; int gs = 0;
            for (int i = 0; i < 4; ++i) { g4[i] = lg[i] + a.bgrp[i]; if (g4[i] > mx) { mx = g4[i]; gs = i; } }
            float den = 0.f; for (int i = 0; i < 4; ++i) den += expf(g4[i] - mx); const float pg = 1.f / den;
            float e[8]; for (int i = 0; i < 8; ++i) e[i] = lg[4 + gs * 8 + i] + a.brt[gs * 8 + i];
            int i1 = 0; for (int i = 1; i < 8; ++i) if (e[i] > e[i1]) i1 = i;
            int i2 = -1; for (int i = 0; i < 8; ++i) if (i != i1 && (i2 < 0 || e[i] > e[i2])) i2 = i;
            const float w1 = 1.f / (1.f + expf(e[i2] - e[i1])), w2 = 1.f - w1;
            const int ea = gs * 8 + i1, eb = gs * 8 + i2;
            const int pa = atomicAdd(a.rcnt + ea * 32, 1), pb = atomicAdd(a.rcnt + eb * 32, 1);
            a.ote[t * 2] = ea; a.ote[t * 2 + 1] = eb; a.otpos[t * 2] = pa; a.otpos[t * 2 + 1] = pb; a.otw[t * 2] = w1 * pg; a.otw[t * 2 + 1] = w2 * pg;
            a.list[ea * NT + pa] = t; a.list[eb * NT + pb] = t; a.sw[ea * NT + pa] = w1 * pg; a.sw[eb * NT + pb] = w2 * pg; }
        __syncthreads();
    }
}

__device__ __forceinline__ void moe_tables(const int* cnt, FK_LAS int* tab) {
    const int tid = fk_tid(), lane = tid & 63;
    __syncthreads();
    if (tid < 64) { const int c = lane < 32 ? cnt[lane * 32] : 0; const int nt = (c + 255) >> 8; int incl = nt;
#pragma unroll
        for (int o = 1; o < 32; o <<= 1) { const int v = __shfl_up(incl, o); if (lane >= o) incl += v; }
        if (lane < 32) { tab[lane] = incl - nt; tab[40 + lane] = (incl - nt) * 256; tab[80 + lane] = c; }
        if (lane == 31) tab[32] = incl; }
    __syncthreads();
}
struct MoeSched1 {
    const char* xb; const char* Bt; const int* list; FK_LAS const int* tab; int G, c;
    __device__ __forceinline__ bool next(int i, GUnit& u) const {
        const int L = i * G + c; const int tot = tab[32] * 4; if (L >= tot) return false;
        int e = 0;
#pragma unroll 1
        for (int q = 1; q < 32; ++q) if (L >= tab[q] * 4) e = q;
        const int r = L - tab[e] * 4, nte = tab[e + 1] - tab[e]; const int mt = r % nte, pn = r / nte;
        u.e = e; u.pm = mt; u.pn = pn; u.nrows = min(256, tab[80 + e] - 256 * mt); u.A = xb; u.B = Bt + ((size_t)e * 1024 + (size_t)pn * 256) * D * 2; return true; }
    __device__ __forceinline__ void a_offs(const GUnit& u, int tid, unsigned (&o)[2][2]) const { int R0, C0, R1, C1; stage_rc(tid * 16, R0, C0); stage_rc(tid * 16 + 8192, R1, C1);
        const int* l = list + (size_t)u.e * NT + u.pm * 256;
        const int r00 = R0 < u.nrows ? R0 : 0, r01 = R1 < u.nrows ? R1 : 0, r10 = R0 + HALF < u.nrows ? R0 + HALF : 0, r11 = R1 + HALF < u.nrows ? R1 + HALF : 0;
        o[0][0] = (unsigned)(l[r00] * D + C0) * 2u; o[0][1] = (unsigned)(l[r01] * D + C1) * 2u; o[1][0] = (unsigned)(l[r10] * D + C0) * 2u; o[1][1] = (unsigned)(l[r11] * D + C1) * 2u; }
};
struct MoeSched2 {
    const char* H; const char* Bt; FK_LAS const int* tab; int G, c;
    __device__ __forceinline__ bool next(int i, GUnit& u) const {
        const int L = i * G + c; const int tot = tab[32] * 8; if (L >= tot) return false;
        int e = 0;
#pragma unroll 1
        for (int q = 1; q < 32; ++q) if (L >= tab[q] * 8) e = q;
        const int r = L - tab[e] * 8, nte = tab[e + 1] - tab[e]; const int mt = r % nte, pn = r / nte;
        u.e = e; u.pm = mt; u.pn = pn; u.nrows = min(256, tab[80 + e] - 256 * mt); u.A = H + (size_t)(tab[40 + e] + 256 * mt) * 512 * 2; u.B = Bt + ((size_t)e * 2048 + (size_t)pn * 256) * 512 * 2; return true; }
    __device__ __forceinline__ void a_offs(const GUnit&, int tid, unsigned (&o)[2][2]) const { int R0, C0, R1, C1; stage_rc(tid * 16, R0, C0); stage_rc(tid * 16 + 8192, R1, C1);
        o[0][0] = (unsigned)(R0 * 512 + C0) * 2u; o[0][1] = (unsigned)(R1 * 512 + C1) * 2u; o[1][0] = o[0][0] + (unsigned)(HALF * 512 * 2); o[1][1] = o[0][1] + (unsigned)(HALF * 512 * 2); }
};
struct EpiMoe1 {
    static constexpr bool PERM = false;
    bf16_t* H; const float* sw; FK_LAS const int* tab;
    __device__ __forceinline__ void operator()(const f32x4 (&acc)[2][2][4][2], const GUnit& u, int wr, int wc, int fr, int fq) const {
        const int hrow0 = tab[40 + u.e] + 256 * u.pm; const float* swe = sw + (size_t)u.e * NT + 256 * u.pm;
#pragma unroll
        for (int ai = 0; ai < 2; ++ai)
#pragma unroll
            for (int m = 0; m < 4; ++m) { const int r = ai * HALF + wr * 64 + m * 16 + fr; if (r < u.nrows) { const float wgt = swe[r];
#pragma unroll
                for (int bj = 0; bj < 2; ++bj) { const f32x4 g = acc[ai][bj][m][0], up = acc[ai][bj][m][1]; f32x4 h;
#pragma unroll
                    for (int j = 0; j < 4; ++j) h[j] = g[j] * __builtin_amdgcn_rcpf(1.0f + __builtin_amdgcn_exp2f(-g[j] * LOG2E)) * up[j] * wgt;
                    u32x2 p; p.x = cvt_pk_bf16(h[0], h[1]); p.y = cvt_pk_bf16(h[2], h[3]);
                    *(u32x2*)(H + (size_t)(hrow0 + r) * 512 + u.pn * 128 + bj * 64 + wc * 16 + 4 * fq) = p; } } }
    }
};
struct EpiMoe2 {
    static constexpr bool PERM = true;
    bf16_t* Y2; FK_LAS const int* tab;
    __device__ __forceinline__ void operator()(const f32x4 (&acc)[2][2][4][2], const GUnit& u, int wr, int wc, int fr, int fq) const {
        const int hrow0 = tab[40 + u.e] + 256 * u.pm;
#pragma unroll
        for (int ai = 0; ai < 2; ++ai)
#pragma unroll
            for (int m = 0; m < 4; ++m) { const int r = ai * HALF + wr * 64 + m * 16 + fr; if (r < u.nrows) {
#pragma unroll
                for (int bj = 0; bj < 2; ++bj) *(u32x4*)(Y2 + (size_t)(hrow0 + r) * D + u.pn * BM + bj * HALF + wc * 32 + 8 * fq) = pack8(acc[ai][bj][m][0], acc[ai][bj][m][1]); } }
    }
};
}
namespace fk {
constexpr int SG_ROWS = 640, SG_ASTG = SG_ROWS * 64, SG_BPITCH = 1040, SG_BSTG = 16 * SG_BPITCH, SG_A = 0, SG_B = 2 * SG_ASTG;
struct SgArgs {
    const char* A; const int* rowlist; int arow0, lda_bytes, nr;
    const float* B0; const float* B1; int ldn, K;
    bf16_t* out; int out_row0, out_ld, out_col0; const float* roww; int var;
};
template <int MODE>
__device__ __forceinline__ void sg_unit(FK_LAS unsigned char* lds, const SgArgs a) {
    const int tid = fk_tid(), wid = __builtin_amdgcn_readfirstlane(tid >> 6), lane = tid & 63, r16 = lane & 15, kq = lane >> 4, wm = wid >> 1, wn = wid & 1;
    const int rpw = ((a.nr + 63) >> 6) << 4, mf = rpw >> 4;
    const int nt = a.K >> 5;
    const char* ap[5];
    { const int kc = (lane & 3) ^ ((lane >> 4) & 3);
#pragma unroll
      for (int i = 0; i < 5; ++i) { int r = 16 * (5 * wid + i) + (lane >> 2); r = r < a.nr ? r : a.nr - 1; if (a.var & 4) r = 0; const int gr = a.rowlist ? a.rowlist[r] : a.arow0 + r; ap[i] = a.A + (size_t)gr * a.lda_bytes + kc * 16; } }
    const float* bp[2];
#pragma unroll
    for (int i = 0; i < 2; ++i) { const int k = 2 * (2 * wid + i) + (lane >> 5), c = lane & 31;
        if (MODE == 1) { const int blk = c >> 3; bp[i] = ((blk & 1) ? a.B1 : a.B0) + (size_t)k * a.ldn + 32 * (blk >> 1) + 4 * (c & 7); }
        else bp[i] = a.B0 + (size_t)k * a.ldn + 4 * c; }
    const unsigned a_rd = (unsigned)(SG_A + (wm * rpw + r16) * 64 + ((kq ^ ((r16 >> 2) & 3)) << 4));
    const unsigned b_rd = (unsigned)(SG_B + 4 * kq * SG_BPITCH + (wn * 64 + r16) * 4);
    f32x4 acc[10][4];
#pragma unroll
    for (int i = 0; i < 10; ++i)
#pragma unroll
        for (int j = 0; j < 4; ++j) acc[i][j] = (f32x4){0.f, 0.f, 0.f, 0.f};
#define SG_ISSUE(t, stg) do {         _Pragma("unroll") for (int i = 0; i < 5; ++i) __builtin_amdgcn_global_load_lds((const unsigned*)(ap[i] + (size_t)(t) * 64), (FK_LAS unsigned*)(lds + SG_A + (stg) * SG_ASTG + (5 * wid + i) * 1024), 16, 0, 0);         _Pragma("unroll") for (int i = 0; i < 2; ++i) __builtin_amdgcn_global_load_lds((const unsigned*)(bp[i] + (size_t)((a.var & 2) ? 0 : (t)) * 32 * a.ldn), (FK_LAS unsigned*)(lds + SG_B + (stg) * SG_BSTG + (2 * wid + i) * SG_BPITCH), 16, 0, 0); } while (0)
    SG_ISSUE(0, 0);
    int stg = 0;
#pragma unroll 1
    for (int t = 0; t < nt; ++t) {
        asm volatile("s_waitcnt vmcnt(0)\n\ts_barrier" ::: "memory");
        if (t + 1 < nt) SG_ISSUE(t + 1, stg ^ 1);
        FK_LAS const unsigned char* ab = lds + a_rd + stg * SG_ASTG; FK_LAS const unsigned char* bb = lds + b_rd + stg * SG_BSTG;
        bf16x8 bf[4];
#pragma unroll
        for (int j = 0; j < 4; ++j) { FK_LAS const float* p = (FK_LAS const float*)(bb + j * 64);
            const float v0 = p[0], v1 = p[128], v2 = p[260], v3 = p[388], v4 = p[520], v5 = p[648], v6 = p[780], v7 = p[908];
            u32x4 w; w.x = cvt_pk_bf16(v0, v1); w.y = cvt_pk_bf16(v2, v3); w.z = cvt_pk_bf16(v4, v5); w.w = cvt_pk_bf16(v6, v7); bf[j] = *reinterpret_cast<bf16x8*>(&w); }
#pragma unroll
        for (int i = 0; i < 10; ++i) if (i < mf && !(a.var & 1)) { const bf16x8 af = *(FK_LAS const bf16x8*)(ab + i * 1024);
#pragma unroll
            for (int j = 0; j < 4; ++j) acc[i][j] = __builtin_amdgcn_mfma_f32_16x16x32_bf16(bf[j], af, acc[i][j], 0, 0, 0); }
        stg ^= 1;
    }
#undef SG_ISSUE
    float wgts[10];
#pragma unroll
    for (int i = 0; i < 10; ++i) { const int r = wm * rpw + 16 * i + r16; wgts[i] = (MODE == 1 && i < mf && r < a.nr) ? a.roww[r] : 0.f; }
#pragma unroll
    for (int i = 0; i < 10; ++i) if (i < mf) { const int r = wm * rpw + 16 * i + r16; if (r < a.nr) {
        if (MODE == 1) { const float wgt = wgts[i]; bf16_t* orow = a.out + (size_t)(a.out_row0 + r) * a.out_ld + a.out_col0 + 32 * wn + 4 * kq;
#pragma unroll
            for (int j = 0; j < 2; ++j) { const f32x4 g = acc[i][j], up = acc[i][j + 2]; f32x4 h;
#pragma unroll
                for (int q = 0; q < 4; ++q) h[q] = g[q] * __builtin_amdgcn_rcpf(1.0f + __builtin_amdgcn_exp2f(-g[q] * LOG2E)) * up[q] * wgt;
                u32x2 p; p.x = cvt_pk_bf16(h[0], h[1]); p.y = cvt_pk_bf16(h[2], h[3]); *(u32x2*)(orow + 16 * j) = p; } }
        else { bf16_t* orow = a.out + (size_t)(a.out_row0 + r) * a.out_ld + a.out_col0 + 64 * wn + 4 * kq;
#pragma unroll
            for (int j = 0; j < 4; ++j) { const f32x4 v = acc[i][j]; u32x2 p; p.x = cvt_pk_bf16(v[0], v[1]); p.y = cvt_pk_bf16(v[2], v[3]); *(u32x2*)(orow + 16 * j) = p; } } } }
    asm volatile("s_waitcnt vmcnt(0)" ::: "memory");
    __syncthreads();
}
__device__ __forceinline__ void phase_moe1(FK_LAS unsigned char* lds, FK_LAS const int* tab, const bf16_t* xb, const int* list, const float* sw, const float* wgate, const float* wup, bf16_t* H, int var) {
#pragma unroll 1
    for (int u = fk_bid(), nb = fk_nblk(); u < 256; u += nb) { const int xcd = u & 7, q = u >> 3, e = xcd + 8 * (q >> 3), s = q & 7; const int ne = tab[80 + e], hrow0 = tab[40 + e];
        const int rbeg = 0, rend = ne;
#pragma unroll 1
        for (int r0 = rbeg; r0 < rend; r0 += SG_ROWS) { SgArgs a; a.A = (const char*)xb; a.rowlist = list + (size_t)e * NT + r0; a.arow0 = 0; a.lda_bytes = D * 2; a.nr = min(SG_ROWS, rend - r0);
            a.B0 = wgate + (size_t)e * D * 512 + 64 * s; a.B1 = wup + (size_t)e * D * 512 + 64 * s; a.ldn = 512; a.K = D;
            a.out = H; a.out_row0 = hrow0 + r0; a.out_ld = 512; a.out_col0 = 64 * s; a.roww = sw + (size_t)e * NT + r0; a.var = var; sg_unit<1>(lds, a); } }
}
__device__ __forceinline__ void phase_moe2(FK_LAS unsigned char* lds, FK_LAS const int* tab, const bf16_t* H, const float* wdown, bf16_t* Y2, int var) {
#pragma unroll 1
    for (int u = fk_bid(), nb = fk_nblk(); u < 512; u += nb) { const int xcd = u & 7, q = u >> 3, e = xcd + 8 * (q >> 4), s = q & 15; const int ne = tab[80 + e], hrow0 = tab[40 + e];
        const int rbeg = 0, rend = ne;
#pragma unroll 1
        for (int r0 = rbeg; r0 < rend; r0 += SG_ROWS) { SgArgs a; a.A = (const char*)H; a.rowlist = nullptr; a.arow0 = hrow0 + r0; a.lda_bytes = 512 * 2; a.nr = min(SG_ROWS, rend - r0);
            a.B0 = wdown + (size_t)e * 512 * D + 128 * s; a.B1 = nullptr; a.ldn = D; a.K = 512;
            a.out = Y2; a.out_row0 = hrow0 + r0; a.out_ld = D; a.out_col0 = 128 * s; a.roww = nullptr; a.var = var; sg_unit<2>(lds, a); } }
}
}
namespace fk {
struct EpiBf16Q {
    static constexpr bool PERM = true;
    bf16_t* O; int ldc, qcols; float qscale;
    __device__ __forceinline__ void operator()(const f32x4 (&acc)[2][2][4][2], const GUnit& u, int wr, int wc, int fr, int fq) const {
        const int row0 = u.pm * BM + wr * 64 + fr;
#pragma unroll
        for (int bj = 0; bj < 2; ++bj) { const int gc = u.pn * BM + bj * HALF + wc * 32 + 8 * fq; const float sc = gc < qcols ? qscale : 1.0f;
#pragma unroll
            for (int ai = 0; ai < 2; ++ai)
#pragma unroll
                for (int m = 0; m < 4; ++m) *(u32x4*)(O + (size_t)(row0 + ai * HALF + m * 16) * ldc + gc) = pack8(acc[ai][bj][m][0] * sc, acc[ai][bj][m][1] * sc); }
    }
};
__device__ __forceinline__ void fox_cumsum_lds(const float* lsig, FK_LAS float* cfl, FK_LAS double* wtot, const int b, const int h) {
    const int tid = fk_tid(), lane = tid & 63, wid = tid >> 6;
    __syncthreads();
    const f32x4 v = *(const f32x4*)(lsig + (size_t)(b * 16 + h) * S + 4 * tid);
    const double s0 = (double)v[0], s1 = s0 + (double)v[1], s2 = s1 + (double)v[2], s3 = s2 + (double)v[3];
    double incl = s3;
#pragma unroll
    for (int o = 1; o < 64; o <<= 1) { const double u = __shfl_up(incl, o); if (lane >= o) incl += u; }
    if (lane == 63) wtot[wid] = incl;
    __syncthreads();
    double off = incl - s3;
#pragma unroll
    for (int w = 0; w < 7; ++w) if (w < wid) off += wtot[w];
    f32x4 o4; o4[0] = (float)((off + s0) * 1.4426950408889634); o4[1] = (float)((off + s1) * 1.4426950408889634); o4[2] = (float)((off + s2) * 1.4426950408889634); o4[3] = (float)((off + s3) * 1.4426950408889634);
    *(FK_LAS f32x4*)(cfl + 4 * tid) = o4;
    __syncthreads();
}
struct EpiDsaIn {
    static constexpr bool PERM = true;
    bf16_t *q, *k, *v, *qidx, *kidx; float* widx;
    __device__ __forceinline__ void operator()(const f32x4 (&acc)[2][2][4][2], const GUnit& u, int wr, int wc, int fr, int fq) const {
        const int row0 = u.pm * BM + wr * 64 + fr;
#pragma unroll
        for (int bj = 0; bj < 2; ++bj) { const int gc = u.pn * BM + bj * HALF + wc * 32 + 8 * fq;
            bf16_t* dst; int ld, c; float sc = 1.0f;
            if (gc < 2048) { dst = q; ld = 2048; c = gc; sc = QSCALE_128; } else if (gc < 2176) { dst = k; ld = 128; c = gc - 2048; } else if (gc < 2304) { dst = v; ld = 128; c = gc - 2176; }
            else if (gc < 3328) { dst = qidx; ld = 1024; c = gc - 2304; } else if (gc < 3392) { dst = kidx; ld = 64; c = gc - 3328; } else { dst = nullptr; ld = 0; c = gc - 3392; }
#pragma unroll
            for (int ai = 0; ai < 2; ++ai)
#pragma unroll
                for (int m = 0; m < 4; ++m) { const int row = row0 + ai * HALF + m * 16;
                    if (dst) *(u32x4*)(dst + (size_t)row * ld + c) = pack8(acc[ai][bj][m][0] * sc, acc[ai][bj][m][1] * sc);
                    else if (c < 16) { *(f32x4*)(widx + (size_t)row * 16 + c) = acc[ai][bj][m][0] * 0.03125f; *(f32x4*)(widx + (size_t)row * 16 + c + 4) = acc[ai][bj][m][1] * 0.03125f; } } }
    }
};

__device__ __forceinline__ unsigned ord_u32(float f) { const unsigned b = __float_as_uint(f); return b ^ ((b >> 31) ? 0xFFFFFFFFu : 0x80000000u); }
__device__ __forceinline__ int half_sum(int v) {
    v += __shfl_xor(v, 1); v += __shfl_xor(v, 2); v += __shfl_xor(v, 4); v += __shfl_xor(v, 8); v += __shfl_xor(v, 16); return v; }
__device__ __forceinline__ void dsa_index_unit(FK_LAS unsigned char* lds, const bf16_t* qidx, const bf16_t* kidx, const float* widx, unsigned short* sel, int* nsel, const int b, const int g, const int var = 0) {
    const int tid = fk_tid(), wid = __builtin_amdgcn_readfirstlane(tid >> 6), lane = tid & 63, r32 = lane & 31, hi = lane >> 5;
    const int t0 = 16 * g, ntile = (t0 >> 6) + 1, nk = 64 * ntile;
    const int tq = t0 + 2 * wid;
    bf16x8 qa[4]; float wv[16];
    { const int row = r32, q = row >> 4, h = row & 15; const bf16_t* p = qidx + ((size_t)(b * S + tq + q)) * 1024 + h * 64 + hi * 8;
#pragma unroll
      for (int ks = 0; ks < 4; ++ks) qa[ks] = *(const bf16x8*)(p + ks * 16);
#pragma unroll
      for (int r = 0; r < 16; ++r) { const int rw = crow(r, hi); wv[r] = widx[((size_t)(b * S + tq + (rw >> 4))) * 16 + (rw & 15)]; } }
    const int krr = tid >> 3, krc = tid & 7, krw = FK_KRSWZ(krr, krc);
    unsigned uk[64];
    bf16x8 stg[4];
#define DI_LOAD(T) do { _Pragma("unroll") for (int q_ = 0; q_ < 4; ++q_) stg[q_] = *(const bf16x8*)(kidx + ((size_t)(b * S + (T) * 256 + q_ * 64 + krr)) * 64 + krc * 8); } while (0)
#define DI_WRITE(bf) do { _Pragma("unroll") for (int q_ = 0; q_ < 4; ++q_) *(FK_LAS bf16x8*)(lds + (bf) * 32768 + q_ * 8192 + krw) = stg[q_]; } while (0)
    const int nt256 = (nk + 255) >> 8;
    DI_LOAD(0); DI_WRITE(0); __syncthreads();
#pragma unroll
    for (int i = 0; i < 64; ++i) uk[i] = 0u;
#pragma unroll 1
    for (int it = 0; it < 8; ++it) {
#pragma unroll
        for (int i = 0; i < 56; ++i) uk[i] = uk[i + 8];
        if (it < nt256 && !(var & 16)) {
            if (it + 1 < nt256) DI_LOAD(it + 1);
#pragma unroll
            for (int jj = 0; jj < 4; ++jj) { const int j = 4 * it + jj;
                if (j < ntile) {
                    FK_LAS const unsigned char* kb = lds + (it & 1) * 32768 + jj * 8192;
#pragma unroll
                    for (int sub = 0; sub < 2; ++sub) {
                        f32x16 acc;
#pragma unroll
                        for (int r = 0; r < 16; ++r) acc[r] = 0.f;
#pragma unroll
                        for (int ks = 0; ks < 4; ++ks) { const bf16x8 kf = *(FK_LAS const bf16x8*)(kb + FK_KRSWZ(32 * sub + r32, 2 * ks + hi)); acc = __builtin_amdgcn_mfma_f32_32x32x16_bf16(qa[ks], kf, acc, 0, 0, 0); }
                        float s0 = 0.f, s1 = 0.f;
#pragma unroll
                        for (int r = 0; r < 8; ++r) { s0 += fmaxf(acc[r], 0.f) * wv[r]; s1 += fmaxf(acc[8 + r], 0.f) * wv[8 + r]; }
                        auto rr = __builtin_amdgcn_permlane32_swap(__float_as_uint(s0), __float_as_uint(s1), false, false);
                        uk[56 + 2 * jj + sub] = ord_u32(__uint_as_float(rr[0]) + __uint_as_float(rr[1]));
                    }
                } else { uk[56 + 2 * jj] = 0u; uk[56 + 2 * jj + 1] = 0u; }
            }
            if (it + 1 < nt256) DI_WRITE((it + 1) & 1);
            __syncthreads();
        } else {
#pragma unroll
            for (int q_ = 0; q_ < 8; ++q_) uk[56 + q_] = 0u; }
    }
#undef DI_LOAD
#undef DI_WRITE
    const int t = tq + hi;
    unsigned short* so = sel + ((size_t)(b * S + t)) * 256;
    int base = 0;
    if (nk <= 256 || (var & 8)) {
#pragma unroll
        for (int s = 0; s < 8; ++s) { const int key = 32 * s + r32; so[key] = (unsigned short)(key < nk ? key : 0); }
        base = nk;
    } else {
        unsigned T = 0u; bool done = false;
#pragma unroll 1
        for (int bit = 31; bit >= 0; --bit) { const unsigned cand = T | (1u << bit); int c = 0;
#pragma unroll
            for (int s = 0; s < 64; ++s) c += (uk[s] >= cand) ? 1 : 0;
            c = half_sum(c); if (!done && c >= 256) { T = cand; done = (c == 256); }
            if (__all(done)) break; }
        int cgt = 0;
#pragma unroll
        for (int s = 0; s < 64; ++s) cgt += (uk[s] > T) ? 1 : 0;
        cgt = half_sum(cgt);
        const int need = 256 - cgt; int eqb = 0;
#pragma unroll
        for (int s = 0; s < 64; ++s) { const int key = 32 * s + r32; const unsigned u = uk[s];
            const bool iseq = (u == T);
            const unsigned long long em = __ballot(iseq); const unsigned eh = hi ? (unsigned)(em >> 32) : (unsigned)em; const int erank = eqb + __popc(eh & ((1u << r32) - 1u)); eqb += __popc(eh);
            const bool take = (u > T) || (iseq && erank < need);
            const unsigned long long tm = __ballot(take); const unsigned th = hi ? (unsigned)(tm >> 32) : (unsigned)tm; const int pos = base + __popc(th & ((1u << r32) - 1u)); base += __popc(th);
            if (take) so[pos] = (unsigned short)key; }
    }
    if (r32 == 0) nsel[b * S + t] = base;
}

constexpr int DS_T5 = 131072, DS_LUT = 133120, DS_SEL = 135168;
__device__ __forceinline__ void phase_dsa_attn(FK_LAS unsigned char* lds, const bf16_t* dq, const bf16_t* dk, const bf16_t* dv, const unsigned short* sel, const int* nsel, const float* t5, bf16_t* o) {
    const int tid = fk_tid(), wid = __builtin_amdgcn_readfirstlane(tid >> 6), lane = tid & 63, c16 = lane & 15, g = lane >> 4;
    FK_LAS float* t5l = (FK_LAS float*)(lds + DS_T5); FK_LAS unsigned char* lut = lds + DS_LUT;
    for (int i = tid; i < 512; i += NTHR) t5l[i] = t5[i] * LOG2E;
    for (int n = tid; n < 2048; n += NTHR) { int bk; if (n < 8) bk = n; else { bk = 8 + (int)(logf((float)n / 8.0f) / 2.772588722239781f * 8.0f); if (bk > 15) bk = 15; } lut[n] = (unsigned char)bk; }
    __syncthreads();
    FK_LAS unsigned char* vst = lds + wid * 16384;
    FK_LAS unsigned short* sell = (FK_LAS unsigned short*)(lds + DS_SEL + wid * 512);
    const unsigned vbase = (unsigned)(size_t)vst;
#pragma unroll 1
    for (int tg = fk_bid() * 8 + wid; tg < NT; tg += fk_nblk() * 8) {
        const int b = tg >> 11, t = tg & (S - 1); const int cnt = nsel[tg];
        const bf16_t* kb = dk + (size_t)b * S * 128; const bf16_t* vb = dv + (size_t)b * S * 128;
        { const u32x2 s4 = *(const u32x2*)(sel + (size_t)tg * 256 + lane * 4); *(FK_LAS u32x2*)(sell + lane * 4) = s4; }
        bf16x8 qf[4];
#pragma unroll
        for (int ks = 0; ks < 4; ++ks) qf[ks] = *(const bf16x8*)(dq + (size_t)tg * 2048 + c16 * 128 + ks * 32 + g * 8);
        asm volatile("s_waitcnt lgkmcnt(0)" ::: "memory");
        f32x4 sc[16];
#pragma unroll
        for (int ib = 0; ib < 4; ++ib) {
            bf16x8 kf[4][4];
#pragma unroll
            for (int u = 0; u < 4; ++u) { const int kk = sell[16 * (4 * ib + u) + c16]; const bf16_t* kr = kb + (size_t)kk * 128 + g * 8;
#pragma unroll
                for (int ks = 0; ks < 4; ++ks) kf[u][ks] = *(const bf16x8*)(kr + ks * 32); }
#pragma unroll
            for (int u = 0; u < 4; ++u) { f32x4 a = {0.f, 0.f, 0.f, 0.f};
#pragma unroll
                for (int ks = 0; ks < 4; ++ks) a = __builtin_amdgcn_mfma_f32_16x16x32_bf16(kf[u][ks], qf[ks], a, 0, 0, 0);
                sc[4 * ib + u] = a; }
        }
        float mx = -3.0e38f;
#pragma unroll
        for (int i = 0; i < 16; ++i) { const u32x2 k4 = *(FK_LAS const u32x2*)(sell + 16 * i + 4 * g);
#pragma unroll
            for (int r = 0; r < 4; ++r) { const int kk = (r < 2 ? (k4.x >> (16 * r)) : (k4.y >> (16 * (r - 2)))) & 0xffff; const int rel = kk - t; const int n = rel < 0 ? -rel : rel; const int bk = (rel > 0 ? 16 : 0) + lut[n];
                float v = sc[i][r] + t5l[bk * 16 + c16]; v = (16 * i + 4 * g + r < cnt) ? v : -__builtin_inff(); sc[i][r] = v; mx = fmaxf(mx, v); } }
        mx = fmaxf(mx, __shfl_xor(mx, 16)); mx = fmaxf(mx, __shfl_xor(mx, 32));
        float sum = 0.f;
#pragma unroll
        for (int i = 0; i < 16; ++i)
#pragma unroll
            for (int r = 0; r < 4; ++r) { const float p = __builtin_amdgcn_exp2f(sc[i][r] - mx); sc[i][r] = p; sum += p; }
        sum += __shfl_xor(sum, 16); sum += __shfl_xor(sum, 32);
        const float inv = __builtin_amdgcn_rcpf(sum);
        u32x4 pw[8];
#pragma unroll
        for (int c = 0; c < 8; ++c) pw[c] = pack8(sc[2 * c], sc[2 * c + 1]);
        f32x4 oa[8];
#pragma unroll
        for (int d = 0; d < 8; ++d) oa[d] = (f32x4){0.f, 0.f, 0.f, 0.f};
        bf16x8 vv[2][8];
#define DS_VLOAD(c, B) do { _Pragma("unroll") for (int it = 0; it < 8; ++it) { const int idx = lane + 64 * it, lr = idx >> 4, ch = idx & 15; const int kk = sell[32 * (c) + lr]; vv[B][it] = *(const bf16x8*)(vb + (size_t)kk * 128 + ch * 8); } } while (0)
        DS_VLOAD(0, 0);
#pragma unroll
        for (int c = 0; c < 8; ++c) {
            if (32 * c < cnt) {
                if (c + 1 < 8 && 32 * (c + 1) < cnt) DS_VLOAD(c + 1, (c + 1) & 1);
#pragma unroll
                for (int it = 0; it < 8; ++it) { const int idx = lane + 64 * it, lr = idx >> 4, ch = idx & 15; *(FK_LAS bf16x8*)(vst + lr * 256 + ((ch ^ ((lr & 7) << 1)) << 4)) = vv[c & 1][it]; }
                const bf16x8 pf = *reinterpret_cast<const bf16x8*>(&pw[c]);
                asm volatile("s_waitcnt lgkmcnt(0)" ::: "memory");
                const int q4 = c16 >> 2, p4 = c16 & 3; const int rowA = 4 * g + q4, rowB = 16 + 4 * g + q4;
#pragma unroll
                for (int d = 0; d < 8; ++d) { s16x4 lo, hi4;
                    const unsigned aA = vbase + rowA * 256 + (((2 * d + (p4 >> 1)) ^ ((rowA & 7) << 1)) << 4) + (p4 & 1) * 8;
                    const unsigned aB = vbase + rowB * 256 + (((2 * d + (p4 >> 1)) ^ ((rowB & 7) << 1)) << 4) + (p4 & 1) * 8;
                    asm volatile("ds_read_b64_tr_b16 %0, %1" : "=&v"(lo) : "v"(aA) : "memory");
                    asm volatile("ds_read_b64_tr_b16 %0, %1" : "=&v"(hi4) : "v"(aB) : "memory");
                    asm volatile("s_waitcnt lgkmcnt(0)" ::: "memory"); __builtin_amdgcn_sched_barrier(0);
                    oa[d] = __builtin_amdgcn_mfma_f32_16x16x32_bf16((bf16x8){lo[0], lo[1], lo[2], lo[3], hi4[0], hi4[1], hi4[2], hi4[3]}, pf, oa[d], 0, 0, 0); }
            }
        }
#undef DS_VLOAD
#pragma unroll
        for (int d = 0; d < 8; ++d) { u32x2 p; p.x = cvt_pk_bf16(oa[d][0] * inv, oa[d][1] * inv); p.y = cvt_pk_bf16(oa[d][2] * inv, oa[d][3] * inv);
            *(u32x2*)(o + (size_t)tg * 2048 + c16 * 128 + 16 * d + 4 * g) = p; }
    }
}
}
#define XB_TMO      128
#define XB_XCNT(j)  (256  + 64 * (j))
#define XB_XSUB(j)  (1280 + 64 * (j))
#define XB_XGEN(j)  (2304 + 64 * (j))
#define XB_TOP      3328
#define XB_TOPGEN   3392
#define XCD_BAR_WORDS 3456
#define XB_SPIN_CAP (1u << 18)
#define LAS __attribute__((address_space(3)))

__device__ __forceinline__ unsigned xb_ld(unsigned* p)              { return __hip_atomic_load(p, __ATOMIC_RELAXED, __HIP_MEMORY_SCOPE_AGENT); }
__device__ __forceinline__ unsigned xb_add(unsigned* p, unsigned v) { return __hip_atomic_fetch_add(p, v, __ATOMIC_RELAXED, __HIP_MEMORY_SCOPE_AGENT); }
__device__ __forceinline__ unsigned xb_xcc_id() { return (unsigned)__builtin_amdgcn_s_getreg((3 << 11) | 20) & 0xFu; }
#define XB_SPIN(cond, bar) do { unsigned _sp = 0; while (cond) { __builtin_amdgcn_s_sleep(1); \
    if ((++_sp & 255u) == 0u) { if (xb_ld(&(bar)[XB_TMO])) break; if (_sp > XB_SPIN_CAP) { atomicAdd(&(bar)[XB_TMO], 1u); break; } } } } while (0)

struct XcdBarrier {
    unsigned* bar; unsigned x;
    volatile LAS unsigned* st;
};

__device__ __forceinline__ XcdBarrier xcd_barrier_post(unsigned* bar, volatile LAS unsigned* st) {
    XcdBarrier b; b.bar = bar; b.x = xb_xcc_id(); b.st = st;
    if (threadIdx.x == 0) (void)xb_add(&bar[XB_XCNT(b.x)], 1u);
    return b;
}
__device__ __forceinline__ void xcd_barrier_complete(unsigned* bar, unsigned x, unsigned& nloc, unsigned& nx) {
    const unsigned G = gridDim.x * gridDim.y * gridDim.z;
    unsigned sum, cnt, mine, sp = 0u;
    for (;;) {
        sum = 0u; cnt = 0u; mine = 0u;
#pragma unroll
        for (unsigned j = 0; j < 16; ++j) { const unsigned c = xb_ld(&bar[XB_XCNT(j)]); sum += c; cnt += (c > 0u) ? 1u : 0u; mine = (j == x) ? c : mine; }
        if (sum == G) break;
        __builtin_amdgcn_s_sleep(1);
        if ((++sp & 255u) == 0u) { if (xb_ld(&bar[XB_TMO])) break; if (sp > XB_SPIN_CAP) { atomicAdd(&bar[XB_TMO], 1u); break; } }
    }
    nloc = mine > 0u ? mine : 1u; nx = cnt > 0u ? cnt : 1u;
}

__device__ __forceinline__ void xcd_barrier(const XcdBarrier& b) {
    asm volatile("s_waitcnt vmcnt(0)" ::: "memory");
    __syncthreads();
    if (threadIdx.x == 0) {
        unsigned* bar = b.bar;
        __builtin_amdgcn_s_waitcnt(0);
        unsigned nloc = b.st[0], nx = b.st[1];
        if (nloc == 0u) { xcd_barrier_complete(bar, b.x, nloc, nx); b.st[0] = nloc; b.st[1] = nx; }
        const unsigned old = xb_add(&bar[XB_XSUB(b.x)], 1u);
        const unsigned gen = old / nloc;
        if (old + 1u == (gen + 1u) * nloc) {
            __builtin_amdgcn_fence(__ATOMIC_RELEASE, "agent");
            asm volatile("s_waitcnt vmcnt(0)" ::: "memory");
            const unsigned og = xb_add(&bar[XB_TOP], 1u);
            const unsigned tg = og / nx;
            if (og + 1u == (tg + 1u) * nx) xb_add(&bar[XB_TOPGEN], 1u);
            else XB_SPIN(xb_ld(&bar[XB_TOPGEN]) == tg, bar);
            __builtin_amdgcn_fence(__ATOMIC_ACQUIRE, "agent");
            xb_add(&bar[XB_XGEN(b.x)], 1u);
            asm volatile("s_waitcnt vmcnt(0)" ::: "memory");
        } else {
            XB_SPIN(xb_ld(&bar[XB_XGEN(b.x)]) == gen, bar);
            __builtin_amdgcn_fence(__ATOMIC_ACQUIRE, "agent");
            asm volatile("s_waitcnt vmcnt(0)" ::: "memory");
        }
    }
    __syncthreads();
}


__device__ __forceinline__ void xcd_barrier_slim(const XcdBarrier& b) {
    asm volatile("s_waitcnt vmcnt(0)" ::: "memory");
    __syncthreads();
    if (threadIdx.x == 0) {
        unsigned* bar = b.bar;
        __builtin_amdgcn_s_waitcnt(0);
        unsigned nloc = b.st[0], nx = b.st[1];
        if (nloc == 0u) { nloc = 1u; nx = 1u; }
        const unsigned old = xb_add(&bar[XB_XSUB(b.x)], 1u);
        const unsigned gen = old / nloc;
        if (old + 1u == (gen + 1u) * nloc) {
            __builtin_amdgcn_fence(__ATOMIC_RELEASE, "agent");
            asm volatile("s_waitcnt vmcnt(0)" ::: "memory");
            const unsigned og = xb_add(&bar[XB_TOP], 1u);
            const unsigned tg = og / nx;
            if (og + 1u == (tg + 1u) * nx) xb_add(&bar[XB_TOPGEN], 1u);
            else XB_SPIN(xb_ld(&bar[XB_TOPGEN]) == tg, bar);
            __builtin_amdgcn_fence(__ATOMIC_ACQUIRE, "agent");
            xb_add(&bar[XB_XGEN(b.x)], 1u);
            asm volatile("s_waitcnt vmcnt(0)" ::: "memory");
        } else {
            XB_SPIN(xb_ld(&bar[XB_XGEN(b.x)]) == gen, bar);
            __builtin_amdgcn_fence(__ATOMIC_ACQUIRE, "agent");
            asm volatile("s_waitcnt vmcnt(0)" ::: "memory");
        }
    }
    __syncthreads();
}

namespace fk {
template <int FK_PHASE_MASK_, int ML>
__global__ void __launch_bounds__(NTHR, 2) fk_fwd(const FWK kw, const CvtTable T, const int p_lo, const int p_hi) {
    extern __shared__ __attribute__((aligned(16))) unsigned char shm_[];
    FK_LAS unsigned char* lds = (FK_LAS unsigned char*)shm_;
    FK_LAS unsigned* xbw = (FK_LAS unsigned*)(lds + LDS_BYTES - 16);
    if (threadIdx.x == 0) { xbw[0] = 0u; xbw[1] = 0u; xbw[2] = 0u; xbw[3] = 0u; }
    __syncthreads();
#define FWK_FIELDS(X) X(x_in) X(t5) X(mla_w_in) X(mla_qn) X(mla_kvn) X(mla_wq) X(mla_wkv) X(mla_wo) X(fox_w_in) X(fox_bf) X(fox_wo) X(dsa_w_in) X(dsa_wo) X(ln_g) X(ln_b) X(wgrp) X(bgrp) X(wrt) X(brt) X(wgate) X(wup) X(wdown) X(out) X(ws) X(moe_bias_gu) X(moe_bias_d) X(var)
    FK_LAS unsigned long long* kl = (FK_LAS unsigned long long*)(lds + 146944);
    if (threadIdx.x == 0) { int i_ = 0;
#define FWK_PUT(f) kl[i_++] = (unsigned long long)kw.f;
        FWK_FIELDS(FWK_PUT)
#undef FWK_PUT
    }
    __syncthreads();
    XcdBarrier bar = xcd_barrier_post((unsigned*)(kw.ws + WsMap<ML>::CTL), (volatile LAS unsigned*)xbw);
    FK_LAS int* tab = (FK_LAS int*)(lds + TAB_OFF);
    if (p_hi - p_lo > 1) xcd_barrier(bar);
#define PH_ON(k) (((FK_PHASE_MASK_) >> (k)) & 1)
#ifndef FK_REP_MASK
#define FK_REP_MASK 0
#endif
#define PH_REP(k) ((((FK_REP_MASK) >> (k)) & 1) ? 2 : 1)
#define FWK_GET(f) { const unsigned long long v_ = kl[i_++]; const unsigned lo_ = __builtin_amdgcn_readfirstlane((unsigned)v_), hi_ = __builtin_amdgcn_readfirstlane((unsigned)(v_ >> 32)); kq_.f = (decltype(kq_.f))(((unsigned long long)hi_ << 32) | lo_); }
#define PH_BEGIN(id) if ((id) >= p_lo && (id) < p_hi) { if ((id) > p_lo) xcd_barrier_slim(bar); FWK kq_; { int i_ = 0; FWK_FIELDS(FWK_GET) } const FW w = make_fw<ML>(kq_, kq_.ws);
#define PH_END }
#define PH_BEGINR(id, bit) PH_BEGIN(id) for (int rep_ = 0; rep_ < PH_REP(bit); ++rep_)
    if constexpr (PH_ON(8)) { PH_BEGINR(0, 8) phase_prologue(w, T, lds); PH_END }
#pragma unroll 1
    for (int layer = 0; layer < 4; ++layer) {
        const int kind = layer % 3, j = layer / 3, pb = 1 + 8 * layer;
        if (kind == 0) {
#define MLA_PTRS bf16_t* cq = (bf16_t*)w.arena; bf16_t* ckv = cq + (size_t)NT * 512; bf16_t* kr = ckv + (size_t)NT * 512; bf16_t* q = kr + (size_t)NT * 64; bf16_t* kv = q + (size_t)NT * 3072; (void)cq; (void)ckv; (void)kr; (void)q; (void)kv;
            if constexpr (PH_ON(0)) PH_BEGINR(pb + 0, 0) { MLA_PTRS RectSched s; s.init(w.xb0, D, w.mla_win_t + (size_t)j * 1280 * D, D, NT, 1280); EpiMlaIn e{cq, ckv, kr, w.ss, w.rope_cs}; gemm_phase(lds, D, D, s, e); } PH_END
            if constexpr (PH_ON(1)) PH_BEGINR(pb + 1, 1) { MLA_PTRS Rect2Sched s; s.s0.init(cq, 512, w.mla_wq_t + (size_t)j * 3072 * 512, 512, NT, 3072); s.s1.init(ckv, 512, w.mla_wkv_t + (size_t)j * 4096 * 512, 512, NT, 4096); s.n0 = 0;
                EpiMlaQKV e{q, kv, w.ss, w.rope_cs}; gemm_phase(lds, 512, 512, s, e); } PH_END
            if constexpr (PH_ON(2)) PH_BEGINR(pb + 2, 2) { MLA_PTRS
#pragma unroll 1
                for (int p = fk_bid(), np_ = fk_nblk(); p < 256; p += np_) { const int bh = p >> 2, x = p & 3, b = bh >> 4, h = bh & 15;
                    AttnPtrs P; P.Q = q + (size_t)b * S * 3072 + h * 192; P.K = kv + (size_t)b * S * 4096 + h * 256; P.V = P.K + 128; P.KR = kr + (size_t)b * S * 64; P.CF = nullptr; P.O = w.o + (size_t)b * S * D + h * 128; P.qld = 3072; P.kld = 4096;
                    attn_block<0>(lds, P, 7 - x); attn_block<0>(lds, P, x); } } PH_END
        }
        if (kind == 1) {
#define FOX_PTRS bf16_t* qkv = (bf16_t*)w.arena;
            if constexpr (PH_ON(9)) PH_BEGINR(pb + 0, 9) { FOX_PTRS RectSched s; s.init(w.xb0, D, w.fox_win_t, D, NT, 6144); EpiBf16Q e{qkv, 6144, 2048, QSCALE_128}; gemm_phase(lds, D, D, s, e); } PH_END
            if constexpr (PH_ON(10)) PH_BEGINR(pb + 2, 10) { FOX_PTRS
#pragma unroll 1
                for (int p = fk_bid(), np_ = fk_nblk(); p < 256; p += np_) { const int bh = p >> 2, x = p & 3, b = bh >> 4, h = bh & 15;
                    AttnPtrs P; P.Q = qkv + (size_t)b * S * 6144 + h * 128; P.K = P.Q + 2048; P.V = P.Q + 4096; P.KR = nullptr; P.CF = nullptr; P.O = w.o + (size_t)b * S * D + h * 128; P.qld = 6144; P.kld = 6144;
                    fox_cumsum_lds(w.flog, (FK_LAS float*)(lds + AT_CF), (FK_LAS double*)(lds + AT_WS), b, h);
                    attn_block<1>(lds, P, 7 - x); attn_block<1>(lds, P, x); } } PH_END
        }
        if (kind == 2) {
#define DSA_PTRS bf16_t* dq = (bf16_t*)w.arena; bf16_t* dk = dq + (size_t)NT * 2048; bf16_t* dv = dk + (size_t)NT * 128; bf16_t* qidx = dv + (size_t)NT * 128; bf16_t* kidx = qidx + (size_t)NT * 1024; \
            float* widx = (float*)(kidx + (size_t)NT * 64); unsigned short* sel = (unsigned short*)(widx + (size_t)NT * 16); int* nsel = (int*)(sel + (size_t)NT * 256); (void)dq; (void)dk; (void)dv; (void)qidx; (void)kidx; (void)widx; (void)sel; (void)nsel;
            if constexpr (PH_ON(11)) PH_BEGINR(pb + 0, 11) { DSA_PTRS RectSched s; s.init(w.xb0, D, w.dsa_win_t, D, NT, 3584); EpiDsaIn e{dq, dk, dv, qidx, kidx, widx}; gemm_phase(lds, D, D, s, e); } PH_END
            if constexpr (PH_ON(12)) PH_BEGINR(pb + 1, 12) { DSA_PTRS
#pragma unroll 1
                for (int p = fk_bid(), np_ = fk_nblk(); p < 256; p += np_) { const int b = p >> 6, x = p & 63;
                    dsa_index_unit(lds, qidx, kidx, widx, sel, nsel, b, 127 - x, (int)kq_.var); dsa_index_unit(lds, qidx, kidx, widx, sel, nsel, b, x, (int)kq_.var); } } PH_END
            if constexpr (PH_ON(13)) PH_BEGINR(pb + 2, 13) { DSA_PTRS phase_dsa_attn(lds, dq, dk, dv, sel, nsel, w.t5, w.o); } PH_END
        }
        if constexpr (PH_ON(3)) PH_BEGINR(pb + 3, 3) { const bf16_t* wo_t = kind == 0 ? w.mla_wo_t + (size_t)j * D * D : (kind == 1 ? w.fox_wo_t : w.dsa_wo_t); RectSched s; s.init(w.o, D, wo_t, D, NT, D); EpiBf16Q e{(bf16_t*)w.y, D, 0, 1.0f}; gemm_phase(lds, D, D, s, e); } PH_END
        if constexpr (PH_ON(4)) PH_BEGIN(pb + 4) { LnArgs a; a.x = (layer == 0) ? w.x_in : w.xA; a.yb = (const bf16_t*)w.y; a.Y2 = nullptr; a.te = nullptr; a.tpos = nullptr; a.cnt = nullptr; a.g = w.ln_g + (size_t)(layer * 2) * D; a.b = w.ln_b + (size_t)(layer * 2) * D; a.xo = w.xB; a.xbo = w.xb1; a.out2 = nullptr; a.xqo = nullptr;
            a.w4 = (const f32x4*)w.wr4 + (size_t)layer * 128 * 3 * 64; a.ntile = 3; a.bgrp = w.bgrp + layer * 4; a.brt = w.brt + layer * 32; a.rcnt = w.moe_cnt + layer * 1024; a.ote = w.te; a.otpos = w.tpos; a.otw = w.tw; a.list = w.list; a.sw = w.sw; a.flog = nullptr; a.fbias = nullptr;
            phase_ln(a, lds);
            } PH_END
        if constexpr (PH_ON(5)) PH_BEGINR(pb + 5, 5) { moe_tables(w.moe_cnt + layer * 1024, tab); phase_moe1(lds, tab, w.xb1, w.list, w.sw, w.wgate + (size_t)layer * 32 * D * 512, w.wup + (size_t)layer * 32 * D * 512, w.H, (int)kq_.var); } PH_END
        if constexpr (PH_ON(6)) PH_BEGINR(pb + 6, 6) { moe_tables(w.moe_cnt + layer * 1024, tab); phase_moe2(lds, tab, w.H, w.wdown + (size_t)layer * 32 * 512 * D, w.Y2, (int)kq_.var); } PH_END
        if constexpr (PH_ON(7)) PH_BEGINR(pb + 7, 7) { LnArgs a; a.x = w.xB; a.yb = nullptr; a.Y2 = w.Y2; a.te = w.te; a.tpos = w.tpos; a.cnt = w.moe_cnt + layer * 1024; a.g = w.ln_g + (size_t)(layer * 2 + 1) * D; a.b = w.ln_b + (size_t)(layer * 2 + 1) * D; a.xo = w.xA; a.xbo = w.xb0; a.xqo = nullptr;
            a.out2 = (layer == 3) ? w.out : nullptr; a.w4 = (layer == 0) ? (const f32x4*)w.fox_wf4 : nullptr; a.ntile = (layer == 0) ? 1 : 0; a.bgrp = nullptr; a.brt = nullptr; a.rcnt = nullptr; a.ote = nullptr; a.otpos = nullptr; a.otw = nullptr; a.list = nullptr; a.sw = nullptr; a.flog = w.flog; a.fbias = w.fox_bf;
            phase_ln(a, lds); } PH_END
    }
#undef PH_BEGIN
#undef PH_END
}

constexpr size_t CTL_BYTES = 65536;
static FWK make_fwk(void* const* d_in, void* d_out, char* ws) {
    FWK k; memset(&k, 0, sizeof(k));
    k.x_in = (const float*)d_in[0]; k.t5 = (const float*)d_in[1]; k.mla_w_in = (const float*)d_in[2]; k.mla_qn = (const float*)d_in[3]; k.mla_kvn = (const float*)d_in[4]; k.mla_wq = (const float*)d_in[5];
    k.mla_wkv = (const float*)d_in[6]; k.mla_wo = (const float*)d_in[7]; k.fox_w_in = (const float*)d_in[8]; k.fox_bf = (const float*)d_in[9]; k.fox_wo = (const float*)d_in[10]; k.dsa_w_in = (const float*)d_in[11];
    k.dsa_wo = (const float*)d_in[12]; k.ln_g = (const float*)d_in[13]; k.ln_b = (const float*)d_in[14]; k.wgrp = (const float*)d_in[15]; k.bgrp = (const float*)d_in[16]; k.wrt = (const float*)d_in[17];
    k.brt = (const float*)d_in[18]; k.wgate = (const float*)d_in[19]; k.wup = (const float*)d_in[20]; k.wdown = (const float*)d_in[21]; k.out = (float*)d_out; k.ws = ws;
    return k;
}
static void add_job(CvtTable& T, const float* s0, const float* s1, const float* scale, bf16_t* dst, long sbs, long dbs, int K, int N, int Np, int map, int nbatch) {
    CvtJob& J = T.j[T.njobs++]; J.src0 = s0; J.src1 = s1; J.scale = scale; J.dst = dst; J.src_bstride = sbs; J.dst_bstride = dbs; J.K = K; J.N = N; J.Np = Np; J.map = map; J.nbatch = nbatch; J.tile0 = T.ntiles;
    J.wide = ((map == MAP_ID || map == MAP_MOE_GU) && (K % 128 == 0) && (Np % 256 == 0) && (N % 4 == 0)) ? 1 : 0;
    T.ntiles += J.wide ? nbatch * (K / 128) * (Np / 256) : nbatch * (K / 64) * (Np / 64);
}
static void build_table(CvtTable& T, const FW& w, int moe_l0, int moe_l1, bool base) {
    memset(&T, 0, sizeof(T)); T.misc = base ? 1 : 0;
    if (base) {
    for (int j = 0; j < 2; ++j) {
        add_job(T, w.mla_w_in + (size_t)j * D * 1088, nullptr, nullptr, w.mla_win_t + (size_t)j * 1280 * D, 0, 0, D, 1088, 1280, MAP_MLA_IN, 1);
        add_job(T, w.mla_wq + (size_t)j * 512 * 3072, nullptr, w.mla_qn + j * 512, w.mla_wq_t + (size_t)j * 3072 * 512, 0, 0, 512, 3072, 3072, MAP_MLA_Q, 1);
        add_job(T, w.mla_wkv + (size_t)j * 512 * 4096, nullptr, w.mla_kvn + j * 512, w.mla_wkv_t + (size_t)j * 4096 * 512, 0, 0, 512, 4096, 4096, MAP_ID, 1);
        add_job(T, w.mla_wo + (size_t)j * D * D, nullptr, nullptr, w.mla_wo_t + (size_t)j * D * D, 0, 0, D, D, D, MAP_ID, 1);
    }
    add_job(T, w.fox_w_in, nullptr, nullptr, w.fox_win_t, 0, 0, D, 6160, 6144, MAP_ID, 1);
    add_job(T, w.fox_wo, nullptr, nullptr, w.fox_wo_t, 0, 0, D, D, D, MAP_ID, 1);
    add_job(T, w.dsa_w_in, nullptr, nullptr, w.dsa_win_t, 0, 0, D, 3408, 3584, MAP_ID, 1);
    add_job(T, w.dsa_wo, nullptr, nullptr, w.dsa_wo_t, 0, 0, D, D, D, MAP_ID, 1);
    }
    for (int l = moe_l0; l < moe_l1; ++l) {
        add_job(T, w.wgate + (size_t)l * 32 * D * 512, w.wup + (size_t)l * 32 * D * 512, nullptr, w.moe_gu_t + (size_t)l * 32 * 1024 * D, (long)D * 512, (long)1024 * D, D, 512, 1024, MAP_MOE_GU, 32);
        add_job(T, w.wdown + (size_t)l * 32 * 512 * D, nullptr, nullptr, w.moe_d_t + (size_t)l * 32 * D * 512, (long)512 * D, (long)D * 512, 512, D, D, MAP_ID, 32);
    }
}
static int g_grid = 0;
static void setup_once() {
    if (g_grid) return;
    int dev = 0, cus = 0, per_cu = 0;
    (void)hipGetDevice(&dev); (void)hipDeviceGetAttribute(&cus, hipDeviceAttributeMultiprocessorCount, dev);
    (void)per_cu;
    if (cus <= 0) cus = 256;
    g_grid = cus;
}
template <int MASK, int ML> static void launch_mask(const FWK& w, const CvtTable& T, int lo, int hi, hipStream_t st) {
    static bool attr = false; if (!attr) { (void)hipFuncSetAttribute((const void*)fk_fwd<MASK, ML>, hipFuncAttributeMaxDynamicSharedMemorySize, LDS_BYTES); attr = true; }
    hipLaunchKernelGGL((fk_fwd<MASK, ML>), dim3(g_grid), dim3(NTHR), LDS_BYTES, st, w, T, lo, hi);
}
#ifdef FK_DEBUG_BUILD
static void launch_phase(const FWK& w, const CvtTable& T, int p, hipStream_t st) {
    if (p == 0) { launch_mask<(1 << 8), 1>(w, T, p, p + 1, st); return; }
    const int layer = (p - 1) >> 3, k = (p - 1) & 7, kind = layer % 3;
    if (k >= 3) { switch (k) { case 3: launch_mask<(1 << 3), 1>(w, T, p, p + 1, st); break; case 4: launch_mask<(1 << 4), 1>(w, T, p, p + 1, st); break; case 5: launch_mask<(1 << 5), 1>(w, T, p, p + 1, st); break;
                               case 6: launch_mask<(1 << 6), 1>(w, T, p, p + 1, st); break; default: launch_mask<(1 << 7), 1>(w, T, p, p + 1, st); break; } return; }
    if (kind == 0) { if (k == 0) launch_mask<(1 << 0), 1>(w, T, p, p + 1, st); else if (k == 1) launch_mask<(1 << 1), 1>(w, T, p, p + 1, st); else launch_mask<(1 << 2), 1>(w, T, p, p + 1, st); }
    else if (kind == 1) { if (k == 0) launch_mask<(1 << 9), 1>(w, T, p, p + 1, st); else if (k == 2) launch_mask<(1 << 10), 1>(w, T, p, p + 1, st); }
    else { if (k == 0) launch_mask<(1 << 11), 1>(w, T, p, p + 1, st); else if (k == 1) launch_mask<(1 << 12), 1>(w, T, p, p + 1, st); else launch_mask<(1 << 13), 1>(w, T, p, p + 1, st); }
}
#endif
}
#ifndef FK_EXTRA
#define FK_EXTRA {}
#endif
extern "C" void kernel_launch(void* const* d_in, const int* in_sizes, int n_in, void* d_out, int out_size, void* d_ws, size_t ws_size, hipStream_t stream) {
    using namespace fk;
    setup_once();
    const FWK k = make_fwk(d_in, d_out, (char*)d_ws);
    const FW w = make_fw<0>(k, k.ws);
    static CvtTable T; build_table(T, w, 0, 0, true);
    (void)hipMemsetAsync(w.bar, 0, CTL_BYTES, stream);
    launch_mask<0x3FFF, 0>(k, T, 0, 33, stream);
    { static const int extra[] = FK_EXTRA; (void)extra; FWK kv = k;
#ifdef FK_VAR
      kv.var = FK_VAR;
#endif
      for (unsigned i = 0; i < sizeof(extra) / sizeof(int); ++i) launch_mask<0x3FFF, 0>(kv, T, extra[i], extra[i] + 1, stream); }
}
```

```cpp
#include <hip/hip_runtime.h>
#include <stdint.h>
#include <math.h>
#include <string.h>
namespace fk {
#define FK_LAS __attribute__((address_space(3)))
typedef unsigned short bf16_t;
typedef short bf16x8 __attribute__((ext_vector_type(8)));
typedef short s16x4 __attribute__((ext_vector_type(4)));
typedef float f32x4 __attribute__((ext_vector_type(4)));
typedef float f32x16 __attribute__((ext_vector_type(16)));
typedef float f32x2 __attribute__((ext_vector_type(2)));
typedef unsigned u32x4 __attribute__((ext_vector_type(4)));
typedef unsigned u32x2 __attribute__((ext_vector_type(2)));
constexpr int NB = 4, S = 2048, D = 2048, NT = NB * S;
constexpr float ALPHA = 1.681792830507429f;
constexpr float LOG2E = 1.4426950408889634f;
__device__ __forceinline__ int fk_tid();
__device__ __forceinline__ int fk_bid();
__device__ __forceinline__ int fk_nblk();
constexpr int BM = 256, BK = 64, HALF = 128, HTB = HALF * BK * 2, STAGE_BYTES = 8 * HTB;

__device__ __forceinline__ unsigned cvt_pk_bf16(float lo, float hi) { unsigned r; asm volatile("v_cvt_pk_bf16_f32 %0, %1, %2" : "=v"(r) : "v"(lo), "v"(hi)); return r; }
__device__ __forceinline__ float bf2f(bf16_t b) { return __uint_as_float(((unsigned)b) << 16); }
__device__ __forceinline__ bf16_t f2bf(float f) { unsigned u = __float_as_uint(f); u += 0x7FFFu + ((u >> 16) & 1u); return (bf16_t)(u >> 16); }

__host__ __device__ __forceinline__ int lds_byte(int r, int c) { const int st = (r >> 4) * 2 + (c >> 5), rr = r & 15, cc = c & 31, ob = rr * 64 + cc * 2; return st * 1024 + (ob ^ (((ob >> 9) & 1) << 5)); }
__host__ __device__ __forceinline__ void stage_rc(int b, int& R, int& C) { const int st = b / 1024, sb = b % 1024, swz = sb ^ (((sb >> 9) & 1) << 5); R = (st >> 1) * 16 + swz / 64; C = (st & 1) * 32 + (swz % 64) / 2; }
__host__ __device__ __forceinline__ int perm32(int rho) { const int n = rho >> 4, i = rho & 15; return 8 * (i >> 2) + 4 * n + (i & 3); }

struct GUnit { const char* A; const char* B; int pm, pn, e, nrows; };

template <class Epi, class Sched>
__device__ __forceinline__ void gemm_phase(FK_LAS unsigned char* lds, const int K, const int ldb, const Sched& S, const Epi& E) {
    const int tid = fk_tid(), wid = __builtin_amdgcn_readfirstlane(tid >> 6), lane = tid & 63, wr = wid >> 2, wc = wid & 3, fr = lane & 15, fq = lane >> 4;
    const int nt = K / BK;
    unsigned voffB[2];
#pragma unroll
    for (int i = 0; i < 2; ++i) { int R_, C_; stage_rc(tid * 16 + i * 8192, R_, C_); const int Rb = Epi::PERM ? ((R_ & ~31) + perm32(R_ & 31)) : R_; voffB[i] = (unsigned)(Rb * ldb + C_) * 2u; }
    const size_t kstep = (size_t)(BK * 2);
    const size_t hstepB = (size_t)HALF * ldb * 2;
    const unsigned ldsw = (unsigned)wid * 1024u;
    const int aoff = lds_byte(wr * 64 + fr, fq * 8), boff = lds_byte(wc * 32 + fr, fq * 8);
#define PG8_SA(b, h) (((b) * 2 + (h)) * HTB)
#define PG8_SB(b, h) ((4 + (b) * 2 + (h)) * HTB)
#define PG8_STAGE2(bufoff, gbase, v0, v1) do { \
        __builtin_amdgcn_global_load_lds((const unsigned*)((const char*)(gbase) + (v0)), (FK_LAS unsigned*)(lds + (bufoff) + ldsw), 16, 0, 0); \
        __builtin_amdgcn_global_load_lds((const unsigned*)((const char*)(gbase) + (v1)), (FK_LAS unsigned*)(lds + (bufoff) + ldsw + 8192), 16, 0, 0); } while (0)
#define PG8_STAGEB(bufoff, gbase) PG8_STAGE2(bufoff, gbase, voffB[0], voffB[1])
#define PG8_LDA(dst, b, h) do { _Pragma("unroll") for (int m = 0; m < 4; ++m) _Pragma("unroll") for (int k = 0; k < 2; ++k) dst[m][k] = *(const FK_LAS bf16x8*)(lds + PG8_SA(b, h) + aoff + m * 2048 + k * 1024); } while (0)
#define PG8_LDB(dst, b, h) do { _Pragma("unroll") for (int n = 0; n < 2; ++n) _Pragma("unroll") for (int k = 0; k < 2; ++k) dst[n][k] = *(const FK_LAS bf16x8*)(lds + PG8_SB(b, h) + boff + n * 2048 + k * 1024); } while (0)
#define PG8_MMA(ai, bj, At, Bt) do { __builtin_amdgcn_s_setprio(1); _Pragma("unroll") for (int m = 0; m < 4; ++m) _Pragma("unroll") for (int n = 0; n < 2; ++n) _Pragma("unroll") for (int k = 0; k < 2; ++k) \
        acc[ai][bj][m][n] = __builtin_amdgcn_mfma_f32_16x16x32_bf16(Bt[n][k], At[m][k], acc[ai][bj][m][n], 0, 0, 0); __builtin_amdgcn_s_setprio(0); } while (0)
#define PG8_WAIT_V(n) asm volatile("s_waitcnt vmcnt(" #n ")" ::: "memory")
#define PG8_WAIT_L(n) asm volatile("s_waitcnt lgkmcnt(" #n ")" ::: "memory")
#define PG8_BAR __builtin_amdgcn_s_barrier()
#define PG8_SCHED __builtin_amdgcn_sched_barrier(0)
    GUnit cur, nxt; int ui = 0;
    if (!S.next(0, cur)) return;
    f32x4 acc[2][2][4][2];
#pragma unroll
    for (int a = 0; a < 2; ++a)
#pragma unroll
        for (int b = 0; b < 2; ++b)
#pragma unroll
            for (int m = 0; m < 4; ++m)
#pragma unroll
                for (int n = 0; n < 2; ++n) acc[a][b][m][n] = (f32x4){0.f, 0.f, 0.f, 0.f};
    bf16x8 At[4][2], B0[2][2], B1[2][2];
    unsigned oc[2][2], on[2][2];
    S.a_offs(cur, tid, oc);
    const char* cA = cur.A; const char* cB = cur.B;
    PG8_STAGEB(PG8_SB(0, 0), cB); PG8_STAGE2(PG8_SA(0, 0), cA, oc[0][0], oc[0][1]); PG8_STAGEB(PG8_SB(0, 1), cB + hstepB); PG8_STAGE2(PG8_SA(0, 1), cA, oc[1][0], oc[1][1]);
    if (wr == 1) PG8_BAR;
    PG8_WAIT_V(4); PG8_BAR;
    PG8_STAGEB(PG8_SB(1, 0), cB + kstep); PG8_STAGE2(PG8_SA(1, 0), cA + kstep, oc[0][0], oc[0][1]); PG8_STAGEB(PG8_SB(1, 1), cB + hstepB + kstep);
    PG8_WAIT_V(6); PG8_BAR;
    for (;;) {
        const bool has_next = S.next(ui + 1, nxt);
        if (has_next) S.a_offs(nxt, tid, on);
        else {
#pragma unroll
            for (int h = 0; h < 2; ++h)
#pragma unroll
                for (int i = 0; i < 2; ++i) on[h][i] = oc[h][i]; }
        const char* nA = has_next ? nxt.A : cA; const char* nB = has_next ? nxt.B : cB;
        for (int t = 0; t < nt; t += 2) {
            const bool last = (t == nt - 2);
            const char* a1 = cA + (size_t)(t + 1) * kstep;
            const char* a2 = last ? nA : cA + (size_t)(t + 2) * kstep; const char* b2 = last ? nB : cB + (size_t)(t + 2) * kstep;
            const char* a3 = a2 + kstep; const char* b3 = b2 + kstep;
            const unsigned o00 = last ? on[0][0] : oc[0][0], o01 = last ? on[0][1] : oc[0][1], o10 = last ? on[1][0] : oc[1][0], o11 = last ? on[1][1] : oc[1][1];
            PG8_LDB(B0, 0, 0); PG8_SCHED; PG8_LDA(At, 0, 0); PG8_STAGE2(PG8_SA(1, 1), a1, oc[1][0], oc[1][1]);
            PG8_WAIT_L(8); PG8_BAR; PG8_WAIT_L(0); PG8_MMA(0, 0, At, B0); PG8_BAR; PG8_SCHED;
            PG8_LDB(B1, 0, 1); PG8_STAGEB(PG8_SB(0, 0), b2);
            PG8_BAR; PG8_WAIT_L(0); PG8_MMA(0, 1, At, B1); PG8_BAR;
            PG8_LDA(At, 0, 1); PG8_STAGE2(PG8_SA(0, 0), a2, o00, o01);
            PG8_BAR; PG8_WAIT_L(0); PG8_MMA(1, 0, At, B0); PG8_BAR; PG8_SCHED;
            PG8_STAGEB(PG8_SB(0, 1), b2 + hstepB);
            PG8_WAIT_V(6); PG8_BAR; PG8_MMA(1, 1, At, B1); PG8_BAR;
            PG8_LDB(B0, 1, 0); PG8_SCHED; PG8_LDA(At, 1, 0); PG8_STAGE2(PG8_SA(0, 1), a2, o10, o11);
            PG8_WAIT_L(8); PG8_BAR; PG8_WAIT_L(0); PG8_MMA(0, 0, At, B0); PG8_BAR; PG8_SCHED;
            PG8_LDB(B1, 1, 1); PG8_STAGEB(PG8_SB(1, 0), b3);
            PG8_BAR; PG8_WAIT_L(0); PG8_MMA(0, 1, At, B1); PG8_BAR;
            PG8_LDA(At, 1, 1); PG8_STAGE2(PG8_SA(1, 0), a3, o00, o01);
            PG8_BAR; PG8_WAIT_L(0); PG8_MMA(1, 0, At, B0); PG8_BAR; PG8_SCHED;
            PG8_STAGEB(PG8_SB(1, 1), b3 + hstepB);
            PG8_WAIT_V(6); PG8_BAR; PG8_MMA(1, 1, At, B1); PG8_BAR;
        }
        E(acc, cur, wr, wc, fr, fq);
        if (!has_next) break;
#pragma unroll
        for (int a = 0; a < 2; ++a)
#pragma unroll
            for (int b = 0; b < 2; ++b)
#pragma unroll
                for (int m = 0; m < 4; ++m)
#pragma unroll
                    for (int n = 0; n < 2; ++n) acc[a][b][m][n] = (f32x4){0.f, 0.f, 0.f, 0.f};
        cur = nxt; cA = nA; cB = nB; ++ui;
#pragma unroll
        for (int h = 0; h < 2; ++h)
#pragma unroll
            for (int i = 0; i < 2; ++i) oc[h][i] = on[h][i];
    }
    PG8_WAIT_V(0);
    if (wr == 0) PG8_BAR;
    PG8_BAR;
#undef PG8_SA
#undef PG8_SB
#undef PG8_STAGE2
#undef PG8_STAGEB
#undef PG8_LDA
#undef PG8_LDB
#undef PG8_MMA
#undef PG8_WAIT_V
#undef PG8_WAIT_L
#undef PG8_BAR
#undef PG8_SCHED
}
}
namespace fk {
constexpr int NTHR = 512;
constexpr int LDS_BYTES = 147456;
constexpr int HCAP = 24576;
constexpr float QSCALE_MLA = 0.07216878364870322f * LOG2E;
constexpr float QSCALE_128 = 0.08838834764831845f * LOG2E;

struct FW {
    const float *x_in, *t5, *mla_w_in, *mla_qn, *mla_kvn, *mla_wq, *mla_wkv, *mla_wo, *fox_w_in, *fox_bf, *fox_wo, *dsa_w_in, *dsa_wo, *ln_g, *ln_b, *wgrp, *bgrp, *wrt, *brt, *wgate, *wup, *wdown;
    float* out;
    unsigned* bar; int* moe_cnt;
    bf16_t *mla_win_t, *mla_wq_t, *mla_wkv_t, *mla_wo_t, *fox_win_t, *fox_wo_t, *dsa_win_t, *dsa_wo_t, *moe_gu_t, *moe_d_t;
    float *wr4, *fox_wf4; f32x2* rope_cs;
    float *xA, *xB, *y; bf16_t *xb0, *xb1, *o;
    char* arena;
    float* ss;
    float *flog, *cf2;
    int *te, *tpos, *list; float *tw, *sw; bf16_t *H, *Y2; unsigned char* x1q;
};

template <class T> struct FkCvt { static __device__ __forceinline__ T get(unsigned long long v) { return (T)v; } };
template <class T> struct FkCvt<T*> { static __device__ __forceinline__ T* get(unsigned long long v) { return (T*)(__attribute__((address_space(1))) T*)v; } };
struct FWK { const float *x_in, *t5, *mla_w_in, *mla_qn, *mla_kvn, *mla_wq, *mla_wkv, *mla_wo, *fox_w_in, *fox_bf, *fox_wo, *dsa_w_in, *dsa_wo, *ln_g, *ln_b, *wgrp, *bgrp, *wrt, *brt, *wgate, *wup, *wdown; float* out; char* ws; long moe_bias_gu, moe_bias_d; long var; };
constexpr size_t al256(size_t x) { return (x + 255) & ~(size_t)255; }
template <int MOE_LAYERS> struct WsMap {
    static constexpr size_t CTL = 0, CTL_BYTES = 65536;
    static constexpr size_t MLA_WIN_T = CTL + CTL_BYTES, MLA_WQ_T = MLA_WIN_T + al256((size_t)2 * 1280 * D * 2), MLA_WKV_T = MLA_WQ_T + al256((size_t)2 * 3072 * 512 * 2), MLA_WO_T = MLA_WKV_T + al256((size_t)2 * 4096 * 512 * 2);
    static constexpr size_t FOX_WIN_T = MLA_WO_T + al256((size_t)2 * D * D * 2), FOX_WO_T = FOX_WIN_T + al256((size_t)6144 * D * 2), DSA_WIN_T = FOX_WO_T + al256((size_t)D * D * 2), DSA_WO_T = DSA_WIN_T + al256((size_t)3584 * D * 2);
    static constexpr size_t MOE_GU_T = DSA_WO_T + al256((size_t)D * D * 2), MOE_D_T = MOE_GU_T + al256((size_t)MOE_LAYERS * 32 * 1024 * D * 2);
    static constexpr size_t WR4 = MOE_D_T + al256((size_t)MOE_LAYERS * 32 * D * 512 * 2), FOX_WF4 = WR4 + al256((size_t)4 * D * 48 * 4), ROPE = FOX_WF4 + al256((size_t)D * 16 * 4);
    static constexpr size_t XA = ROPE + al256((size_t)S * 32 * 8), XB = XA + al256((size_t)NT * D * 4), Y = XB + al256((size_t)NT * D * 4);
    static constexpr size_t XB0 = Y + al256((size_t)NT * D * 4), XB1 = XB0 + al256((size_t)NT * D * 2), O = XB1 + al256((size_t)NT * D * 2), ARENA = O + al256((size_t)NT * D * 2);
    static constexpr size_t SS = ARENA + al256((size_t)NT * (512 + 512 + 64 + 3072 + 4096) * 2), FLOG = SS + al256((size_t)NT * 2 * 8 * 4), CF2 = FLOG + al256((size_t)NT * 16 * 4);
    static constexpr size_t TE = CF2 + al256((size_t)NB * 16 * S * 4), TPOS = TE + al256((size_t)NT * 2 * 4), LIST = TPOS + al256((size_t)NT * 2 * 4), TW = LIST + al256((size_t)32 * NT * 4), SW = TW + al256((size_t)NT * 2 * 4);
    static constexpr size_t H = SW + al256((size_t)32 * NT * 4), Y2 = H + al256((size_t)HCAP * 512 * 2), X1Q = Y2 + al256((size_t)HCAP * D * 2), END = X1Q + al256((size_t)NT * D);
};
template <int ML> __host__ __device__ __forceinline__ FW make_fw(const FWK& k, char* ws) {
    typedef WsMap<ML> M; FW w;
    w.x_in = k.x_in; w.t5 = k.t5; w.mla_w_in = k.mla_w_in; w.mla_qn = k.mla_qn; w.mla_kvn = k.mla_kvn; w.mla_wq = k.mla_wq; w.mla_wkv = k.mla_wkv; w.mla_wo = k.mla_wo; w.fox_w_in = k.fox_w_in; w.fox_bf = k.fox_bf; w.fox_wo = k.fox_wo;
    w.dsa_w_in = k.dsa_w_in; w.dsa_wo = k.dsa_wo; w.ln_g = k.ln_g; w.ln_b = k.ln_b; w.wgrp = k.wgrp; w.bgrp = k.bgrp; w.wrt = k.wrt; w.brt = k.brt; w.wgate = k.wgate; w.wup = k.wup; w.wdown = k.wdown; w.out = k.out;
    w.bar = (unsigned*)(ws + M::CTL); w.moe_cnt = (int*)(ws + M::CTL + 32768);
    w.mla_win_t = (bf16_t*)(ws + M::MLA_WIN_T); w.mla_wq_t = (bf16_t*)(ws + M::MLA_WQ_T); w.mla_wkv_t = (bf16_t*)(ws + M::MLA_WKV_T); w.mla_wo_t = (bf16_t*)(ws + M::MLA_WO_T);
    w.fox_win_t = (bf16_t*)(ws + M::FOX_WIN_T); w.fox_wo_t = (bf16_t*)(ws + M::FOX_WO_T); w.dsa_win_t = (bf16_t*)(ws + M::DSA_WIN_T); w.dsa_wo_t = (bf16_t*)(ws + M::DSA_WO_T);
    w.moe_gu_t = (bf16_t*)(ws + M::MOE_GU_T) - k.moe_bias_gu; w.moe_d_t = (bf16_t*)(ws + M::MOE_D_T) - k.moe_bias_d;
    w.wr4 = (float*)(ws + M::WR4); w.fox_wf4 = (float*)(ws + M::FOX_WF4); w.rope_cs = (f32x2*)(ws + M::ROPE);
    w.xA = (float*)(ws + M::XA); w.xB = (float*)(ws + M::XB); w.y = (float*)(ws + M::Y); w.xb0 = (bf16_t*)(ws + M::XB0); w.xb1 = (bf16_t*)(ws + M::XB1); w.o = (bf16_t*)(ws + M::O); w.arena = ws + M::ARENA;
    w.ss = (float*)(ws + M::SS); w.flog = (float*)(ws + M::FLOG); w.cf2 = (float*)(ws + M::CF2);
    w.te = (int*)(ws + M::TE); w.tpos = (int*)(ws + M::TPOS); w.list = (int*)(ws + M::LIST); w.tw = (float*)(ws + M::TW); w.sw = (float*)(ws + M::SW); w.H = (bf16_t*)(ws + M::H); w.Y2 = (bf16_t*)(ws + M::Y2); w.x1q = (unsigned char*)(ws + M::X1Q);
    return w;
}
__device__ __forceinline__ int fk_tid() { int t = threadIdx.x; asm volatile("" : "+v"(t)); return t; }
__device__ __forceinline__ int fk_bid() { int t = blockIdx.x; asm volatile("" : "+s"(t)); return t; }
__device__ __forceinline__ int fk_nblk() { int t = gridDim.x; asm volatile("" : "+s"(t)); return t; }

enum { MAP_ID = 0, MAP_MLA_IN = 1, MAP_MLA_Q = 2, MAP_MOE_GU = 3 };
struct CvtJob { const float* src0; const float* src1; const float* scale; bf16_t* dst; long src_bstride, dst_bstride; int K, N, Np, map, nbatch, tile0, wide, pad; };
constexpr int MAXJOBS = 24;
struct CvtTable { CvtJob j[MAXJOBS]; int njobs, ntiles, misc, pad; };

__device__ __forceinline__ int map_col(int map, int np, int N, int& which) {
    which = 0;
    if (map == MAP_ID) return np < N ? np : -1;
    if (map == MAP_MLA_IN) { if (np < 1024) return np; if (np < 1088) { const int i = np - 1024; return 1024 + (i >> 1) + 32 * (i & 1); } return -1; }
    if (map == MAP_MLA_Q) { const int h = np / 192, j = np % 192; if (j < 128) return np; const int i = j - 128; return h * 192 + 128 + (i >> 1) + 32 * (i & 1); }
      { const int q = np >> 5, r = np & 31; which = r >> 4; return 16 * q + (r & 15); }
}
__device__ __forceinline__ void cvt_tile(const CvtJob& J, int lt, FK_LAS float* tile  , const int tid) {
    const int tk = J.K / 64, tn = J.Np / 64, per = tk * tn;
    const int b = lt / per, r = lt % per, tkk = r % tk, tnn = r / tk;
    const int k0 = tkk * 64, n0 = tnn * 64;
    const float* s0 = J.src0 + (size_t)b * J.src_bstride; const float* s1 = J.src1 ? J.src1 + (size_t)b * J.src_bstride : nullptr;
    bf16_t* d = J.dst + (size_t)b * J.dst_bstride;
    { const int np = n0 + (tid & 63); int which; const int sc = map_col(J.map, np, J.N, which); const float* s = which ? s1 : s0;
#pragma unroll
      for (int i = 0; i < 8; ++i) { const int k = (tid >> 6) + 8 * i; float v = 0.f; if (sc >= 0) { v = s[(size_t)(k0 + k) * J.N + sc]; if (J.scale) v *= J.scale[k0 + k]; } tile[k * 65 + (tid & 63)] = v; } }
    __syncthreads();
    { const int np = tid >> 3, kg = (tid & 7) * 8; float v[8];
#pragma unroll
      for (int j = 0; j < 8; ++j) v[j] = tile[(kg + j) * 65 + np];
      u32x4 w; w.x = cvt_pk_bf16(v[0], v[1]); w.y = cvt_pk_bf16(v[2], v[3]); w.z = cvt_pk_bf16(v[4], v[5]); w.w = cvt_pk_bf16(v[6], v[7]);
      *(u32x4*)(d + (size_t)(n0 + np) * J.K + k0 + kg) = w; }
    __syncthreads();
}
__device__ __forceinline__ void cvt_tile_wide(const CvtJob& J, int lt, FK_LAS unsigned char* img, const int tid) {
    const int wid = tid >> 6, lane = tid & 63;
    const int tk = J.K / 128, tn = J.Np / 256, per = tk * tn;
    const int b = lt / per, r = lt % per, tkk = r % tk, tnn = r / tk;
    const int k0 = tkk * 128, n0 = tnn * 256;
    const float* s0 = J.src0 + (size_t)b * J.src_bstride; const float* s1 = J.src1 ? J.src1 + (size_t)b * J.src_bstride : nullptr;
    bf16_t* d = J.dst + (size_t)b * J.dst_bstride;
    const int np = n0 + 4 * lane; int which; const int sc = map_col(J.map, np, J.N, which); const float* s = which ? s1 : s0;
    const bool ok = sc >= 0 && sc + 3 < J.N;
    f32x4 v[16];
#pragma unroll
    for (int i = 0; i < 16; ++i) { const int k = k0 + wid * 16 + i; v[i] = ok ? *(const f32x4*)(s + (size_t)k * J.N + sc) : (f32x4){0.f, 0.f, 0.f, 0.f}; if (J.scale) v[i] = v[i] * J.scale[k]; }
#pragma unroll
    for (int j = 0; j < 4; ++j) { const int n = 4 * lane + j;
#pragma unroll
        for (int h = 0; h < 2; ++h) { u32x4 w; w.x = cvt_pk_bf16(v[8 * h + 0][j], v[8 * h + 1][j]); w.y = cvt_pk_bf16(v[8 * h + 2][j], v[8 * h + 3][j]); w.z = cvt_pk_bf16(v[8 * h + 4][j], v[8 * h + 5][j]); w.w = cvt_pk_bf16(v[8 * h + 6][j], v[8 * h + 7][j]);
            const int c = wid * 2 + h; *(FK_LAS u32x4*)(img + n * 256 + ((c ^ (n & 15)) << 4)) = w; } }
    __syncthreads();
#pragma unroll
    for (int i = 0; i < 8; ++i) { const int idx = tid + 512 * i, n = idx >> 4, c = idx & 15; const u32x4 w = *(FK_LAS const u32x4*)(img + n * 256 + ((c ^ (n & 15)) << 4));
        *(u32x4*)(d + (size_t)(n0 + n) * J.K + k0 + c * 8) = w; }
    __syncthreads();
}
__device__ __forceinline__ void phase_prologue(const FW& w, const CvtTable& T, FK_LAS unsigned char* lds) {
    FK_LAS float* tile = (FK_LAS float*)lds; const int tid0 = fk_tid();
    for (int t = fk_bid(); t < T.ntiles; t += fk_nblk()) {
        int ji = 0;
#pragma unroll 1
        for (int q = 1; q < T.njobs; ++q) if (t >= T.j[q].tile0) ji = q;
        if (T.j[ji].wide) cvt_tile_wide(T.j[ji], t - T.j[ji].tile0, lds, tid0); else cvt_tile(T.j[ji], t - T.j[ji].tile0, tile, tid0);
    }
    if (!T.misc) return;
    const int gt = fk_bid() * NTHR + tid0, gn = fk_nblk() * NTHR;
    for (int i = gt; i < S * 32; i += gn) { const int pos = i >> 5, j = i & 31; const float invf = powf(10000.f, -(float)j / 32.f); const float ang = (float)pos * invf; w.rope_cs[i] = (f32x2){cosf(ang), sinf(ang)}; }
    for (int i = gt; i < 4 * 128 * 3 * 64 * 4; i += gn) { const int ii = i & 3, lane = (i >> 2) & 63, q = i >> 8, nt = q % 3, kg = (q / 3) & 127, layer = q / (3 * 128); const int k = 16 * kg + 4 * (lane >> 4) + ii, n = 16 * nt + (lane & 15);
        float v = 0.f; if (n < 4) v = w.wgrp[((size_t)layer * D + k) * 4 + n]; else if (n < 36) v = w.wrt[((size_t)layer * D + k) * 32 + (n - 4)]; w.wr4[i] = v; }
    for (int i = gt; i < 128 * 64 * 4; i += gn) { const int ii = i & 3, lane = (i >> 2) & 63, kg = i >> 8; const int k = 16 * kg + 4 * (lane >> 4) + ii; w.fox_wf4[i] = w.fox_w_in[(size_t)k * 6160 + 6144 + (lane & 15)]; }
    for (int i = gt; i < NT * D / 4; i += gn) { const f32x4 v = ((const f32x4*)w.x_in)[i]; u32x2 p; p.x = cvt_pk_bf16(v[0], v[1]); p.y = cvt_pk_bf16(v[2], v[3]); ((u32x2*)w.xb0)[i] = p; }
}

struct RectSched {
    const char* A; const char* B; int lda, ldb, nM, nN, nwg, G, c;
    __device__ void init(const bf16_t* A_, int lda_, const bf16_t* B_, int ldb_, int M, int N) { A = (const char*)A_; B = (const char*)B_; lda = lda_; ldb = ldb_; nM = M / BM; nN = N / BM; nwg = nM * nN; G = fk_nblk(); c = fk_bid(); }
    __device__ __forceinline__ bool tile(int i, int& pm, int& pn) const {
        const long L = (long)i * G + c; if (L >= nwg) return false;
        int wgid = (int)L; { const int q = nwg / 8, r = nwg % 8, xcd = wgid % 8, off = wgid / 8; wgid = (xcd < r ? xcd * (q + 1) : r * (q + 1) + (xcd - r) * q) + off; }
        const int nig = 8 * nN, gid = wgid / nig, fm = gid * 8, gsz = (nM - fm) < 8 ? (nM - fm) : 8;
        pm = fm + ((wgid % nig) % gsz); pn = (wgid % nig) / gsz; return true;
    }
    __device__ __forceinline__ bool next(int i, GUnit& u) const { int pm, pn; if (!tile(i, pm, pn)) return false; u.pm = pm; u.pn = pn; u.e = 0; u.nrows = BM; u.A = A + (size_t)pm * BM * lda * 2; u.B = B + (size_t)pn * BM * ldb * 2; return true; }
    __device__ __forceinline__ void a_offs(const GUnit&, int tid, unsigned (&o)[2][2]) const { int R0, C0, R1, C1; stage_rc(tid * 16, R0, C0); stage_rc(tid * 16 + 8192, R1, C1);
        o[0][0] = (unsigned)(R0 * lda + C0) * 2u; o[0][1] = (unsigned)(R1 * lda + C1) * 2u; o[1][0] = o[0][0] + (unsigned)(HALF * lda * 2); o[1][1] = o[0][1] + (unsigned)(HALF * lda * 2); }
};
struct Rect2Sched {
    RectSched s0, s1; int n0;
    __device__ __forceinline__ bool next(int i, GUnit& u) const {
        const long L = (long)i * s0.G + s0.c; const int tot = s0.nwg + s1.nwg; if (L >= tot) return false;
        if (L < s0.nwg) { const int pm = (int)L % s0.nM, pn = (int)L / s0.nM; u.pm = pm; u.pn = pn; u.e = 0; u.nrows = BM; u.A = s0.A + (size_t)pm * BM * s0.lda * 2; u.B = s0.B + (size_t)pn * BM * s0.ldb * 2; }
        else { const int l = (int)L - s0.nwg; const int pm = l % s1.nM, pn = l / s1.nM; u.pm = pm; u.pn = pn; u.e = 1; u.nrows = BM; u.A = s1.A + (size_t)pm * BM * s1.lda * 2; u.B = s1.B + (size_t)pn * BM * s1.ldb * 2; }
        return true; }
    __device__ __forceinline__ void a_offs(const GUnit& u, int tid, unsigned (&o)[2][2]) const { s0.a_offs(u, tid, o); }
};

struct EpiF32 {
    static constexpr bool PERM = false;
    float* Cp; int ldc;
    __device__ __forceinline__ void operator()(const f32x4 (&acc)[2][2][4][2], const GUnit& u, int wr, int wc, int fr, int fq) const {
        const int row0 = u.pm * BM + wr * 64 + fr, col0 = u.pn * BM + wc * 32 + 4 * fq;
#pragma unroll
        for (int ai = 0; ai < 2; ++ai)
#pragma unroll
            for (int m = 0; m < 4; ++m) { float* rowp = Cp + (size_t)(row0 + ai * HALF + m * 16) * ldc + col0;
#pragma unroll
                for (int bj = 0; bj < 2; ++bj)
#pragma unroll
                    for (int n = 0; n < 2; ++n) *(f32x4*)(rowp + bj * HALF + n * 16) = acc[ai][bj][m][n]; }
    }
};
__device__ __forceinline__ u32x4 pack8(const f32x4& a, const f32x4& b) { u32x4 w; w.x = cvt_pk_bf16(a[0], a[1]); w.y = cvt_pk_bf16(a[2], a[3]); w.z = cvt_pk_bf16(b[0], b[1]); w.w = cvt_pk_bf16(b[2], b[3]); return w; }
__device__ __forceinline__ void rope8(f32x4& v0, f32x4& v1, const f32x2* cs) {
    const f32x4 c01 = *(const f32x4*)cs, c23 = *(const f32x4*)(cs + 2);
    f32x4 r0, r1;
    r0[0] = v0[0] * c01[0] - v0[1] * c01[1]; r0[1] = v0[1] * c01[0] + v0[0] * c01[1]; r0[2] = v0[2] * c01[2] - v0[3] * c01[3]; r0[3] = v0[3] * c01[2] + v0[2] * c01[3];
    r1[0] = v1[0] * c23[0] - v1[1] * c23[1]; r1[1] = v1[1] * c23[0] + v1[0] * c23[1]; r1[2] = v1[2] * c23[2] - v1[3] * c23[3]; r1[3] = v1[3] * c23[2] + v1[2] * c23[3];
    v0 = r0; v1 = r1;
}
struct EpiMlaIn {
    static constexpr bool PERM = true;
    bf16_t *cq, *ckv, *kr; float* ss; const f32x2* cs;
    __device__ __forceinline__ void operator()(const f32x4 (&acc)[2][2][4][2], const GUnit& u, int wr, int wc, int fr, int fq) const {
        const int row0 = u.pm * BM + wr * 64 + fr;
        if (u.pn < 4) {
            bf16_t* dst = (u.pn < 2) ? cq : ckv; const int which = u.pn >> 1; const int col0 = (u.pn & 1) * BM + wc * 32 + 8 * fq;
#pragma unroll
            for (int ai = 0; ai < 2; ++ai)
#pragma unroll
                for (int m = 0; m < 4; ++m) { const int row = row0 + ai * HALF + m * 16; float q = 0.f;
#pragma unroll
                    for (int bj = 0; bj < 2; ++bj) { const f32x4 v0 = acc[ai][bj][m][0], v1 = acc[ai][bj][m][1];
                        q += (v0[0] * v0[0] + v0[1] * v0[1]) + (v0[2] * v0[2] + v0[3] * v0[3]) + (v1[0] * v1[0] + v1[1] * v1[1]) + (v1[2] * v1[2] + v1[3] * v1[3]);
                        *(u32x4*)(dst + (size_t)row * 512 + col0 + bj * HALF) = pack8(v0, v1); }
                    q += __shfl_xor(q, 16); q += __shfl_xor(q, 32);
                    if (fq == 0) ss[((size_t)row * 2 + which) * 8 + (u.pn & 1) * 4 + wc] = q; }
        } else if (wc < 2) {
#pragma unroll
            for (int ai = 0; ai < 2; ++ai) { f32x4 c01[4], c23[4];
#pragma unroll
                for (int m = 0; m < 4; ++m) { const int row = row0 + ai * HALF + m * 16; const f32x2* cp = cs + (size_t)(row & (S - 1)) * 32 + 16 * wc + 4 * fq; c01[m] = *(const f32x4*)cp; c23[m] = *(const f32x4*)(cp + 2); }
#pragma unroll
                for (int m = 0; m < 4; ++m) { const int row = row0 + ai * HALF + m * 16; const f32x4 v0 = acc[ai][0][m][0], v1 = acc[ai][0][m][1]; const f32x4 a = c01[m], b = c23[m]; f32x4 r0, r1;
                    r0[0] = v0[0] * a[0] - v0[1] * a[1]; r0[1] = v0[1] * a[0] + v0[0] * a[1]; r0[2] = v0[2] * a[2] - v0[3] * a[3]; r0[3] = v0[3] * a[2] + v0[2] * a[3];
                    r1[0] = v1[0] * b[0] - v1[1] * b[1]; r1[1] = v1[1] * b[0] + v1[0] * b[1]; r1[2] = v1[2] * b[2] - v1[3] * b[3]; r1[3] = v1[3] * b[2] + v1[2] * b[3];
                    *(u32x4*)(kr + (size_t)row * 64 + wc * 32 + 8 * fq) = pack8(r0, r1); } }
        }
    }
};
struct EpiMlaQKV {
    static constexpr bool PERM = true;
    bf16_t *q, *kv; const float* ss; const f32x2* cs;
    __device__ __forceinline__ void operator()(const f32x4 (&acc)[2][2][4][2], const GUnit& u, int wr, int wc, int fr, int fq) const {
        const int row0 = u.pm * BM + wr * 64 + fr;
#pragma unroll
        for (int ai = 0; ai < 2; ++ai) {
            float rs[4];
            { f32x4 sa[4], sb[4];
#pragma unroll
              for (int m = 0; m < 4; ++m) { const int row = row0 + ai * HALF + m * 16; sa[m] = *(const f32x4*)(ss + ((size_t)row * 2 + u.e) * 8); sb[m] = *(const f32x4*)(ss + ((size_t)row * 2 + u.e) * 8 + 4); }
#pragma unroll
              for (int m = 0; m < 4; ++m) rs[m] = rsqrtf((((sa[m][0] + sa[m][1]) + (sa[m][2] + sa[m][3])) + ((sb[m][0] + sb[m][1]) + (sb[m][2] + sb[m][3]))) * (1.0f / 512.0f) + 1e-6f); }
#pragma unroll
            for (int bj = 0; bj < 2; ++bj) { const int gc = u.pn * BM + bj * HALF + wc * 32 + 8 * fq; const int j = gc % 192; const bool rope = __builtin_amdgcn_readfirstlane((int)((u.e == 0) && (j >= 128))) != 0;
                f32x4 c01[4], c23[4];
                if (rope) {
#pragma unroll
                    for (int m = 0; m < 4; ++m) { const int row = row0 + ai * HALF + m * 16; const f32x2* cp = cs + (size_t)(row & (S - 1)) * 32 + ((j - 128) >> 1); c01[m] = *(const f32x4*)cp; c23[m] = *(const f32x4*)(cp + 2); } }
#pragma unroll
                for (int m = 0; m < 4; ++m) { const int row = row0 + ai * HALF + m * 16; f32x4 v0 = acc[ai][bj][m][0] * rs[m], v1 = acc[ai][bj][m][1] * rs[m];
                    if (u.e == 0) {
                        if (rope) { f32x4 r0, r1; const f32x4 a = c01[m], b = c23[m];
                            r0[0] = v0[0] * a[0] - v0[1] * a[1]; r0[1] = v0[1] * a[0] + v0[0] * a[1]; r0[2] = v0[2] * a[2] - v0[3] * a[3]; r0[3] = v0[3] * a[2] + v0[2] * a[3];
                            r1[0] = v1[0] * b[0] - v1[1] * b[1]; r1[1] = v1[1] * b[0] + v1[0] * b[1]; r1[2] = v1[2] * b[2] - v1[3] * b[3]; r1[3] = v1[3] * b[2] + v1[2] * b[3]; v0 = r0; v1 = r1; }
                        v0 = v0 * QSCALE_MLA; v1 = v1 * QSCALE_MLA; *(u32x4*)(q + (size_t)row * 3072 + gc) = pack8(v0, v1); }
                    else *(u32x4*)(kv + (size_t)row * 4096 + gc) = pack8(v0, v1); } }
        }
    }
};
}
namespace fk {
#define FK_KSWZ(row, colB) ((row) * 256 + ((colB) ^ (((row) & 7) << 4)))
#define FK_KRSWZ(row, ch) ((row) * 128 + ((((ch)) ^ (((row) >> 1) & 7)) << 4))
__device__ __forceinline__ int v_st(int k, int c) { const int kk = (k & ~0xC) | ((k & 4) << 1) | ((k & 8) >> 1); return ((kk >> 3) * 4 + (c >> 5)) * 512 + ((kk & 7) * 32 + (c & 31)) * 2; }
__device__ __forceinline__ int v_rd_base(int lane) { return ((lane & 3) << 3) | (((lane >> 2) & 3) << 6) | (((lane >> 4) & 1) << 5) | (((lane >> 5) & 1) << 8); }
__device__ __forceinline__ int crow(int r, int hi) { return (r & 3) + 8 * (r >> 2) + 4 * hi; }

constexpr int AT_K = 0, AT_V = 32768, AT_KR = 65536, AT_CF = 81920, AT_WS = 90112;

struct AttnPtrs { const bf16_t* Q; const bf16_t* K; const bf16_t* V; const bf16_t* KR; const float* CF; bf16_t* O; int qld, kld; };

template <int MODE>
__device__ __forceinline__ void attn_block(FK_LAS unsigned char* lds, const AttnPtrs P, const int qb) {
    constexpr int NQ = MODE == 0 ? 12 : 8;
    const int tid = fk_tid(), wid = __builtin_amdgcn_readfirstlane(tid >> 6), lane = tid & 63, r32 = lane & 31, hi = lane >> 5;
    const int q0w = qb * 256 + wid * 32;
    const int nt = 4 * (qb + 1);
    bf16x8 qr[NQ];
    { const bf16_t* qrow = P.Q + (size_t)(q0w + r32) * P.qld;
#pragma unroll
      for (int d0 = 0; d0 < NQ; ++d0) qr[d0] = *(const bf16x8*)(qrow + d0 * 16 + hi * 8); }
    float ct2 = 0.f; if (MODE == 1) ct2 = ((FK_LAS const float*)(lds + AT_CF))[q0w + r32];
    const int sr = tid >> 4, sc = (tid & 15) * 8;
    const int kws = FK_KSWZ(sr, sc * 2), vst0 = v_st(sr, sc), vst1 = v_st(32 + sr, sc);
    const int krr = tid >> 3, krc = tid & 7, krw = FK_KRSWZ(krr, krc);
    const int vb0 = AT_V + v_rd_base(lane);
    FK_LAS float* wsl = (FK_LAS float*)(lds + AT_WS) + wid * 64;
    bf16x8 sk0, sk1, sv0, sv1, skr;
    float m_reg = -1e30f, l_reg = 0.f; f32x16 o[4];
#pragma unroll
    for (int d = 0; d < 4; ++d)
#pragma unroll
        for (int r = 0; r < 16; ++r) o[d][r] = 0.f;
#define AT_LOAD(j) do { const size_t k0_ = (size_t)(j) * 64; \
        sk0 = *(const bf16x8*)(P.K + (k0_ + sr) * P.kld + sc); sk1 = *(const bf16x8*)(P.K + (k0_ + 32 + sr) * P.kld + sc); \
        sv0 = *(const bf16x8*)(P.V + (k0_ + sr) * P.kld + sc); sv1 = *(const bf16x8*)(P.V + (k0_ + 32 + sr) * P.kld + sc); \
        if (MODE == 0) skr = *(const bf16x8*)(P.KR + (k0_ + krr) * 64 + krc * 8); \
        } while (0)
#define AT_WRITE(bf) do { *(FK_LAS bf16x8*)(lds + AT_K + (bf) * 16384 + kws) = sk0; *(FK_LAS bf16x8*)(lds + AT_K + (bf) * 16384 + kws + 32 * 256) = sk1; \
        *(FK_LAS bf16x8*)(lds + AT_V + (bf) * 16384 + vst0) = sv0; *(FK_LAS bf16x8*)(lds + AT_V + (bf) * 16384 + vst1) = sv1; \
        if (MODE == 0) *(FK_LAS bf16x8*)(lds + AT_KR + (bf) * 8192 + krw) = skr; \
        } while (0)
#define AT_TRRD(dst, off) asm volatile("ds_read_b64_tr_b16 %0, %1 offset:%2" : "=&v"(dst) : "v"(vb0), "i"(off) : "memory")
#define AT_PV_D0(KB, d0) do { s16x4 l0, l1, l2, l3, h0, h1, h2, h3; constexpr int b_ = (KB) * 16384 + (d0) * 512; \
        AT_TRRD(l0, b_); AT_TRRD(h0, b_ + 2048); AT_TRRD(l1, b_ + 4096); AT_TRRD(h1, b_ + 6144); AT_TRRD(l2, b_ + 8192); AT_TRRD(h2, b_ + 10240); AT_TRRD(l3, b_ + 12288); AT_TRRD(h3, b_ + 14336); \
        asm volatile("s_waitcnt lgkmcnt(0)" ::: "memory"); __builtin_amdgcn_sched_barrier(0); \
        o[d0] = __builtin_amdgcn_mfma_f32_32x32x16_bf16(pa0, (bf16x8){l0[0], l0[1], l0[2], l0[3], h0[0], h0[1], h0[2], h0[3]}, o[d0], 0, 0, 0); \
        o[d0] = __builtin_amdgcn_mfma_f32_32x32x16_bf16(pa1, (bf16x8){l1[0], l1[1], l1[2], l1[3], h1[0], h1[1], h1[2], h1[3]}, o[d0], 0, 0, 0); \
        o[d0] = __builtin_amdgcn_mfma_f32_32x32x16_bf16(pa2, (bf16x8){l2[0], l2[1], l2[2], l2[3], h2[0], h2[1], h2[2], h2[3]}, o[d0], 0, 0, 0); \
        o[d0] = __builtin_amdgcn_mfma_f32_32x32x16_bf16(pa3, (bf16x8){l3[0], l3[1], l3[2], l3[3], h3[0], h3[1], h3[2], h3[3]}, o[d0], 0, 0, 0); } while (0)
#define AT_PK4(Pv, B_, OUT) do { unsigned a0 = cvt_pk_bf16(Pv[B_ + 0], Pv[B_ + 1]), a1 = cvt_pk_bf16(Pv[B_ + 2], Pv[B_ + 3]); \
        unsigned b0 = cvt_pk_bf16(Pv[B_ + 4], Pv[B_ + 5]), b1 = cvt_pk_bf16(Pv[B_ + 6], Pv[B_ + 7]); \
        auto r0 = __builtin_amdgcn_permlane32_swap(a0, b0, false, false); auto r1 = __builtin_amdgcn_permlane32_swap(a1, b1, false, false); \
        u32x4 w_ = {r0[0], r1[0], r0[1], r1[1]}; OUT = *reinterpret_cast<bf16x8*>(&w_); } while (0)
#define AT_STEP(j, KB) do { \
        if ((j) + 1 < nt) AT_LOAD((j) + 1); \
        if ((j) * 64 <= q0w) { \
            f32x16 p0, p1; \
            _Pragma("unroll") for (int r = 0; r < 16; ++r) { p0[r] = 0.f; p1[r] = 0.f; } \
            __builtin_amdgcn_s_setprio(1); \
            { FK_LAS const unsigned char* kb_ = lds + AT_K + (KB) * 16384; \
              _Pragma("unroll") for (int d0 = 0; d0 < 8; ++d0) { \
                const bf16x8 b0 = *(FK_LAS const bf16x8*)(kb_ + FK_KSWZ(r32, (d0 * 16 + hi * 8) * 2)); \
                const bf16x8 b1 = *(FK_LAS const bf16x8*)(kb_ + FK_KSWZ(r32, (d0 * 16 + hi * 8) * 2) + 32 * 256); \
                p0 = __builtin_amdgcn_mfma_f32_32x32x16_bf16(b0, qr[d0], p0, 0, 0, 0); \
                p1 = __builtin_amdgcn_mfma_f32_32x32x16_bf16(b1, qr[d0], p1, 0, 0, 0); } } \
            if (MODE == 0) { FK_LAS const unsigned char* kr_ = lds + AT_KR + (KB) * 8192; \
              _Pragma("unroll") for (int d0 = 0; d0 < 4; ++d0) { \
                const bf16x8 b0 = *(FK_LAS const bf16x8*)(kr_ + FK_KRSWZ(r32, 2 * d0 + hi)); \
                const bf16x8 b1 = *(FK_LAS const bf16x8*)(kr_ + FK_KRSWZ(r32 + 32, 2 * d0 + hi)); \
                p0 = __builtin_amdgcn_mfma_f32_32x32x16_bf16(b0, qr[(MODE == 0 ? 8 : 0) + d0], p0, 0, 0, 0); \
                p1 = __builtin_amdgcn_mfma_f32_32x32x16_bf16(b1, qr[(MODE == 0 ? 8 : 0) + d0], p1, 0, 0, 0); } } \
            __builtin_amdgcn_s_setprio(0); \
            if (MODE == 1) { FK_LAS const float* cf_ = (FK_LAS const float*)(lds + AT_CF) + (j) * 64; \
              _Pragma("unroll") for (int g = 0; g < 4; ++g) { const f32x4 c0 = *(FK_LAS const f32x4*)(cf_ + 8 * g + 4 * hi), c1 = *(FK_LAS const f32x4*)(cf_ + 32 + 8 * g + 4 * hi); \
                _Pragma("unroll") for (int i = 0; i < 4; ++i) { p0[4 * g + i] += ct2 - c0[i]; p1[4 * g + i] += ct2 - c1[i]; } } \
              if ((j) * 64 + 63 > q0w) { const int dq = q0w + r32 - (j) * 64 - 4 * hi; const float NEG = -__builtin_inff(); \
                _Pragma("unroll") for (int r = 0; r < 16; ++r) { const int c = (r & 3) + 8 * (r >> 2); if (c > dq) p0[r] = NEG; if (c + 32 > dq) p1[r] = NEG; } } } \
            float pmax = p0[0]; \
            _Pragma("unroll") for (int r = 1; r < 16; ++r) pmax = fmaxf(pmax, p0[r]); \
            _Pragma("unroll") for (int r = 0; r < 16; ++r) pmax = fmaxf(pmax, p1[r]); \
            { auto rr = __builtin_amdgcn_permlane32_swap(__float_as_uint(pmax), __float_as_uint(pmax), false, false); pmax = fmaxf(__uint_as_float(rr[0]), __uint_as_float(rr[1])); } \
            float mn, alpha; \
            if (__all(pmax - m_reg <= 11.5415603f)) { mn = m_reg; alpha = 1.f; }     \
            else { mn = fmaxf(m_reg, pmax); alpha = __builtin_amdgcn_exp2f(m_reg - mn); m_reg = mn; } \
            float ps = 0.f; \
            _Pragma("unroll") for (int r = 0; r < 16; ++r) { p0[r] = __builtin_amdgcn_exp2f(p0[r] - mn); ps += p0[r]; } \
            _Pragma("unroll") for (int r = 0; r < 16; ++r) { p1[r] = __builtin_amdgcn_exp2f(p1[r] - mn); ps += p1[r]; } \
            { auto rr = __builtin_amdgcn_permlane32_swap(__float_as_uint(ps), __float_as_uint(ps), false, false); ps = __uint_as_float(rr[0]) + __uint_as_float(rr[1]); } \
            l_reg = l_reg * alpha + ps; \
            bf16x8 pa0, pa1, pa2, pa3; AT_PK4(p0, 0, pa0); AT_PK4(p0, 8, pa1); AT_PK4(p1, 0, pa2); AT_PK4(p1, 8, pa3); \
            if (__any(alpha < 1.f)) { if (hi == 0) wsl[32 + r32] = alpha; asm volatile("s_waitcnt lgkmcnt(0)" ::: "memory"); \
                _Pragma("unroll") for (int g = 0; g < 4; ++g) { const f32x4 a4 = *(FK_LAS const f32x4*)(wsl + 32 + 8 * g + 4 * hi); \
                    _Pragma("unroll") for (int d_ = 0; d_ < 4; ++d_) _Pragma("unroll") for (int i = 0; i < 4; ++i) o[d_][4 * g + i] *= a4[i]; } } \
            __builtin_amdgcn_s_setprio(1); AT_PV_D0(KB, 0); AT_PV_D0(KB, 1); AT_PV_D0(KB, 2); AT_PV_D0(KB, 3); __builtin_amdgcn_s_setprio(0); \
        } \
        if ((j) + 1 < nt) AT_WRITE((KB) ^ 1); \
        __syncthreads(); } while (0)

    AT_LOAD(0); AT_WRITE(0); __syncthreads();
    for (int j = 0; j < nt; j += 2) { AT_STEP(j, 0); AT_STEP(j + 1, 1); }
    if (hi == 0) wsl[r32] = l_reg; asm volatile("s_waitcnt lgkmcnt(0)" ::: "memory");
    bf16_t* Ow = P.O + (size_t)q0w * D;
#pragma unroll
    for (int g = 0; g < 4; ++g) { const f32x4 l4 = *(FK_LAS const f32x4*)(wsl + 8 * g + 4 * hi);
#pragma unroll
        for (int i = 0; i < 4; ++i) { const int r = 4 * g + i; const int orow = crow(r, hi); const float rl = __builtin_amdgcn_rcpf(l4[i]);
#pragma unroll
            for (int d0 = 0; d0 < 4; ++d0) { const float v = o[d0][r] * rl; const float vn = __shfl_xor(v, 1);
                if ((r32 & 1) == 0) *(unsigned*)(Ow + (size_t)orow * D + d0 * 32 + r32) = cvt_pk_bf16(v, vn); } } }
    __syncthreads();
#undef AT_LOAD
#undef AT_WRITE
#undef AT_TRRD
#undef AT_PV_D0
#undef AT_PK4
#undef AT_STEP
}
}
namespace fk {
constexpr int LN_XS = 2052;
constexpr int TAB_OFF = 143360;

struct LnArgs {
    const float* x; const bf16_t* yb; const bf16_t* Y2; const int* te; const int* tpos; const int* cnt;
    const float *g, *b; float* xo; bf16_t* xbo; float* out2; unsigned char* xqo;
    const f32x4* w4; int ntile;
    const float *bgrp, *brt; int* rcnt; int* ote; int* otpos; float* otw; int* list; float* sw;
    float* flog; const float* fbias;
};

__device__ __forceinline__ float wave_sum(float v) { for (int o = 32; o >= 1; o >>= 1) v += __shfl_xor(v, o); return v; }

struct LnRows { f32x4 x[2][8]; u32x2 ya[2][8]; u32x2 yb[2][8]; };
__device__ __forceinline__ void ln_load(const LnArgs& a, FK_LAS const int* hoff, int grp, int wid, int lane, LnRows& R) {
#pragma unroll
    for (int rr = 0; rr < 2; ++rr) { const int t = grp * 16 + 2 * wid + rr;
        const bf16_t *pa, *pb = nullptr;
        if (a.Y2) { const int e0 = a.te[t * 2], e1 = a.te[t * 2 + 1]; pa = a.Y2 + (size_t)(hoff[e0] + a.tpos[t * 2]) * D; pb = a.Y2 + (size_t)(hoff[e1] + a.tpos[t * 2 + 1]) * D; }
        else pa = a.yb + (size_t)t * D;
#pragma unroll
        for (int i = 0; i < 8; ++i) { const int c = 4 * lane + 256 * i; R.x[rr][i] = *(const f32x4*)(a.x + (size_t)t * D + c); R.ya[rr][i] = *(const u32x2*)(pa + c); if (a.Y2) R.yb[rr][i] = *(const u32x2*)(pb + c); else R.yb[rr][i] = (u32x2){0u, 0u}; } }
}
__device__ __forceinline__ void phase_ln(const LnArgs& a, FK_LAS unsigned char* lds) {
    const int tid = fk_tid(), wid = __builtin_amdgcn_readfirstlane(tid >> 6), lane = tid & 63;
    FK_LAS float* part = (FK_LAS float*)lds;
    FK_LAS float* logit = (FK_LAS float*)(lds + 65536);
    FK_LAS int* hoff = (FK_LAS int*)(lds + TAB_OFF);
    if (a.Y2) { if (tid < 64) { const int c = lane < 32 ? a.cnt[lane * 32] : 0; const int pc = ((c + 255) >> 8) << 8; int incl = pc;
#pragma unroll
            for (int o = 1; o < 32; o <<= 1) { const int v = __shfl_up(incl, o); if (lane >= o) incl += v; }
            if (lane < 32) hoff[lane] = incl - pc; }
        __syncthreads(); }
    const int nb = fk_nblk(); int grp = fk_bid();
    if (grp >= NT / 16) return;
    LnRows cur; ln_load(a, hoff, grp, wid, lane, cur);
#pragma unroll 1
    for (; grp < NT / 16; grp += nb) {
        const bool has_next = grp + nb < NT / 16;
#pragma unroll
        for (int rr = 0; rr < 2; ++rr) {
            const int lr = 2 * wid + rr, t = grp * 16 + lr;
            f32x4 v[8]; float s = 0.f;
#pragma unroll
            for (int i = 0; i < 8; ++i) { f32x4 xv = cur.x[rr][i] * ALPHA; const u32x2 pa = cur.ya[rr][i], pb = cur.yb[rr][i];
                xv[0] += __uint_as_float(pa.x << 16) + __uint_as_float(pb.x << 16); xv[1] += __uint_as_float(pa.x & 0xffff0000u) + __uint_as_float(pb.x & 0xffff0000u);
                xv[2] += __uint_as_float(pa.y << 16) + __uint_as_float(pb.y << 16); xv[3] += __uint_as_float(pa.y & 0xffff0000u) + __uint_as_float(pb.y & 0xffff0000u);
                v[i] = xv; s += (xv[0] + xv[1]) + (xv[2] + xv[3]); }
            const float mean = wave_sum(s) * (1.0f / D); float q = 0.f;
#pragma unroll
            for (int i = 0; i < 8; ++i) { const f32x4 d = v[i] - mean; q += (d[0] * d[0] + d[1] * d[1]) + (d[2] * d[2] + d[3] * d[3]); }
            const float rs = rsqrtf(wave_sum(q) * (1.0f / D) + 1e-5f);
#pragma unroll
            for (int i = 0; i < 8; ++i) { const int c = 4 * lane + 256 * i; const f32x4 gv = *(const f32x4*)(a.g + c), bv = *(const f32x4*)(a.b + c);
                const f32x4 o = (v[i] - mean) * rs * gv + bv;
                *(f32x4*)(a.xo + (size_t)t * D + c) = o;
                if (a.out2) *(f32x4*)(a.out2 + (size_t)t * D + c) = o;
                u32x2 p; p.x = cvt_pk_bf16(o[0], o[1]); p.y = cvt_pk_bf16(o[2], o[3]); *(u32x2*)(a.xbo + (size_t)t * D + c) = p; }
        }
        if (has_next) ln_load(a, hoff, grp + nb, wid, lane, cur);
    }
    if (!a.w4) return;
    __syncthreads();
    const int row = lane & 15, kq = lane >> 4;
#pragma unroll 1
    for (int g0 = fk_bid(); g0 < NT / 16; g0 += 2 * nb) {
        const int g1 = g0 + nb; const bool two = g1 < NT / 16;
        const int ks = (wid + (fk_bid() >> 3)) & 7, jrot = 4 * ((fk_bid() >> 6) & 3);
        const float* xp0 = a.xo + (size_t)(g0 * 16 + row) * D + 4 * kq + 256 * ks;
        const float* xp1 = a.xo + (size_t)((two ? g1 : g0) * 16 + row) * D + 4 * kq + 256 * ks;
        const f32x4* wp = a.w4 + (size_t)(ks * 16 * a.ntile) * 64 + lane;
        f32x4 acc[2][3];
#pragma unroll
        for (int g = 0; g < 2; ++g)
#pragma unroll
            for (int n = 0; n < 3; ++n) acc[g][n] = (f32x4){0.f, 0.f, 0.f, 0.f};
#pragma unroll 4
        for (int j0 = 0; j0 < 16; ++j0) { const int j = (j0 + jrot) & 15;
            const f32x4 a0 = *(const f32x4*)(xp0 + 16 * j), a1 = *(const f32x4*)(xp1 + 16 * j);
#pragma unroll
            for (int n = 0; n < 3; ++n) if (n < a.ntile) { const f32x4 bv = wp[(size_t)(j * a.ntile + n) * 64];
#pragma unroll
                for (int i = 0; i < 4; ++i) { acc[0][n] = __builtin_amdgcn_mfma_f32_16x16x4f32(a0[i], bv[i], acc[0][n], 0, 0, 0); acc[1][n] = __builtin_amdgcn_mfma_f32_16x16x4f32(a1[i], bv[i], acc[1][n], 0, 0, 0); } } }
#pragma unroll
        for (int g = 0; g < 2; ++g)
#pragma unroll
            for (int n = 0; n < 3; ++n) if (n < a.ntile) {
#pragma unroll
                for (int r = 0; r < 4; ++r) part[(wid * 32 + 16 * g + 4 * kq + r) * 48 + 16 * n + row] = acc[g][n][r]; }
        __syncthreads();
        for (int i = tid; i < 32 * 16 * a.ntile; i += NTHR) { const int n = i % (16 * a.ntile), r = i / (16 * a.ntile); float s = 0.f;
#pragma unroll
            for (int w = 0; w < 8; ++w) s += part[(w * 32 + r) * 48 + n]; logit[r * 48 + n] = s; }
        __syncthreads();
        if (a.ntile == 1) { const int r = tid & 31, n = tid >> 5; if (r < 16 || two) { const int t = (r < 16 ? g0 : g1) * 16 + (r & 15); const float x = logit[r * 48 + n] + a.fbias[n]; const float ls = fminf(x, 0.f) - 0.6931471805599453f * __builtin_amdgcn_logf(1.0f + __builtin_amdgcn_exp2f(-fabsf(x) * LOG2E));     a.flog[((size_t)((t >> 11) * 16 + n)) * S + (t & (S - 1))] = ls; } }
        else if (tid < 16 || (tid < 32 && two)) { const int t = (tid < 16 ? g0 : g1) * 16 + (tid & 15); FK_LAS const float* lg = logit + tid * 48;
            float g4[4]; float mx = -3e38f; int gs = 0;
            for (int i = 0; i < 4; ++i) { g4[i] = lg[i] + a.bgrp[i]; if (g4[i] > mx) { mx = g4[i]; gs = i; } }
            float den = 0.f; for (int i = 0; i < 4; ++i) den += expf(g4[i] - mx); const float pg = 1.f / den;
            float e[8]; for (int i = 0; i < 8; ++i) e[i] = lg[4 + gs * 8 + i] + a.brt[gs * 8 + i];
            int i1 = 0; for (int i = 1; i < 8; ++i) if (e[i] > e[i1]) i1 = i;
            int i2 = -1; for (int i = 0; i < 8; ++i) if (i != i1 && (i2 < 0 || e[i] > e[i2])) i2 = i;
            const float w1 = 1.f / (1.f + expf(e[i2] - e[i1])), w2 = 1.f - w1;
            const int ea = gs * 8 + i1, eb = gs * 8 + i2;
            const int pa = atomicAdd(a.rcnt + ea * 32, 1), pb = atomicAdd(a.rcnt + eb * 32, 1);
            a.ote[t * 2] = ea; a.ote[t * 2 + 1] = eb; a.otpos[t * 2] = pa; a.otpos[t * 2 + 1] = pb; a.otw[t * 2] = w1 * pg; a.otw[t * 2 + 1] = w2 * pg;
            a.list[ea * NT + pa] = t; a.list[eb * NT + pb] = t; a.sw[ea * NT + pa] = w1 * pg; a.sw[eb * NT + pb] = w2 * pg; }
        __syncthreads();
    }
}

__device__ __forceinline__ void moe_tables(const int* cnt, FK_LAS int* tab) {
    const int tid = fk_tid(), lane = tid & 63;
    __syncthreads();
    if (tid < 64) { const int c = lane < 32 ? cnt[lane * 32] : 0; const int nt = (c + 255) >> 8; int incl = nt;
#pragma unroll
        for (int o = 1; o < 32; o <<= 1) { const int v = __shfl_up(incl, o); if (lane >= o) incl += v; }
        if (lane < 32) { tab[lane] = incl - nt; tab[40 + lane] = (incl - nt) * 256; tab[80 + lane] = c; }
        if (lane == 31) tab[32] = incl; }
    __syncthreads();
}
struct MoeSched1 {
    const char* xb; const char* Bt; const int* list; FK_LAS const int* tab; int G, c;
    __device__ __forceinline__ bool next(int i, GUnit& u) const {
        const int L = i * G + c; const int tot = tab[32] * 4; if (L >= tot) return false;
        int e = 0;
#pragma unroll 1
        for (int q = 1; q < 32; ++q) if (L >= tab[q] * 4) e = q;
        const int r = L - tab[e] * 4, nte = tab[e + 1] - tab[e]; const int mt = r % nte, pn = r / nte;
        u.e = e; u.pm = mt; u.pn = pn; u.nrows = min(256, tab[80 + e] - 256 * mt); u.A = xb; u.B = Bt + ((size_t)e * 1024 + (size_t)pn * 256) * D * 2; return true; }
    __device__ __forceinline__ void a_offs(const GUnit& u, int tid, unsigned (&o)[2][2]) const { int R0, C0, R1, C1; stage_rc(tid * 16, R0, C0); stage_rc(tid * 16 + 8192, R1, C1);
        const int* l = list + (size_t)u.e * NT + u.pm * 256;
        const int r00 = R0 < u.nrows ? R0 : 0, r01 = R1 < u.nrows ? R1 : 0, r10 = R0 + HALF < u.nrows ? R0 + HALF : 0, r11 = R1 + HALF < u.nrows ? R1 + HALF : 0;
        o[0][0] = (unsigned)(l[r00] * D + C0) * 2u; o[0][1] = (unsigned)(l[r01] * D + C1) * 2u; o[1][0] = (unsigned)(l[r10] * D + C0) * 2u; o[1][1] = (unsigned)(l[r11] * D + C1) * 2u; }
};
struct MoeSched2 {
    const char* H; const char* Bt; FK_LAS const int* tab; int G, c;
    __device__ __forceinline__ bool next(int i, GUnit& u) const {
        const int L = i * G + c; const int tot = tab[32] * 8; if (L >= tot) return false;
        int e = 0;
#pragma unroll 1
        for (int q = 1; q < 32; ++q) if (L >= tab[q] * 8) e = q;
        const int r = L - tab[e] * 8, nte = tab[e + 1] - tab[e]; const int mt = r % nte, pn = r / nte;
        u.e = e; u.pm = mt; u.pn = pn; u.nrows = min(256, tab[80 + e] - 256 * mt); u.A = H + (size_t)(tab[40 + e] + 256 * mt) * 512 * 2; u.B = Bt + ((size_t)e * 2048 + (size_t)pn * 256) * 512 * 2; return true; }
    __device__ __forceinline__ void a_offs(const GUnit&, int tid, unsigned (&o)[2][2]) const { int R0, C0, R1, C1; stage_rc(tid * 16, R0, C0); stage_rc(tid * 16 + 8192, R1, C1);
        o[0][0] = (unsigned)(R0 * 512 + C0) * 2u; o[0][1] = (unsigned)(R1 * 512 + C1) * 2u; o[1][0] = o[0][0] + (unsigned)(HALF * 512 * 2); o[1][1] = o[0][1] + (unsigned)(HALF * 512 * 2); }
};
struct EpiMoe1 {
    static constexpr bool PERM = false;
    bf16_t* H; const float* sw; FK_LAS const int* tab;
    __device__ __forceinline__ void operator()(const f32x4 (&acc)[2][2][4][2], const GUnit& u, int wr, int wc, int fr, int fq) const {
        const int hrow0 = tab[40 + u.e] + 256 * u.pm; const float* swe = sw + (size_t)u.e * NT + 256 * u.pm;
#pragma unroll
        for (int ai = 0; ai < 2; ++ai)
#pragma unroll
            for (int m = 0; m < 4; ++m) { const int r = ai * HALF + wr * 64 + m * 16 + fr; if (r < u.nrows) { const float wgt = swe[r];
#pragma unroll
                for (int bj = 0; bj < 2; ++bj) { const f32x4 g = acc[ai][bj][m][0], up = acc[ai][bj][m][1]; f32x4 h;
#pragma unroll
                    for (int j = 0; j < 4; ++j) h[j] = g[j] * __builtin_amdgcn_rcpf(1.0f + __builtin_amdgcn_exp2f(-g[j] * LOG2E)) * up[j] * wgt;
                    u32x2 p; p.x = cvt_pk_bf16(h[0], h[1]); p.y = cvt_pk_bf16(h[2], h[3]);
                    *(u32x2*)(H + (size_t)(hrow0 + r) * 512 + u.pn * 128 + bj * 64 + wc * 16 + 4 * fq) = p; } } }
    }
};
struct EpiMoe2 {
    static constexpr bool PERM = true;
    bf16_t* Y2; FK_LAS const int* tab;
    __device__ __forceinline__ void operator()(const f32x4 (&acc)[2][2][4][2], const GUnit& u, int wr, int wc, int fr, int fq) const {
        const int hrow0 = tab[40 + u.e] + 256 * u.pm;
#pragma unroll
        for (int ai = 0; ai < 2; ++ai)
#pragma unroll
            for (int m = 0; m < 4; ++m) { const int r = ai * HALF + wr * 64 + m * 16 + fr; if (r < u.nrows) {
#pragma unroll
                for (int bj = 0; bj < 2; ++bj) *(u32x4*)(Y2 + (size_t)(hrow0 + r) * D + u.pn * BM + bj * HALF + wc * 32 + 8 * fq) = pack8(acc[ai][bj][m][0], acc[ai][bj][m][1]); } }
    }
};
}
namespace fk {
constexpr int SG_ROWS = 640, SG_ASTG = SG_ROWS * 64, SG_BPITCH = 1040, SG_BSTG = 16 * SG_BPITCH, SG_A = 0, SG_B = 2 * SG_ASTG;
struct SgArgs {
    const char* A; const int* rowlist; int arow0, lda_bytes, nr;
    const float* B0; const float* B1; int ldn, K;
    bf16_t* out; int out_row0, out_ld, out_col0; const float* roww; int var;
};
template <int MODE>
__device__ __forceinline__ void sg_unit(FK_LAS unsigned char* lds, const SgArgs a) {
    const int tid = fk_tid(), wid = __builtin_amdgcn_readfirstlane(tid >> 6), lane = tid & 63, r16 = lane & 15, kq = lane >> 4, wm = wid >> 1, wn = wid & 1;
    const int rpw = ((a.nr + 63) >> 6) << 4, mf = rpw >> 4;
    const int nt = a.K >> 5;
    const char* ap[5];
    { const int kc = (lane & 3) ^ ((lane >> 4) & 3);
#pragma unroll
      for (int i = 0; i < 5; ++i) { int r = 16 * (5 * wid + i) + (lane >> 2); r = r < a.nr ? r : a.nr - 1; if (a.var & 4) r = 0; const int gr = a.rowlist ? a.rowlist[r] : a.arow0 + r; ap[i] = a.A + (size_t)gr * a.lda_bytes + kc * 16; } }
    const float* bp[2];
#pragma unroll
    for (int i = 0; i < 2; ++i) { const int k = 2 * (2 * wid + i) + (lane >> 5), c = lane & 31;
        if (MODE == 1) { const int blk = c >> 3; bp[i] = ((blk & 1) ? a.B1 : a.B0) + (size_t)k * a.ldn + 32 * (blk >> 1) + 4 * (c & 7); }
        else bp[i] = a.B0 + (size_t)k * a.ldn + 4 * c; }
    const unsigned a_rd = (unsigned)(SG_A + (wm * rpw + r16) * 64 + ((kq ^ ((r16 >> 2) & 3)) << 4));
    const unsigned b_rd = (unsigned)(SG_B + 4 * kq * SG_BPITCH + (wn * 64 + r16) * 4);
    f32x4 acc[10][4];
#pragma unroll
    for (int i = 0; i < 10; ++i)
#pragma unroll
        for (int j = 0; j < 4; ++j) acc[i][j] = (f32x4){0.f, 0.f, 0.f, 0.f};
#define SG_ISSUE(t, stg) do {         _Pragma("unroll") for (int i = 0; i < 5; ++i) __builtin_amdgcn_global_load_lds((const unsigned*)(ap[i] + (size_t)(t) * 64), (FK_LAS unsigned*)(lds + SG_A + (stg) * SG_ASTG + (5 * wid + i) * 1024), 16, 0, 0);         _Pragma("unroll") for (int i = 0; i < 2; ++i) __builtin_amdgcn_global_load_lds((const unsigned*)(bp[i] + (size_t)((a.var & 2) ? 0 : (t)) * 32 * a.ldn), (FK_LAS unsigned*)(lds + SG_B + (stg) * SG_BSTG + (2 * wid + i) * SG_BPITCH), 16, 0, 0); } while (0)
    SG_ISSUE(0, 0);
    int stg = 0;
#pragma unroll 1
    for (int t = 0; t < nt; ++t) {
        asm volatile("s_waitcnt vmcnt(0)\n\ts_barrier" ::: "memory");
        if (t + 1 < nt) SG_ISSUE(t + 1, stg ^ 1);
        FK_LAS const unsigned char* ab = lds + a_rd + stg * SG_ASTG; FK_LAS const unsigned char* bb = lds + b_rd + stg * SG_BSTG;
        bf16x8 bf[4];
#pragma unroll
        for (int j = 0; j < 4; ++j) { FK_LAS const float* p = (FK_LAS const float*)(bb + j * 64);
            const float v0 = p[0], v1 = p[128], v2 = p[260], v3 = p[388], v4 = p[520], v5 = p[648], v6 = p[780], v7 = p[908];
            u32x4 w; w.x = cvt_pk_bf16(v0, v1); w.y = cvt_pk_bf16(v2, v3); w.z = cvt_pk_bf16(v4, v5); w.w = cvt_pk_bf16(v6, v7); bf[j] = *reinterpret_cast<bf16x8*>(&w); }
#pragma unroll
        for (int i = 0; i < 10; ++i) if (i < mf && !(a.var & 1)) { const bf16x8 af = *(FK_LAS const bf16x8*)(ab + i * 1024);
#pragma unroll
            for (int j = 0; j < 4; ++j) acc[i][j] = __builtin_amdgcn_mfma_f32_16x16x32_bf16(bf[j], af, acc[i][j], 0, 0, 0); }
        stg ^= 1;
    }
#undef SG_ISSUE
    float wgts[10];
#pragma unroll
    for (int i = 0; i < 10; ++i) { const int r = wm * rpw + 16 * i + r16; wgts[i] = (MODE == 1 && i < mf && r < a.nr) ? a.roww[r] : 0.f; }
#pragma unroll
    for (int i = 0; i < 10; ++i) if (i < mf) { const int r = wm * rpw + 16 * i + r16; if (r < a.nr) {
        if (MODE == 1) { const float wgt = wgts[i]; bf16_t* orow = a.out + (size_t)(a.out_row0 + r) * a.out_ld + a.out_col0 + 32 * wn + 4 * kq;
#pragma unroll
            for (int j = 0; j < 2; ++j) { const f32x4 g = acc[i][j], up = acc[i][j + 2]; f32x4 h;
#pragma unroll
                for (int q = 0; q < 4; ++q) h[q] = g[q] * __builtin_amdgcn_rcpf(1.0f + __builtin_amdgcn_exp2f(-g[q] * LOG2E)) * up[q] * wgt;
                u32x2 p; p.x = cvt_pk_bf16(h[0], h[1]); p.y = cvt_pk_bf16(h[2], h[3]); *(u32x2*)(orow + 16 * j) = p; } }
        else { bf16_t* orow = a.out + (size_t)(a.out_row0 + r) * a.out_ld + a.out_col0 + 64 * wn + 4 * kq;
#pragma unroll
            for (int j = 0; j < 4; ++j) { const f32x4 v = acc[i][j]; u32x2 p; p.x = cvt_pk_bf16(v[0], v[1]); p.y = cvt_pk_bf16(v[2], v[3]); *(u32x2*)(orow + 16 * j) = p; } } } }
    asm volatile("s_waitcnt vmcnt(0)" ::: "memory");
    __syncthreads();
}
__device__ __forceinline__ void phase_moe1(FK_LAS unsigned char* lds, FK_LAS const int* tab, const bf16_t* xb, const int* list, const float* sw, const float* wgate, const float* wup, bf16_t* H, int var) {
#pragma unroll 1
    for (int u = fk_bid(), nb = fk_nblk(); u < 256; u += nb) { const int xcd = u & 7, q = u >> 3, e = xcd + 8 * (q >> 3), s = q & 7; const int ne = tab[80 + e], hrow0 = tab[40 + e];
        const int rbeg = 0, rend = ne;
#pragma unroll 1
        for (int r0 = rbeg; r0 < rend; r0 += SG_ROWS) { SgArgs a; a.A = (const char*)xb; a.rowlist = list + (size_t)e * NT + r0; a.arow0 = 0; a.lda_bytes = D * 2; a.nr = min(SG_ROWS, rend - r0);
            a.B0 = wgate + (size_t)e * D * 512 + 64 * s; a.B1 = wup + (size_t)e * D * 512 + 64 * s; a.ldn = 512; a.K = D;
            a.out = H; a.out_row0 = hrow0 + r0; a.out_ld = 512; a.out_col0 = 64 * s; a.roww = sw + (size_t)e * NT + r0; a.var = var; sg_unit<1>(lds, a); } }
}
__device__ __forceinline__ void phase_moe2(FK_LAS unsigned char* lds, FK_LAS const int* tab, const bf16_t* H, const float* wdown, bf16_t* Y2, int var) {
#pragma unroll 1
    for (int u = fk_bid(), nb = fk_nblk(); u < 512; u += nb) { const int xcd = u & 7, q = u >> 3, e = xcd + 8 * (q >> 4), s = q & 15; const int ne = tab[80 + e], hrow0 = tab[40 + e];
        const int rbeg = 0, rend = ne;
#pragma unroll 1
        for (int r0 = rbeg; r0 < rend; r0 += SG_ROWS) { SgArgs a; a.A = (const char*)H; a.rowlist = nullptr; a.arow0 = hrow0 + r0; a.lda_bytes = 512 * 2; a.nr = min(SG_ROWS, rend - r0);
            a.B0 = wdown + (size_t)e * 512 * D + 128 * s; a.B1 = nullptr; a.ldn = D; a.K = 512;
            a.out = Y2; a.out_row0 = hrow0 + r0; a.out_ld = D; a.out_col0 = 128 * s; a.roww = nullptr; a.var = var; sg_unit<2>(lds, a); } }
}
}
namespace fk {
struct EpiBf16Q {
    static constexpr bool PERM = true;
    bf16_t* O; int ldc, qcols; float qscale;
    __device__ __forceinline__ void operator()(const f32x4 (&acc)[2][2][4][2], const GUnit& u, int wr, int wc, int fr, int fq) const {
        const int row0 = u.pm * BM + wr * 64 + fr;
#pragma unroll
        for (int bj = 0; bj < 2; ++bj) { const int gc = u.pn * BM + bj * HALF + wc * 32 + 8 * fq; const float sc = gc < qcols ? qscale : 1.0f;
#pragma unroll
            for (int ai = 0; ai < 2; ++ai)
#pragma unroll
                for (int m = 0; m < 4; ++m) *(u32x4*)(O + (size_t)(row0 + ai * HALF + m * 16) * ldc + gc) = pack8(acc[ai][bj][m][0] * sc, acc[ai][bj][m][1] * sc); }
    }
};
__device__ __forceinline__ void fox_cumsum_lds(const float* lsig, FK_LAS float* cfl, FK_LAS double* wtot, const int b, const int h) {
    const int tid = fk_tid(), lane = tid & 63, wid = tid >> 6;
    __syncthreads();
    const f32x4 v = *(const f32x4*)(lsig + (size_t)(b * 16 + h) * S + 4 * tid);
    const double s0 = (double)v[0], s1 = s0 + (double)v[1], s2 = s1 + (double)v[2], s3 = s2 + (double)v[3];
    double incl = s3;
#pragma unroll
    for (int o = 1; o < 64; o <<= 1) { const double u = __shfl_up(incl, o); if (lane >= o) incl += u; }
    if (lane == 63) wtot[wid] = incl;
    __syncthreads();
    double off = incl - s3;
#pragma unroll
    for (int w = 0; w < 7; ++w) if (w < wid) off += wtot[w];
    f32x4 o4; o4[0] = (float)((off + s0) * 1.4426950408889634); o4[1] = (float)((off + s1) * 1.4426950408889634); o4[2] = (float)((off + s2) * 1.4426950408889634); o4[3] = (float)((off + s3) * 1.4426950408889634);
    *(FK_LAS f32x4*)(cfl + 4 * tid) = o4;
    __syncthreads();
}
struct EpiDsaIn {
    static constexpr bool PERM = true;
    bf16_t *q, *k, *v, *qidx, *kidx; float* widx;
    __device__ __forceinline__ void operator()(const f32x4 (&acc)[2][2][4][2], const GUnit& u, int wr, int wc, int fr, int fq) const {
        const int row0 = u.pm * BM + wr * 64 + fr;
#pragma unroll
        for (int bj = 0; bj < 2; ++bj) { const int gc = u.pn * BM + bj * HALF + wc * 32 + 8 * fq;
            bf16_t* dst; int ld, c; float sc = 1.0f;
            if (gc < 2048) { dst = q; ld = 2048; c = gc; sc = QSCALE_128; } else if (gc < 2176) { dst = k; ld = 128; c = gc - 2048; } else if (gc < 2304) { dst = v; ld = 128; c = gc - 2176; }
            else if (gc < 3328) { dst = qidx; ld = 1024; c = gc - 2304; } else if (gc < 3392) { dst = kidx; ld = 64; c = gc - 3328; } else { dst = nullptr; ld = 0; c = gc - 3392; }
#pragma unroll
            for (int ai = 0; ai < 2; ++ai)
#pragma unroll
                for (int m = 0; m < 4; ++m) { const int row = row0 + ai * HALF + m * 16;
                    if (dst) *(u32x4*)(dst + (size_t)row * ld + c) = pack8(acc[ai][bj][m][0] * sc, acc[ai][bj][m][1] * sc);
                    else if (c < 16) { *(f32x4*)(widx + (size_t)row * 16 + c) = acc[ai][bj][m][0] * 0.03125f; *(f32x4*)(widx + (size_t)row * 16 + c + 4) = acc[ai][bj][m][1] * 0.03125f; } } }
    }
};

__device__ __forceinline__ unsigned ord_u32(float f) { const unsigned b = __float_as_uint(f); return b ^ ((b >> 31) ? 0xFFFFFFFFu : 0x80000000u); }
__device__ __forceinline__ int half_sum(int v) {
    v += __shfl_xor(v, 1); v += __shfl_xor(v, 2); v += __shfl_xor(v, 4); v += __shfl_xor(v, 8); v += __shfl_xor(v, 16); return v; }
__device__ __forceinline__ void dsa_index_unit(FK_LAS unsigned char* lds, const bf16_t* qidx, const bf16_t* kidx, const float* widx, unsigned short* sel, int* nsel, const int b, const int g, const int var = 0) {
    const int tid = fk_tid(), wid = __builtin_amdgcn_readfirstlane(tid >> 6), lane = tid & 63, r32 = lane & 31, hi = lane >> 5;
    const int t0 = 16 * g, ntile = (t0 >> 6) + 1, nk = 64 * ntile;
    const int tq = t0 + 2 * wid;
    bf16x8 qa[4]; float wv[16];
    { const int row = r32, q = row >> 4, h = row & 15; const bf16_t* p = qidx + ((size_t)(b * S + tq + q)) * 1024 + h * 64 + hi * 8;
#pragma unroll
      for (int ks = 0; ks < 4; ++ks) qa[ks] = *(const bf16x8*)(p + ks * 16);
#pragma unroll
      for (int r = 0; r < 16; ++r) { const int rw = crow(r, hi); wv[r] = widx[((size_t)(b * S + tq + (rw >> 4))) * 16 + (rw & 15)]; } }
    const int krr = tid >> 3, krc = tid & 7, krw = FK_KRSWZ(krr, krc);
    unsigned uk[64];
    bf16x8 stg[4];
#define DI_LOAD(T) do { _Pragma("unroll") for (int q_ = 0; q_ < 4; ++q_) stg[q_] = *(const bf16x8*)(kidx + ((size_t)(b * S + (T) * 256 + q_ * 64 + krr)) * 64 + krc * 8); } while (0)
#define DI_WRITE(bf) do { _Pragma("unroll") for (int q_ = 0; q_ < 4; ++q_) *(FK_LAS bf16x8*)(lds + (bf) * 32768 + q_ * 8192 + krw) = stg[q_]; } while (0)
    const int nt256 = (nk + 255) >> 8;
    DI_LOAD(0); DI_WRITE(0); __syncthreads();
#pragma unroll
    for (int i = 0; i < 64; ++i) uk[i] = 0u;
#pragma unroll 1
    for (int it = 0; it < 8; ++it) {
#pragma unroll
        for (int i = 0; i < 56; ++i) uk[i] = uk[i + 8];
        if (it < nt256 && !(var & 16)) {
            if (it + 1 < nt256) DI_LOAD(it + 1);
#pragma unroll
            for (int jj = 0; jj < 4; ++jj) { const int j = 4 * it + jj;
                if (j < ntile) {
                    FK_LAS const unsigned char* kb = lds + (it & 1) * 32768 + jj * 8192;
#pragma unroll
                    for (int sub = 0; sub < 2; ++sub) {
                        f32x16 acc;
#pragma unroll
                        for (int r = 0; r < 16; ++r) acc[r] = 0.f;
#pragma unroll
                        for (int ks = 0; ks < 4; ++ks) { const bf16x8 kf = *(FK_LAS const bf16x8*)(kb + FK_KRSWZ(32 * sub + r32, 2 * ks + hi)); acc = __builtin_amdgcn_mfma_f32_32x32x16_bf16(qa[ks], kf, acc, 0, 0, 0); }
                        float s0 = 0.f, s1 = 0.f;
#pragma unroll
                        for (int r = 0; r < 8; ++r) { s0 += fmaxf(acc[r], 0.f) * wv[r]; s1 += fmaxf(acc[8 + r], 0.f) * wv[8 + r]; }
                        auto rr = __builtin_amdgcn_permlane32_swap(__float_as_uint(s0), __float_as_uint(s1), false, false);
                        uk[56 + 2 * jj + sub] = ord_u32(__uint_as_float(rr[0]) + __uint_as_float(rr[1]));
                    }
                } else { uk[56 + 2 * jj] = 0u; uk[56 + 2 * jj + 1] = 0u; }
            }
            if (it + 1 < nt256) DI_WRITE((it + 1) & 1);
            __syncthreads();
        } else {
#pragma unroll
            for (int q_ = 0; q_ < 8; ++q_) uk[56 + q_] = 0u; }
    }
#undef DI_LOAD
#undef DI_WRITE
    const int t = tq + hi;
    unsigned short* so = sel + ((size_t)(b * S + t)) * 256;
    int base = 0;
    if (nk <= 256 || (var & 8)) {
#pragma unroll
        for (int s = 0; s < 8; ++s) { const int key = 32 * s + r32; so[key] = (unsigned short)(key < nk ? key : 0); }
        base = nk;
    } else {
        unsigned T = 0u; bool done = false;
#pragma unroll 1
        for (int bit = 31; bit >= 0; --bit) { const unsigned cand = T | (1u << bit); int c = 0;
#pragma unroll
            for (int s = 0; s < 64; ++s) c += (uk[s] >= cand) ? 1 : 0;
            c = half_sum(c); if (!done && c >= 256) { T = cand; done = (c == 256); }
            if (__all(done)) break; }
        int cgt = 0;
#pragma unroll
        for (int s = 0; s < 64; ++s) cgt += (uk[s] > T) ? 1 : 0;
        cgt = half_sum(cgt);
        const int need = 256 - cgt; int eqb = 0;
#pragma unroll
        for (int s = 0; s < 64; ++s) { const int key = 32 * s + r32; const unsigned u = uk[s];
            const bool iseq = (u == T);
            const unsigned long long em = __ballot(iseq); const unsigned eh = hi ? (unsigned)(em >> 32) : (unsigned)em; const int erank = eqb + __popc(eh & ((1u << r32) - 1u)); eqb += __popc(eh);
            const bool take = (u > T) || (iseq && erank < need);
            const unsigned long long tm = __ballot(take); const unsigned th = hi ? (unsigned)(tm >> 32) : (unsigned)tm; const int pos = base + __popc(th & ((1u << r32) - 1u)); base += __popc(th);
            if (take) so[pos] = (unsigned short)key; }
    }
    if (r32 == 0) nsel[b * S + t] = base;
}

constexpr int DS_T5 = 131072, DS_LUT = 133120, DS_SEL = 135168;
__device__ __forceinline__ void phase_dsa_attn(FK_LAS unsigned char* lds, const bf16_t* dq, const bf16_t* dk, const bf16_t* dv, const unsigned short* sel, const int* nsel, const float* t5, bf16_t* o) {
    const int tid = fk_tid(), wid = __builtin_amdgcn_readfirstlane(tid >> 6), lane = tid & 63, c16 = lane & 15, g = lane >> 4;
    FK_LAS float* t5l = (FK_LAS float*)(lds + DS_T5); FK_LAS unsigned char* lut = lds + DS_LUT;
    for (int i = tid; i < 512; i += NTHR) t5l[i] = t5[i] * LOG2E;
    for (int n = tid; n < 2048; n += NTHR) { int bk; if (n < 8) bk = n; else { bk = 8 + (int)(logf((float)n / 8.0f) / 2.772588722239781f * 8.0f); if (bk > 15) bk = 15; } lut[n] = (unsigned char)bk; }
    __syncthreads();
    FK_LAS unsigned char* vst = lds + wid * 16384;
    FK_LAS unsigned short* sell = (FK_LAS unsigned short*)(lds + DS_SEL + wid * 512);
    const unsigned vbase = (unsigned)(size_t)vst;
#pragma unroll 1
    for (int tg = fk_bid() * 8 + wid; tg < NT; tg += fk_nblk() * 8) {
        const int b = tg >> 11, t = tg & (S - 1); const int cnt = nsel[tg];
        const bf16_t* kb = dk + (size_t)b * S * 128; const bf16_t* vb = dv + (size_t)b * S * 128;
        { const u32x2 s4 = *(const u32x2*)(sel + (size_t)tg * 256 + lane * 4); *(FK_LAS u32x2*)(sell + lane * 4) = s4; }
        bf16x8 qf[4];
#pragma unroll
        for (int ks = 0; ks < 4; ++ks) qf[ks] = *(const bf16x8*)(dq + (size_t)tg * 2048 + c16 * 128 + ks * 32 + g * 8);
        asm volatile("s_waitcnt lgkmcnt(0)" ::: "memory");
        f32x4 sc[16];
#pragma unroll
        for (int ib = 0; ib < 4; ++ib) {
            bf16x8 kf[4][4];
#pragma unroll
            for (int u = 0; u < 4; ++u) { const int kk = sell[16 * (4 * ib + u) + c16]; const bf16_t* kr = kb + (size_t)kk * 128 + g * 8;
#pragma unroll
                for (int ks = 0; ks < 4; ++ks) kf[u][ks] = *(const bf16x8*)(kr + ks * 32); }
#pragma unroll
            for (int u = 0; u < 4; ++u) { f32x4 a = {0.f, 0.f, 0.f, 0.f};
#pragma unroll
                for (int ks = 0; ks < 4; ++ks) a = __builtin_amdgcn_mfma_f32_16x16x32_bf16(kf[u][ks], qf[ks], a, 0, 0, 0);
                sc[4 * ib + u] = a; }
        }
        float mx = -3.0e38f;
#pragma unroll
        for (int i = 0; i < 16; ++i) { const u32x2 k4 = *(FK_LAS const u32x2*)(sell + 16 * i + 4 * g);
#pragma unroll
            for (int r = 0; r < 4; ++r) { const int kk = (r < 2 ? (k4.x >> (16 * r)) : (k4.y >> (16 * (r - 2)))) & 0xffff; const int rel = kk - t; const int n = rel < 0 ? -rel : rel; const int bk = (rel > 0 ? 16 : 0) + lut[n];
                float v = sc[i][r] + t5l[bk * 16 + c16]; v = (16 * i + 4 * g + r < cnt) ? v : -__builtin_inff(); sc[i][r] = v; mx = fmaxf(mx, v); } }
        mx = fmaxf(mx, __shfl_xor(mx, 16)); mx = fmaxf(mx, __shfl_xor(mx, 32));
        float sum = 0.f;
#pragma unroll
        for (int i = 0; i < 16; ++i)
#pragma unroll
            for (int r = 0; r < 4; ++r) { const float p = __builtin_amdgcn_exp2f(sc[i][r] - mx); sc[i][r] = p; sum += p; }
        sum += __shfl_xor(sum, 16); sum += __shfl_xor(sum, 32);
        const float inv = __builtin_amdgcn_rcpf(sum);
        u32x4 pw[8];
#pragma unroll
        for (int c = 0; c < 8; ++c) pw[c] = pack8(sc[2 * c], sc[2 * c + 1]);
        f32x4 oa[8];
#pragma unroll
        for (int d = 0; d < 8; ++d) oa[d] = (f32x4){0.f, 0.f, 0.f, 0.f};
        bf16x8 vv[2][8];
#define DS_VLOAD(c, B) do { _Pragma("unroll") for (int it = 0; it < 8; ++it) { const int idx = lane + 64 * it, lr = idx >> 4, ch = idx & 15; const int kk = sell[32 * (c) + lr]; vv[B][it] = *(const bf16x8*)(vb + (size_t)kk * 128 + ch * 8); } } while (0)
        DS_VLOAD(0, 0);
#pragma unroll
        for (int c = 0; c < 8; ++c) {
            if (32 * c < cnt) {
                if (c + 1 < 8 && 32 * (c + 1) < cnt) DS_VLOAD(c + 1, (c + 1) & 1);
#pragma unroll
                for (int it = 0; it < 8; ++it) { const int idx = lane + 64 * it, lr = idx >> 4, ch = idx & 15; *(FK_LAS bf16x8*)(vst + lr * 256 + ((ch ^ ((lr & 7) << 1)) << 4)) = vv[c & 1][it]; }
                const bf16x8 pf = *reinterpret_cast<const bf16x8*>(&pw[c]);
                asm volatile("s_waitcnt lgkmcnt(0)" ::: "memory");
                const int q4 = c16 >> 2, p4 = c16 & 3; const int rowA = 4 * g + q4, rowB = 16 + 4 * g + q4;
#pragma unroll
                for (int d = 0; d < 8; ++d) { s16x4 lo, hi4;
                    const unsigned aA = vbase + rowA * 256 + (((2 * d + (p4 >> 1)) ^ ((rowA & 7) << 1)) << 4) + (p4 & 1) * 8;
                    const unsigned aB = vbase + rowB * 256 + (((2 * d + (p4 >> 1)) ^ ((rowB & 7) << 1)) << 4) + (p4 & 1) * 8;
                    asm volatile("ds_read_b64_tr_b16 %0, %1" : "=&v"(lo) : "v"(aA) : "memory");
                    asm volatile("ds_read_b64_tr_b16 %0, %1" : "=&v"(hi4) : "v"(aB) : "memory");
                    asm volatile("s_waitcnt lgkmcnt(0)" ::: "memory"); __builtin_amdgcn_sched_barrier(0);
                    oa[d] = __builtin_amdgcn_mfma_f32_16x16x32_bf16((bf16x8){lo[0], lo[1], lo[2], lo[3], hi4[0], hi4[1], hi4[2], hi4[3]}, pf, oa[d], 0, 0, 0); }
            }
        }
#undef DS_VLOAD
#pragma unroll
        for (int d = 0; d < 8; ++d) { u32x2 p; p.x = cvt_pk_bf16(oa[d][0] * inv, oa[d][1] * inv); p.y = cvt_pk_bf16(oa[d][2] * inv, oa[d][3] * inv);
            *(u32x2*)(o + (size_t)tg * 2048 + c16 * 128 + 16 * d + 4 * g) = p; }
    }
}
}
#define XB_TMO      128
#define XB_XCNT(j)  (256  + 64 * (j))
#define XB_XSUB(j)  (1280 + 64 * (j))
#define XB_XGEN(j)  (2304 + 64 * (j))
#define XB_TOP      3328
#define XB_TOPGEN   3392
#define XCD_BAR_WORDS 3456
#define XB_SPIN_CAP (1u << 18)
#define LAS __attribute__((address_space(3)))

__device__ __forceinline__ unsigned xb_ld(unsigned* p)              { return __hip_atomic_load(p, __ATOMIC_RELAXED, __HIP_MEMORY_SCOPE_AGENT); }
__device__ __forceinline__ unsigned xb_add(unsigned* p, unsigned v) { return __hip_atomic_fetch_add(p, v, __ATOMIC_RELAXED, __HIP_MEMORY_SCOPE_AGENT); }
__device__ __forceinline__ unsigned xb_xcc_id() { return (unsigned)__builtin_amdgcn_s_getreg((3 << 11) | 20) & 0xFu; }
#define XB_SPIN(cond, bar) do { unsigned _sp = 0; while (cond) { __builtin_amdgcn_s_sleep(1); \
    if ((++_sp & 255u) == 0u) { if (xb_ld(&(bar)[XB_TMO])) break; if (_sp > XB_SPIN_CAP) { atomicAdd(&(bar)[XB_TMO], 1u); break; } } } } while (0)

struct XcdBarrier {
    unsigned* bar; unsigned x;
    volatile LAS unsigned* st;
};

__device__ __forceinline__ XcdBarrier xcd_barrier_post(unsigned* bar, volatile LAS unsigned* st) {
    XcdBarrier b; b.bar = bar; b.x = xb_xcc_id(); b.st = st;
    if (threadIdx.x == 0) (void)xb_add(&bar[XB_XCNT(b.x)], 1u);
    return b;
}
__device__ __forceinline__ void xcd_barrier_complete(unsigned* bar, unsigned x, unsigned& nloc, unsigned& nx) {
    const unsigned G = gridDim.x * gridDim.y * gridDim.z;
    unsigned sum, cnt, mine, sp = 0u;
    for (;;) {
        sum = 0u; cnt = 0u; mine = 0u;
#pragma unroll
        for (unsigned j = 0; j < 16; ++j) { const unsigned c = xb_ld(&bar[XB_XCNT(j)]); sum += c; cnt += (c > 0u) ? 1u : 0u; mine = (j == x) ? c : mine; }
        if (sum == G) break;
        __builtin_amdgcn_s_sleep(1);
        if ((++sp & 255u) == 0u) { if (xb_ld(&bar[XB_TMO])) break; if (sp > XB_SPIN_CAP) { atomicAdd(&bar[XB_TMO], 1u); break; } }
    }
    nloc = mine > 0u ? mine : 1u; nx = cnt > 0u ? cnt : 1u;
}

__device__ __forceinline__ void xcd_barrier(const XcdBarrier& b) {
    asm volatile("s_waitcnt vmcnt(0)" ::: "memory");
    __syncthreads();
    if (threadIdx.x == 0) {
        unsigned* bar = b.bar;
        __builtin_amdgcn_s_waitcnt(0);
        unsigned nloc = b.st[0], nx = b.st[1];
        if (nloc == 0u) { xcd_barrier_complete(bar, b.x, nloc, nx); b.st[0] = nloc; b.st[1] = nx; }
        const unsigned old = xb_add(&bar[XB_XSUB(b.x)], 1u);
        const unsigned gen = old / nloc;
        if (old + 1u == (gen + 1u) * nloc) {
            __builtin_amdgcn_fence(__ATOMIC_RELEASE, "agent");
            asm volatile("s_waitcnt vmcnt(0)" ::: "memory");
            const unsigned og = xb_add(&bar[XB_TOP], 1u);
            const unsigned tg = og / nx;
            if (og + 1u == (tg + 1u) * nx) xb_add(&bar[XB_TOPGEN], 1u);
            else XB_SPIN(xb_ld(&bar[XB_TOPGEN]) == tg, bar);
            __builtin_amdgcn_fence(__ATOMIC_ACQUIRE, "agent");
            xb_add(&bar[XB_XGEN(b.x)], 1u);
            asm volatile("s_waitcnt vmcnt(0)" ::: "memory");
        } else {
            XB_SPIN(xb_ld(&bar[XB_XGEN(b.x)]) == gen, bar);
            __builtin_amdgcn_fence(__ATOMIC_ACQUIRE, "agent");
            asm volatile("s_waitcnt vmcnt(0)" ::: "memory");
        }
    }
    __syncthreads();
}


__device__ __forceinline__ void xcd_barrier_slim(const XcdBarrier& b) {
    asm volatile("s_waitcnt vmcnt(0)" ::: "memory");
    __syncthreads();
    if (threadIdx.x == 0) {
        unsigned* bar = b.bar;
        __builtin_amdgcn_s_waitcnt(0);
        unsigned nloc = b.st[0], nx = b.st[1];
        if (nloc == 0u) { nloc = 1u; nx = 1u; }
        const unsigned old = xb_add(&bar[XB_XSUB(b.x)], 1u);
        const unsigned gen = old / nloc;
        if (old + 1u == (gen + 1u) * nloc) {
            __builtin_amdgcn_fence(__ATOMIC_RELEASE, "agent");
            asm volatile("s_waitcnt vmcnt(0)" ::: "memory");
            const unsigned og = xb_add(&bar[XB_TOP], 1u);
            const unsigned tg = og / nx;
            if (og + 1u == (tg + 1u) * nx) xb_add(&bar[XB_TOPGEN], 1u);
            else XB_SPIN(xb_ld(&bar[XB_TOPGEN]) == tg, bar);
            __builtin_amdgcn_fence(__ATOMIC_ACQUIRE, "agent");
            xb_add(&bar[XB_XGEN(b.x)], 1u);
            asm volatile("s_waitcnt vmcnt(0)" ::: "memory");
        } else {
            XB_SPIN(xb_ld(&bar[XB_XGEN(b.x)]) == gen, bar);
            __builtin_amdgcn_fence(__ATOMIC_ACQUIRE, "agent");
            asm volatile("s_waitcnt vmcnt(0)" ::: "memory");
        }
    }
    __syncthreads();
}

namespace fk {
template <int FK_PHASE_MASK_, int ML>
__global__ void __launch_bounds__(NTHR, 2) fk_fwd(const FWK kw, const CvtTable T, const int p_lo, const int p_hi) {
    extern __shared__ __attribute__((aligned(16))) unsigned char shm_[];
    FK_LAS unsigned char* lds = (FK_LAS unsigned char*)shm_;
    FK_LAS unsigned* xbw = (FK_LAS unsigned*)(lds + LDS_BYTES - 16);
    if (threadIdx.x == 0) { xbw[0] = 0u; xbw[1] = 0u; xbw[2] = 0u; xbw[3] = 0u; }
    __syncthreads();
#define FWK_FIELDS(X) X(x_in) X(t5) X(mla_w_in) X(mla_qn) X(mla_kvn) X(mla_wq) X(mla_wkv) X(mla_wo) X(fox_w_in) X(fox_bf) X(fox_wo) X(dsa_w_in) X(dsa_wo) X(ln_g) X(ln_b) X(wgrp) X(bgrp) X(wrt) X(brt) X(wgate) X(wup) X(wdown) X(out) X(ws) X(moe_bias_gu) X(moe_bias_d) X(var)
    FK_LAS unsigned long long* kl = (FK_LAS unsigned long long*)(lds + 146944);
    if (threadIdx.x == 0) { int i_ = 0;
#define FWK_PUT(f) kl[i_++] = (unsigned long long)kw.f;
        FWK_FIELDS(FWK_PUT)
#undef FWK_PUT
    }
    __syncthreads();
    XcdBarrier bar = xcd_barrier_post((unsigned*)(kw.ws + WsMap<ML>::CTL), (volatile LAS unsigned*)xbw);
    FK_LAS int* tab = (FK_LAS int*)(lds + TAB_OFF);
    if (p_hi - p_lo > 1) xcd_barrier(bar);
#define PH_ON(k) (((FK_PHASE_MASK_) >> (k)) & 1)
#ifndef FK_REP_MASK
#define FK_REP_MASK 0
#endif
#define PH_REP(k) ((((FK_REP_MASK) >> (k)) & 1) ? 2 : 1)
#define FWK_GET(f) { const unsigned long long v_ = kl[i_++]; const unsigned lo_ = __builtin_amdgcn_readfirstlane((unsigned)v_), hi_ = __builtin_amdgcn_readfirstlane((unsigned)(v_ >> 32)); kq_.f = FkCvt<decltype(kq_.f)>::get(((unsigned long long)hi_ << 32) | lo_); }
#define PH_BEGIN(id) if ((id) >= p_lo && (id) < p_hi) { if ((id) > p_lo) xcd_barrier_slim(bar); FWK kq_; { int i_ = 0; FWK_FIELDS(FWK_GET) } const FW w = make_fw<ML>(kq_, kq_.ws);
#define PH_END }
#define PH_BEGINR(id, bit) PH_BEGIN(id) for (int rep_ = 0; rep_ < PH_REP(bit); ++rep_)
    if constexpr (PH_ON(8)) { PH_BEGINR(0, 8) phase_prologue(w, T, lds); PH_END }
#pragma unroll 1
    for (int layer = 0; layer < 4; ++layer) {
        const int kind = layer % 3, j = layer / 3, pb = 1 + 8 * layer;
        if (kind == 0) {
#define MLA_PTRS bf16_t* cq = (bf16_t*)w.arena; bf16_t* ckv = cq + (size_t)NT * 512; bf16_t* kr = ckv + (size_t)NT * 512; bf16_t* q = kr + (size_t)NT * 64; bf16_t* kv = q + (size_t)NT * 3072; (void)cq; (void)ckv; (void)kr; (void)q; (void)kv;
            if constexpr (PH_ON(0)) PH_BEGINR(pb + 0, 0) { MLA_PTRS RectSched s; s.init(w.xb0, D, w.mla_win_t + (size_t)j * 1280 * D, D, NT, 1280); EpiMlaIn e{cq, ckv, kr, w.ss, w.rope_cs}; gemm_phase(lds, D, D, s, e); } PH_END
            if constexpr (PH_ON(1)) PH_BEGINR(pb + 1, 1) { MLA_PTRS Rect2Sched s; s.s0.init(cq, 512, w.mla_wq_t + (size_t)j * 3072 * 512, 512, NT, 3072); s.s1.init(ckv, 512, w.mla_wkv_t + (size_t)j * 4096 * 512, 512, NT, 4096); s.n0 = 0;
                EpiMlaQKV e{q, kv, w.ss, w.rope_cs}; gemm_phase(lds, 512, 512, s, e); } PH_END
            if constexpr (PH_ON(2)) PH_BEGINR(pb + 2, 2) { MLA_PTRS
#pragma unroll 1
                for (int p = fk_bid(), np_ = fk_nblk(); p < 256; p += np_) { const int bh = p >> 2, x = p & 3, b = bh >> 4, h = bh & 15;
                    AttnPtrs P; P.Q = q + (size_t)b * S * 3072 + h * 192; P.K = kv + (size_t)b * S * 4096 + h * 256; P.V = P.K + 128; P.KR = kr + (size_t)b * S * 64; P.CF = nullptr; P.O = w.o + (size_t)b * S * D + h * 128; P.qld = 3072; P.kld = 4096;
                    attn_block<0>(lds, P, 7 - x); attn_block<0>(lds, P, x); } } PH_END
        }
        if (kind == 1) {
#define FOX_PTRS bf16_t* qkv = (bf16_t*)w.arena;
            if constexpr (PH_ON(9)) PH_BEGINR(pb + 0, 9) { FOX_PTRS RectSched s; s.init(w.xb0, D, w.fox_win_t, D, NT, 6144); EpiBf16Q e{qkv, 6144, 2048, QSCALE_128}; gemm_phase(lds, D, D, s, e); } PH_END
            if constexpr (PH_ON(10)) PH_BEGINR(pb + 2, 10) { FOX_PTRS
#pragma unroll 1
                for (int p = fk_bid(), np_ = fk_nblk(); p < 256; p += np_) { const int bh = p >> 2, x = p & 3, b = bh >> 4, h = bh & 15;
                    AttnPtrs P; P.Q = qkv + (size_t)b * S * 6144 + h * 128; P.K = P.Q + 2048; P.V = P.Q + 4096; P.KR = nullptr; P.CF = nullptr; P.O = w.o + (size_t)b * S * D + h * 128; P.qld = 6144; P.kld = 6144;
                    fox_cumsum_lds(w.flog, (FK_LAS float*)(lds + AT_CF), (FK_LAS double*)(lds + AT_WS), b, h);
                    attn_block<1>(lds, P, 7 - x); attn_block<1>(lds, P, x); } } PH_END
        }
        if (kind == 2) {
#define DSA_PTRS bf16_t* dq = (bf16_t*)w.arena; bf16_t* dk = dq + (size_t)NT * 2048; bf16_t* dv = dk + (size_t)NT * 128; bf16_t* qidx = dv + (size_t)NT * 128; bf16_t* kidx = qidx + (size_t)NT * 1024; \
            float* widx = (float*)(kidx + (size_t)NT * 64); unsigned short* sel = (unsigned short*)(widx + (size_t)NT * 16); int* nsel = (int*)(sel + (size_t)NT * 256); (void)dq; (void)dk; (void)dv; (void)qidx; (void)kidx; (void)widx; (void)sel; (void)nsel;
            if constexpr (PH_ON(11)) PH_BEGINR(pb + 0, 11) { DSA_PTRS RectSched s; s.init(w.xb0, D, w.dsa_win_t, D, NT, 3584); EpiDsaIn e{dq, dk, dv, qidx, kidx, widx}; gemm_phase(lds, D, D, s, e); } PH_END
            if constexpr (PH_ON(12)) PH_BEGINR(pb + 1, 12) { DSA_PTRS
#pragma unroll 1
                for (int p = fk_bid(), np_ = fk_nblk(); p < 256; p += np_) { const int b = p >> 6, x = p & 63;
                    dsa_index_unit(lds, qidx, kidx, widx, sel, nsel, b, 127 - x, (int)kq_.var); dsa_index_unit(lds, qidx, kidx, widx, sel, nsel, b, x, (int)kq_.var); } } PH_END
            if constexpr (PH_ON(13)) PH_BEGINR(pb + 2, 13) { DSA_PTRS phase_dsa_attn(lds, dq, dk, dv, sel, nsel, w.t5, w.o); } PH_END
        }
        if constexpr (PH_ON(3)) PH_BEGINR(pb + 3, 3) { const bf16_t* wo_t = kind == 0 ? w.mla_wo_t + (size_t)j * D * D : (kind == 1 ? w.fox_wo_t : w.dsa_wo_t); RectSched s; s.init(w.o, D, wo_t, D, NT, D); EpiBf16Q e{(bf16_t*)w.y, D, 0, 1.0f}; gemm_phase(lds, D, D, s, e); } PH_END
        if constexpr (PH_ON(4)) PH_BEGIN(pb + 4) { LnArgs a; a.x = (layer == 0) ? w.x_in : w.xA; a.yb = (const bf16_t*)w.y; a.Y2 = nullptr; a.te = nullptr; a.tpos = nullptr; a.cnt = nullptr; a.g = w.ln_g + (size_t)(layer * 2) * D; a.b = w.ln_b + (size_t)(layer * 2) * D; a.xo = w.xB; a.xbo = w.xb1; a.out2 = nullptr; a.xqo = nullptr;
            a.w4 = (const f32x4*)w.wr4 + (size_t)layer * 128 * 3 * 64; a.ntile = 3; a.bgrp = w.bgrp + layer * 4; a.brt = w.brt + layer * 32; a.rcnt = w.moe_cnt + layer * 1024; a.ote = w.te; a.otpos = w.tpos; a.otw = w.tw; a.list = w.list; a.sw = w.sw; a.flog = nullptr; a.fbias = nullptr;
            phase_ln(a, lds);
            } PH_END
        if constexpr (PH_ON(5)) PH_BEGINR(pb + 5, 5) { moe_tables(w.moe_cnt + layer * 1024, tab); phase_moe1(lds, tab, w.xb1, w.list, w.sw, w.wgate + (size_t)layer * 32 * D * 512, w.wup + (size_t)layer * 32 * D * 512, w.H, (int)kq_.var); } PH_END
        if constexpr (PH_ON(6)) PH_BEGINR(pb + 6, 6) { moe_tables(w.moe_cnt + layer * 1024, tab); phase_moe2(lds, tab, w.H, w.wdown + (size_t)layer * 32 * 512 * D, w.Y2, (int)kq_.var); } PH_END
        if constexpr (PH_ON(7)) PH_BEGINR(pb + 7, 7) { LnArgs a; a.x = w.xB; a.yb = nullptr; a.Y2 = w.Y2; a.te = w.te; a.tpos = w.tpos; a.cnt = w.moe_cnt + layer * 1024; a.g = w.ln_g + (size_t)(layer * 2 + 1) * D; a.b = w.ln_b + (size_t)(layer * 2 + 1) * D; a.xo = w.xA; a.xbo = w.xb0; a.xqo = nullptr;
            a.out2 = (layer == 3) ? w.out : nullptr; a.w4 = (layer == 0) ? (const f32x4*)w.fox_wf4 : nullptr; a.ntile = (layer == 0) ? 1 : 0; a.bgrp = nullptr; a.brt = nullptr; a.rcnt = nullptr; a.ote = nullptr; a.otpos = nullptr; a.otw = nullptr; a.list = nullptr; a.sw = nullptr; a.flog = w.flog; a.fbias = w.fox_bf;
            phase_ln(a, lds); } PH_END
    }
#undef PH_BEGIN
#undef PH_END
}

constexpr size_t CTL_BYTES = 65536;
static FWK make_fwk(void* const* d_in, void* d_out, char* ws) {
    FWK k; memset(&k, 0, sizeof(k));
    k.x_in = (const float*)d_in[0]; k.t5 = (const float*)d_in[1]; k.mla_w_in = (const float*)d_in[2]; k.mla_qn = (const float*)d_in[3]; k.mla_kvn = (const float*)d_in[4]; k.mla_wq = (const float*)d_in[5];
    k.mla_wkv = (const float*)d_in[6]; k.mla_wo = (const float*)d_in[7]; k.fox_w_in = (const float*)d_in[8]; k.fox_bf = (const float*)d_in[9]; k.fox_wo = (const float*)d_in[10]; k.dsa_w_in = (const float*)d_in[11];
    k.dsa_wo = (const float*)d_in[12]; k.ln_g = (const float*)d_in[13]; k.ln_b = (const float*)d_in[14]; k.wgrp = (const float*)d_in[15]; k.bgrp = (const float*)d_in[16]; k.wrt = (const float*)d_in[17];
    k.brt = (const float*)d_in[18]; k.wgate = (const float*)d_in[19]; k.wup = (const float*)d_in[20]; k.wdown = (const float*)d_in[21]; k.out = (float*)d_out; k.ws = ws;
    return k;
}
static void add_job(CvtTable& T, const float* s0, const float* s1, const float* scale, bf16_t* dst, long sbs, long dbs, int K, int N, int Np, int map, int nbatch) {
    CvtJob& J = T.j[T.njobs++]; J.src0 = s0; J.src1 = s1; J.scale = scale; J.dst = dst; J.src_bstride = sbs; J.dst_bstride = dbs; J.K = K; J.N = N; J.Np = Np; J.map = map; J.nbatch = nbatch; J.tile0 = T.ntiles;
    J.wide = ((map == MAP_ID || map == MAP_MOE_GU) && (K % 128 == 0) && (Np % 256 == 0) && (N % 4 == 0)) ? 1 : 0;
    T.ntiles += J.wide ? nbatch * (K / 128) * (Np / 256) : nbatch * (K / 64) * (Np / 64);
}
static void build_table(CvtTable& T, const FW& w, int moe_l0, int moe_l1, bool base) {
    memset(&T, 0, sizeof(T)); T.misc = base ? 1 : 0;
    if (base) {
    for (int j = 0; j < 2; ++j) {
        add_job(T, w.mla_w_in + (size_t)j * D * 1088, nullptr, nullptr, w.mla_win_t + (size_t)j * 1280 * D, 0, 0, D, 1088, 1280, MAP_MLA_IN, 1);
        add_job(T, w.mla_wq + (size_t)j * 512 * 3072, nullptr, w.mla_qn + j * 512, w.mla_wq_t + (size_t)j * 3072 * 512, 0, 0, 512, 3072, 3072, MAP_MLA_Q, 1);
        add_job(T, w.mla_wkv + (size_t)j * 512 * 4096, nullptr, w.mla_kvn + j * 512, w.mla_wkv_t + (size_t)j * 4096 * 512, 0, 0, 512, 4096, 4096, MAP_ID, 1);
        add_job(T, w.mla_wo + (size_t)j * D * D, nullptr, nullptr, w.mla_wo_t + (size_t)j * D * D, 0, 0, D, D, D, MAP_ID, 1);
    }
    add_job(T, w.fox_w_in, nullptr, nullptr, w.fox_win_t, 0, 0, D, 6160, 6144, MAP_ID, 1);
    add_job(T, w.fox_wo, nullptr, nullptr, w.fox_wo_t, 0, 0, D, D, D, MAP_ID, 1);
    add_job(T, w.dsa_w_in, nullptr, nullptr, w.dsa_win_t, 0, 0, D, 3408, 3584, MAP_ID, 1);
    add_job(T, w.dsa_wo, nullptr, nullptr, w.dsa_wo_t, 0, 0, D, D, D, MAP_ID, 1);
    }
    for (int l = moe_l0; l < moe_l1; ++l) {
        add_job(T, w.wgate + (size_t)l * 32 * D * 512, w.wup + (size_t)l * 32 * D * 512, nullptr, w.moe_gu_t + (size_t)l * 32 * 1024 * D, (long)D * 512, (long)1024 * D, D, 512, 1024, MAP_MOE_GU, 32);
        add_job(T, w.wdown + (size_t)l * 32 * 512 * D, nullptr, nullptr, w.moe_d_t + (size_t)l * 32 * D * 512, (long)512 * D, (long)D * 512, 512, D, D, MAP_ID, 32);
    }
}
static int g_grid = 0;
static void setup_once() {
    if (g_grid) return;
    int dev = 0, cus = 0, per_cu = 0;
    (void)hipGetDevice(&dev); (void)hipDeviceGetAttribute(&cus, hipDeviceAttributeMultiprocessorCount, dev);
    (void)per_cu;
    if (cus <= 0) cus = 256;
    g_grid = cus;
}
template <int MASK, int ML> static void launch_mask(const FWK& w, const CvtTable& T, int lo, int hi, hipStream_t st) {
    static bool attr = false; if (!attr) { (void)hipFuncSetAttribute((const void*)fk_fwd<MASK, ML>, hipFuncAttributeMaxDynamicSharedMemorySize, LDS_BYTES); attr = true; }
    hipLaunchKernelGGL((fk_fwd<MASK, ML>), dim3(g_grid), dim3(NTHR), LDS_BYTES, st, w, T, lo, hi);
}
#ifdef FK_DEBUG_BUILD
static void launch_phase(const FWK& w, const CvtTable& T, int p, hipStream_t st) {
    if (p == 0) { launch_mask<(1 << 8), 1>(w, T, p, p + 1, st); return; }
    const int layer = (p - 1) >> 3, k = (p - 1) & 7, kind = layer % 3;
    if (k >= 3) { switch (k) { case 3: launch_mask<(1 << 3), 1>(w, T, p, p + 1, st); break; case 4: launch_mask<(1 << 4), 1>(w, T, p, p + 1, st); break; case 5: launch_mask<(1 << 5), 1>(w, T, p, p + 1, st); break;
                               case 6: launch_mask<(1 << 6), 1>(w, T, p, p + 1, st); break; default: launch_mask<(1 << 7), 1>(w, T, p, p + 1, st); break; } return; }
    if (kind == 0) { if (k == 0) launch_mask<(1 << 0), 1>(w, T, p, p + 1, st); else if (k == 1) launch_mask<(1 << 1), 1>(w, T, p, p + 1, st); else launch_mask<(1 << 2), 1>(w, T, p, p + 1, st); }
    else if (kind == 1) { if (k == 0) launch_mask<(1 << 9), 1>(w, T, p, p + 1, st); else if (k == 2) launch_mask<(1 << 10), 1>(w, T, p, p + 1, st); }
    else { if (k == 0) launch_mask<(1 << 11), 1>(w, T, p, p + 1, st); else if (k == 1) launch_mask<(1 << 12), 1>(w, T, p, p + 1, st); else launch_mask<(1 << 13), 1>(w, T, p, p + 1, st); }
}
#endif
}
#ifndef FK_EXTRA
#define FK_EXTRA {}
#endif
extern "C" void kernel_launch(void* const* d_in, const int* in_sizes, int n_in, void* d_out, int out_size, void* d_ws, size_t ws_size, hipStream_t stream) {
    using namespace fk;
    setup_once();
    const FWK k = make_fwk(d_in, d_out, (char*)d_ws);
    const FW w = make_fw<0>(k, k.ws);
    static CvtTable T; build_table(T, w, 0, 0, true);
    (void)hipMemsetAsync(w.bar, 0, CTL_BYTES, stream);
    launch_mask<0x3FFF, 0>(k, T, 0, 33, stream);
    { static const int extra[] = FK_EXTRA; (void)extra; FWK kv = k;
#ifdef FK_VAR
      kv.var = FK_VAR;
#endif
      for (unsigned i = 0; i < sizeof(extra) / sizeof(int); ++i) launch_mask<0x3FFF, 0>(kv, T, extra[i], extra[i] + 1, stream); }
}
```

```cpp
#include <hip/hip_runtime.h>
#include <stdint.h>
#include <math.h>
#include <string.h>
namespace fk {
#define FK_LAS __attribute__((address_space(3)))
typedef unsigned short bf16_t;
typedef short bf16x8 __attribute__((ext_vector_type(8)));
typedef short s16x4 __attribute__((ext_vector_type(4)));
typedef float f32x4 __attribute__((ext_vector_type(4)));
typedef float f32x16 __attribute__((ext_vector_type(16)));
typedef float f32x2 __attribute__((ext_vector_type(2)));
typedef unsigned u32x4 __attribute__((ext_vector_type(4)));
typedef unsigned u32x2 __attribute__((ext_vector_type(2)));
constexpr int NB = 4, S = 2048, D = 2048, NT = NB * S;
constexpr float ALPHA = 1.681792830507429f;
constexpr float LOG2E = 1.4426950408889634f;
__device__ __forceinline__ int fk_tid();
__device__ __forceinline__ int fk_bid();
__device__ __forceinline__ int fk_nblk();
constexpr int BM = 256, BK = 64, HALF = 128, HTB = HALF * BK * 2, STAGE_BYTES = 8 * HTB;

__device__ __forceinline__ unsigned cvt_pk_bf16(float lo, float hi) { unsigned r; asm volatile("v_cvt_pk_bf16_f32 %0, %1, %2" : "=v"(r) : "v"(lo), "v"(hi)); return r; }
__device__ __forceinline__ float bf2f(bf16_t b) { return __uint_as_float(((unsigned)b) << 16); }
__device__ __forceinline__ bf16_t f2bf(float f) { unsigned u = __float_as_uint(f); u += 0x7FFFu + ((u >> 16) & 1u); return (bf16_t)(u >> 16); }

__host__ __device__ __forceinline__ int lds_byte(int r, int c) { const int st = (r >> 4) * 2 + (c >> 5), rr = r & 15, cc = c & 31, ob = rr * 64 + cc * 2; return st * 1024 + (ob ^ (((ob >> 9) & 1) << 5)); }
__host__ __device__ __forceinline__ void stage_rc(int b, int& R, int& C) { const int st = b / 1024, sb = b % 1024, swz = sb ^ (((sb >> 9) & 1) << 5); R = (st >> 1) * 16 + swz / 64; C = (st & 1) * 32 + (swz % 64) / 2; }
__host__ __device__ __forceinline__ int perm32(int rho) { const int n = rho >> 4, i = rho & 15; return 8 * (i >> 2) + 4 * n + (i & 3); }

struct GUnit { const char* A; const char* B; int pm, pn, e, nrows; };

template <class Epi, class Sched>
__device__ __forceinline__ void gemm_phase(FK_LAS unsigned char* lds, const int K, const int ldb, const Sched& S, const Epi& E) {
    const int tid = fk_tid(), wid = __builtin_amdgcn_readfirstlane(tid >> 6), lane = tid & 63, wr = wid >> 2, wc = wid & 3, fr = lane & 15, fq = lane >> 4;
    const int nt = K / BK;
    unsigned voffB[2];
#pragma unroll
    for (int i = 0; i < 2; ++i) { int R_, C_; stage_rc(tid * 16 + i * 8192, R_, C_); const int Rb = Epi::PERM ? ((R_ & ~31) + perm32(R_ & 31)) : R_; voffB[i] = (unsigned)(Rb * ldb + C_) * 2u; }
    const size_t kstep = (size_t)(BK * 2);
    const size_t hstepB = (size_t)HALF * ldb * 2;
    const unsigned ldsw = (unsigned)wid * 1024u;
    const int aoff = lds_byte(wr * 64 + fr, fq * 8), boff = lds_byte(wc * 32 + fr, fq * 8);
#define PG8_SA(b, h) (((b) * 2 + (h)) * HTB)
#define PG8_SB(b, h) ((4 + (b) * 2 + (h)) * HTB)
#define PG8_STAGE2(bufoff, gbase, v0, v1) do { \
        __builtin_amdgcn_global_load_lds((const unsigned*)((const char*)(gbase) + (v0)), (FK_LAS unsigned*)(lds + (bufoff) + ldsw), 16, 0, 0); \
        __builtin_amdgcn_global_load_lds((const unsigned*)((const char*)(gbase) + (v1)), (FK_LAS unsigned*)(lds + (bufoff) + ldsw + 8192), 16, 0, 0); } while (0)
#define PG8_STAGEB(bufoff, gbase) PG8_STAGE2(bufoff, gbase, voffB[0], voffB[1])
#define PG8_LDA(dst, b, h) do { _Pragma("unroll") for (int m = 0; m < 4; ++m) _Pragma("unroll") for (int k = 0; k < 2; ++k) dst[m][k] = *(const FK_LAS bf16x8*)(lds + PG8_SA(b, h) + aoff + m * 2048 + k * 1024); } while (0)
#define PG8_LDB(dst, b, h) do { _Pragma("unroll") for (int n = 0; n < 2; ++n) _Pragma("unroll") for (int k = 0; k < 2; ++k) dst[n][k] = *(const FK_LAS bf16x8*)(lds + PG8_SB(b, h) + boff + n * 2048 + k * 1024); } while (0)
#define PG8_MMA(ai, bj, At, Bt) do { __builtin_amdgcn_s_setprio(1); _Pragma("unroll") for (int m = 0; m < 4; ++m) _Pragma("unroll") for (int n = 0; n < 2; ++n) _Pragma("unroll") for (int k = 0; k < 2; ++k) \
        acc[ai][bj][m][n] = __builtin_amdgcn_mfma_f32_16x16x32_bf16(Bt[n][k], At[m][k], acc[ai][bj][m][n], 0, 0, 0); __builtin_amdgcn_s_setprio(0); } while (0)
#define PG8_WAIT_V(n) asm volatile("s_waitcnt vmcnt(" #n ")" ::: "memory")
#define PG8_WAIT_L(n) asm volatile("s_waitcnt lgkmcnt(" #n ")" ::: "memory")
#define PG8_BAR __builtin_amdgcn_s_barrier()
#define PG8_SCHED __builtin_amdgcn_sched_barrier(0)
    GUnit cur, nxt; int ui = 0;
    if (!S.next(0, cur)) return;
    f32x4 acc[2][2][4][2];
#pragma unroll
    for (int a = 0; a < 2; ++a)
#pragma unroll
        for (int b = 0; b < 2; ++b)
#pragma unroll
            for (int m = 0; m < 4; ++m)
#pragma unroll
                for (int n = 0; n < 2; ++n) acc[a][b][m][n] = (f32x4){0.f, 0.f, 0.f, 0.f};
    bf16x8 At[4][2], B0[2][2], B1[2][2];
    unsigned oc[2][2], on[2][2];
    S.a_offs(cur, tid, oc);
    const char* cA = cur.A; const char* cB = cur.B;
    PG8_STAGEB(PG8_SB(0, 0), cB); PG8_STAGE2(PG8_SA(0, 0), cA, oc[0][0], oc[0][1]); PG8_STAGEB(PG8_SB(0, 1), cB + hstepB); PG8_STAGE2(PG8_SA(0, 1), cA, oc[1][0], oc[1][1]);
    if (wr == 1) PG8_BAR;
    PG8_WAIT_V(4); PG8_BAR;
    PG8_STAGEB(PG8_SB(1, 0), cB + kstep); PG8_STAGE2(PG8_SA(1, 0), cA + kstep, oc[0][0], oc[0][1]); PG8_STAGEB(PG8_SB(1, 1), cB + hstepB + kstep);
    PG8_WAIT_V(6); PG8_BAR;
    for (;;) {
        const bool has_next = S.next(ui + 1, nxt);
        if (has_next) S.a_offs(nxt, tid, on);
        else {
#pragma unroll
            for (int h = 0; h < 2; ++h)
#pragma unroll
                for (int i = 0; i < 2; ++i) on[h][i] = oc[h][i]; }
        const char* nA = has_next ? nxt.A : cA; const char* nB = has_next ? nxt.B : cB;
        for (int t = 0; t < nt; t += 2) {
            const bool last = (t == nt - 2);
            const char* a1 = cA + (size_t)(t + 1) * kstep;
            const char* a2 = last ? nA : cA + (size_t)(t + 2) * kstep; const char* b2 = last ? nB : cB + (size_t)(t + 2) * kstep;
            const char* a3 = a2 + kstep; const char* b3 = b2 + kstep;
            const unsigned o00 = last ? on[0][0] : oc[0][0], o01 = last ? on[0][1] : oc[0][1], o10 = last ? on[1][0] : oc[1][0], o11 = last ? on[1][1] : oc[1][1];
            PG8_LDB(B0, 0, 0); PG8_SCHED; PG8_LDA(At, 0, 0); PG8_STAGE2(PG8_SA(1, 1), a1, oc[1][0], oc[1][1]);
            PG8_WAIT_L(8); PG8_BAR; PG8_WAIT_L(0); PG8_MMA(0, 0, At, B0); PG8_BAR; PG8_SCHED;
            PG8_LDB(B1, 0, 1); PG8_STAGEB(PG8_SB(0, 0), b2);
            PG8_BAR; PG8_WAIT_L(0); PG8_MMA(0, 1, At, B1); PG8_BAR;
            PG8_LDA(At, 0, 1); PG8_STAGE2(PG8_SA(0, 0), a2, o00, o01);
            PG8_BAR; PG8_WAIT_L(0); PG8_MMA(1, 0, At, B0); PG8_BAR; PG8_SCHED;
            PG8_STAGEB(PG8_SB(0, 1), b2 + hstepB);
            PG8_WAIT_V(6); PG8_BAR; PG8_MMA(1, 1, At, B1); PG8_BAR;
            PG8_LDB(B0, 1, 0); PG8_SCHED; PG8_LDA(At, 1, 0); PG8_STAGE2(PG8_SA(0, 1), a2, o10, o11);
            PG8_WAIT_L(8); PG8_BAR; PG8_WAIT_L(0); PG8_MMA(0, 0, At, B0); PG8_BAR; PG8_SCHED;
            PG8_LDB(B1, 1, 1); PG8_STAGEB(PG8_SB(1, 0), b3);
            PG8_BAR; PG8_WAIT_L(0); PG8_MMA(0, 1, At, B1); PG8_BAR;
            PG8_LDA(At, 1, 1); PG8_STAGE2(PG8_SA(1, 0), a3, o00, o01);
            PG8_BAR; PG8_WAIT_L(0); PG8_MMA(1, 0, At, B0); PG8_BAR; PG8_SCHED;
            PG8_STAGEB(PG8_SB(1, 1), b3 + hstepB);
            PG8_WAIT_V(6); PG8_BAR; PG8_MMA(1, 1, At, B1); PG8_BAR;
        }
        E(acc, cur, wr, wc, fr, fq);
        if (!has_next) break;
#pragma unroll
        for (int a = 0; a < 2; ++a)
#pragma unroll
            for (int b = 0; b < 2; ++b)
#pragma unroll
                for (int m = 0; m < 4; ++m)
#pragma unroll
                    for (int n = 0; n < 2; ++n) acc[a][b][m][n] = (f32x4){0.f, 0.f, 0.f, 0.f};
        cur = nxt; cA = nA; cB = nB; ++ui;
#pragma unroll
        for (int h = 0; h < 2; ++h)
#pragma unroll
            for (int i = 0; i < 2; ++i) oc[h][i] = on[h][i];
    }
    PG8_WAIT_V(0);
    if (wr == 0) PG8_BAR;
    PG8_BAR;
#undef PG8_SA
#undef PG8_SB
#undef PG8_STAGE2
#undef PG8_STAGEB
#undef PG8_LDA
#undef PG8_LDB
#undef PG8_MMA
#undef PG8_WAIT_V
#undef PG8_WAIT_L
#undef PG8_BAR
#undef PG8_SCHED
}
}
namespace fk {
constexpr int NTHR = 512;
constexpr int LDS_BYTES = 147456;
constexpr int HCAP = 24576;
constexpr float QSCALE_MLA = 0.07216878364870322f * LOG2E;
constexpr float QSCALE_128 = 0.08838834764831845f * LOG2E;

struct FW {
    const float *x_in, *t5, *mla_w_in, *mla_qn, *mla_kvn, *mla_wq, *mla_wkv, *mla_wo, *fox_w_in, *fox_bf, *fox_wo, *dsa_w_in, *dsa_wo, *ln_g, *ln_b, *wgrp, *bgrp, *wrt, *brt, *wgate, *wup, *wdown;
    float* out;
    unsigned* bar; int* moe_cnt;
    bf16_t *mla_win_t, *mla_wq_t, *mla_wkv_t, *mla_wo_t, *fox_win_t, *fox_wo_t, *dsa_win_t, *dsa_wo_t, *moe_gu_t, *moe_d_t;
    float *wr4, *fox_wf4; f32x2* rope_cs;
    float *xA, *xB, *y; bf16_t *xb0, *xb1, *o;
    char* arena;
    float* ss;
    float *flog, *cf2;
    int *te, *tpos, *list; float *tw, *sw; bf16_t *H, *Y2; unsigned char* x1q;
};

template <class T> struct FkCvt { static __device__ __forceinline__ T get(unsigned long long v) { return (T)v; } };
template <class T> struct FkCvt<T*> { static __device__ __forceinline__ T* get(unsigned long long v) { return (T*)(__attribute__((address_space(1))) T*)v; } };
struct FWK { const float *x_in, *t5, *mla_w_in, *mla_qn, *mla_kvn, *mla_wq, *mla_wkv, *mla_wo, *fox_w_in, *fox_bf, *fox_wo, *dsa_w_in, *dsa_wo, *ln_g, *ln_b, *wgrp, *bgrp, *wrt, *brt, *wgate, *wup, *wdown; float* out; char* ws; long moe_bias_gu, moe_bias_d; long var; };
constexpr size_t al256(size_t x) { return (x + 255) & ~(size_t)255; }
template <int MOE_LAYERS> struct WsMap {
    static constexpr size_t CTL = 0, CTL_BYTES = 65536;
    static constexpr size_t MLA_WIN_T = CTL + CTL_BYTES, MLA_WQ_T = MLA_WIN_T + al256((size_t)2 * 1280 * D * 2), MLA_WKV_T = MLA_WQ_T + al256((size_t)2 * 3072 * 512 * 2), MLA_WO_T = MLA_WKV_T + al256((size_t)2 * 4096 * 512 * 2);
    static constexpr size_t FOX_WIN_T = MLA_WO_T + al256((size_t)2 * D * D * 2), FOX_WO_T = FOX_WIN_T + al256((size_t)6144 * D * 2), DSA_WIN_T = FOX_WO_T + al256((size_t)D * D * 2), DSA_WO_T = DSA_WIN_T + al256((size_t)3584 * D * 2);
    static constexpr size_t MOE_GU_T = DSA_WO_T + al256((size_t)D * D * 2), MOE_D_T = MOE_GU_T + al256((size_t)MOE_LAYERS * 32 * 1024 * D * 2);
    static constexpr size_t WR4 = MOE_D_T + al256((size_t)MOE_LAYERS * 32 * D * 512 * 2), FOX_WF4 = WR4 + al256((size_t)4 * D * 48 * 4), ROPE = FOX_WF4 + al256((size_t)D * 16 * 4);
    static constexpr size_t XA = ROPE + al256((size_t)S * 32 * 8), XB = XA + al256((size_t)NT * D * 4), Y = XB + al256((size_t)NT * D * 4);
    static constexpr size_t XB0 = Y + al256((size_t)NT * D * 4), XB1 = XB0 + al256((size_t)NT * D * 2), O = XB1 + al256((size_t)NT * D * 2), ARENA = O + al256((size_t)NT * D * 2);
    static constexpr size_t SS = ARENA + al256((size_t)NT * (512 + 512 + 64 + 3072 + 4096) * 2), FLOG = SS + al256((size_t)NT * 2 * 8 * 4), CF2 = FLOG + al256((size_t)NT * 16 * 4);
    static constexpr size_t TE = CF2 + al256((size_t)NB * 16 * S * 4), TPOS = TE + al256((size_t)NT * 2 * 4), LIST = TPOS + al256((size_t)NT * 2 * 4), TW = LIST + al256((size_t)32 * NT * 4), SW = TW + al256((size_t)NT * 2 * 4);
    static constexpr size_t H = SW + al256((size_t)32 * NT * 4), Y2 = H + al256((size_t)HCAP * 512 * 2), X1Q = Y2 + al256((size_t)HCAP * D * 2), END = X1Q + al256((size_t)NT * D);
};
template <int ML> __host__ __device__ __forceinline__ FW make_fw(const FWK& k, char* ws) {
    typedef WsMap<ML> M; FW w;
    w.x_in = k.x_in; w.t5 = k.t5; w.mla_w_in = k.mla_w_in; w.mla_qn = k.mla_qn; w.mla_kvn = k.mla_kvn; w.mla_wq = k.mla_wq; w.mla_wkv = k.mla_wkv; w.mla_wo = k.mla_wo; w.fox_w_in = k.fox_w_in; w.fox_bf = k.fox_bf; w.fox_wo = k.fox_wo;
    w.dsa_w_in = k.dsa_w_in; w.dsa_wo = k.dsa_wo; w.ln_g = k.ln_g; w.ln_b = k.ln_b; w.wgrp = k.wgrp; w.bgrp = k.bgrp; w.wrt = k.wrt; w.brt = k.brt; w.wgate = k.wgate; w.wup = k.wup; w.wdown = k.wdown; w.out = k.out;
    w.bar = (unsigned*)(ws + M::CTL); w.moe_cnt = (int*)(ws + M::CTL + 32768);
    w.mla_win_t = (bf16_t*)(ws + M::MLA_WIN_T); w.mla_wq_t = (bf16_t*)(ws + M::MLA_WQ_T); w.mla_wkv_t = (bf16_t*)(ws + M::MLA_WKV_T); w.mla_wo_t = (bf16_t*)(ws + M::MLA_WO_T);
    w.fox_win_t = (bf16_t*)(ws + M::FOX_WIN_T); w.fox_wo_t = (bf16_t*)(ws + M::FOX_WO_T); w.dsa_win_t = (bf16_t*)(ws + M::DSA_WIN_T); w.dsa_wo_t = (bf16_t*)(ws + M::DSA_WO_T);
    w.moe_gu_t = (bf16_t*)(ws + M::MOE_GU_T) - k.moe_bias_gu; w.moe_d_t = (bf16_t*)(ws + M::MOE_D_T) - k.moe_bias_d;
    w.wr4 = (float*)(ws + M::WR4); w.fox_wf4 = (float*)(ws + M::FOX_WF4); w.rope_cs = (f32x2*)(ws + M::ROPE);
    w.xA = (float*)(ws + M::XA); w.xB = (float*)(ws + M::XB); w.y = (float*)(ws + M::Y); w.xb0 = (bf16_t*)(ws + M::XB0); w.xb1 = (bf16_t*)(ws + M::XB1); w.o = (bf16_t*)(ws + M::O); w.arena = ws + M::ARENA;
    w.ss = (float*)(ws + M::SS); w.flog = (float*)(ws + M::FLOG); w.cf2 = (float*)(ws + M::CF2);
    w.te = (int*)(ws + M::TE); w.tpos = (int*)(ws + M::TPOS); w.list = (int*)(ws + M::LIST); w.tw = (float*)(ws + M::TW); w.sw = (float*)(ws + M::SW); w.H = (bf16_t*)(ws + M::H); w.Y2 = (bf16_t*)(ws + M::Y2); w.x1q = (unsigned char*)(ws + M::X1Q);
    return w;
}
__device__ __forceinline__ int fk_tid() { int t = threadIdx.x; asm volatile("" : "+v"(t)); return t; }
__device__ __forceinline__ int fk_bid() { int t = blockIdx.x; asm volatile("" : "+s"(t)); return t; }
__device__ __forceinline__ int fk_nblk() { int t = gridDim.x; asm volatile("" : "+s"(t)); return t; }

enum { MAP_ID = 0, MAP_MLA_IN = 1, MAP_MLA_Q = 2, MAP_MOE_GU = 3 };
struct CvtJob { const float* src0; const float* src1; const float* scale; bf16_t* dst; long src_bstride, dst_bstride; int K, N, Np, map, nbatch, tile0, wide, pad; };
constexpr int MAXJOBS = 24;
struct CvtTable { CvtJob j[MAXJOBS]; int njobs, ntiles, misc, pad; };

__device__ __forceinline__ int map_col(int map, int np, int N, int& which) {
    which = 0;
    if (map == MAP_ID) return np < N ? np : -1;
    if (map == MAP_MLA_IN) { if (np < 1024) return np; if (np < 1088) { const int i = np - 1024; return 1024 + (i >> 1) + 32 * (i & 1); } return -1; }
    if (map == MAP_MLA_Q) { const int h = np / 192, j = np % 192; if (j < 128) return np; const int i = j - 128; return h * 192 + 128 + (i >> 1) + 32 * (i & 1); }
      { const int q = np >> 5, r = np & 31; which = r >> 4; return 16 * q + (r & 15); }
}
__device__ __forceinline__ void cvt_tile(const CvtJob& J, int lt, FK_LAS float* tile  , const int tid) {
    const int tk = J.K / 64, tn = J.Np / 64, per = tk * tn;
    const int b = lt / per, r = lt % per, tkk = r % tk, tnn = r / tk;
    const int k0 = tkk * 64, n0 = tnn * 64;
    const float* s0 = J.src0 + (size_t)b * J.src_bstride; const float* s1 = J.src1 ? J.src1 + (size_t)b * J.src_bstride : nullptr;
    bf16_t* d = J.dst + (size_t)b * J.dst_bstride;
    { const int np = n0 + (tid & 63); int which; const int sc = map_col(J.map, np, J.N, which); const float* s = which ? s1 : s0;
#pragma unroll
      for (int i = 0; i < 8; ++i) { const int k = (tid >> 6) + 8 * i; float v = 0.f; if (sc >= 0) { v = s[(size_t)(k0 + k) * J.N + sc]; if (J.scale) v *= J.scale[k0 + k]; } tile[k * 65 + (tid & 63)] = v; } }
    __syncthreads();
    { const int np = tid >> 3, kg = (tid & 7) * 8; float v[8];
#pragma unroll
      for (int j = 0; j < 8; ++j) v[j] = tile[(kg + j) * 65 + np];
      u32x4 w; w.x = cvt_pk_bf16(v[0], v[1]); w.y = cvt_pk_bf16(v[2], v[3]); w.z = cvt_pk_bf16(v[4], v[5]); w.w = cvt_pk_bf16(v[6], v[7]);
      *(u32x4*)(d + (size_t)(n0 + np) * J.K + k0 + kg) = w; }
    __syncthreads();
}
__device__ __forceinline__ void cvt_tile_wide(const CvtJob& J, int lt, FK_LAS unsigned char* img, const int tid) {
    const int wid = tid >> 6, lane = tid & 63;
    const int tk = J.K / 128, tn = J.Np / 256, per = tk * tn;
    const int b = lt / per, r = lt % per, tkk = r % tk, tnn = r / tk;
    const int k0 = tkk * 128, n0 = tnn * 256;
    const float* s0 = J.src0 + (size_t)b * J.src_bstride; const float* s1 = J.src1 ? J.src1 + (size_t)b * J.src_bstride : nullptr;
    bf16_t* d = J.dst + (size_t)b * J.dst_bstride;
    const int np = n0 + 4 * lane; int which; const int sc = map_col(J.map, np, J.N, which); const float* s = which ? s1 : s0;
    const bool ok = sc >= 0 && sc + 3 < J.N;
    f32x4 v[16];
#pragma unroll
    for (int i = 0; i < 16; ++i) { const int k = k0 + wid * 16 + i; v[i] = ok ? *(const f32x4*)(s + (size_t)k * J.N + sc) : (f32x4){0.f, 0.f, 0.f, 0.f}; if (J.scale) v[i] = v[i] * J.scale[k]; }
#pragma unroll
    for (int j = 0; j < 4; ++j) { const int n = 4 * lane + j;
#pragma unroll
        for (int h = 0; h < 2; ++h) { u32x4 w; w.x = cvt_pk_bf16(v[8 * h + 0][j], v[8 * h + 1][j]); w.y = cvt_pk_bf16(v[8 * h + 2][j], v[8 * h + 3][j]); w.z = cvt_pk_bf16(v[8 * h + 4][j], v[8 * h + 5][j]); w.w = cvt_pk_bf16(v[8 * h + 6][j], v[8 * h + 7][j]);
            const int c = wid * 2 + h; *(FK_LAS u32x4*)(img + n * 256 + ((c ^ (n & 15)) << 4)) = w; } }
    __syncthreads();
#pragma unroll
    for (int i = 0; i < 8; ++i) { const int idx = tid + 512 * i, n = idx >> 4, c = idx & 15; const u32x4 w = *(FK_LAS const u32x4*)(img + n * 256 + ((c ^ (n & 15)) << 4));
        *(u32x4*)(d + (size_t)(n0 + n) * J.K + k0 + c * 8) = w; }
    __syncthreads();
}
__device__ __forceinline__ void phase_prologue(const FW& w, const CvtTable& T, FK_LAS unsigned char* lds) {
    FK_LAS float* tile = (FK_LAS float*)lds; const int tid0 = fk_tid();
    for (int t = fk_bid(); t < T.ntiles; t += fk_nblk()) {
        int ji = 0;
#pragma unroll 1
        for (int q = 1; q < T.njobs; ++q) if (t >= T.j[q].tile0) ji = q;
        if (T.j[ji].wide) cvt_tile_wide(T.j[ji], t - T.j[ji].tile0, lds, tid0); else cvt_tile(T.j[ji], t - T.j[ji].tile0, tile, tid0);
    }
    if (!T.misc) return;
    const int gt = fk_bid() * NTHR + tid0, gn = fk_nblk() * NTHR;
    for (int i = gt; i < S * 32; i += gn) { const int pos = i >> 5, j = i & 31; const float invf = powf(10000.f, -(float)j / 32.f); const float ang = (float)pos * invf; w.rope_cs[i] = (f32x2){cosf(ang), sinf(ang)}; }
    for (int i = gt; i < 4 * 128 * 3 * 64 * 4; i += gn) { const int ii = i & 3, lane = (i >> 2) & 63, q = i >> 8, nt = q % 3, kg = (q / 3) & 127, layer = q / (3 * 128); const int k = 16 * kg + 4 * (lane >> 4) + ii, n = 16 * nt + (lane & 15);
        float v = 0.f; if (n < 4) v = w.wgrp[((size_t)layer * D + k) * 4 + n]; else if (n < 36) v = w.wrt[((size_t)layer * D + k) * 32 + (n - 4)]; w.wr4[i] = v; }
    for (int i = gt; i < 128 * 64 * 4; i += gn) { const int ii = i & 3, lane = (i >> 2) & 63, kg = i >> 8; const int k = 16 * kg + 4 * (lane >> 4) + ii; w.fox_wf4[i] = w.fox_w_in[(size_t)k * 6160 + 6144 + (lane & 15)]; }
    for (int i = gt; i < NT * D / 4; i += gn) { const f32x4 v = ((const f32x4*)w.x_in)[i]; u32x2 p; p.x = cvt_pk_bf16(v[0], v[1]); p.y = cvt_pk_bf16(v[2], v[3]); ((u32x2*)w.xb0)[i] = p; }
}

struct RectSched {
    const char* A; const char* B; int lda, ldb, nM, nN, nwg, G, c;
    __device__ void init(const bf16_t* A_, int lda_, const bf16_t* B_, int ldb_, int M, int N) { A = (const char*)A_; B = (const char*)B_; lda = lda_; ldb = ldb_; nM = M / BM; nN = N / BM; nwg = nM * nN; G = fk_nblk(); c = fk_bid(); }
    __device__ __forceinline__ bool tile(int i, int& pm, int& pn) const {
        const long L = (long)i * G + c; if (L >= nwg) return false;
        int wgid = (int)L; { const int q = nwg / 8, r = nwg % 8, xcd = wgid % 8, off = wgid / 8; wgid = (xcd < r ? xcd * (q + 1) : r * (q + 1) + (xcd - r) * q) + off; }
        const int nig = 8 * nN, gid = wgid / nig, fm = gid * 8, gsz = (nM - fm) < 8 ? (nM - fm) : 8;
        pm = fm + ((wgid % nig) % gsz); pn = (wgid % nig) / gsz; return true;
    }
    __device__ __forceinline__ bool next(int i, GUnit& u) const { int pm, pn; if (!tile(i, pm, pn)) return false; u.pm = pm; u.pn = pn; u.e = 0; u.nrows = BM; u.A = A + (size_t)pm * BM * lda * 2; u.B = B + (size_t)pn * BM * ldb * 2; return true; }
    __device__ __forceinline__ void a_offs(const GUnit&, int tid, unsigned (&o)[2][2]) const { int R0, C0, R1, C1; stage_rc(tid * 16, R0, C0); stage_rc(tid * 16 + 8192, R1, C1);
        o[0][0] = (unsigned)(R0 * lda + C0) * 2u; o[0][1] = (unsigned)(R1 * lda + C1) * 2u; o[1][0] = o[0][0] + (unsigned)(HALF * lda * 2); o[1][1] = o[0][1] + (unsigned)(HALF * lda * 2); }
};
struct Rect2Sched {
    RectSched s0, s1; int n0;
    __device__ __forceinline__ bool next(int i, GUnit& u) const {
        const long L = (long)i * s0.G + s0.c; const int tot = s0.nwg + s1.nwg; if (L >= tot) return false;
        if (L < s0.nwg) { const int pm = (int)L % s0.nM, pn = (int)L / s0.nM; u.pm = pm; u.pn = pn; u.e = 0; u.nrows = BM; u.A = s0.A + (size_t)pm * BM * s0.lda * 2; u.B = s0.B + (size_t)pn * BM * s0.ldb * 2; }
        else { const int l = (int)L - s0.nwg; const int pm = l % s1.nM, pn = l / s1.nM; u.pm = pm; u.pn = pn; u.e = 1; u.nrows = BM; u.A = s1.A + (size_t)pm * BM * s1.lda * 2; u.B = s1.B + (size_t)pn * BM * s1.ldb * 2; }
        return true; }
    __device__ __forceinline__ void a_offs(const GUnit& u, int tid, unsigned (&o)[2][2]) const { s0.a_offs(u, tid, o); }
};

struct EpiF32 {
    static constexpr bool PERM = false;
    float* Cp; int ldc;
    __device__ __forceinline__ void operator()(const f32x4 (&acc)[2][2][4][2], const GUnit& u, int wr, int wc, int fr, int fq) const {
        const int row0 = u.pm * BM + wr * 64 + fr, col0 = u.pn * BM + wc * 32 + 4 * fq;
#pragma unroll
        for (int ai = 0; ai < 2; ++ai)
#pragma unroll
            for (int m = 0; m < 4; ++m) { float* rowp = Cp + (size_t)(row0 + ai * HALF + m * 16) * ldc + col0;
#pragma unroll
                for (int bj = 0; bj < 2; ++bj)
#pragma unroll
                    for (int n = 0; n < 2; ++n) *(f32x4*)(rowp + bj * HALF + n * 16) = acc[ai][bj][m][n]; }
    }
};
__device__ __forceinline__ u32x4 pack8(const f32x4& a, const f32x4& b) { u32x4 w; w.x = cvt_pk_bf16(a[0], a[1]); w.y = cvt_pk_bf16(a[2], a[3]); w.z = cvt_pk_bf16(b[0], b[1]); w.w = cvt_pk_bf16(b[2], b[3]); return w; }
__device__ __forceinline__ void rope8(f32x4& v0, f32x4& v1, const f32x2* cs) {
    const f32x4 c01 = *(const f32x4*)cs, c23 = *(const f32x4*)(cs + 2);
    f32x4 r0, r1;
    r0[0] = v0[0] * c01[0] - v0[1] * c01[1]; r0[1] = v0[1] * c01[0] + v0[0] * c01[1]; r0[2] = v0[2] * c01[2] - v0[3] * c01[3]; r0[3] = v0[3] * c01[2] + v0[2] * c01[3];
    r1[0] = v1[0] * c23[0] - v1[1] * c23[1]; r1[1] = v1[1] * c23[0] + v1[0] * c23[1]; r1[2] = v1[2] * c23[2] - v1[3] * c23[3]; r1[3] = v1[3] * c23[2] + v1[2] * c23[3];
    v0 = r0; v1 = r1;
}
struct EpiMlaIn {
    static constexpr bool PERM = true;
    bf16_t *cq, *ckv, *kr; float* ss; const f32x2* cs;
    __device__ __forceinline__ void operator()(const f32x4 (&acc)[2][2][4][2], const GUnit& u, int wr, int wc, int fr, int fq) const {
        const int row0 = u.pm * BM + wr * 64 + fr;
        if (u.pn < 4) {
            bf16_t* dst = (u.pn < 2) ? cq : ckv; const int which = u.pn >> 1; const int col0 = (u.pn & 1) * BM + wc * 32 + 8 * fq;
#pragma unroll
            for (int ai = 0; ai < 2; ++ai)
#pragma unroll
                for (int m = 0; m < 4; ++m) { const int row = row0 + ai * HALF + m * 16; float q = 0.f;
#pragma unroll
                    for (int bj = 0; bj < 2; ++bj) { const f32x4 v0 = acc[ai][bj][m][0], v1 = acc[ai][bj][m][1];
                        q += (v0[0] * v0[0] + v0[1] * v0[1]) + (v0[2] * v0[2] + v0[3] * v0[3]) + (v1[0] * v1[0] + v1[1] * v1[1]) + (v1[2] * v1[2] + v1[3] * v1[3]);
                        *(u32x4*)(dst + (size_t)row * 512 + col0 + bj * HALF) = pack8(v0, v1); }
                    q += __shfl_xor(q, 16); q += __shfl_xor(q, 32);
                    if (fq == 0) ss[((size_t)row * 2 + which) * 8 + (u.pn & 1) * 4 + wc] = q; }
        } else if (wc < 2) {
#pragma unroll
            for (int ai = 0; ai < 2; ++ai) { f32x4 c01[4], c23[4];
#pragma unroll
                for (int m = 0; m < 4; ++m) { const int row = row0 + ai * HALF + m * 16; const f32x2* cp = cs + (size_t)(row & (S - 1)) * 32 + 16 * wc + 4 * fq; c01[m] = *(const f32x4*)cp; c23[m] = *(const f32x4*)(cp + 2); }
#pragma unroll
                for (int m = 0; m < 4; ++m) { const int row = row0 + ai * HALF + m * 16; const f32x4 v0 = acc[ai][0][m][0], v1 = acc[ai][0][m][1]; const f32x4 a = c01[m], b = c23[m]; f32x4 r0, r1;
                    r0[0] = v0[0] * a[0] - v0[1] * a[1]; r0[1] = v0[1] * a[0] + v0[0] * a[1]; r0[2] = v0[2] * a[2] - v0[3] * a[3]; r0[3] = v0[3] * a[2] + v0[2] * a[3];
                    r1[0] = v1[0] * b[0] - v1[1] * b[1]; r1[1] = v1[1] * b[0] + v1[0] * b[1]; r1[2] = v1[2] * b[2] - v1[3] * b[3]; r1[3] = v1[3] * b[2] + v1[2] * b[3];
                    *(u32x4*)(kr + (size_t)row * 64 + wc * 32 + 8 * fq) = pack8(r0, r1); } }
        }
    }
};
struct EpiMlaQKV {
    static constexpr bool PERM = true;
    bf16_t *q, *kv; const float* ss; const f32x2* cs;
    __device__ __forceinline__ void operator()(const f32x4 (&acc)[2][2][4][2], const GUnit& u, int wr, int wc, int fr, int fq) const {
        const int row0 = u.pm * BM + wr * 64 + fr;
#pragma unroll
        for (int ai = 0; ai < 2; ++ai) {
            float rs[4];
            { f32x4 sa[4], sb[4];
#pragma unroll
              for (int m = 0; m < 4; ++m) { const int row = row0 + ai * HALF + m * 16; sa[m] = *(const f32x4*)(ss + ((size_t)row * 2 + u.e) * 8); sb[m] = *(const f32x4*)(ss + ((size_t)row * 2 + u.e) * 8 + 4); }
#pragma unroll
              for (int m = 0; m < 4; ++m) rs[m] = rsqrtf((((sa[m][0] + sa[m][1]) + (sa[m][2] + sa[m][3])) + ((sb[m][0] + sb[m][1]) + (sb[m][2] + sb[m][3]))) * (1.0f / 512.0f) + 1e-6f); }
#pragma unroll
            for (int bj = 0; bj < 2; ++bj) { const int gc = u.pn * BM + bj * HALF + wc * 32 + 8 * fq; const int j = gc % 192; const bool rope = __builtin_amdgcn_readfirstlane((int)((u.e == 0) && (j >= 128))) != 0;
                f32x4 c01[4], c23[4];
                if (rope) {
#pragma unroll
                    for (int m = 0; m < 4; ++m) { const int row = row0 + ai * HALF + m * 16; const f32x2* cp = cs + (size_t)(row & (S - 1)) * 32 + ((j - 128) >> 1); c01[m] = *(const f32x4*)cp; c23[m] = *(const f32x4*)(cp + 2); } }
#pragma unroll
                for (int m = 0; m < 4; ++m) { const int row = row0 + ai * HALF + m * 16; f32x4 v0 = acc[ai][bj][m][0] * rs[m], v1 = acc[ai][bj][m][1] * rs[m];
                    if (u.e == 0) {
                        if (rope) { f32x4 r0, r1; const f32x4 a = c01[m], b = c23[m];
                            r0[0] = v0[0] * a[0] - v0[1] * a[1]; r0[1] = v0[1] * a[0] + v0[0] * a[1]; r0[2] = v0[2] * a[2] - v0[3] * a[3]; r0[3] = v0[3] * a[2] + v0[2] * a[3];
                            r1[0] = v1[0] * b[0] - v1[1] * b[1]; r1[1] = v1[1] * b[0] + v1[0] * b[1]; r1[2] = v1[2] * b[2] - v1[3] * b[3]; r1[3] = v1[3] * b[2] + v1[2] * b[3]; v0 = r0; v1 = r1; }
                        v0 = v0 * QSCALE_MLA; v1 = v1 * QSCALE_MLA; *(u32x4*)(q + (size_t)row * 3072 + gc) = pack8(v0, v1); }
                    else *(u32x4*)(kv + (size_t)row * 4096 + gc) = pack8(v0, v1); } }
        }
    }
};
}
namespace fk {
#define FK_KSWZ(row, colB) ((row) * 256 + ((colB) ^ (((row) & 7) << 4)))
#define FK_KRSWZ(row, ch) ((row) * 128 + ((((ch)) ^ (((row) >> 1) & 7)) << 4))
__device__ __forceinline__ int v_st(int k, int c) { const int kk = (k & ~0xC) | ((k & 4) << 1) | ((k & 8) >> 1); return ((kk >> 3) * 4 + (c >> 5)) * 512 + ((kk & 7) * 32 + (c & 31)) * 2; }
__device__ __forceinline__ int v_rd_base(int lane) { return ((lane & 3) << 3) | (((lane >> 2) & 3) << 6) | (((lane >> 4) & 1) << 5) | (((lane >> 5) & 1) << 8); }
__device__ __forceinline__ int crow(int r, int hi) { return (r & 3) + 8 * (r >> 2) + 4 * hi; }

constexpr int AT_K = 0, AT_V = 32768, AT_KR = 65536, AT_CF = 81920, AT_WS = 90112;

struct AttnPtrs { const bf16_t* Q; const bf16_t* K; const bf16_t* V; const bf16_t* KR; const float* CF; bf16_t* O; int qld, kld; };

template <int MODE>
__device__ __forceinline__ void attn_block(FK_LAS unsigned char* lds, const AttnPtrs P, const int qb) {
    constexpr int NQ = MODE == 0 ? 12 : 8;
    const int tid = fk_tid(), wid = __builtin_amdgcn_readfirstlane(tid >> 6), lane = tid & 63, r32 = lane & 31, hi = lane >> 5;
    const int q0w = qb * 256 + wid * 32;
    const int nt = 4 * (qb + 1);
    bf16x8 qr[NQ];
    { const bf16_t* qrow = P.Q + (size_t)(q0w + r32) * P.qld;
#pragma unroll
      for (int d0 = 0; d0 < NQ; ++d0) qr[d0] = *(const bf16x8*)(qrow + d0 * 16 + hi * 8); }
    float ct2 = 0.f; if (MODE == 1) ct2 = ((FK_LAS const float*)(lds + AT_CF))[q0w + r32];
    const int sr = tid >> 4, sc = (tid & 15) * 8;
    const int kws = FK_KSWZ(sr, sc * 2), vst0 = v_st(sr, sc), vst1 = v_st(32 + sr, sc);
    const int krr = tid >> 3, krc = tid & 7, krw = FK_KRSWZ(krr, krc);
    const int vb0 = AT_V + v_rd_base(lane);
    FK_LAS float* wsl = (FK_LAS float*)(lds + AT_WS) + wid * 64;
    bf16x8 sk0, sk1, sv0, sv1, skr;
    float m_reg = -1e30f, l_reg = 0.f; f32x16 o[4];
#pragma unroll
    for (int d = 0; d < 4; ++d)
#pragma unroll
        for (int r = 0; r < 16; ++r) o[d][r] = 0.f;
#define AT_LOAD(j) do { const size_t k0_ = (size_t)(j) * 64; \
        sk0 = *(const bf16x8*)(P.K + (k0_ + sr) * P.kld + sc); sk1 = *(const bf16x8*)(P.K + (k0_ + 32 + sr) * P.kld + sc); \
        sv0 = *(const bf16x8*)(P.V + (k0_ + sr) * P.kld + sc); sv1 = *(const bf16x8*)(P.V + (k0_ + 32 + sr) * P.kld + sc); \
        if (MODE == 0) skr = *(const bf16x8*)(P.KR + (k0_ + krr) * 64 + krc * 8); \
        } while (0)
#define AT_WRITE(bf) do { *(FK_LAS bf16x8*)(lds + AT_K + (bf) * 16384 + kws) = sk0; *(FK_LAS bf16x8*)(lds + AT_K + (bf) * 16384 + kws + 32 * 256) = sk1; \
        *(FK_LAS bf16x8*)(lds + AT_V + (bf) * 16384 + vst0) = sv0; *(FK_LAS bf16x8*)(lds + AT_V + (bf) * 16384 + vst1) = sv1; \
        if (MODE == 0) *(FK_LAS bf16x8*)(lds + AT_KR + (bf) * 8192 + krw) = skr; \
        } while (0)
#define AT_TRRD(dst, off) asm volatile("ds_read_b64_tr_b16 %0, %1 offset:%2" : "=&v"(dst) : "v"(vb0), "i"(off) : "memory")
#define AT_PV_D0(KB, d0) do { s16x4 l0, l1, l2, l3, h0, h1, h2, h3; constexpr int b_ = (KB) * 16384 + (d0) * 512; \
        AT_TRRD(l0, b_); AT_TRRD(h0, b_ + 2048); AT_TRRD(l1, b_ + 4096); AT_TRRD(h1, b_ + 6144); AT_TRRD(l2, b_ + 8192); AT_TRRD(h2, b_ + 10240); AT_TRRD(l3, b_ + 12288); AT_TRRD(h3, b_ + 14336); \
        asm volatile("s_waitcnt lgkmcnt(0)" ::: "memory"); __builtin_amdgcn_sched_barrier(0); \
        o[d0] = __builtin_amdgcn_mfma_f32_32x32x16_bf16(pa0, (bf16x8){l0[0], l0[1], l0[2], l0[3], h0[0], h0[1], h0[2], h0[3]}, o[d0], 0, 0, 0); \
        o[d0] = __builtin_amdgcn_mfma_f32_32x32x16_bf16(pa1, (bf16x8){l1[0], l1[1], l1[2], l1[3], h1[0], h1[1], h1[2], h1[3]}, o[d0], 0, 0, 0); \
        o[d0] = __builtin_amdgcn_mfma_f32_32x32x16_bf16(pa2, (bf16x8){l2[0], l2[1], l2[2], l2[3], h2[0], h2[1], h2[2], h2[3]}, o[d0], 0, 0, 0); \
        o[d0] = __builtin_amdgcn_mfma_f32_32x32x16_bf16(pa3, (bf16x8){l3[0], l3[1], l3[2], l3[3], h3[0], h3[1], h3[2], h3[3]}, o[d0], 0, 0, 0); } while (0)
#define AT_PK4(Pv, B_, OUT) do { unsigned a0 = cvt_pk_bf16(Pv[B_ + 0], Pv[B_ + 1]), a1 = cvt_pk_bf16(Pv[B_ + 2], Pv[B_ + 3]); \
        unsigned b0 = cvt_pk_bf16(Pv[B_ + 4], Pv[B_ + 5]), b1 = cvt_pk_bf16(Pv[B_ + 6], Pv[B_ + 7]); \
        auto r0 = __builtin_amdgcn_permlane32_swap(a0, b0, false, false); auto r1 = __builtin_amdgcn_permlane32_swap(a1, b1, false, false); \
        u32x4 w_ = {r0[0], r1[0], r0[1], r1[1]}; OUT = *reinterpret_cast<bf16x8*>(&w_); } while (0)
#define AT_STEP(j, KB) do { \
        if ((j) + 1 < nt) AT_LOAD((j) + 1); \
        if ((j) * 64 <= q0w) { \
            f32x16 p0, p1; \
            _Pragma("unroll") for (int r = 0; r < 16; ++r) { p0[r] = 0.f; p1[r] = 0.f; } \
            __builtin_amdgcn_s_setprio(1); \
            { FK_LAS const unsigned char* kb_ = lds + AT_K + (KB) * 16384; \
              _Pragma("unroll") for (int d0 = 0; d0 < 8; ++d0) { \
                const bf16x8 b0 = *(FK_LAS const bf16x8*)(kb_ + FK_KSWZ(r32, (d0 * 16 + hi * 8) * 2)); \
                const bf16x8 b1 = *(FK_LAS const bf16x8*)(kb_ + FK_KSWZ(r32, (d0 * 16 + hi * 8) * 2) + 32 * 256); \
                p0 = __builtin_amdgcn_mfma_f32_32x32x16_bf16(b0, qr[d0], p0, 0, 0, 0); \
                p1 = __builtin_amdgcn_mfma_f32_32x32x16_bf16(b1, qr[d0], p1, 0, 0, 0); } } \
            if (MODE == 0) { FK_LAS const unsigned char* kr_ = lds + AT_KR + (KB) * 8192; \
              _Pragma("unroll") for (int d0 = 0; d0 < 4; ++d0) { \
                const bf16x8 b0 = *(FK_LAS const bf16x8*)(kr_ + FK_KRSWZ(r32, 2 * d0 + hi)); \
                const bf16x8 b1 = *(FK_LAS const bf16x8*)(kr_ + FK_KRSWZ(r32 + 32, 2 * d0 + hi)); \
                p0 = __builtin_amdgcn_mfma_f32_32x32x16_bf16(b0, qr[(MODE == 0 ? 8 : 0) + d0], p0, 0, 0, 0); \
                p1 = __builtin_amdgcn_mfma_f32_32x32x16_bf16(b1, qr[(MODE == 0 ? 8 : 0) + d0], p1, 0, 0, 0); } } \
            __builtin_amdgcn_s_setprio(0); \
            if (MODE == 1) { FK_LAS const float* cf_ = (FK_LAS const float*)(lds + AT_CF) + (j) * 64; \
              _Pragma("unroll") for (int g = 0; g < 4; ++g) { const f32x4 c0 = *(FK_LAS const f32x4*)(cf_ + 8 * g + 4 * hi), c1 = *(FK_LAS const f32x4*)(cf_ + 32 + 8 * g + 4 * hi); \
                _Pragma("unroll") for (int i = 0; i < 4; ++i) { p0[4 * g + i] += ct2 - c0[i]; p1[4 * g + i] += ct2 - c1[i]; } } \
              if ((j) * 64 + 63 > q0w) { const int dq = q0w + r32 - (j) * 64 - 4 * hi; const float NEG = -__builtin_inff(); \
                _Pragma("unroll") for (int r = 0; r < 16; ++r) { const int c = (r & 3) + 8 * (r >> 2); if (c > dq) p0[r] = NEG; if (c + 32 > dq) p1[r] = NEG; } } } \
            float pmax = p0[0]; \
            _Pragma("unroll") for (int r = 1; r < 16; ++r) pmax = fmaxf(pmax, p0[r]); \
            _Pragma("unroll") for (int r = 0; r < 16; ++r) pmax = fmaxf(pmax, p1[r]); \
            { auto rr = __builtin_amdgcn_permlane32_swap(__float_as_uint(pmax), __float_as_uint(pmax), false, false); pmax = fmaxf(__uint_as_float(rr[0]), __uint_as_float(rr[1])); } \
            float mn, alpha; \
            if (__all(pmax - m_reg <= 11.5415603f)) { mn = m_reg; alpha = 1.f; }     \
            else { mn = fmaxf(m_reg, pmax); alpha = __builtin_amdgcn_exp2f(m_reg - mn); m_reg = mn; } \
            float ps = 0.f; \
            _Pragma("unroll") for (int r = 0; r < 16; ++r) { p0[r] = __builtin_amdgcn_exp2f(p0[r] - mn); ps += p0[r]; } \
            _Pragma("unroll") for (int r = 0; r < 16; ++r) { p1[r] = __builtin_amdgcn_exp2f(p1[r] - mn); ps += p1[r]; } \
            { auto rr = __builtin_amdgcn_permlane32_swap(__float_as_uint(ps), __float_as_uint(ps), false, false); ps = __uint_as_float(rr[0]) + __uint_as_float(rr[1]); } \
            l_reg = l_reg * alpha + ps; \
            bf16x8 pa0, pa1, pa2, pa3; AT_PK4(p0, 0, pa0); AT_PK4(p0, 8, pa1); AT_PK4(p1, 0, pa2); AT_PK4(p1, 8, pa3); \
            if (__any(alpha < 1.f)) { if (hi == 0) wsl[32 + r32] = alpha; asm volatile("s_waitcnt lgkmcnt(0)" ::: "memory"); \
                _Pragma("unroll") for (int g = 0; g < 4; ++g) { const f32x4 a4 = *(FK_LAS const f32x4*)(wsl + 32 + 8 * g + 4 * hi); \
                    _Pragma("unroll") for (int d_ = 0; d_ < 4; ++d_) _Pragma("unroll") for (int i = 0; i < 4; ++i) o[d_][4 * g + i] *= a4[i]; } } \
            __builtin_amdgcn_s_setprio(1); AT_PV_D0(KB, 0); AT_PV_D0(KB, 1); AT_PV_D0(KB, 2); AT_PV_D0(KB, 3); __builtin_amdgcn_s_setprio(0); \
        } \
        if ((j) + 1 < nt) AT_WRITE((KB) ^ 1); \
        __syncthreads(); } while (0)

    AT_LOAD(0); AT_WRITE(0); __syncthreads();
    for (int j = 0; j < nt; j += 2) { AT_STEP(j, 0); AT_STEP(j + 1, 1); }
    if (hi == 0) wsl[r32] = l_reg; asm volatile("s_waitcnt lgkmcnt(0)" ::: "memory");
    bf16_t* Ow = P.O + (size_t)q0w * D;
#pragma unroll
    for (int g = 0; g < 4; ++g) { const f32x4 l4 = *(FK_LAS const f32x4*)(wsl + 8 * g + 4 * hi);
#pragma unroll
        for (int i = 0; i < 4; ++i) { const int r = 4 * g + i; const int orow = crow(r, hi); const float rl = __builtin_amdgcn_rcpf(l4[i]);
#pragma unroll
            for (int d0 = 0; d0 < 4; ++d0) { const float v = o[d0][r] * rl; const float vn = __shfl_xor(v, 1);
                if ((r32 & 1) == 0) *(unsigned*)(Ow + (size_t)orow * D + d0 * 32 + r32) = cvt_pk_bf16(v, vn); } } }
    __syncthreads();
#undef AT_LOAD
#undef AT_WRITE
#undef AT_TRRD
#undef AT_PV_D0
#undef AT_PK4
#undef AT_STEP
}
}
namespace fk {
constexpr int LN_XS = 2052;
constexpr int TAB_OFF = 143360;

struct LnArgs {
    const float* x; const bf16_t* yb; const bf16_t* Y2; const int* te; const int* tpos; const int* cnt;
    const float *g, *b; float* xo; bf16_t* xbo; float* out2; unsigned char* xqo;
    const f32x4* w4; int ntile;
    const float *bgrp, *brt; int* rcnt; int* ote; int* otpos; float* otw; int* list; float* sw;
    float* flog; const float* fbias;
};

__device__ __forceinline__ float wave_sum(float v) { for (int o = 32; o >= 1; o >>= 1) v += __shfl_xor(v, o); return v; }

struct LnRows { f32x4 x[2][8]; u32x2 ya[2][8]; u32x2 yb[2][8]; };
__device__ __forceinline__ void ln_load(const LnArgs& a, FK_LAS const int* hoff, int grp, int wid, int lane, LnRows& R) {
#pragma unroll
    for (int rr = 0; rr < 2; ++rr) { const int t = grp * 16 + 2 * wid + rr;
        const bf16_t *pa, *pb = nullptr;
        if (a.Y2) { const int e0 = a.te[t * 2], e1 = a.te[t * 2 + 1]; pa = a.Y2 + (size_t)(hoff[e0] + a.tpos[t * 2]) * D; pb = a.Y2 + (size_t)(hoff[e1] + a.tpos[t * 2 + 1]) * D; }
        else pa = a.yb + (size_t)t * D;
#pragma unroll
        for (int i = 0; i < 8; ++i) { const int c = 4 * lane + 256 * i; R.x[rr][i] = *(const f32x4*)(a.x + (size_t)t * D + c); R.ya[rr][i] = *(const u32x2*)(pa + c); if (a.Y2) R.yb[rr][i] = *(const u32x2*)(pb + c); else R.yb[rr][i] = (u32x2){0u, 0u}; } }
}
__device__ __forceinline__ void phase_ln(const LnArgs& a, FK_LAS unsigned char* lds) {
    const int tid = fk_tid(), wid = __builtin_amdgcn_readfirstlane(tid >> 6), lane = tid & 63;
    FK_LAS float* part = (FK_LAS float*)lds;
    FK_LAS float* logit = (FK_LAS float*)(lds + 65536);
    FK_LAS int* hoff = (FK_LAS int*)(lds + TAB_OFF);
    if (a.Y2) { if (tid < 64) { const int c = lane < 32 ? a.cnt[lane * 32] : 0; const int pc = ((c + 255) >> 8) << 8; int incl = pc;
#pragma unroll
            for (int o = 1; o < 32; o <<= 1) { const int v = __shfl_up(incl, o); if (lane >= o) incl += v; }
            if (lane < 32) hoff[lane] = incl - pc; }
        __syncthreads(); }
    const int nb = fk_nblk(); int grp = fk_bid();
    if (grp >= NT / 16) return;
    LnRows cur; ln_load(a, hoff, grp, wid, lane, cur);
#pragma unroll 1
    for (; grp < NT / 16; grp += nb) {
        const bool has_next = grp + nb < NT / 16;
#pragma unroll
        for (int rr = 0; rr < 2; ++rr) {
            const int lr = 2 * wid + rr, t = grp * 16 + lr;
            f32x4 v[8]; float s = 0.f;
#pragma unroll
            for (int i = 0; i < 8; ++i) { f32x4 xv = cur.x[rr][i] * ALPHA; const u32x2 pa = cur.ya[rr][i], pb = cur.yb[rr][i];
                xv[0] += __uint_as_float(pa.x << 16) + __uint_as_float(pb.x << 16); xv[1] += __uint_as_float(pa.x & 0xffff0000u) + __uint_as_float(pb.x & 0xffff0000u);
                xv[2] += __uint_as_float(pa.y << 16) + __uint_as_float(pb.y << 16); xv[3] += __uint_as_float(pa.y & 0xffff0000u) + __uint_as_float(pb.y & 0xffff0000u);
                v[i] = xv; s += (xv[0] + xv[1]) + (xv[2] + xv[3]); }
            const float mean = wave_sum(s) * (1.0f / D); float q = 0.f;
#pragma unroll
            for (int i = 0; i < 8; ++i) { const f32x4 d = v[i] - mean; q += (d[0] * d[0] + d[1] * d[1]) + (d[2] * d[2] + d[3] * d[3]); }
            const float rs = rsqrtf(wave_sum(q) * (1.0f / D) + 1e-5f);
#pragma unroll
            for (int i = 0; i < 8; ++i) { const int c = 4 * lane + 256 * i; const f32x4 gv = *(const f32x4*)(a.g + c), bv = *(const f32x4*)(a.b + c);
                const f32x4 o = (v[i] - mean) * rs * gv + bv;
                *(f32x4*)(a.xo + (size_t)t * D + c) = o;
                if (a.out2) *(f32x4*)(a.out2 + (size_t)t * D + c) = o;
                u32x2 p; p.x = cvt_pk_bf16(o[0], o[1]); p.y = cvt_pk_bf16(o[2], o[3]); *(u32x2*)(a.xbo + (size_t)t * D + c) = p; }
        }
        if (has_next) ln_load(a, hoff, grp + nb, wid, lane, cur);
    }
    if (!a.w4) return;
    __syncthreads();
    const int row = lane & 15, kq = lane >> 4;
#pragma unroll 1
    for (int g0 = fk_bid(); g0 < NT / 16; g0 += 2 * nb) {
        const int g1 = g0 + nb; const bool two = g1 < NT / 16;
        const int ks = (wid + (fk_bid() >> 3)) & 7, jrot = 4 * ((fk_bid() >> 6) & 3);
        const float* xp0 = a.xo + (size_t)(g0 * 16 + row) * D + 4 * kq + 256 * ks;
        const float* xp1 = a.xo + (size_t)((two ? g1 : g0) * 16 + row) * D + 4 * kq + 256 * ks;
        const f32x4* wp = a.w4 + (size_t)(ks * 16 * a.ntile) * 64 + lane;
        f32x4 acc[2][3];
#pragma unroll
        for (int g = 0; g < 2; ++g)
#pragma unroll
            for (int n = 0; n < 3; ++n) acc[g][n] = (f32x4){0.f, 0.f, 0.f, 0.f};
#pragma unroll 4
        for (int j0 = 0; j0 < 16; ++j0) { const int j = (j0 + jrot) & 15;
            const f32x4 a0 = *(const f32x4*)(xp0 + 16 * j), a1 = *(const f32x4*)(xp1 + 16 * j);
#pragma unroll
            for (int n = 0; n < 3; ++n) if (n < a.ntile) { const f32x4 bv = wp[(size_t)(j * a.ntile + n) * 64];
#pragma unroll
                for (int i = 0; i < 4; ++i) { acc[0][n] = __builtin_amdgcn_mfma_f32_16x16x4f32(a0[i], bv[i], acc[0][n], 0, 0, 0); acc[1][n] = __builtin_amdgcn_mfma_f32_16x16x4f32(a1[i], bv[i], acc[1][n], 0, 0, 0); } } }
#pragma unroll
        for (int g = 0; g < 2; ++g)
#pragma unroll
            for (int n = 0; n < 3; ++n) if (n < a.ntile) {
#pragma unroll
                for (int r = 0; r < 4; ++r) part[(wid * 32 + 16 * g + 4 * kq + r) * 48 + 16 * n + row] = acc[g][n][r]; }
        __syncthreads();
        for (int i = tid; i < 32 * 16 * a.ntile; i += NTHR) { const int n = i % (16 * a.ntile), r = i / (16 * a.ntile); float s = 0.f;
#pragma unroll
            for (int w = 0; w < 8; ++w) s += part[(w * 32 + r) * 48 + n]; logit[r * 48 + n] = s; }
        __syncthreads();
        if (a.ntile == 1) { const int r = tid & 31, n = tid >> 5; if (r < 16 || two) { const int t = (r < 16 ? g0 : g1) * 16 + (r & 15); const float x = logit[r * 48 + n] + a.fbias[n]; const float ls = fminf(x, 0.f) - 0.6931471805599453f * __builtin_amdgcn_logf(1.0f + __builtin_amdgcn_exp2f(-fabsf(x) * LOG2E));     a.flog[((size_t)((t >> 11) * 16 + n)) * S + (t & (S - 1))] = ls; } }
        else if (tid < 16 || (tid < 32 && two)) { const int t = (tid < 16 ? g0 : g1) * 16 + (tid & 15); FK_LAS const float* lg = logit + tid * 48;
            float g4[4]; float mx = -3e38f; int gs = 0;
            for (int i = 0; i < 4; ++i) { g4[i] = lg[i] + a.bgrp[i]; if (g4[i] > mx) { mx = g4[i]; gs = i; } }
            float den = 0.f; for (int i = 0; i < 4; ++i) den += expf(g4[i] - mx); const float pg = 1.f / den;
            float e[8]; for (int i = 0; i < 8; ++i) e[i] = lg[4 + gs * 8 + i] + a.brt[gs * 8 + i];
            int i1 = 0; for (int i = 1; i < 8; ++i) if (e[i] > e[i1]) i1 = i;
            int i2 = -1; for (int i = 0; i < 8; ++i) if (i != i1 && (i2 < 0 || e[i] > e[i2])) i2 = i;
            const float w1 = 1.f / (1.f + expf(e[i2] - e[i1])), w2 = 1.f - w1;
            const int ea = gs * 8 + i1, eb = gs * 8 + i2;
            const int pa = atomicAdd(a.rcnt + ea * 32, 1), pb = atomicAdd(a.rcnt + eb * 32, 1);
            a.ote[t * 2] = ea; a.ote[t * 2 + 1] = eb; a.otpos[t * 2] = pa; a.otpos[t * 2 + 1] = pb; a.otw[t * 2] = w1 * pg; a.otw[t * 2 + 1] = w2 * pg;
            a.list[ea * NT + pa] = t; a.list[eb * NT + pb] = t; a.sw[ea * NT + pa] = w1 * pg; a.sw[eb * NT + pb] = w2 * pg; }
        __syncthreads();
    }
}

__device__ __forceinline__ void moe_tables(const int* cnt, FK_LAS int* tab) {
    const int tid = fk_tid(), lane = tid & 63;
    __syncthreads();
    if (tid < 64) { const int c = lane < 32 ? cnt[lane * 32] : 0; const int nt = (c + 255) >> 8; int incl = nt;
#pragma unroll
        for (int o = 1; o < 32; o <<= 1) { const int v = __shfl_up(incl, o); if (lane >= o) incl += v; }
        if (lane < 32) { tab[lane] = incl - nt; tab[40 + lane] = (incl - nt) * 256; tab[80 + lane] = c; }
        if (lane == 31) tab[32] = incl; }
    __syncthreads();
}
struct MoeSched1 {
    const char* xb; const char* Bt; const int* list; FK_LAS const int* tab; int G, c;
    __device__ __forceinline__ bool next(int i, GUnit& u) const {
        const int L = i * G + c; const int tot = tab[32] * 4; if (L >= tot) return false;
        int e = 0;
#pragma unroll 1
        for (int q = 1; q < 32; ++q) if (L >= tab[q] * 4) e = q;
        const int r = L - tab[e] * 4, nte = tab[e + 1] - tab[e]; const int mt = r % nte, pn = r / nte;
        u.e = e; u.pm = mt; u.pn = pn; u.nrows = min(256, tab[80 + e] - 256 * mt); u.A = xb; u.B = Bt + ((size_t)e * 1024 + (size_t)pn * 256) * D * 2; return true; }
    __device__ __forceinline__ void a_offs(const GUnit& u, int tid, unsigned (&o)[2][2]) const { int R0, C0, R1, C1; stage_rc(tid * 16, R0, C0); stage_rc(tid * 16 + 8192, R1, C1);
        const int* l = list + (size_t)u.e * NT + u.pm * 256;
        const int r00 = R0 < u.nrows ? R0 : 0, r01 = R1 < u.nrows ? R1 : 0, r10 = R0 + HALF < u.nrows ? R0 + HALF : 0, r11 = R1 + HALF < u.nrows ? R1 + HALF : 0;
        o[0][0] = (unsigned)(l[r00] * D + C0) * 2u; o[0][1] = (unsigned)(l[r01] * D + C1) * 2u; o[1][0] = (unsigned)(l[r10] * D + C0) * 2u; o[1][1] = (unsigned)(l[r11] * D + C1) * 2u; }
};
struct MoeSched2 {
    const char* H; const char* Bt; FK_LAS const int* tab; int G, c;
    __device__ __forceinline__ bool next(int i, GUnit& u) const {
        const int L = i * G + c; const int tot = tab[32] * 8; if (L >= tot) return false;
        int e = 0;
#pragma unroll 1
        for (int q = 1; q < 32; ++q) if (L >= tab[q] * 8) e = q;
        const int r = L - tab[e] * 8, nte = tab[e + 1] - tab[e]; const int mt = r % nte, pn = r / nte;
        u.e = e; u.pm = mt; u.pn = pn; u.nrows = min(256, tab[80 + e] - 256 * mt); u.A = H + (size_t)(tab[40 + e] + 256 * mt) * 512 * 2; u.B = Bt + ((size_t)e * 2048 + (size_t)pn * 256) * 512 * 2; return true; }
    __device__ __forceinline__ void a_offs(const GUnit&, int tid, unsigned (&o)[2][2]) const { int R0, C0, R1, C1; stage_rc(tid * 16, R0, C0); stage_rc(tid * 16 + 8192, R1, C1);
        o[0][0] = (unsigned)(R0 * 512 + C0) * 2u; o[0][1] = (unsigned)(R1 * 512 + C1) * 2u; o[1][0] = o[0][0] + (unsigned)(HALF * 512 * 2); o[1][1] = o[0][1] + (unsigned)(HALF * 512 * 2); }
};
struct EpiMoe1 {
    static constexpr bool PERM = false;
    bf16_t* H; const float* sw; FK_LAS const int* tab;
    __device__ __forceinline__ void operator()(const f32x4 (&acc)[2][2][4][2], const GUnit& u, int wr, int wc, int fr, int fq) const {
        const int hrow0 = tab[40 + u.e] + 256 * u.pm; const float* swe = sw + (size_t)u.e * NT + 256 * u.pm;
#pragma unroll
        for (int ai = 0; ai < 2; ++ai)
#pragma unroll
            for (int m = 0; m < 4; ++m) { const int r = ai * HALF + wr * 64 + m * 16 + fr; if (r < u.nrows) { const float wgt = swe[r];
#pragma unroll
                for (int bj = 0; bj < 2; ++bj) { const f32x4 g = acc[ai][bj][m][0], up = acc[ai][bj][m][1]; f32x4 h;
#pragma unroll
                    for (int j = 0; j < 4; ++j) h[j] = g[j] * __builtin_amdgcn_rcpf(1.0f + __builtin_amdgcn_exp2f(-g[j] * LOG2E)) * up[j] * wgt;
                    u32x2 p; p.x = cvt_pk_bf16(h[0], h[1]); p.y = cvt_pk_bf16(h[2], h[3]);
                    *(u32x2*)(H + (size_t)(hrow0 + r) * 512 + u.pn * 128 + bj * 64 + wc * 16 + 4 * fq) = p; } } }
    }
};
struct EpiMoe2 {
    static constexpr bool PERM = true;
    bf16_t* Y2; FK_LAS const int* tab;
    __device__ __forceinline__ void operator()(const f32x4 (&acc)[2][2][4][2], const GUnit& u, int wr, int wc, int fr, int fq) const {
        const int hrow0 = tab[40 + u.e] + 256 * u.pm;
#pragma unroll
        for (int ai = 0; ai < 2; ++ai)
#pragma unroll
            for (int m = 0; m < 4; ++m) { const int r = ai * HALF + wr * 64 + m * 16 + fr; if (r < u.nrows) {
#pragma unroll
                for (int bj = 0; bj < 2; ++bj) *(u32x4*)(Y2 + (size_t)(hrow0 + r) * D + u.pn * BM + bj * HALF + wc * 32 + 8 * fq) = pack8(acc[ai][bj][m][0], acc[ai][bj][m][1]); } }
    }
};
}
namespace fk {
constexpr int SG_ROWS = 640, SG_ASTG = SG_ROWS * 64, SG_BSTG = 128 * 64, SG_A = 0, SG_B = 3 * SG_ASTG;
struct SgArgs {
    const char* A; const int* rowlist; int arow0, lda_bytes, nr;
    const float* B0; const float* B1; int ldn, K;
    bf16_t* out; int out_row0, out_ld, out_col0; const float* roww; int var;
};
template <int MF>
__device__ __forceinline__ void sg_loop(FK_LAS unsigned char* lds, f32x4 (&acc)[10][4], const char* const (&ap)[5], const float* bpt, const int ldn, const int nt, const unsigned a_rd, const unsigned b_rd, const unsigned b_wr, const int wid) {
    float br0[8], br1[8];
#define SG_ISSUE(t, sA, R) do { const int t_ = (t) < nt ? (t) : nt - 1; \
        _Pragma("unroll") for (int i = 0; i < 5; ++i) __builtin_amdgcn_global_load_lds((const unsigned*)(ap[i] + (size_t)t_ * 64), (FK_LAS unsigned*)(lds + SG_A + (sA) * SG_ASTG + (5 * wid + i) * 1024), 16, 0, 0); \
        const float* bq_ = bpt + (size_t)t_ * 32 * ldn; \
        _Pragma("unroll") for (int i = 0; i < 8; ++i) R[i] = bq_[(size_t)i * ldn]; } while (0)
#define SG_CONV(R, sB) do { u32x4 w_; w_.x = cvt_pk_bf16(R[0], R[1]); w_.y = cvt_pk_bf16(R[2], R[3]); w_.z = cvt_pk_bf16(R[4], R[5]); w_.w = cvt_pk_bf16(R[6], R[7]); \
        *(FK_LAS u32x4*)(lds + SG_B + (sB) * SG_BSTG + b_wr) = w_; } while (0)
#define SG_DSR(dst, addr, off) asm volatile("ds_read_b128 %0, %1 offset:%2" : "=v"(dst) : "v"(addr), "n"(off))
#define SG_STEP(t, RI, RC) do { \
        asm volatile("s_waitcnt lgkmcnt(0)\n\ts_barrier" ::: "memory");                \
        { const int s2_ = sa == 0 ? 2 : sa - 1; SG_ISSUE((t) + 2, s2_, RI); }          \
        __builtin_amdgcn_sched_barrier(0); \
        const unsigned aa_ = a_rd + (unsigned)(sa * SG_ASTG), ba_ = b_rd + (unsigned)(((t) & 1) * SG_BSTG); \
        bf16x8 b0_, b1_, b2_, b3_, a0_, a1_; \
        SG_DSR(b0_, ba_, 0); SG_DSR(b1_, ba_, 1024); SG_DSR(b2_, ba_, 2048); SG_DSR(b3_, ba_, 3072); \
        SG_DSR(a0_, aa_, 0); SG_DSR(a1_, aa_, 1024);                                    \
        asm volatile("s_waitcnt lgkmcnt(1)" : "+v"(b0_), "+v"(b1_), "+v"(b2_), "+v"(b3_), "+v"(a0_)); \
        _Pragma("unroll") for (int i = 0; i < MF; i += 2) { \
            if (i > 0) asm volatile("s_waitcnt lgkmcnt(1)" : "+v"(a0_)); \
            acc[i][0] = __builtin_amdgcn_mfma_f32_16x16x32_bf16(b0_, a0_, acc[i][0], 0, 0, 0); acc[i][1] = __builtin_amdgcn_mfma_f32_16x16x32_bf16(b1_, a0_, acc[i][1], 0, 0, 0); \
            acc[i][2] = __builtin_amdgcn_mfma_f32_16x16x32_bf16(b2_, a0_, acc[i][2], 0, 0, 0); acc[i][3] = __builtin_amdgcn_mfma_f32_16x16x32_bf16(b3_, a0_, acc[i][3], 0, 0, 0); \
            if (i + 2 < MF) { SG_DSR(a0_, aa_, (i + 2) * 1024); asm volatile("s_waitcnt lgkmcnt(1)" : "+v"(a1_)); } else asm volatile("s_waitcnt lgkmcnt(0)" : "+v"(a1_)); \
            acc[i + 1][0] = __builtin_amdgcn_mfma_f32_16x16x32_bf16(b0_, a1_, acc[i + 1][0], 0, 0, 0); acc[i + 1][1] = __builtin_amdgcn_mfma_f32_16x16x32_bf16(b1_, a1_, acc[i + 1][1], 0, 0, 0); \
            acc[i + 1][2] = __builtin_amdgcn_mfma_f32_16x16x32_bf16(b2_, a1_, acc[i + 1][2], 0, 0, 0); acc[i + 1][3] = __builtin_amdgcn_mfma_f32_16x16x32_bf16(b3_, a1_, acc[i + 1][3], 0, 0, 0); \
            if (i + 3 < MF) SG_DSR(a1_, aa_, (i + 3) * 1024); } \
        asm volatile("s_waitcnt vmcnt(13)" ::: "memory");                              \
        SG_CONV(RC, ((t) + 1) & 1); \
        sa = sa == 2 ? 0 : sa + 1; } while (0)
    SG_ISSUE(0, 0, br0); SG_ISSUE(1, 1, br1);
    asm volatile("s_waitcnt vmcnt(13)" ::: "memory");
    SG_CONV(br0, 0);
    int sa = 0;
#pragma unroll 1
    for (int t = 0; t < nt; t += 2) { SG_STEP(t, br0, br1); SG_STEP(t + 1, br1, br0); }
#undef SG_ISSUE
#undef SG_CONV
#undef SG_STEP
#undef SG_DSR
}
template <int MODE>
__device__ __forceinline__ void sg_unit(FK_LAS unsigned char* lds, const SgArgs a) {
    const int tid = fk_tid(), wid = __builtin_amdgcn_readfirstlane(tid >> 6), lane = tid & 63, r16 = lane & 15, kq = lane >> 4, wm = wid >> 1, wn = wid & 1;
    const int rpw = ((a.nr + 63) >> 6) << 4, mf = rpw >> 4;
    const int nt = a.K >> 5;
    const char* ap[5];
    { const int kc = (lane & 3) ^ ((lane >> 4) & 3);
#pragma unroll
      for (int i = 0; i < 5; ++i) { int r = 16 * (5 * wid + i) + (lane >> 2); r = r < a.nr ? r : a.nr - 1; const int gr = a.rowlist ? a.rowlist[r] : a.arow0 + r; ap[i] = a.A + (size_t)gr * a.lda_bytes + kc * 16; } }
    const int cimg = tid & 127, kqw = tid >> 7;
    const float* bpt;
    if (MODE == 1) { const int blk = cimg >> 5; bpt = ((blk & 1) ? a.B1 : a.B0) + 32 * (blk >> 1) + (cimg & 31) + (size_t)(8 * kqw) * a.ldn; }
    else bpt = a.B0 + cimg + (size_t)(8 * kqw) * a.ldn;
    const unsigned b_wr = (unsigned)(cimg * 64 + ((kqw ^ ((cimg >> 2) & 3)) << 4));
    const unsigned a_rd = (unsigned)(SG_A + (wm * rpw + r16) * 64 + ((kq ^ ((r16 >> 2) & 3)) << 4));
    const unsigned b_rd = (unsigned)(SG_B + (wn * 64 + r16) * 64 + ((kq ^ ((r16 >> 2) & 3)) << 4));
    f32x4 acc[10][4];
#pragma unroll
    for (int i = 0; i < 10; ++i)
#pragma unroll
        for (int j = 0; j < 4; ++j) acc[i][j] = (f32x4){0.f, 0.f, 0.f, 0.f};
    switch ((mf + 1) >> 1) {
        case 1: sg_loop<2>(lds, acc, ap, bpt, a.ldn, nt, a_rd, b_rd, b_wr, wid); break;
        case 2: sg_loop<4>(lds, acc, ap, bpt, a.ldn, nt, a_rd, b_rd, b_wr, wid); break;
        case 3: sg_loop<6>(lds, acc, ap, bpt, a.ldn, nt, a_rd, b_rd, b_wr, wid); break;
        case 4: sg_loop<8>(lds, acc, ap, bpt, a.ldn, nt, a_rd, b_rd, b_wr, wid); break;
        default: sg_loop<10>(lds, acc, ap, bpt, a.ldn, nt, a_rd, b_rd, b_wr, wid); break;
    }
    float wgts[10];
#pragma unroll
    for (int i = 0; i < 10; ++i) { const int r = wm * rpw + 16 * i + r16; wgts[i] = (MODE == 1 && i < mf && r < a.nr) ? a.roww[r] : 0.f; }
#pragma unroll
    for (int i = 0; i < 10; ++i) if (i < mf) { const int r = wm * rpw + 16 * i + r16; if (r < a.nr) {
        if (MODE == 1) { const float wgt = wgts[i]; bf16_t* orow = a.out + (size_t)(a.out_row0 + r) * a.out_ld + a.out_col0 + 32 * wn + 4 * kq;
#pragma unroll
            for (int j = 0; j < 2; ++j) { const f32x4 g = acc[i][j], up = acc[i][j + 2]; f32x4 h;
#pragma unroll
                for (int q = 0; q < 4; ++q) h[q] = g[q] * __builtin_amdgcn_rcpf(1.0f + __builtin_amdgcn_exp2f(-g[q] * LOG2E)) * up[q] * wgt;
                u32x2 p; p.x = cvt_pk_bf16(h[0], h[1]); p.y = cvt_pk_bf16(h[2], h[3]); *(u32x2*)(orow + 16 * j) = p; } }
        else { bf16_t* orow = a.out + (size_t)(a.out_row0 + r) * a.out_ld + a.out_col0 + 64 * wn + 4 * kq;
#pragma unroll
            for (int j = 0; j < 4; ++j) { const f32x4 v = acc[i][j]; u32x2 p; p.x = cvt_pk_bf16(v[0], v[1]); p.y = cvt_pk_bf16(v[2], v[3]); *(u32x2*)(orow + 16 * j) = p; } } } }
    asm volatile("s_waitcnt vmcnt(0)" ::: "memory");
    __syncthreads();
}
__device__ __forceinline__ void phase_moe1(FK_LAS unsigned char* lds, FK_LAS const int* tab, const bf16_t* xb, const int* list, const float* sw, const float* wgate, const float* wup, bf16_t* H, int var) {
#pragma unroll 1
    for (int u = fk_bid(), nb = fk_nblk(); u < 256; u += nb) { const int xcd = u & 7, q = u >> 3, e = xcd + 8 * (q >> 3), s = q & 7; const int ne = tab[80 + e], hrow0 = tab[40 + e];
        const int rbeg = 0, rend = ne;
#pragma unroll 1
        for (int r0 = rbeg; r0 < rend; r0 += SG_ROWS) { SgArgs a; a.A = (const char*)xb; a.rowlist = list + (size_t)e * NT + r0; a.arow0 = 0; a.lda_bytes = D * 2; a.nr = min(SG_ROWS, rend - r0);
            a.B0 = wgate + (size_t)e * D * 512 + 64 * s; a.B1 = wup + (size_t)e * D * 512 + 64 * s; a.ldn = 512; a.K = D;
            a.out = H; a.out_row0 = hrow0 + r0; a.out_ld = 512; a.out_col0 = 64 * s; a.roww = sw + (size_t)e * NT + r0; a.var = var; sg_unit<1>(lds, a); } }
}
__device__ __forceinline__ void phase_moe2(FK_LAS unsigned char* lds, FK_LAS const int* tab, const bf16_t* H, const float* wdown, bf16_t* Y2, int var) {
#pragma unroll 1
    for (int u = fk_bid(), nb = fk_nblk(); u < 512; u += nb) { const int xcd = u & 7, q = u >> 3, e = xcd + 8 * (q >> 4), s = q & 15; const int ne = tab[80 + e], hrow0 = tab[40 + e];
        const int rbeg = 0, rend = ne;
#pragma unroll 1
        for (int r0 = rbeg; r0 < rend; r0 += SG_ROWS) { SgArgs a; a.A = (const char*)H; a.rowlist = nullptr; a.arow0 = hrow0 + r0; a.lda_bytes = 512 * 2; a.nr = min(SG_ROWS, rend - r0);
            a.B0 = wdown + (size_t)e * 512 * D + 128 * s; a.B1 = nullptr; a.ldn = D; a.K = 512;
            a.out = Y2; a.out_row0 = hrow0 + r0; a.out_ld = D; a.out_col0 = 128 * s; a.roww = nullptr; a.var = var; sg_unit<2>(lds, a); } }
}
}
namespace fk {
struct EpiBf16Q {
    static constexpr bool PERM = true;
    bf16_t* O; int ldc, qcols; float qscale;
    __device__ __forceinline__ void operator()(const f32x4 (&acc)[2][2][4][2], const GUnit& u, int wr, int wc, int fr, int fq) const {
        const int row0 = u.pm * BM + wr * 64 + fr;
#pragma unroll
        for (int bj = 0; bj < 2; ++bj) { const int gc = u.pn * BM + bj * HALF + wc * 32 + 8 * fq; const float sc = gc < qcols ? qscale : 1.0f;
#pragma unroll
            for (int ai = 0; ai < 2; ++ai)
#pragma unroll
                for (int m = 0; m < 4; ++m) *(u32x4*)(O + (size_t)(row0 + ai * HALF + m * 16) * ldc + gc) = pack8(acc[ai][bj][m][0] * sc, acc[ai][bj][m][1] * sc); }
    }
};
__device__ __forceinline__ void fox_cumsum_lds(const float* lsig, FK_LAS float* cfl, FK_LAS double* wtot, const int b, const int h) {
    const int tid = fk_tid(), lane = tid & 63, wid = tid >> 6;
    __syncthreads();
    const f32x4 v = *(const f32x4*)(lsig + (size_t)(b * 16 + h) * S + 4 * tid);
    const double s0 = (double)v[0], s1 = s0 + (double)v[1], s2 = s1 + (double)v[2], s3 = s2 + (double)v[3];
    double incl = s3;
#pragma unroll
    for (int o = 1; o < 64; o <<= 1) { const double u = __shfl_up(incl, o); if (lane >= o) incl += u; }
    if (lane == 63) wtot[wid] = incl;
    __syncthreads();
    double off = incl - s3;
#pragma unroll
    for (int w = 0; w < 7; ++w) if (w < wid) off += wtot[w];
    f32x4 o4; o4[0] = (float)((off + s0) * 1.4426950408889634); o4[1] = (float)((off + s1) * 1.4426950408889634); o4[2] = (float)((off + s2) * 1.4426950408889634); o4[3] = (float)((off + s3) * 1.4426950408889634);
    *(FK_LAS f32x4*)(cfl + 4 * tid) = o4;
    __syncthreads();
}
struct EpiDsaIn {
    static constexpr bool PERM = true;
    bf16_t *q, *k, *v, *qidx, *kidx; float* widx;
    __device__ __forceinline__ void operator()(const f32x4 (&acc)[2][2][4][2], const GUnit& u, int wr, int wc, int fr, int fq) const {
        const int row0 = u.pm * BM + wr * 64 + fr;
#pragma unroll
        for (int bj = 0; bj < 2; ++bj) { const int gc = u.pn * BM + bj * HALF + wc * 32 + 8 * fq;
            bf16_t* dst; int ld, c; float sc = 1.0f;
            if (gc < 2048) { dst = q; ld = 2048; c = gc; sc = QSCALE_128; } else if (gc < 2176) { dst = k; ld = 128; c = gc - 2048; } else if (gc < 2304) { dst = v; ld = 128; c = gc - 2176; }
            else if (gc < 3328) { dst = qidx; ld = 1024; c = gc - 2304; } else if (gc < 3392) { dst = kidx; ld = 64; c = gc - 3328; } else { dst = nullptr; ld = 0; c = gc - 3392; }
#pragma unroll
            for (int ai = 0; ai < 2; ++ai)
#pragma unroll
                for (int m = 0; m < 4; ++m) { const int row = row0 + ai * HALF + m * 16;
                    if (dst) *(u32x4*)(dst + (size_t)row * ld + c) = pack8(acc[ai][bj][m][0] * sc, acc[ai][bj][m][1] * sc);
                    else if (c < 16) { *(f32x4*)(widx + (size_t)row * 16 + c) = acc[ai][bj][m][0] * 0.03125f; *(f32x4*)(widx + (size_t)row * 16 + c + 4) = acc[ai][bj][m][1] * 0.03125f; } } }
    }
};

__device__ __forceinline__ unsigned ord_u32(float f) { const unsigned b = __float_as_uint(f); return b ^ ((b >> 31) ? 0xFFFFFFFFu : 0x80000000u); }
__device__ __forceinline__ int half_sum(int v) {
    v += __shfl_xor(v, 1); v += __shfl_xor(v, 2); v += __shfl_xor(v, 4); v += __shfl_xor(v, 8); v += __shfl_xor(v, 16); return v; }
__device__ __forceinline__ void dsa_index_unit(FK_LAS unsigned char* lds, const bf16_t* qidx, const bf16_t* kidx, const float* widx, unsigned short* sel, int* nsel, const int b, const int g, const int var = 0) {
    const int tid = fk_tid(), wid = __builtin_amdgcn_readfirstlane(tid >> 6), lane = tid & 63, r32 = lane & 31, hi = lane >> 5;
    const int t0 = 16 * g, ntile = (t0 >> 6) + 1, nk = 64 * ntile;
    const int tq = t0 + 2 * wid;
    bf16x8 qa[4]; float wv[16];
    { const int row = r32, q = row >> 4, h = row & 15; const bf16_t* p = qidx + ((size_t)(b * S + tq + q)) * 1024 + h * 64 + hi * 8;
#pragma unroll
      for (int ks = 0; ks < 4; ++ks) qa[ks] = *(const bf16x8*)(p + ks * 16);
#pragma unroll
      for (int r = 0; r < 16; ++r) { const int rw = crow(r, hi); wv[r] = widx[((size_t)(b * S + tq + (rw >> 4))) * 16 + (rw & 15)]; } }
    const int krr = tid >> 3, krc = tid & 7, krw = FK_KRSWZ(krr, krc);
    unsigned uk[64];
    bf16x8 stg[4];
#define DI_LOAD(T) do { _Pragma("unroll") for (int q_ = 0; q_ < 4; ++q_) stg[q_] = *(const bf16x8*)(kidx + ((size_t)(b * S + (T) * 256 + q_ * 64 + krr)) * 64 + krc * 8); } while (0)
#define DI_WRITE(bf) do { _Pragma("unroll") for (int q_ = 0; q_ < 4; ++q_) *(FK_LAS bf16x8*)(lds + (bf) * 32768 + q_ * 8192 + krw) = stg[q_]; } while (0)
    const int nt256 = (nk + 255) >> 8;
    DI_LOAD(0); DI_WRITE(0); __syncthreads();
#pragma unroll
    for (int i = 0; i < 64; ++i) uk[i] = 0u;
#pragma unroll 1
    for (int it = 0; it < 8; ++it) {
#pragma unroll
        for (int i = 0; i < 56; ++i) uk[i] = uk[i + 8];
        if (it < nt256 && !(var & 16)) {
            if (it + 1 < nt256) DI_LOAD(it + 1);
#pragma unroll
            for (int jj = 0; jj < 4; ++jj) { const int j = 4 * it + jj;
                if (j < ntile) {
                    FK_LAS const unsigned char* kb = lds + (it & 1) * 32768 + jj * 8192;
#pragma unroll
                    for (int sub = 0; sub < 2; ++sub) {
                        f32x16 acc;
#pragma unroll
                        for (int r = 0; r < 16; ++r) acc[r] = 0.f;
#pragma unroll
                        for (int ks = 0; ks < 4; ++ks) { const bf16x8 kf = *(FK_LAS const bf16x8*)(kb + FK_KRSWZ(32 * sub + r32, 2 * ks + hi)); acc = __builtin_amdgcn_mfma_f32_32x32x16_bf16(qa[ks], kf, acc, 0, 0, 0); }
                        float s0 = 0.f, s1 = 0.f;
#pragma unroll
                        for (int r = 0; r < 8; ++r) { s0 += fmaxf(acc[r], 0.f) * wv[r]; s1 += fmaxf(acc[8 + r], 0.f) * wv[8 + r]; }
                        auto rr = __builtin_amdgcn_permlane32_swap(__float_as_uint(s0), __float_as_uint(s1), false, false);
                        uk[56 + 2 * jj + sub] = ord_u32(__uint_as_float(rr[0]) + __uint_as_float(rr[1]));
                    }
                } else { uk[56 + 2 * jj] = 0u; uk[56 + 2 * jj + 1] = 0u; }
            }
            if (it + 1 < nt256) DI_WRITE((it + 1) & 1);
            __syncthreads();
        } else {
#pragma unroll
            for (int q_ = 0; q_ < 8; ++q_) uk[56 + q_] = 0u; }
    }
#undef DI_LOAD
#undef DI_WRITE
    const int t = tq + hi;
    unsigned short* so = sel + ((size_t)(b * S + t)) * 256;
    int base = 0;
    if (nk <= 256 || (var & 8)) {
#pragma unroll
        for (int s = 0; s < 8; ++s) { const int key = 32 * s + r32; so[key] = (unsigned short)(key < nk ? key : 0); }
        base = nk;
    } else {
        unsigned T = 0u; bool done = false;
#pragma unroll 1
        for (int bit = 31; bit >= 0; --bit) { const unsigned cand = T | (1u << bit); int c = 0;
#pragma unroll
            for (int s = 0; s < 64; ++s) c += (uk[s] >= cand) ? 1 : 0;
            c = half_sum(c); if (!done && c >= 256) { T = cand; done = (c == 256); }
            if (__all(done)) break; }
        int cgt = 0;
#pragma unroll
        for (int s = 0; s < 64; ++s) cgt += (uk[s] > T) ? 1 : 0;
        cgt = half_sum(cgt);
        const int need = 256 - cgt; int eqb = 0;
#pragma unroll
        for (int s = 0; s < 64; ++s) { const int key = 32 * s + r32; const unsigned u = uk[s];
            const bool iseq = (u == T);
            const unsigned long long em = __ballot(iseq); const unsigned eh = hi ? (unsigned)(em >> 32) : (unsigned)em; const int erank = eqb + __popc(eh & ((1u << r32) - 1u)); eqb += __popc(eh);
            const bool take = (u > T) || (iseq && erank < need);
            const unsigned long long tm = __ballot(take); const unsigned th = hi ? (unsigned)(tm >> 32) : (unsigned)tm; const int pos = base + __popc(th & ((1u << r32) - 1u)); base += __popc(th);
            if (take) so[pos] = (unsigned short)key; }
    }
    if (r32 == 0) nsel[b * S + t] = base;
}

constexpr int DS_T5 = 131072, DS_LUT = 133120, DS_SEL = 135168;
__device__ __forceinline__ void phase_dsa_attn(FK_LAS unsigned char* lds, const bf16_t* dq, const bf16_t* dk, const bf16_t* dv, const unsigned short* sel, const int* nsel, const float* t5, bf16_t* o) {
    const int tid = fk_tid(), wid = __builtin_amdgcn_readfirstlane(tid >> 6), lane = tid & 63, c16 = lane & 15, g = lane >> 4;
    FK_LAS float* t5l = (FK_LAS float*)(lds + DS_T5); FK_LAS unsigned char* lut = lds + DS_LUT;
    for (int i = tid; i < 512; i += NTHR) t5l[i] = t5[i] * LOG2E;
    for (int n = tid; n < 2048; n += NTHR) { int bk; if (n < 8) bk = n; else { bk = 8 + (int)(logf((float)n / 8.0f) / 2.772588722239781f * 8.0f); if (bk > 15) bk = 15; } lut[n] = (unsigned char)bk; }
    __syncthreads();
    FK_LAS unsigned char* vst = lds + wid * 16384;
    FK_LAS unsigned short* sell = (FK_LAS unsigned short*)(lds + DS_SEL + wid * 512);
    const unsigned vbase = (unsigned)(size_t)vst;
#pragma unroll 1
    for (int tg = fk_bid() * 8 + wid; tg < NT; tg += fk_nblk() * 8) {
        const int b = tg >> 11, t = tg & (S - 1); const int cnt = nsel[tg];
        const bf16_t* kb = dk + (size_t)b * S * 128; const bf16_t* vb = dv + (size_t)b * S * 128;
        { const u32x2 s4 = *(const u32x2*)(sel + (size_t)tg * 256 + lane * 4); *(FK_LAS u32x2*)(sell + lane * 4) = s4; }
        bf16x8 qf[4];
#pragma unroll
        for (int ks = 0; ks < 4; ++ks) qf[ks] = *(const bf16x8*)(dq + (size_t)tg * 2048 + c16 * 128 + ks * 32 + g * 8);
        asm volatile("s_waitcnt lgkmcnt(0)" ::: "memory");
        f32x4 sc[16];
#pragma unroll
        for (int ib = 0; ib < 4; ++ib) {
            bf16x8 kf[4][4];
#pragma unroll
            for (int u = 0; u < 4; ++u) { const int kk = sell[16 * (4 * ib + u) + c16]; const bf16_t* kr = kb + (size_t)kk * 128 + g * 8;
#pragma unroll
                for (int ks = 0; ks < 4; ++ks) kf[u][ks] = *(const bf16x8*)(kr + ks * 32); }
#pragma unroll
            for (int u = 0; u < 4; ++u) { f32x4 a = {0.f, 0.f, 0.f, 0.f};
#pragma unroll
                for (int ks = 0; ks < 4; ++ks) a = __builtin_amdgcn_mfma_f32_16x16x32_bf16(kf[u][ks], qf[ks], a, 0, 0, 0);
                sc[4 * ib + u] = a; }
        }
        float mx = -3.0e38f;
#pragma unroll
        for (int i = 0; i < 16; ++i) { const u32x2 k4 = *(FK_LAS const u32x2*)(sell + 16 * i + 4 * g);
#pragma unroll
            for (int r = 0; r < 4; ++r) { const int kk = (r < 2 ? (k4.x >> (16 * r)) : (k4.y >> (16 * (r - 2)))) & 0xffff; const int rel = kk - t; const int n = rel < 0 ? -rel : rel; const int bk = (rel > 0 ? 16 : 0) + lut[n];
                float v = sc[i][r] + t5l[bk * 16 + c16]; v = (16 * i + 4 * g + r < cnt) ? v : -__builtin_inff(); sc[i][r] = v; mx = fmaxf(mx, v); } }
        mx = fmaxf(mx, __shfl_xor(mx, 16)); mx = fmaxf(mx, __shfl_xor(mx, 32));
        float sum = 0.f;
#pragma unroll
        for (int i = 0; i < 16; ++i)
#pragma unroll
            for (int r = 0; r < 4; ++r) { const float p = __builtin_amdgcn_exp2f(sc[i][r] - mx); sc[i][r] = p; sum += p; }
        sum += __shfl_xor(sum, 16); sum += __shfl_xor(sum, 32);
        const float inv = __builtin_amdgcn_rcpf(sum);
        u32x4 pw[8];
#pragma unroll
        for (int c = 0; c < 8; ++c) pw[c] = pack8(sc[2 * c], sc[2 * c + 1]);
        f32x4 oa[8];
#pragma unroll
        for (int d = 0; d < 8; ++d) oa[d] = (f32x4){0.f, 0.f, 0.f, 0.f};
        bf16x8 vv[2][8];
#define DS_VLOAD(c, B) do { _Pragma("unroll") for (int it = 0; it < 8; ++it) { const int idx = lane + 64 * it, lr = idx >> 4, ch = idx & 15; const int kk = sell[32 * (c) + lr]; vv[B][it] = *(const bf16x8*)(vb + (size_t)kk * 128 + ch * 8); } } while (0)
        DS_VLOAD(0, 0);
#pragma unroll
        for (int c = 0; c < 8; ++c) {
            if (32 * c < cnt) {
                if (c + 1 < 8 && 32 * (c + 1) < cnt) DS_VLOAD(c + 1, (c + 1) & 1);
#pragma unroll
                for (int it = 0; it < 8; ++it) { const int idx = lane + 64 * it, lr = idx >> 4, ch = idx & 15; *(FK_LAS bf16x8*)(vst + lr * 256 + ((ch ^ ((lr & 7) << 1)) << 4)) = vv[c & 1][it]; }
                const bf16x8 pf = *reinterpret_cast<const bf16x8*>(&pw[c]);
                asm volatile("s_waitcnt lgkmcnt(0)" ::: "memory");
                const int q4 = c16 >> 2, p4 = c16 & 3; const int rowA = 4 * g + q4, rowB = 16 + 4 * g + q4;
#pragma unroll
                for (int d = 0; d < 8; ++d) { s16x4 lo, hi4;
                    const unsigned aA = vbase + rowA * 256 + (((2 * d + (p4 >> 1)) ^ ((rowA & 7) << 1)) << 4) + (p4 & 1) * 8;
                    const unsigned aB = vbase + rowB * 256 + (((2 * d + (p4 >> 1)) ^ ((rowB & 7) << 1)) << 4) + (p4 & 1) * 8;
                    asm volatile("ds_read_b64_tr_b16 %0, %1" : "=&v"(lo) : "v"(aA) : "memory");
                    asm volatile("ds_read_b64_tr_b16 %0, %1" : "=&v"(hi4) : "v"(aB) : "memory");
                    asm volatile("s_waitcnt lgkmcnt(0)" ::: "memory"); __builtin_amdgcn_sched_barrier(0);
                    oa[d] = __builtin_amdgcn_mfma_f32_16x16x32_bf16((bf16x8){lo[0], lo[1], lo[2], lo[3], hi4[0], hi4[1], hi4[2], hi4[3]}, pf, oa[d], 0, 0, 0); }
            }
        }
#undef DS_VLOAD
#pragma unroll
        for (int d = 0; d < 8; ++d) { u32x2 p; p.x = cvt_pk_bf16(oa[d][0] * inv, oa[d][1] * inv); p.y = cvt_pk_bf16(oa[d][2] * inv, oa[d][3] * inv);
            *(u32x2*)(o + (size_t)tg * 2048 + c16 * 128 + 16 * d + 4 * g) = p; }
    }
}
}
#define XB_TMO      128
#define XB_XCNT(j)  (256  + 64 * (j))
#define XB_XSUB(j)  (1280 + 64 * (j))
#define XB_XGEN(j)  (2304 + 64 * (j))
#define XB_TOP      3328
#define XB_TOPGEN   3392
#define XCD_BAR_WORDS 3456
#define XB_SPIN_CAP (1u << 18)
#define LAS __attribute__((address_space(3)))

__device__ __forceinline__ unsigned xb_ld(unsigned* p)              { return __hip_atomic_load(p, __ATOMIC_RELAXED, __HIP_MEMORY_SCOPE_AGENT); }
__device__ __forceinline__ unsigned xb_add(unsigned* p, unsigned v) { return __hip_atomic_fetch_add(p, v, __ATOMIC_RELAXED, __HIP_MEMORY_SCOPE_AGENT); }
__device__ __forceinline__ unsigned xb_xcc_id() { return (unsigned)__builtin_amdgcn_s_getreg((3 << 11) | 20) & 0xFu; }
#define XB_SPIN(cond, bar) do { unsigned _sp = 0; while (cond) { __builtin_amdgcn_s_sleep(1); \
    if ((++_sp & 255u) == 0u) { if (xb_ld(&(bar)[XB_TMO])) break; if (_sp > XB_SPIN_CAP) { atomicAdd(&(bar)[XB_TMO], 1u); break; } } } } while (0)

struct XcdBarrier {
    unsigned* bar; unsigned x;
    volatile LAS unsigned* st;
};

__device__ __forceinline__ XcdBarrier xcd_barrier_post(unsigned* bar, volatile LAS unsigned* st) {
    XcdBarrier b; b.bar = bar; b.x = xb_xcc_id(); b.st = st;
    if (threadIdx.x == 0) (void)xb_add(&bar[XB_XCNT(b.x)], 1u);
    return b;
}
__device__ __forceinline__ void xcd_barrier_complete(unsigned* bar, unsigned x, unsigned& nloc, unsigned& nx) {
    const unsigned G = gridDim.x * gridDim.y * gridDim.z;
    unsigned sum, cnt, mine, sp = 0u;
    for (;;) {
        sum = 0u; cnt = 0u; mine = 0u;
#pragma unroll
        for (unsigned j = 0; j < 16; ++j) { const unsigned c = xb_ld(&bar[XB_XCNT(j)]); sum += c; cnt += (c > 0u) ? 1u : 0u; mine = (j == x) ? c : mine; }
        if (sum == G) break;
        __builtin_amdgcn_s_sleep(1);
        if ((++sp & 255u) == 0u) { if (xb_ld(&bar[XB_TMO])) break; if (sp > XB_SPIN_CAP) { atomicAdd(&bar[XB_TMO], 1u); break; } }
    }
    nloc = mine > 0u ? mine : 1u; nx = cnt > 0u ? cnt : 1u;
}

__device__ __forceinline__ void xcd_barrier(const XcdBarrier& b) {
    asm volatile("s_waitcnt vmcnt(0)" ::: "memory");
    __syncthreads();
    if (threadIdx.x == 0) {
        unsigned* bar = b.bar;
        __builtin_amdgcn_s_waitcnt(0);
        unsigned nloc = b.st[0], nx = b.st[1];
        if (nloc == 0u) { xcd_barrier_complete(bar, b.x, nloc, nx); b.st[0] = nloc; b.st[1] = nx; }
        const unsigned old = xb_add(&bar[XB_XSUB(b.x)], 1u);
        const unsigned gen = old / nloc;
        if (old + 1u == (gen + 1u) * nloc) {
            __builtin_amdgcn_fence(__ATOMIC_RELEASE, "agent");
            asm volatile("s_waitcnt vmcnt(0)" ::: "memory");
            const unsigned og = xb_add(&bar[XB_TOP], 1u);
            const unsigned tg = og / nx;
            if (og + 1u == (tg + 1u) * nx) xb_add(&bar[XB_TOPGEN], 1u);
            else XB_SPIN(xb_ld(&bar[XB_TOPGEN]) == tg, bar);
            __builtin_amdgcn_fence(__ATOMIC_ACQUIRE, "agent");
            xb_add(&bar[XB_XGEN(b.x)], 1u);
            asm volatile("s_waitcnt vmcnt(0)" ::: "memory");
        } else {
            XB_SPIN(xb_ld(&bar[XB_XGEN(b.x)]) == gen, bar);
            __builtin_amdgcn_fence(__ATOMIC_ACQUIRE, "agent");
            asm volatile("s_waitcnt vmcnt(0)" ::: "memory");
        }
    }
    __syncthreads();
}


__device__ __forceinline__ void xcd_barrier_slim(const XcdBarrier& b) {
    asm volatile("s_waitcnt vmcnt(0)" ::: "memory");
    __syncthreads();
    if (threadIdx.x == 0) {
        unsigned* bar = b.bar;
        __builtin_amdgcn_s_waitcnt(0);
        unsigned nloc = b.st[0], nx = b.st[1];
        if (nloc == 0u) { nloc = 1u; nx = 1u; }
        const unsigned old = xb_add(&bar[XB_XSUB(b.x)], 1u);
        const unsigned gen = old / nloc;
        if (old + 1u == (gen + 1u) * nloc) {
            __builtin_amdgcn_fence(__ATOMIC_RELEASE, "agent");
            asm volatile("s_waitcnt vmcnt(0)" ::: "memory");
            const unsigned og = xb_add(&bar[XB_TOP], 1u);
            const unsigned tg = og / nx;
            if (og + 1u == (tg + 1u) * nx) xb_add(&bar[XB_TOPGEN], 1u);
            else XB_SPIN(xb_ld(&bar[XB_TOPGEN]) == tg, bar);
            __builtin_amdgcn_fence(__ATOMIC_ACQUIRE, "agent");
            xb_add(&bar[XB_XGEN(b.x)], 1u);
            asm volatile("s_waitcnt vmcnt(0)" ::: "memory");
        } else {
            XB_SPIN(xb_ld(&bar[XB_XGEN(b.x)]) == gen, bar);
            __builtin_amdgcn_fence(__ATOMIC_ACQUIRE, "agent");
            asm volatile("s_waitcnt vmcnt(0)" ::: "memory");
        }
    }
    __syncthreads();
}

namespace fk {
template <int FK_PHASE_MASK_, int ML>
__global__ void __launch_bounds__(NTHR, 2) fk_fwd(const FWK kw, const CvtTable T, const int p_lo, const int p_hi) {
    extern __shared__ __attribute__((aligned(16))) unsigned char shm_[];
    FK_LAS unsigned char* lds = (FK_LAS unsigned char*)shm_;
    FK_LAS unsigned* xbw = (FK_LAS unsigned*)(lds + LDS_BYTES - 16);
    if (threadIdx.x == 0) { xbw[0] = 0u; xbw[1] = 0u; xbw[2] = 0u; xbw[3] = 0u; }
    __syncthreads();
#define FWK_FIELDS(X) X(x_in) X(t5) X(mla_w_in) X(mla_qn) X(mla_kvn) X(mla_wq) X(mla_wkv) X(mla_wo) X(fox_w_in) X(fox_bf) X(fox_wo) X(dsa_w_in) X(dsa_wo) X(ln_g) X(ln_b) X(wgrp) X(bgrp) X(wrt) X(brt) X(wgate) X(wup) X(wdown) X(out) X(ws) X(moe_bias_gu) X(moe_bias_d) X(var)
    FK_LAS unsigned long long* kl = (FK_LAS unsigned long long*)(lds + 146944);
    if (threadIdx.x == 0) { int i_ = 0;
#define FWK_PUT(f) kl[i_++] = (unsigned long long)kw.f;
        FWK_FIELDS(FWK_PUT)
#undef FWK_PUT
    }
    __syncthreads();
    XcdBarrier bar = xcd_barrier_post((unsigned*)(kw.ws + WsMap<ML>::CTL), (volatile LAS unsigned*)xbw);
    FK_LAS int* tab = (FK_LAS int*)(lds + TAB_OFF);
    if (p_hi - p_lo > 1) xcd_barrier(bar);
#define PH_ON(k) (((FK_PHASE_MASK_) >> (k)) & 1)
#ifndef FK_REP_MASK
#define FK_REP_MASK 0
#endif
#define PH_REP(k) ((((FK_REP_MASK) >> (k)) & 1) ? 2 : 1)
#define FWK_GET(f) { const unsigned long long v_ = kl[i_++]; const unsigned lo_ = __builtin_amdgcn_readfirstlane((unsigned)v_), hi_ = __builtin_amdgcn_readfirstlane((unsigned)(v_ >> 32)); kq_.f = FkCvt<decltype(kq_.f)>::get(((unsigned long long)hi_ << 32) | lo_); }
#define PH_BEGIN(id) if ((id) >= p_lo && (id) < p_hi) { if ((id) > p_lo) xcd_barrier_slim(bar); FWK kq_; { int i_ = 0; FWK_FIELDS(FWK_GET) } const FW w = make_fw<ML>(kq_, kq_.ws);
#define PH_END }
#define PH_BEGINR(id, bit) PH_BEGIN(id) for (int rep_ = 0; rep_ < PH_REP(bit); ++rep_)
    if constexpr (PH_ON(8)) { PH_BEGINR(0, 8) phase_prologue(w, T, lds); PH_END }
#pragma unroll 1
    for (int layer = 0; layer < 4; ++layer) {
        const int kind = layer % 3, j = layer / 3, pb = 1 + 8 * layer;
        if (kind == 0) {
#define MLA_PTRS bf16_t* cq = (bf16_t*)w.arena; bf16_t* ckv = cq + (size_t)NT * 512; bf16_t* kr = ckv + (size_t)NT * 512; bf16_t* q = kr + (size_t)NT * 64; bf16_t* kv = q + (size_t)NT * 3072; (void)cq; (void)ckv; (void)kr; (void)q; (void)kv;
            if constexpr (PH_ON(0)) PH_BEGINR(pb + 0, 0) { MLA_PTRS RectSched s; s.init(w.xb0, D, w.mla_win_t + (size_t)j * 1280 * D, D, NT, 1280); EpiMlaIn e{cq, ckv, kr, w.ss, w.rope_cs}; gemm_phase(lds, D, D, s, e); } PH_END
            if constexpr (PH_ON(1)) PH_BEGINR(pb + 1, 1) { MLA_PTRS Rect2Sched s; s.s0.init(cq, 512, w.mla_wq_t + (size_t)j * 3072 * 512, 512, NT, 3072); s.s1.init(ckv, 512, w.mla_wkv_t + (size_t)j * 4096 * 512, 512, NT, 4096); s.n0 = 0;
                EpiMlaQKV e{q, kv, w.ss, w.rope_cs}; gemm_phase(lds, 512, 512, s, e); } PH_END
            if constexpr (PH_ON(2)) PH_BEGINR(pb + 2, 2) { MLA_PTRS
#pragma unroll 1
                for (int p = fk_bid(), np_ = fk_nblk(); p < 256; p += np_) { const int bh = p >> 2, x = p & 3, b = bh >> 4, h = bh & 15;
                    AttnPtrs P; P.Q = q + (size_t)b * S * 3072 + h * 192; P.K = kv + (size_t)b * S * 4096 + h * 256; P.V = P.K + 128; P.KR = kr + (size_t)b * S * 64; P.CF = nullptr; P.O = w.o + (size_t)b * S * D + h * 128; P.qld = 3072; P.kld = 4096;
                    attn_block<0>(lds, P, 7 - x); attn_block<0>(lds, P, x); } } PH_END
        }
        if (kind == 1) {
#define FOX_PTRS bf16_t* qkv = (bf16_t*)w.arena;
            if constexpr (PH_ON(9)) PH_BEGINR(pb + 0, 9) { FOX_PTRS RectSched s; s.init(w.xb0, D, w.fox_win_t, D, NT, 6144); EpiBf16Q e{qkv, 6144, 2048, QSCALE_128}; gemm_phase(lds, D, D, s, e); } PH_END
            if constexpr (PH_ON(10)) PH_BEGINR(pb + 2, 10) { FOX_PTRS
#pragma unroll 1
                for (int p = fk_bid(), np_ = fk_nblk(); p < 256; p += np_) { const int bh = p >> 2, x = p & 3, b = bh >> 4, h = bh & 15;
                    AttnPtrs P; P.Q = qkv + (size_t)b * S * 6144 + h * 128; P.K = P.Q + 2048; P.V = P.Q + 4096; P.KR = nullptr; P.CF = nullptr; P.O = w.o + (size_t)b * S * D + h * 128; P.qld = 6144; P.kld = 6144;
                    fox_cumsum_lds(w.flog, (FK_LAS float*)(lds + AT_CF), (FK_LAS double*)(lds + AT_WS), b, h);
                    attn_block<1>(lds, P, 7 - x); attn_block<1>(lds, P, x); } } PH_END
        }
        if (kind == 2) {
#define DSA_PTRS bf16_t* dq = (bf16_t*)w.arena; bf16_t* dk = dq + (size_t)NT * 2048; bf16_t* dv = dk + (size_t)NT * 128; bf16_t* qidx = dv + (size_t)NT * 128; bf16_t* kidx = qidx + (size_t)NT * 1024; \
            float* widx = (float*)(kidx + (size_t)NT * 64); unsigned short* sel = (unsigned short*)(widx + (size_t)NT * 16); int* nsel = (int*)(sel + (size_t)NT * 256); (void)dq; (void)dk; (void)dv; (void)qidx; (void)kidx; (void)widx; (void)sel; (void)nsel;
            if constexpr (PH_ON(11)) PH_BEGINR(pb + 0, 11) { DSA_PTRS RectSched s; s.init(w.xb0, D, w.dsa_win_t, D, NT, 3584); EpiDsaIn e{dq, dk, dv, qidx, kidx, widx}; gemm_phase(lds, D, D, s, e); } PH_END
            if constexpr (PH_ON(12)) PH_BEGINR(pb + 1, 12) { DSA_PTRS
#pragma unroll 1
                for (int p = fk_bid(), np_ = fk_nblk(); p < 256; p += np_) { const int b = p >> 6, x = p & 63;
                    dsa_index_unit(lds, qidx, kidx, widx, sel, nsel, b, 127 - x, (int)kq_.var); dsa_index_unit(lds, qidx, kidx, widx, sel, nsel, b, x, (int)kq_.var); } } PH_END
            if constexpr (PH_ON(13)) PH_BEGINR(pb + 2, 13) { DSA_PTRS phase_dsa_attn(lds, dq, dk, dv, sel, nsel, w.t5, w.o); } PH_END
        }
        if constexpr (PH_ON(3)) PH_BEGINR(pb + 3, 3) { const bf16_t* wo_t = kind == 0 ? w.mla_wo_t + (size_t)j * D * D : (kind == 1 ? w.fox_wo_t : w.dsa_wo_t); RectSched s; s.init(w.o, D, wo_t, D, NT, D); EpiBf16Q e{(bf16_t*)w.y, D, 0, 1.0f}; gemm_phase(lds, D, D, s, e); } PH_END
        if constexpr (PH_ON(4)) PH_BEGIN(pb + 4) { LnArgs a; a.x = (layer == 0) ? w.x_in : w.xA; a.yb = (const bf16_t*)w.y; a.Y2 = nullptr; a.te = nullptr; a.tpos = nullptr; a.cnt = nullptr; a.g = w.ln_g + (size_t)(layer * 2) * D; a.b = w.ln_b + (size_t)(layer * 2) * D; a.xo = w.xB; a.xbo = w.xb1; a.out2 = nullptr; a.xqo = nullptr;
            a.w4 = (const f32x4*)w.wr4 + (size_t)layer * 128 * 3 * 64; a.ntile = 3; a.bgrp = w.bgrp + layer * 4; a.brt = w.brt + layer * 32; a.rcnt = w.moe_cnt + layer * 1024; a.ote = w.te; a.otpos = w.tpos; a.otw = w.tw; a.list = w.list; a.sw = w.sw; a.flog = nullptr; a.fbias = nullptr;
            phase_ln(a, lds);
            } PH_END
        if constexpr (PH_ON(5)) PH_BEGINR(pb + 5, 5) { moe_tables(w.moe_cnt + layer * 1024, tab); phase_moe1(lds, tab, w.xb1, w.list, w.sw, w.wgate + (size_t)layer * 32 * D * 512, w.wup + (size_t)layer * 32 * D * 512, w.H, (int)kq_.var); } PH_END
        if constexpr (PH_ON(6)) PH_BEGINR(pb + 6, 6) { moe_tables(w.moe_cnt + layer * 1024, tab); phase_moe2(lds, tab, w.H, w.wdown + (size_t)layer * 32 * 512 * D, w.Y2, (int)kq_.var); } PH_END
        if constexpr (PH_ON(7)) PH_BEGINR(pb + 7, 7) { LnArgs a; a.x = w.xB; a.yb = nullptr; a.Y2 = w.Y2; a.te = w.te; a.tpos = w.tpos; a.cnt = w.moe_cnt + layer * 1024; a.g = w.ln_g + (size_t)(layer * 2 + 1) * D; a.b = w.ln_b + (size_t)(layer * 2 + 1) * D; a.xo = w.xA; a.xbo = w.xb0; a.xqo = nullptr;
            a.out2 = (layer == 3) ? w.out : nullptr; a.w4 = (layer == 0) ? (const f32x4*)w.fox_wf4 : nullptr; a.ntile = (layer == 0) ? 1 : 0; a.bgrp = nullptr; a.brt = nullptr; a.rcnt = nullptr; a.ote = nullptr; a.otpos = nullptr; a.otw = nullptr; a.list = nullptr; a.sw = nullptr; a.flog = w.flog; a.fbias = w.fox_bf;
            phase_ln(a, lds); } PH_END
    }
#undef PH_BEGIN
#undef PH_END
}

constexpr size_t CTL_BYTES = 65536;
static FWK make_fwk(void* const* d_in, void* d_out, char* ws) {
    FWK k; memset(&k, 0, sizeof(k));
    k.x_in = (const float*)d_in[0]; k.t5 = (const float*)d_in[1]; k.mla_w_in = (const float*)d_in[2]; k.mla_qn = (const float*)d_in[3]; k.mla_kvn = (const float*)d_in[4]; k.mla_wq = (const float*)d_in[5];
    k.mla_wkv = (const float*)d_in[6]; k.mla_wo = (const float*)d_in[7]; k.fox_w_in = (const float*)d_in[8]; k.fox_bf = (const float*)d_in[9]; k.fox_wo = (const float*)d_in[10]; k.dsa_w_in = (const float*)d_in[11];
    k.dsa_wo = (const float*)d_in[12]; k.ln_g = (const float*)d_in[13]; k.ln_b = (const float*)d_in[14]; k.wgrp = (const float*)d_in[15]; k.bgrp = (const float*)d_in[16]; k.wrt = (const float*)d_in[17];
    k.brt = (const float*)d_in[18]; k.wgate = (const float*)d_in[19]; k.wup = (const float*)d_in[20]; k.wdown = (const float*)d_in[21]; k.out = (float*)d_out; k.ws = ws;
    return k;
}
static void add_job(CvtTable& T, const float* s0, const float* s1, const float* scale, bf16_t* dst, long sbs, long dbs, int K, int N, int Np, int map, int nbatch) {
    CvtJob& J = T.j[T.njobs++]; J.src0 = s0; J.src1 = s1; J.scale = scale; J.dst = dst; J.src_bstride = sbs; J.dst_bstride = dbs; J.K = K; J.N = N; J.Np = Np; J.map = map; J.nbatch = nbatch; J.tile0 = T.ntiles;
    J.wide = ((map == MAP_ID || map == MAP_MOE_GU) && (K % 128 == 0) && (Np % 256 == 0) && (N % 4 == 0)) ? 1 : 0;
    T.ntiles += J.wide ? nbatch * (K / 128) * (Np / 256) : nbatch * (K / 64) * (Np / 64);
}
static void build_table(CvtTable& T, const FW& w, int moe_l0, int moe_l1, bool base) {
    memset(&T, 0, sizeof(T)); T.misc = base ? 1 : 0;
    if (base) {
    for (int j = 0; j < 2; ++j) {
        add_job(T, w.mla_w_in + (size_t)j * D * 1088, nullptr, nullptr, w.mla_win_t + (size_t)j * 1280 * D, 0, 0, D, 1088, 1280, MAP_MLA_IN, 1);
        add_job(T, w.mla_wq + (size_t)j * 512 * 3072, nullptr, w.mla_qn + j * 512, w.mla_wq_t + (size_t)j * 3072 * 512, 0, 0, 512, 3072, 3072, MAP_MLA_Q, 1);
        add_job(T, w.mla_wkv + (size_t)j * 512 * 4096, nullptr, w.mla_kvn + j * 512, w.mla_wkv_t + (size_t)j * 4096 * 512, 0, 0, 512, 4096, 4096, MAP_ID, 1);
        add_job(T, w.mla_wo + (size_t)j * D * D, nullptr, nullptr, w.mla_wo_t + (size_t)j * D * D, 0, 0, D, D, D, MAP_ID, 1);
    }
    add_job(T, w.fox_w_in, nullptr, nullptr, w.fox_win_t, 0, 0, D, 6160, 6144, MAP_ID, 1);
    add_job(T, w.fox_wo, nullptr, nullptr, w.fox_wo_t, 0, 0, D, D, D, MAP_ID, 1);
    add_job(T, w.dsa_w_in, nullptr, nullptr, w.dsa_win_t, 0, 0, D, 3408, 3584, MAP_ID, 1);
    add_job(T, w.dsa_wo, nullptr, nullptr, w.dsa_wo_t, 0, 0, D, D, D, MAP_ID, 1);
    }
    for (int l = moe_l0; l < moe_l1; ++l) {
        add_job(T, w.wgate + (size_t)l * 32 * D * 512, w.wup + (size_t)l * 32 * D * 512, nullptr, w.moe_gu_t + (size_t)l * 32 * 1024 * D, (long)D * 512, (long)1024 * D, D, 512, 1024, MAP_MOE_GU, 32);
        add_job(T, w.wdown + (size_t)l * 32 * 512 * D, nullptr, nullptr, w.moe_d_t + (size_t)l * 32 * D * 512, (long)512 * D, (long)D * 512, 512, D, D, MAP_ID, 32);
    }
}
static int g_grid = 0;
static void setup_once() {
    if (g_grid) return;
    int dev = 0, cus = 0, per_cu = 0;
    (void)hipGetDevice(&dev); (void)hipDeviceGetAttribute(&cus, hipDeviceAttributeMultiprocessorCount, dev);
    (void)per_cu;
    if (cus <= 0) cus = 256;
    g_grid = cus;
}
template <int MASK, int ML> static void launch_mask(const FWK& w, const CvtTable& T, int lo, int hi, hipStream_t st) {
    static bool attr = false; if (!attr) { (void)hipFuncSetAttribute((const void*)fk_fwd<MASK, ML>, hipFuncAttributeMaxDynamicSharedMemorySize, LDS_BYTES); attr = true; }
    hipLaunchKernelGGL((fk_fwd<MASK, ML>), dim3(g_grid), dim3(NTHR), LDS_BYTES, st, w, T, lo, hi);
}
#ifdef FK_DEBUG_BUILD
static void launch_phase(const FWK& w, const CvtTable& T, int p, hipStream_t st) {
    if (p == 0) { launch_mask<(1 << 8), 1>(w, T, p, p + 1, st); return; }
    const int layer = (p - 1) >> 3, k = (p - 1) & 7, kind = layer % 3;
    if (k >= 3) { switch (k) { case 3: launch_mask<(1 << 3), 1>(w, T, p, p + 1, st); break; case 4: launch_mask<(1 << 4), 1>(w, T, p, p + 1, st); break; case 5: launch_mask<(1 << 5), 1>(w, T, p, p + 1, st); break;
                               case 6: launch_mask<(1 << 6), 1>(w, T, p, p + 1, st); break; default: launch_mask<(1 << 7), 1>(w, T, p, p + 1, st); break; } return; }
    if (kind == 0) { if (k == 0) launch_mask<(1 << 0), 1>(w, T, p, p + 1, st); else if (k == 1) launch_mask<(1 << 1), 1>(w, T, p, p + 1, st); else launch_mask<(1 << 2), 1>(w, T, p, p + 1, st); }
    else if (kind == 1) { if (k == 0) launch_mask<(1 << 9), 1>(w, T, p, p + 1, st); else if (k == 2) launch_mask<(1 << 10), 1>(w, T, p, p + 1, st); }
    else { if (k == 0) launch_mask<(1 << 11), 1>(w, T, p, p + 1, st); else if (k == 1) launch_mask<(1 << 12), 1>(w, T, p, p + 1, st); else launch_mask<(1 << 13), 1>(w, T, p, p + 1, st); }
}
#endif
}
#ifndef FK_EXTRA
#define FK_EXTRA {}
#endif
extern "C" void kernel_launch(void* const* d_in, const int* in_sizes, int n_in, void* d_out, int out_size, void* d_ws, size_t ws_size, hipStream_t stream) {
    using namespace fk;
    setup_once();
    const FWK k = make_fwk(d_in, d_out, (char*)d_ws);
    const FW w = make_fw<0>(k, k.ws);
    static CvtTable T; build_table(T, w, 0, 0, true);
    (void)hipMemsetAsync(w.bar, 0, CTL_BYTES, stream);
    launch_mask<0x3FFF, 0>(k, T, 0, 33, stream);
    { static const int extra[] = FK_EXTRA; (void)extra; FWK kv = k;
#ifdef FK_VAR
      kv.var = FK_VAR;
#endif
      for (unsigned i = 0; i < sizeof(extra) / sizeof(int); ++i) launch_mask<0x3FFF, 0>(kv, T, extra[i], extra[i] + 1, stream); }
}
```

```cpp
#include <hip/hip_runtime.h>
#include <stdint.h>
#include <math.h>
#include <string.h>
namespace fk {
#define FK_LAS __attribute__((address_space(3)))
typedef unsigned short bf16_t;
typedef short bf16x8 __attribute__((ext_vector_type(8)));
typedef short s16x4 __attribute__((ext_vector_type(4)));
typedef float f32x4 __attribute__((ext_vector_type(4)));
typedef float f32x16 __attribute__((ext_vector_type(16)));
typedef float f32x2 __attribute__((ext_vector_type(2)));
typedef unsigned u32x4 __attribute__((ext_vector_type(4)));
typedef unsigned u32x2 __attribute__((ext_vector_type(2)));
constexpr int NB = 4, S = 2048, D = 2048, NT = NB * S;
constexpr float ALPHA = 1.681792830507429f;
constexpr float LOG2E = 1.4426950408889634f;
__device__ __forceinline__ int fk_tid();
__device__ __forceinline__ int fk_bid();
__device__ __forceinline__ int fk_nblk();
constexpr int BM = 256, BK = 64, HALF = 128, HTB = HALF * BK * 2, STAGE_BYTES = 8 * HTB;

__device__ __forceinline__ unsigned cvt_pk_bf16(float lo, float hi) { unsigned r; asm volatile("v_cvt_pk_bf16_f32 %0, %1, %2" : "=v"(r) : "v"(lo), "v"(hi)); return r; }
__device__ __forceinline__ float bf2f(bf16_t b) { return __uint_as_float(((unsigned)b) << 16); }
__device__ __forceinline__ bf16_t f2bf(float f) { unsigned u = __float_as_uint(f); u += 0x7FFFu + ((u >> 16) & 1u); return (bf16_t)(u >> 16); }

__host__ __device__ __forceinline__ int lds_byte(int r, int c) { const int st = (r >> 4) * 2 + (c >> 5), rr = r & 15, cc = c & 31, ob = rr * 64 + cc * 2; return st * 1024 + (ob ^ (((ob >> 9) & 1) << 5)); }
__host__ __device__ __forceinline__ void stage_rc(int b, int& R, int& C) { const int st = b / 1024, sb = b % 1024, swz = sb ^ (((sb >> 9) & 1) << 5); R = (st >> 1) * 16 + swz / 64; C = (st & 1) * 32 + (swz % 64) / 2; }
__host__ __device__ __forceinline__ int perm32(int rho) { const int n = rho >> 4, i = rho & 15; return 8 * (i >> 2) + 4 * n + (i & 3); }

struct GUnit { const char* A; const char* B; int pm, pn, e, nrows; };

template <class Epi, class Sched>
__device__ __forceinline__ void gemm_phase(FK_LAS unsigned char* lds, const int K, const int ldb, const Sched& S, const Epi& E) {
    const int tid = fk_tid(), wid = __builtin_amdgcn_readfirstlane(tid >> 6), lane = tid & 63, wr = wid >> 2, wc = wid & 3, fr = lane & 15, fq = lane >> 4;
    const int nt = K / BK;
    unsigned voffB[2];
#pragma unroll
    for (int i = 0; i < 2; ++i) { int R_, C_; stage_rc(tid * 16 + i * 8192, R_, C_); const int Rb = Epi::PERM ? ((R_ & ~31) + perm32(R_ & 31)) : R_; voffB[i] = (unsigned)(Rb * ldb + C_) * 2u; }
    const size_t kstep = (size_t)(BK * 2);
    const size_t hstepB = (size_t)HALF * ldb * 2;
    const unsigned ldsw = (unsigned)wid * 1024u;
    const int aoff = lds_byte(wr * 64 + fr, fq * 8), boff = lds_byte(wc * 32 + fr, fq * 8);
#define PG8_SA(b, h) (((b) * 2 + (h)) * HTB)
#define PG8_SB(b, h) ((4 + (b) * 2 + (h)) * HTB)
#define PG8_STAGE2(bufoff, gbase, v0, v1) do { \
        __builtin_amdgcn_global_load_lds((const unsigned*)((const char*)(gbase) + (v0)), (FK_LAS unsigned*)(lds + (bufoff) + ldsw), 16, 0, 0); \
        __builtin_amdgcn_global_load_lds((const unsigned*)((const char*)(gbase) + (v1)), (FK_LAS unsigned*)(lds + (bufoff) + ldsw + 8192), 16, 0, 0); } while (0)
#define PG8_STAGEB(bufoff, gbase) PG8_STAGE2(bufoff, gbase, voffB[0], voffB[1])
#define PG8_LDA(dst, b, h) do { _Pragma("unroll") for (int m = 0; m < 4; ++m) _Pragma("unroll") for (int k = 0; k < 2; ++k) dst[m][k] = *(const FK_LAS bf16x8*)(lds + PG8_SA(b, h) + aoff + m * 2048 + k * 1024); } while (0)
#define PG8_LDB(dst, b, h) do { _Pragma("unroll") for (int n = 0; n < 2; ++n) _Pragma("unroll") for (int k = 0; k < 2; ++k) dst[n][k] = *(const FK_LAS bf16x8*)(lds + PG8_SB(b, h) + boff + n * 2048 + k * 1024); } while (0)
#define PG8_MMA(ai, bj, At, Bt) do { __builtin_amdgcn_s_setprio(1); _Pragma("unroll") for (int m = 0; m < 4; ++m) _Pragma("unroll") for (int n = 0; n < 2; ++n) _Pragma("unroll") for (int k = 0; k < 2; ++k) \
        acc[ai][bj][m][n] = __builtin_amdgcn_mfma_f32_16x16x32_bf16(Bt[n][k], At[m][k], acc[ai][bj][m][n], 0, 0, 0); __builtin_amdgcn_s_setprio(0); } while (0)
#define PG8_WAIT_V(n) asm volatile("s_waitcnt vmcnt(" #n ")" ::: "memory")
#define PG8_WAIT_L(n) asm volatile("s_waitcnt lgkmcnt(" #n ")" ::: "memory")
#define PG8_BAR __builtin_amdgcn_s_barrier()
#define PG8_SCHED __builtin_amdgcn_sched_barrier(0)
    GUnit cur, nxt; int ui = 0;
    if (!S.next(0, cur)) return;
    f32x4 acc[2][2][4][2];
#pragma unroll
    for (int a = 0; a < 2; ++a)
#pragma unroll
        for (int b = 0; b < 2; ++b)
#pragma unroll
            for (int m = 0; m < 4; ++m)
#pragma unroll
                for (int n = 0; n < 2; ++n) acc[a][b][m][n] = (f32x4){0.f, 0.f, 0.f, 0.f};
    bf16x8 At[4][2], B0[2][2], B1[2][2];
    unsigned oc[2][2], on[2][2];
    S.a_offs(cur, tid, oc);
    const char* cA = cur.A; const char* cB = cur.B;
    PG8_STAGEB(PG8_SB(0, 0), cB); PG8_STAGE2(PG8_SA(0, 0), cA, oc[0][0], oc[0][1]); PG8_STAGEB(PG8_SB(0, 1), cB + hstepB); PG8_STAGE2(PG8_SA(0, 1), cA, oc[1][0], oc[1][1]);
    if (wr == 1) PG8_BAR;
    PG8_WAIT_V(4); PG8_BAR;
    PG8_STAGEB(PG8_SB(1, 0), cB + kstep); PG8_STAGE2(PG8_SA(1, 0), cA + kstep, oc[0][0], oc[0][1]); PG8_STAGEB(PG8_SB(1, 1), cB + hstepB + kstep);
    PG8_WAIT_V(6); PG8_BAR;
    for (;;) {
        const bool has_next = S.next(ui + 1, nxt);
        if (has_next) S.a_offs(nxt, tid, on);
        else {
#pragma unroll
            for (int h = 0; h < 2; ++h)
#pragma unroll
                for (int i = 0; i < 2; ++i) on[h][i] = oc[h][i]; }
        const char* nA = has_next ? nxt.A : cA; const char* nB = has_next ? nxt.B : cB;
        for (int t = 0; t < nt; t += 2) {
            const bool last = (t == nt - 2);
            const char* a1 = cA + (size_t)(t + 1) * kstep;
            const char* a2 = last ? nA : cA + (size_t)(t + 2) * kstep; const char* b2 = last ? nB : cB + (size_t)(t + 2) * kstep;
            const char* a3 = a2 + kstep; const char* b3 = b2 + kstep;
            const unsigned o00 = last ? on[0][0] : oc[0][0], o01 = last ? on[0][1] : oc[0][1], o10 = last ? on[1][0] : oc[1][0], o11 = last ? on[1][1] : oc[1][1];
            PG8_LDB(B0, 0, 0); PG8_SCHED; PG8_LDA(At, 0, 0); PG8_STAGE2(PG8_SA(1, 1), a1, oc[1][0], oc[1][1]);
            PG8_WAIT_L(8); PG8_BAR; PG8_WAIT_L(0); PG8_MMA(0, 0, At, B0); PG8_BAR; PG8_SCHED;
            PG8_LDB(B1, 0, 1); PG8_STAGEB(PG8_SB(0, 0), b2);
            PG8_BAR; PG8_WAIT_L(0); PG8_MMA(0, 1, At, B1); PG8_BAR;
            PG8_LDA(At, 0, 1); PG8_STAGE2(PG8_SA(0, 0), a2, o00, o01);
            PG8_BAR; PG8_WAIT_L(0); PG8_MMA(1, 0, At, B0); PG8_BAR; PG8_SCHED;
            PG8_STAGEB(PG8_SB(0, 1), b2 + hstepB);
            PG8_WAIT_V(6); PG8_BAR; PG8_MMA(1, 1, At, B1); PG8_BAR;
            PG8_LDB(B0, 1, 0); PG8_SCHED; PG8_LDA(At, 1, 0); PG8_STAGE2(PG8_SA(0, 1), a2, o10, o11);
            PG8_WAIT_L(8); PG8_BAR; PG8_WAIT_L(0); PG8_MMA(0, 0, At, B0); PG8_BAR; PG8_SCHED;
            PG8_LDB(B1, 1, 1); PG8_STAGEB(PG8_SB(1, 0), b3);
            PG8_BAR; PG8_WAIT_L(0); PG8_MMA(0, 1, At, B1); PG8_BAR;
            PG8_LDA(At, 1, 1); PG8_STAGE2(PG8_SA(1, 0), a3, o00, o01);
            PG8_BAR; PG8_WAIT_L(0); PG8_MMA(1, 0, At, B0); PG8_BAR; PG8_SCHED;
            PG8_STAGEB(PG8_SB(1, 1), b3 + hstepB);
            PG8_WAIT_V(6); PG8_BAR; PG8_MMA(1, 1, At, B1); PG8_BAR;
        }
        E(acc, cur, wr, wc, fr, fq);
        if (!has_next) break;
#pragma unroll
        for (int a = 0; a < 2; ++a)
#pragma unroll
            for (int b = 0; b < 2; ++b)
#pragma unroll
                for (int m = 0; m < 4; ++m)
#pragma unroll
                    for (int n = 0; n < 2; ++n) acc[a][b][m][n] = (f32x4){0.f, 0.f, 0.f, 0.f};
        cur = nxt; cA = nA; cB = nB; ++ui;
#pragma unroll
        for (int h = 0; h < 2; ++h)
#pragma unroll
            for (int i = 0; i < 2; ++i) oc[h][i] = on[h][i];
    }
    PG8_WAIT_V(0);
    if (wr == 0) PG8_BAR;
    PG8_BAR;
#undef PG8_SA
#undef PG8_SB
#undef PG8_STAGE2
#undef PG8_STAGEB
#undef PG8_LDA
#undef PG8_LDB
#undef PG8_MMA
#undef PG8_WAIT_V
#undef PG8_WAIT_L
#undef PG8_BAR
#undef PG8_SCHED
}
}
namespace fk {
constexpr int NTHR = 512;
constexpr int LDS_BYTES = 147456;
constexpr int HCAP = 24576;
constexpr float QSCALE_MLA = 0.07216878364870322f * LOG2E;
constexpr float QSCALE_128 = 0.08838834764831845f * LOG2E;

struct FW {
    const float *x_in, *t5, *mla_w_in, *mla_qn, *mla_kvn, *mla_wq, *mla_wkv, *mla_wo, *fox_w_in, *fox_bf, *fox_wo, *dsa_w_in, *dsa_wo, *ln_g, *ln_b, *wgrp, *bgrp, *wrt, *brt, *wgate, *wup, *wdown;
    float* out;
    unsigned* bar; int* moe_cnt;
    bf16_t *mla_win_t, *mla_wq_t, *mla_wkv_t, *mla_wo_t, *fox_win_t, *fox_wo_t, *dsa_win_t, *dsa_wo_t, *moe_gu_t, *moe_d_t;
    float *wr4, *fox_wf4; f32x2* rope_cs;
    float *xA, *xB, *y; bf16_t *xb0, *xb1, *o;
    char* arena;
    float* ss;
    float *flog, *cf2;
    int *te, *tpos, *list; float *tw, *sw; bf16_t *H, *Y2; unsigned char* x1q;
};

template <class T> struct FkCvt { static __device__ __forceinline__ T get(unsigned long long v) { return (T)v; } };
template <class T> struct FkCvt<T*> { static __device__ __forceinline__ T* get(unsigned long long v) { return (T*)(__attribute__((address_space(1))) T*)v; } };
struct FWK { const float *x_in, *t5, *mla_w_in, *mla_qn, *mla_kvn, *mla_wq, *mla_wkv, *mla_wo, *fox_w_in, *fox_bf, *fox_wo, *dsa_w_in, *dsa_wo, *ln_g, *ln_b, *wgrp, *bgrp, *wrt, *brt, *wgate, *wup, *wdown; float* out; char* ws; long moe_bias_gu, moe_bias_d; long var; };
constexpr size_t al256(size_t x) { return (x + 255) & ~(size_t)255; }
template <int MOE_LAYERS> struct WsMap {
    static constexpr size_t CTL = 0, CTL_BYTES = 65536;
    static constexpr size_t MLA_WIN_T = CTL + CTL_BYTES, MLA_WQ_T = MLA_WIN_T + al256((size_t)2 * 1280 * D * 2), MLA_WKV_T = MLA_WQ_T + al256((size_t)2 * 3072 * 512 * 2), MLA_WO_T = MLA_WKV_T + al256((size_t)2 * 4096 * 512 * 2);
    static constexpr size_t FOX_WIN_T = MLA_WO_T + al256((size_t)2 * D * D * 2), FOX_WO_T = FOX_WIN_T + al256((size_t)6144 * D * 2), DSA_WIN_T = FOX_WO_T + al256((size_t)D * D * 2), DSA_WO_T = DSA_WIN_T + al256((size_t)3584 * D * 2);
    static constexpr size_t MOE_GU_T = DSA_WO_T + al256((size_t)D * D * 2), MOE_D_T = MOE_GU_T + al256((size_t)MOE_LAYERS * 32 * 1024 * D * 2);
    static constexpr size_t WR4 = MOE_D_T + al256((size_t)MOE_LAYERS * 32 * D * 512 * 2), FOX_WF4 = WR4 + al256((size_t)4 * D * 48 * 4), ROPE = FOX_WF4 + al256((size_t)D * 16 * 4);
    static constexpr size_t XA = ROPE + al256((size_t)S * 32 * 8), XB = XA + al256((size_t)NT * D * 4), Y = XB + al256((size_t)NT * D * 4);
    static constexpr size_t XB0 = Y + al256((size_t)NT * D * 4), XB1 = XB0 + al256((size_t)NT * D * 2), O = XB1 + al256((size_t)NT * D * 2), ARENA = O + al256((size_t)NT * D * 2);
    static constexpr size_t SS = ARENA + al256((size_t)NT * (512 + 512 + 64 + 3072 + 4096) * 2), FLOG = SS + al256((size_t)NT * 2 * 8 * 4), CF2 = FLOG + al256((size_t)NT * 16 * 4);
    static constexpr size_t TE = CF2 + al256((size_t)NB * 16 * S * 4), TPOS = TE + al256((size_t)NT * 2 * 4), LIST = TPOS + al256((size_t)NT * 2 * 4), TW = LIST + al256((size_t)32 * NT * 4), SW = TW + al256((size_t)NT * 2 * 4);
    static constexpr size_t H = SW + al256((size_t)32 * NT * 4), Y2 = H + al256((size_t)HCAP * 512 * 2), X1Q = Y2 + al256((size_t)HCAP * D * 2), END = X1Q + al256((size_t)NT * D);
};
template <int ML> __host__ __device__ __forceinline__ FW make_fw(const FWK& k, char* ws) {
    typedef WsMap<ML> M; FW w;
    w.x_in = k.x_in; w.t5 = k.t5; w.mla_w_in = k.mla_w_in; w.mla_qn = k.mla_qn; w.mla_kvn = k.mla_kvn; w.mla_wq = k.mla_wq; w.mla_wkv = k.mla_wkv; w.mla_wo = k.mla_wo; w.fox_w_in = k.fox_w_in; w.fox_bf = k.fox_bf; w.fox_wo = k.fox_wo;
    w.dsa_w_in = k.dsa_w_in; w.dsa_wo = k.dsa_wo; w.ln_g = k.ln_g; w.ln_b = k.ln_b; w.wgrp = k.wgrp; w.bgrp = k.bgrp; w.wrt = k.wrt; w.brt = k.brt; w.wgate = k.wgate; w.wup = k.wup; w.wdown = k.wdown; w.out = k.out;
    w.bar = (unsigned*)(ws + M::CTL); w.moe_cnt = (int*)(ws + M::CTL + 32768);
    w.mla_win_t = (bf16_t*)(ws + M::MLA_WIN_T); w.mla_wq_t = (bf16_t*)(ws + M::MLA_WQ_T); w.mla_wkv_t = (bf16_t*)(ws + M::MLA_WKV_T); w.mla_wo_t = (bf16_t*)(ws + M::MLA_WO_T);
    w.fox_win_t = (bf16_t*)(ws + M::FOX_WIN_T); w.fox_wo_t = (bf16_t*)(ws + M::FOX_WO_T); w.dsa_win_t = (bf16_t*)(ws + M::DSA_WIN_T); w.dsa_wo_t = (bf16_t*)(ws + M::DSA_WO_T);
    w.moe_gu_t = (bf16_t*)(ws + M::MOE_GU_T) - k.moe_bias_gu; w.moe_d_t = (bf16_t*)(ws + M::MOE_D_T) - k.moe_bias_d;
    w.wr4 = (float*)(ws + M::WR4); w.fox_wf4 = (float*)(ws + M::FOX_WF4); w.rope_cs = (f32x2*)(ws + M::ROPE);
    w.xA = (float*)(ws + M::XA); w.xB = (float*)(ws + M::XB); w.y = (float*)(ws + M::Y); w.xb0 = (bf16_t*)(ws + M::XB0); w.xb1 = (bf16_t*)(ws + M::XB1); w.o = (bf16_t*)(ws + M::O); w.arena = ws + M::ARENA;
    w.ss = (float*)(ws + M::SS); w.flog = (float*)(ws + M::FLOG); w.cf2 = (float*)(ws + M::CF2);
    w.te = (int*)(ws + M::TE); w.tpos = (int*)(ws + M::TPOS); w.list = (int*)(ws + M::LIST); w.tw = (float*)(ws + M::TW); w.sw = (float*)(ws + M::SW); w.H = (bf16_t*)(ws + M::H); w.Y2 = (bf16_t*)(ws + M::Y2); w.x1q = (unsigned char*)(ws + M::X1Q);
    return w;
}
__device__ __forceinline__ int fk_tid() { int t = threadIdx.x; asm volatile("" : "+v"(t)); return t; }
__device__ __forceinline__ int fk_bid() { int t = blockIdx.x; asm volatile("" : "+s"(t)); return t; }
__device__ __forceinline__ int fk_nblk() { int t = gridDim.x; asm volatile("" : "+s"(t)); return t; }

enum { MAP_ID = 0, MAP_MLA_IN = 1, MAP_MLA_Q = 2, MAP_MOE_GU = 3 };
struct CvtJob { const float* src0; const float* src1; const float* scale; bf16_t* dst; long src_bstride, dst_bstride; int K, N, Np, map, nbatch, tile0, wide, pad; };
constexpr int MAXJOBS = 24;
struct CvtTable { CvtJob j[MAXJOBS]; int njobs, ntiles, misc, pad, late0, late1, late2, pad2; };

__device__ __forceinline__ int map_col(int map, int np, int N, int& which) {
    which = 0;
    if (map == MAP_ID) return np < N ? np : -1;
    if (map == MAP_MLA_IN) { if (np < 1024) return np; if (np < 1088) { const int i = np - 1024; return 1024 + (i >> 1) + 32 * (i & 1); } return -1; }
    if (map == MAP_MLA_Q) { const int h = np / 192, j = np % 192; if (j < 128) return np; const int i = j - 128; return h * 192 + 128 + (i >> 1) + 32 * (i & 1); }
      { const int q = np >> 5, r = np & 31; which = r >> 4; return 16 * q + (r & 15); }
}
__device__ __forceinline__ int inv_row(int map, int c) {
    if (map == MAP_MLA_IN) { if (c < 1024 || c >= 1088) return c; const int cc = c - 1024; return 1024 + 2 * (cc & 31) + (cc >> 5); }
      { const int h = c / 192, j = c % 192; if (j < 128) return c; const int jj = j - 128; return h * 192 + 128 + 2 * (jj & 31) + (jj >> 5); }
}
__device__ __forceinline__ void cvt_tile(const CvtJob& J, int lt, FK_LAS float* tile  , const int tid) {
    const int tk = J.K / 64, tn = J.Np / 64, per = tk * tn;
    const int b = lt / per, r = lt % per, tkk = r % tk, tnn = r / tk;
    const int k0 = tkk * 64, n0 = tnn * 64;
    const float* s0 = J.src0 + (size_t)b * J.src_bstride; const float* s1 = J.src1 ? J.src1 + (size_t)b * J.src_bstride : nullptr;
    bf16_t* d = J.dst + (size_t)b * J.dst_bstride;
    { const int np = n0 + (tid & 63); int which; const int sc = map_col(J.map, np, J.N, which); const float* s = which ? s1 : s0;
#pragma unroll
      for (int i = 0; i < 8; ++i) { const int k = (tid >> 6) + 8 * i; float v = 0.f; if (sc >= 0) { v = s[(size_t)(k0 + k) * J.N + sc]; if (J.scale) v *= J.scale[k0 + k]; } tile[k * 65 + (tid & 63)] = v; } }
    __syncthreads();
    { const int np = tid >> 3, kg = (tid & 7) * 8; float v[8];
#pragma unroll
      for (int j = 0; j < 8; ++j) v[j] = tile[(kg + j) * 65 + np];
      u32x4 w; w.x = cvt_pk_bf16(v[0], v[1]); w.y = cvt_pk_bf16(v[2], v[3]); w.z = cvt_pk_bf16(v[4], v[5]); w.w = cvt_pk_bf16(v[6], v[7]);
      *(u32x4*)(d + (size_t)(n0 + np) * J.K + k0 + kg) = w; }
    __syncthreads();
}
struct WideTile { const float* s; bf16_t* d; const float* scale; int k0, n0, K, N, map; bool ok, inv; };
__device__ __forceinline__ void wide_setup(const CvtTable& T, int t, WideTile& W, const int lane) {
    int ji = 0;
#pragma unroll 1
    for (int q = 1; q < T.njobs; ++q) if (t >= T.j[q].tile0) ji = q;
    const CvtJob& J = T.j[ji]; const int lt = t - J.tile0;
    const int tk = J.K / 128, tn = J.Np / 256, per = tk * tn;
    const int b = lt / per, r = lt % per, tkk = r % tk, tnn = r / tk;
    W.k0 = tkk * 128; W.n0 = tnn * 256; W.K = J.K; W.N = J.N; W.map = J.map; W.scale = J.scale;
    const float* s0 = J.src0 + (size_t)b * J.src_bstride; const float* s1 = J.src1 ? J.src1 + (size_t)b * J.src_bstride : nullptr;
    W.d = J.dst + (size_t)b * J.dst_bstride;
    W.inv = J.map == MAP_MLA_IN || J.map == MAP_MLA_Q;
    const int np = W.n0 + 4 * lane; int which = 0; const int sc = W.inv ? np : map_col(J.map, np, J.N, which);
    W.ok = sc >= 0 && sc + 3 < J.N; W.s = (which ? s1 : s0) + (W.ok ? sc : 0);
}
template <bool NT = false>
__device__ __forceinline__ void wide_load(const WideTile& W, f32x4 (&v)[16], const int wid) {
#pragma unroll
    for (int i = 0; i < 16; ++i) { const int k = W.k0 + wid * 16 + i; const f32x4* p = (const f32x4*)(W.s + (size_t)k * W.N); v[i] = W.ok ? (NT ? __builtin_nontemporal_load(p) : *p) : (f32x4){0.f, 0.f, 0.f, 0.f}; }
}
__device__ __forceinline__ void wide_store(const WideTile& W, f32x4 (&v)[16], FK_LAS unsigned char* img, const int tid) {
    const int wid = tid >> 6, lane = tid & 63;
    if (W.scale) {
#pragma unroll
        for (int i = 0; i < 16; ++i) v[i] = v[i] * W.scale[W.k0 + wid * 16 + i]; }
#pragma unroll
    for (int j = 0; j < 4; ++j) { const int n = 4 * lane + j;
#pragma unroll
        for (int h = 0; h < 2; ++h) { u32x4 w; w.x = cvt_pk_bf16(v[8 * h + 0][j], v[8 * h + 1][j]); w.y = cvt_pk_bf16(v[8 * h + 2][j], v[8 * h + 3][j]); w.z = cvt_pk_bf16(v[8 * h + 4][j], v[8 * h + 5][j]); w.w = cvt_pk_bf16(v[8 * h + 6][j], v[8 * h + 7][j]);
            const int c = wid * 2 + h; *(FK_LAS u32x4*)(img + n * 256 + ((c ^ (n & 15)) << 4)) = w; } }
    __syncthreads();
#pragma unroll
    for (int i = 0; i < 8; ++i) { const int idx = tid + 512 * i, n = idx >> 4, c = idx & 15; const u32x4 w = *(FK_LAS const u32x4*)(img + n * 256 + ((c ^ (n & 15)) << 4));
        *(u32x4*)(W.d + (size_t)(W.inv ? inv_row(W.map, W.n0 + n) : W.n0 + n) * W.K + W.k0 + c * 8) = w; }
    __syncthreads();
}
__device__ __forceinline__ void cvt_tile_wide(const CvtTable& T, int t, FK_LAS unsigned char* img, const int tid) {
    WideTile W; wide_setup(T, t, W, tid & 63); f32x4 v[16]; wide_load(W, v, tid >> 6); wide_store(W, v, img, tid);
}
template <bool NT = false>
__device__ __forceinline__ void cvt_wide_range(const CvtTable& T, FK_LAS unsigned char* lds, int t, const int tend, const int nb) {
    const int tid0 = fk_tid(), wid = tid0 >> 6, lane = tid0 & 63;
    if (t < tend) { WideTile Wa, Wb; f32x4 va[16], vb[16];
        wide_setup(T, t, Wa, lane); wide_load<NT>(Wa, va, wid);
#pragma unroll 1
        for (;;) {
            int tn = t + nb; if (tn < tend) { wide_setup(T, tn, Wb, lane); wide_load<NT>(Wb, vb, wid); }
            wide_store(Wa, va, lds, tid0); t = tn; if (t >= tend) break;
            tn = t + nb; if (tn < tend) { wide_setup(T, tn, Wa, lane); wide_load<NT>(Wa, va, wid); }
            wide_store(Wb, vb, lds, tid0); t = tn; if (t >= tend) break;
        } }
}
__device__ __forceinline__ void phase_prologue(const FW& w, const CvtTable& T, FK_LAS unsigned char* lds) {
    FK_LAS float* tile = (FK_LAS float*)lds; const int tid0 = fk_tid();
    if (T.pad) cvt_wide_range(T, lds, fk_bid(), T.late0, fk_nblk());
    else
    for (int t = fk_bid(); t < T.ntiles; t += fk_nblk()) {
        int ji = 0;
#pragma unroll 1
        for (int q = 1; q < T.njobs; ++q) if (t >= T.j[q].tile0) ji = q;
        if (T.j[ji].wide) cvt_tile_wide(T, t, lds, tid0); else cvt_tile(T.j[ji], t - T.j[ji].tile0, tile, tid0);
    }
    if (!T.misc) return;
    const int gt = fk_bid() * NTHR + tid0, gn = fk_nblk() * NTHR;
    for (int i = gt; i < S * 32; i += gn) { const int pos = i >> 5, j = i & 31; const float invf = powf(10000.f, -(float)j / 32.f); const float ang = (float)pos * invf; w.rope_cs[i] = (f32x2){cosf(ang), sinf(ang)}; }
    for (int i = gt; i < 4 * 128 * 3 * 64 * 4; i += gn) { const int ii = i & 3, lane = (i >> 2) & 63, q = i >> 8, nt = q % 3, kg = (q / 3) & 127, layer = q / (3 * 128); const int k = 16 * kg + 4 * (lane >> 4) + ii, n = 16 * nt + (lane & 15);
        float v = 0.f; if (n < 4) v = w.wgrp[((size_t)layer * D + k) * 4 + n]; else if (n < 36) v = w.wrt[((size_t)layer * D + k) * 32 + (n - 4)]; w.wr4[i] = v; }
    for (int i = gt; i < 128 * 64 * 4; i += gn) { const int ii = i & 3, lane = (i >> 2) & 63, kg = i >> 8; const int k = 16 * kg + 4 * (lane >> 4) + ii; w.fox_wf4[i] = w.fox_w_in[(size_t)k * 6160 + 6144 + (lane & 15)]; }
    for (int i = gt; i < NT * D / 4; i += 4 * gn) {
        f32x4 v[4];
#pragma unroll
        for (int q = 0; q < 4; ++q) { const int ii = i + q * gn; v[q] = ii < NT * D / 4 ? ((const f32x4*)w.x_in)[ii] : (f32x4){0.f, 0.f, 0.f, 0.f}; }
#pragma unroll
        for (int q = 0; q < 4; ++q) { const int ii = i + q * gn; if (ii < NT * D / 4) { u32x2 p; p.x = cvt_pk_bf16(v[q][0], v[q][1]); p.y = cvt_pk_bf16(v[q][2], v[q][3]); ((u32x2*)w.xb0)[ii] = p; } } }
}

struct RectSched {
    const char* A; const char* B; int lda, ldb, nM, nN, nwg, G, c;
    __device__ void init(const bf16_t* A_, int lda_, const bf16_t* B_, int ldb_, int M, int N) { A = (const char*)A_; B = (const char*)B_; lda = lda_; ldb = ldb_; nM = M / BM; nN = N / BM; nwg = nM * nN; G = fk_nblk(); c = fk_bid(); }
    __device__ __forceinline__ bool tile(int i, int& pm, int& pn) const {
        const long L = (long)i * G + c; if (L >= nwg) return false;
        int wgid = (int)L; { const int q = nwg / 8, r = nwg % 8, xcd = wgid % 8, off = wgid / 8; wgid = (xcd < r ? xcd * (q + 1) : r * (q + 1) + (xcd - r) * q) + off; }
        const int nig = 8 * nN, gid = wgid / nig, fm = gid * 8, gsz = (nM - fm) < 8 ? (nM - fm) : 8;
        pm = fm + ((wgid % nig) % gsz); pn = (wgid % nig) / gsz; return true;
    }
    __device__ __forceinline__ bool next(int i, GUnit& u) const { int pm, pn; if (!tile(i, pm, pn)) return false; u.pm = pm; u.pn = pn; u.e = 0; u.nrows = BM; u.A = A + (size_t)pm * BM * lda * 2; u.B = B + (size_t)pn * BM * ldb * 2; return true; }
    __device__ __forceinline__ void a_offs(const GUnit&, int tid, unsigned (&o)[2][2]) const { int R0, C0, R1, C1; stage_rc(tid * 16, R0, C0); stage_rc(tid * 16 + 8192, R1, C1);
        o[0][0] = (unsigned)(R0 * lda + C0) * 2u; o[0][1] = (unsigned)(R1 * lda + C1) * 2u; o[1][0] = o[0][0] + (unsigned)(HALF * lda * 2); o[1][1] = o[0][1] + (unsigned)(HALF * lda * 2); }
};
struct Rect2Sched {
    RectSched s0, s1; int n0;
    __device__ __forceinline__ bool next(int i, GUnit& u) const {
        const long L = (long)i * s0.G + s0.c; const int tot = s0.nwg + s1.nwg; if (L >= tot) return false;
        if (L < s0.nwg) { const int pm = (int)L % s0.nM, pn = (int)L / s0.nM; u.pm = pm; u.pn = pn; u.e = 0; u.nrows = BM; u.A = s0.A + (size_t)pm * BM * s0.lda * 2; u.B = s0.B + (size_t)pn * BM * s0.ldb * 2; }
        else { const int l = (int)L - s0.nwg; const int pm = l % s1.nM, pn = l / s1.nM; u.pm = pm; u.pn = pn; u.e = 1; u.nrows = BM; u.A = s1.A + (size_t)pm * BM * s1.lda * 2; u.B = s1.B + (size_t)pn * BM * s1.ldb * 2; }
        return true; }
    __device__ __forceinline__ void a_offs(const GUnit& u, int tid, unsigned (&o)[2][2]) const { s0.a_offs(u, tid, o); }
};

struct EpiF32 {
    static constexpr bool PERM = false;
    float* Cp; int ldc;
    __device__ __forceinline__ void operator()(const f32x4 (&acc)[2][2][4][2], const GUnit& u, int wr, int wc, int fr, int fq) const {
        const int row0 = u.pm * BM + wr * 64 + fr, col0 = u.pn * BM + wc * 32 + 4 * fq;
#pragma unroll
        for (int ai = 0; ai < 2; ++ai)
#pragma unroll
            for (int m = 0; m < 4; ++m) { float* rowp = Cp + (size_t)(row0 + ai * HALF + m * 16) * ldc + col0;
#pragma unroll
                for (int bj = 0; bj < 2; ++bj)
#pragma unroll
                    for (int n = 0; n < 2; ++n) *(f32x4*)(rowp + bj * HALF + n * 16) = acc[ai][bj][m][n]; }
    }
};
__device__ __forceinline__ u32x4 pack8(const f32x4& a, const f32x4& b) { u32x4 w; w.x = cvt_pk_bf16(a[0], a[1]); w.y = cvt_pk_bf16(a[2], a[3]); w.z = cvt_pk_bf16(b[0], b[1]); w.w = cvt_pk_bf16(b[2], b[3]); return w; }
__device__ __forceinline__ void rope8(f32x4& v0, f32x4& v1, const f32x2* cs) {
    const f32x4 c01 = *(const f32x4*)cs, c23 = *(const f32x4*)(cs + 2);
    f32x4 r0, r1;
    r0[0] = v0[0] * c01[0] - v0[1] * c01[1]; r0[1] = v0[1] * c01[0] + v0[0] * c01[1]; r0[2] = v0[2] * c01[2] - v0[3] * c01[3]; r0[3] = v0[3] * c01[2] + v0[2] * c01[3];
    r1[0] = v1[0] * c23[0] - v1[1] * c23[1]; r1[1] = v1[1] * c23[0] + v1[0] * c23[1]; r1[2] = v1[2] * c23[2] - v1[3] * c23[3]; r1[3] = v1[3] * c23[2] + v1[2] * c23[3];
    v0 = r0; v1 = r1;
}
struct EpiMlaIn {
    static constexpr bool PERM = true;
    bf16_t *cq, *ckv, *kr; float* ss; const f32x2* cs;
    __device__ __forceinline__ void operator()(const f32x4 (&acc)[2][2][4][2], const GUnit& u, int wr, int wc, int fr, int fq) const {
        const int row0 = u.pm * BM + wr * 64 + fr;
        if (u.pn < 4) {
            bf16_t* dst = (u.pn < 2) ? cq : ckv; const int which = u.pn >> 1; const int col0 = (u.pn & 1) * BM + wc * 32 + 8 * fq;
#pragma unroll
            for (int ai = 0; ai < 2; ++ai)
#pragma unroll
                for (int m = 0; m < 4; ++m) { const int row = row0 + ai * HALF + m * 16; float q = 0.f;
#pragma unroll
                    for (int bj = 0; bj < 2; ++bj) { const f32x4 v0 = acc[ai][bj][m][0], v1 = acc[ai][bj][m][1];
                        q += (v0[0] * v0[0] + v0[1] * v0[1]) + (v0[2] * v0[2] + v0[3] * v0[3]) + (v1[0] * v1[0] + v1[1] * v1[1]) + (v1[2] * v1[2] + v1[3] * v1[3]);
                        *(u32x4*)(dst + (size_t)row * 512 + col0 + bj * HALF) = pack8(v0, v1); }
                    q += __shfl_xor(q, 16); q += __shfl_xor(q, 32);
                    if (fq == 0) ss[((size_t)row * 2 + which) * 8 + (u.pn & 1) * 4 + wc] = q; }
        } else if (wc < 2) {
#pragma unroll
            for (int ai = 0; ai < 2; ++ai) { f32x4 c01[4], c23[4];
#pragma unroll
                for (int m = 0; m < 4; ++m) { const int row = row0 + ai * HALF + m * 16; const f32x2* cp = cs + (size_t)(row & (S - 1)) * 32 + 16 * wc + 4 * fq; c01[m] = *(const f32x4*)cp; c23[m] = *(const f32x4*)(cp + 2); }
#pragma unroll
                for (int m = 0; m < 4; ++m) { const int row = row0 + ai * HALF + m * 16; const f32x4 v0 = acc[ai][0][m][0], v1 = acc[ai][0][m][1]; const f32x4 a = c01[m], b = c23[m]; f32x4 r0, r1;
                    r0[0] = v0[0] * a[0] - v0[1] * a[1]; r0[1] = v0[1] * a[0] + v0[0] * a[1]; r0[2] = v0[2] * a[2] - v0[3] * a[3]; r0[3] = v0[3] * a[2] + v0[2] * a[3];
                    r1[0] = v1[0] * b[0] - v1[1] * b[1]; r1[1] = v1[1] * b[0] + v1[0] * b[1]; r1[2] = v1[2] * b[2] - v1[3] * b[3]; r1[3] = v1[3] * b[2] + v1[2] * b[3];
                    *(u32x4*)(kr + (size_t)row * 64 + wc * 32 + 8 * fq) = pack8(r0, r1); } }
        }
    }
};
struct EpiMlaQKV {
    static constexpr bool PERM = true;
    bf16_t *q, *kv; const float* ss; const f32x2* cs;
    FK_LAS const float* rsl; bool use_lds; mutable int ui;
    template <class Sched> __device__ __forceinline__ void prepass(FK_LAS unsigned char* lds, const Sched& S) {
        FK_LAS float* r_ = (FK_LAS float*)(lds + STAGE_BYTES); rsl = r_; ui = 0;
        const int tid = fk_tid(), r = tid & 255, h = __builtin_amdgcn_readfirstlane(tid >> 8);
        GUnit u; use_lds = !S.next(10, u);
        if (!use_lds) return;
        f32x4 sa[5], sb[5];
#pragma unroll
        for (int p = 0; p < 5; ++p) { sa[p] = (f32x4){0.f, 0.f, 0.f, 0.f}; sb[p] = sa[p]; if (S.next(2 * p + h, u)) { const int row = u.pm * BM + r; sa[p] = *(const f32x4*)(ss + ((size_t)row * 2 + u.e) * 8); sb[p] = *(const f32x4*)(ss + ((size_t)row * 2 + u.e) * 8 + 4); } }
#pragma unroll
        for (int p = 0; p < 5; ++p) r_[(2 * p + h) * 256 + r] = rsqrtf((((sa[p][0] + sa[p][1]) + (sa[p][2] + sa[p][3])) + ((sb[p][0] + sb[p][1]) + (sb[p][2] + sb[p][3]))) * (1.0f / 512.0f) + 1e-6f);
        __syncthreads();
    }
    __device__ __forceinline__ void operator()(const f32x4 (&acc)[2][2][4][2], const GUnit& u, int wr, int wc, int fr, int fq) const {
        const int row0 = u.pm * BM + wr * 64 + fr;
        float rs[2][4];
        if (use_lds) {
#pragma unroll
            for (int ai = 0; ai < 2; ++ai)
#pragma unroll
                for (int m = 0; m < 4; ++m) rs[ai][m] = rsl[ui * 256 + wr * 64 + fr + ai * HALF + m * 16];
        } else {
#pragma unroll
            for (int ai = 0; ai < 2; ++ai) { f32x4 sa[4], sb[4];
#pragma unroll
                for (int m = 0; m < 4; ++m) { const int row = row0 + ai * HALF + m * 16; sa[m] = *(const f32x4*)(ss + ((size_t)row * 2 + u.e) * 8); sb[m] = *(const f32x4*)(ss + ((size_t)row * 2 + u.e) * 8 + 4); }
#pragma unroll
                for (int m = 0; m < 4; ++m) rs[ai][m] = rsqrtf((((sa[m][0] + sa[m][1]) + (sa[m][2] + sa[m][3])) + ((sb[m][0] + sb[m][1]) + (sb[m][2] + sb[m][3]))) * (1.0f / 512.0f) + 1e-6f); }
        }
        ++ui;
#pragma unroll
        for (int ai = 0; ai < 2; ++ai) {
#pragma unroll
            for (int bj = 0; bj < 2; ++bj) { const int gc = u.pn * BM + bj * HALF + wc * 32 + 8 * fq; const int j = gc % 192; const bool rope = __builtin_amdgcn_readfirstlane((int)((u.e == 0) && (j >= 128))) != 0;
                f32x4 c01[4], c23[4];
                if (rope) {
#pragma unroll
                    for (int m = 0; m < 4; ++m) { const int row = row0 + ai * HALF + m * 16; const f32x2* cp = cs + (size_t)(row & (S - 1)) * 32 + ((j - 128) >> 1); c01[m] = *(const f32x4*)cp; c23[m] = *(const f32x4*)(cp + 2); } }
#pragma unroll
                for (int m = 0; m < 4; ++m) { const int row = row0 + ai * HALF + m * 16; f32x4 v0 = acc[ai][bj][m][0] * rs[ai][m], v1 = acc[ai][bj][m][1] * rs[ai][m];
                    if (u.e == 0) {
                        if (rope) { f32x4 r0, r1; const f32x4 a = c01[m], b = c23[m];
                            r0[0] = v0[0] * a[0] - v0[1] * a[1]; r0[1] = v0[1] * a[0] + v0[0] * a[1]; r0[2] = v0[2] * a[2] - v0[3] * a[3]; r0[3] = v0[3] * a[2] + v0[2] * a[3];
                            r1[0] = v1[0] * b[0] - v1[1] * b[1]; r1[1] = v1[1] * b[0] + v1[0] * b[1]; r1[2] = v1[2] * b[2] - v1[3] * b[3]; r1[3] = v1[3] * b[2] + v1[2] * b[3]; v0 = r0; v1 = r1; }
                        v0 = v0 * QSCALE_MLA; v1 = v1 * QSCALE_MLA; *(u32x4*)(q + (size_t)row * 3072 + gc) = pack8(v0, v1); }
                    else *(u32x4*)(kv + (size_t)row * 4096 + gc) = pack8(v0, v1); } }
        }
    }
};
}
namespace fk {
#define FK_KSWZ(row, colB) ((row) * 256 + ((colB) ^ (((row) & 7) << 4)))
#define FK_KRSWZ(row, ch) ((row) * 128 + ((((ch)) ^ (((row) >> 1) & 7)) << 4))
__device__ __forceinline__ int v_st(int k, int c) { const int kk = (k & ~0xC) | ((k & 4) << 1) | ((k & 8) >> 1); return ((kk >> 3) * 4 + (c >> 5)) * 512 + ((kk & 7) * 32 + (c & 31)) * 2; }
__device__ __forceinline__ int v_rd_base(int lane) { return ((lane & 3) << 3) | (((lane >> 2) & 3) << 6) | (((lane >> 4) & 1) << 5) | (((lane >> 5) & 1) << 8); }
__device__ __forceinline__ int crow(int r, int hi) { return (r & 3) + 8 * (r >> 2) + 4 * hi; }

constexpr int AT_K = 0, AT_V = 32768, AT_KR = 65536, AT_CF = 81920, AT_WS = 90112;

struct AttnPtrs { const bf16_t* Q; const bf16_t* K; const bf16_t* V; const bf16_t* KR; const float* CF; bf16_t* O; int qld, kld; };

template <int MODE>
__device__ __forceinline__ void attn_block(FK_LAS unsigned char* lds, const AttnPtrs P, const int qb) {
    constexpr int NQ = MODE == 0 ? 12 : 8;
    const int tid = fk_tid(), wid = __builtin_amdgcn_readfirstlane(tid >> 6), lane = tid & 63, r32 = lane & 31, hi = lane >> 5;
    const int q0w = qb * 256 + wid * 32;
    const int nt = 4 * (qb + 1);
    bf16x8 qr[NQ];
    { const bf16_t* qrow = P.Q + (size_t)(q0w + r32) * P.qld;
#pragma unroll
      for (int d0 = 0; d0 < NQ; ++d0) qr[d0] = *(const bf16x8*)(qrow + d0 * 16 + hi * 8); }
    float ct2 = 0.f; if (MODE == 1) ct2 = ((FK_LAS const float*)(lds + AT_CF))[q0w + r32];
    const int sr = tid >> 4, sc = (tid & 15) * 8;
    const int kws = FK_KSWZ(sr, sc * 2), vst0 = v_st(sr, sc), vst1 = v_st(32 + sr, sc);
    const int krr = tid >> 3, krc = tid & 7, krw = FK_KRSWZ(krr, krc);
    const int vb0 = AT_V + v_rd_base(lane);
    FK_LAS float* wsl = (FK_LAS float*)(lds + AT_WS) + wid * 64;
    bf16x8 sk0, sk1, sv0, sv1, skr;
    float m_reg = -1e30f, l_reg = 0.f; f32x16 o[4];
#pragma unroll
    for (int d = 0; d < 4; ++d)
#pragma unroll
        for (int r = 0; r < 16; ++r) o[d][r] = 0.f;
#define AT_LOAD(j) do { const size_t k0_ = (size_t)(j) * 64; \
        sk0 = *(const bf16x8*)(P.K + (k0_ + sr) * P.kld + sc); sk1 = *(const bf16x8*)(P.K + (k0_ + 32 + sr) * P.kld + sc); \
        sv0 = *(const bf16x8*)(P.V + (k0_ + sr) * P.kld + sc); sv1 = *(const bf16x8*)(P.V + (k0_ + 32 + sr) * P.kld + sc); \
        if (MODE == 0) skr = *(const bf16x8*)(P.KR + (k0_ + krr) * 64 + krc * 8); \
        } while (0)
#define AT_WRITE(bf) do { *(FK_LAS bf16x8*)(lds + AT_K + (bf) * 16384 + kws) = sk0; *(FK_LAS bf16x8*)(lds + AT_K + (bf) * 16384 + kws + 32 * 256) = sk1; \
        *(FK_LAS bf16x8*)(lds + AT_V + (bf) * 16384 + vst0) = sv0; *(FK_LAS bf16x8*)(lds + AT_V + (bf) * 16384 + vst1) = sv1; \
        if (MODE == 0) *(FK_LAS bf16x8*)(lds + AT_KR + (bf) * 8192 + krw) = skr; \
        } while (0)
#define AT_TRRD(dst, off) asm volatile("ds_read_b64_tr_b16 %0, %1 offset:%2" : "=&v"(dst) : "v"(vb0), "i"(off) : "memory")
#define AT_PV_D0(KB, d0) do { s16x4 l0, l1, l2, l3, h0, h1, h2, h3; constexpr int b_ = (KB) * 16384 + (d0) * 512; \
        AT_TRRD(l0, b_); AT_TRRD(h0, b_ + 2048); AT_TRRD(l1, b_ + 4096); AT_TRRD(h1, b_ + 6144); AT_TRRD(l2, b_ + 8192); AT_TRRD(h2, b_ + 10240); AT_TRRD(l3, b_ + 12288); AT_TRRD(h3, b_ + 14336); \
        asm volatile("s_waitcnt lgkmcnt(0)" ::: "memory"); __builtin_amdgcn_sched_barrier(0); \
        o[d0] = __builtin_amdgcn_mfma_f32_32x32x16_bf16(pa0, (bf16x8){l0[0], l0[1], l0[2], l0[3], h0[0], h0[1], h0[2], h0[3]}, o[d0], 0, 0, 0); \
        o[d0] = __builtin_amdgcn_mfma_f32_32x32x16_bf16(pa1, (bf16x8){l1[0], l1[1], l1[2], l1[3], h1[0], h1[1], h1[2], h1[3]}, o[d0], 0, 0, 0); \
        o[d0] = __builtin_amdgcn_mfma_f32_32x32x16_bf16(pa2, (bf16x8){l2[0], l2[1], l2[2], l2[3], h2[0], h2[1], h2[2], h2[3]}, o[d0], 0, 0, 0); \
        o[d0] = __builtin_amdgcn_mfma_f32_32x32x16_bf16(pa3, (bf16x8){l3[0], l3[1], l3[2], l3[3], h3[0], h3[1], h3[2], h3[3]}, o[d0], 0, 0, 0); } while (0)
#define AT_PK4(Pv, B_, OUT) do { unsigned a0 = cvt_pk_bf16(Pv[B_ + 0], Pv[B_ + 1]), a1 = cvt_pk_bf16(Pv[B_ + 2], Pv[B_ + 3]); \
        unsigned b0 = cvt_pk_bf16(Pv[B_ + 4], Pv[B_ + 5]), b1 = cvt_pk_bf16(Pv[B_ + 6], Pv[B_ + 7]); \
        auto r0 = __builtin_amdgcn_permlane32_swap(a0, b0, false, false); auto r1 = __builtin_amdgcn_permlane32_swap(a1, b1, false, false); \
        u32x4 w_ = {r0[0], r1[0], r0[1], r1[1]}; OUT = *reinterpret_cast<bf16x8*>(&w_); } while (0)
#define AT_STEP(j, KB) do { \
        if ((j) + 1 < nt) AT_LOAD((j) + 1); \
        if ((j) * 64 <= q0w) { \
            f32x16 p0, p1; \
            _Pragma("unroll") for (int r = 0; r < 16; ++r) { p0[r] = 0.f; p1[r] = 0.f; } \
            __builtin_amdgcn_s_setprio(1); \
            { FK_LAS const unsigned char* kb_ = lds + AT_K + (KB) * 16384; \
              _Pragma("unroll") for (int d0 = 0; d0 < 8; ++d0) { \
                const bf16x8 b0 = *(FK_LAS const bf16x8*)(kb_ + FK_KSWZ(r32, (d0 * 16 + hi * 8) * 2)); \
                const bf16x8 b1 = *(FK_LAS const bf16x8*)(kb_ + FK_KSWZ(r32, (d0 * 16 + hi * 8) * 2) + 32 * 256); \
                p0 = __builtin_amdgcn_mfma_f32_32x32x16_bf16(b0, qr[d0], p0, 0, 0, 0); \
                p1 = __builtin_amdgcn_mfma_f32_32x32x16_bf16(b1, qr[d0], p1, 0, 0, 0); } } \
            if (MODE == 0) { FK_LAS const unsigned char* kr_ = lds + AT_KR + (KB) * 8192; \
              _Pragma("unroll") for (int d0 = 0; d0 < 4; ++d0) { \
                const bf16x8 b0 = *(FK_LAS const bf16x8*)(kr_ + FK_KRSWZ(r32, 2 * d0 + hi)); \
                const bf16x8 b1 = *(FK_LAS const bf16x8*)(kr_ + FK_KRSWZ(r32 + 32, 2 * d0 + hi)); \
                p0 = __builtin_amdgcn_mfma_f32_32x32x16_bf16(b0, qr[(MODE == 0 ? 8 : 0) + d0], p0, 0, 0, 0); \
                p1 = __builtin_amdgcn_mfma_f32_32x32x16_bf16(b1, qr[(MODE == 0 ? 8 : 0) + d0], p1, 0, 0, 0); } } \
            __builtin_amdgcn_s_setprio(0); \
            if (MODE == 1) { FK_LAS const float* cf_ = (FK_LAS const float*)(lds + AT_CF) + (j) * 64; \
              _Pragma("unroll") for (int g = 0; g < 4; ++g) { const f32x4 c0 = *(FK_LAS const f32x4*)(cf_ + 8 * g + 4 * hi), c1 = *(FK_LAS const f32x4*)(cf_ + 32 + 8 * g + 4 * hi); \
                _Pragma("unroll") for (int i = 0; i < 4; ++i) { p0[4 * g + i] += ct2 - c0[i]; p1[4 * g + i] += ct2 - c1[i]; } } \
              if ((j) * 64 + 63 > q0w) { const int dq = q0w + r32 - (j) * 64 - 4 * hi; const float NEG = -__builtin_inff(); \
                _Pragma("unroll") for (int r = 0; r < 16; ++r) { const int c = (r & 3) + 8 * (r >> 2); if (c > dq) p0[r] = NEG; if (c + 32 > dq) p1[r] = NEG; } } } \
            float pmax = p0[0]; \
            _Pragma("unroll") for (int r = 1; r < 16; ++r) pmax = fmaxf(pmax, p0[r]); \
            _Pragma("unroll") for (int r = 0; r < 16; ++r) pmax = fmaxf(pmax, p1[r]); \
            { auto rr = __builtin_amdgcn_permlane32_swap(__float_as_uint(pmax), __float_as_uint(pmax), false, false); pmax = fmaxf(__uint_as_float(rr[0]), __uint_as_float(rr[1])); } \
            float mn, alpha; \
            if (__all(pmax - m_reg <= 11.5415603f)) { mn = m_reg; alpha = 1.f; }     \
            else { mn = fmaxf(m_reg, pmax); alpha = __builtin_amdgcn_exp2f(m_reg - mn); m_reg = mn; } \
            float ps = 0.f; \
            _Pragma("unroll") for (int r = 0; r < 16; ++r) { p0[r] = __builtin_amdgcn_exp2f(p0[r] - mn); ps += p0[r]; } \
            _Pragma("unroll") for (int r = 0; r < 16; ++r) { p1[r] = __builtin_amdgcn_exp2f(p1[r] - mn); ps += p1[r]; } \
            { auto rr = __builtin_amdgcn_permlane32_swap(__float_as_uint(ps), __float_as_uint(ps), false, false); ps = __uint_as_float(rr[0]) + __uint_as_float(rr[1]); } \
            l_reg = l_reg * alpha + ps; \
            bf16x8 pa0, pa1, pa2, pa3; AT_PK4(p0, 0, pa0); AT_PK4(p0, 8, pa1); AT_PK4(p1, 0, pa2); AT_PK4(p1, 8, pa3); \
            if (__any(alpha < 1.f)) { if (hi == 0) wsl[32 + r32] = alpha; asm volatile("s_waitcnt lgkmcnt(0)" ::: "memory"); \
                _Pragma("unroll") for (int g = 0; g < 4; ++g) { const f32x4 a4 = *(FK_LAS const f32x4*)(wsl + 32 + 8 * g + 4 * hi); \
                    _Pragma("unroll") for (int d_ = 0; d_ < 4; ++d_) _Pragma("unroll") for (int i = 0; i < 4; ++i) o[d_][4 * g + i] *= a4[i]; } } \
            __builtin_amdgcn_s_setprio(1); AT_PV_D0(KB, 0); AT_PV_D0(KB, 1); AT_PV_D0(KB, 2); AT_PV_D0(KB, 3); __builtin_amdgcn_s_setprio(0); \
        } \
        if ((j) + 1 < nt) AT_WRITE((KB) ^ 1); \
        __syncthreads(); } while (0)

    AT_LOAD(0); AT_WRITE(0); __syncthreads();
#pragma unroll
    for (int d0 = 0; d0 < NQ; ++d0) asm volatile("" :: "v"(qr[d0]));
    for (int j = 0; j < nt; j += 2) { AT_STEP(j, 0); AT_STEP(j + 1, 1); }
    if (hi == 0) wsl[r32] = l_reg; asm volatile("s_waitcnt lgkmcnt(0)" ::: "memory");
    bf16_t* Ow = P.O + (size_t)q0w * D;
#pragma unroll
    for (int g = 0; g < 4; ++g) { const f32x4 l4 = *(FK_LAS const f32x4*)(wsl + 8 * g + 4 * hi);
#pragma unroll
        for (int i = 0; i < 4; ++i) { const int r = 4 * g + i; const int orow = crow(r, hi); const float rl = __builtin_amdgcn_rcpf(l4[i]);
#pragma unroll
            for (int d0 = 0; d0 < 4; ++d0) { const float v = o[d0][r] * rl; const float vn = __shfl_xor(v, 1);
                if ((r32 & 1) == 0) *(unsigned*)(Ow + (size_t)orow * D + d0 * 32 + r32) = cvt_pk_bf16(v, vn); } } }
    __syncthreads();
#undef AT_LOAD
#undef AT_WRITE
#undef AT_TRRD
#undef AT_PV_D0
#undef AT_PK4
#undef AT_STEP
}
}
namespace fk {
constexpr int LN_XS = 2052;
constexpr int TAB_OFF = 143360;

struct LnArgs {
    const float* x; const bf16_t* yb; const bf16_t* Y2; const int* te; const int* tpos; const int* cnt;
    const float *g, *b; float* xo; bf16_t* xbo; float* out2; unsigned char* xqo;
    const f32x4* w4; int ntile;
    const float *bgrp, *brt; int* rcnt; int* ote; int* otpos; float* otw; int* list; float* sw;
    float* flog; const float* fbias;
};

__device__ __forceinline__ float wave_sum(float v) { for (int o = 32; o >= 1; o >>= 1) v += __shfl_xor(v, o); return v; }

struct LnRows { f32x4 x[2][8]; u32x2 ya[2][8]; u32x2 yb[2][8]; };
__device__ __forceinline__ void ln_load(const LnArgs& a, FK_LAS const int* hoff, int grp, int wid, int lane, LnRows& R) {
#pragma unroll
    for (int rr = 0; rr < 2; ++rr) { const int t = grp * 16 + 2 * wid + rr;
        const bf16_t *pa, *pb = nullptr;
        if (a.Y2) { const int e0 = a.te[t * 2], e1 = a.te[t * 2 + 1]; pa = a.Y2 + (size_t)(hoff[e0] + a.tpos[t * 2]) * D; pb = a.Y2 + (size_t)(hoff[e1] + a.tpos[t * 2 + 1]) * D; }
        else pa = a.yb + (size_t)t * D;
#pragma unroll
        for (int i = 0; i < 8; ++i) { const int c = 4 * lane + 256 * i; R.x[rr][i] = __builtin_nontemporal_load((const f32x4*)(a.x + (size_t)t * D + c)); R.ya[rr][i] = __builtin_nontemporal_load((const u32x2*)(pa + c)); if (a.Y2) R.yb[rr][i] = __builtin_nontemporal_load((const u32x2*)(pb + c)); else R.yb[rr][i] = (u32x2){0u, 0u}; } }
}
__device__ __forceinline__ void phase_ln(const LnArgs& a, FK_LAS unsigned char* lds) {
    const int tid = fk_tid(), wid = __builtin_amdgcn_readfirstlane(tid >> 6), lane = tid & 63;
    FK_LAS float* part = (FK_LAS float*)lds;
    FK_LAS float* logit = (FK_LAS float*)(lds + 65536);
    FK_LAS int* hoff = (FK_LAS int*)(lds + TAB_OFF);
    FK_LAS float* gbl = (FK_LAS float*)(lds + 98304);
    { const f32x4 gq = ((const f32x4*)a.g)[tid], bq = ((const f32x4*)a.b)[tid]; ((FK_LAS f32x4*)gbl)[tid] = gq; ((FK_LAS f32x4*)(gbl + 2048))[tid] = bq; }
    if (!a.Y2) __syncthreads();
    if (a.Y2) { if (tid < 64) { const int c = lane < 32 ? a.cnt[lane * 32] : 0; const int pc = ((c + 255) >> 8) << 8; int incl = pc;
#pragma unroll
            for (int o = 1; o < 32; o <<= 1) { const int v = __shfl_up(incl, o); if (lane >= o) incl += v; }
            if (lane < 32) hoff[lane] = incl - pc; }
        __syncthreads(); }
    const int nb = fk_nblk(); int grp = fk_bid();
    if (grp >= NT / 16) return;
    LnRows cur; ln_load(a, hoff, grp, wid, lane, cur);
#pragma unroll 1
    for (; grp < NT / 16; grp += nb) {
        const bool has_next = grp + nb < NT / 16;
#pragma unroll
        for (int rr = 0; rr < 2; ++rr) {
            const int lr = 2 * wid + rr, t = grp * 16 + lr;
            f32x4 v[8]; float s = 0.f;
#pragma unroll
            for (int i = 0; i < 8; ++i) { f32x4 xv = cur.x[rr][i] * ALPHA; const u32x2 pa = cur.ya[rr][i], pb = cur.yb[rr][i];
                xv[0] += __uint_as_float(pa.x << 16) + __uint_as_float(pb.x << 16); xv[1] += __uint_as_float(pa.x & 0xffff0000u) + __uint_as_float(pb.x & 0xffff0000u);
                xv[2] += __uint_as_float(pa.y << 16) + __uint_as_float(pb.y << 16); xv[3] += __uint_as_float(pa.y & 0xffff0000u) + __uint_as_float(pb.y & 0xffff0000u);
                v[i] = xv; s += (xv[0] + xv[1]) + (xv[2] + xv[3]); }
            const float mean = wave_sum(s) * (1.0f / D); float q = 0.f;
#pragma unroll
            for (int i = 0; i < 8; ++i) { const f32x4 d = v[i] - mean; q += (d[0] * d[0] + d[1] * d[1]) + (d[2] * d[2] + d[3] * d[3]); }
            const float rs = rsqrtf(wave_sum(q) * (1.0f / D) + 1e-5f);
#pragma unroll
            for (int i = 0; i < 8; ++i) { const int c = 4 * lane + 256 * i; const f32x4 gv = *(FK_LAS const f32x4*)(gbl + c), bv = *(FK_LAS const f32x4*)(gbl + 2048 + c);
                const f32x4 o = (v[i] - mean) * rs * gv + bv;
                *(f32x4*)(a.xo + (size_t)t * D + c) = o;
                if (a.out2) *(f32x4*)(a.out2 + (size_t)t * D + c) = o;
                u32x2 p; p.x = cvt_pk_bf16(o[0], o[1]); p.y = cvt_pk_bf16(o[2], o[3]); *(u32x2*)(a.xbo + (size_t)t * D + c) = p; }
        }
        if (has_next) ln_load(a, hoff, grp + nb, wid, lane, cur);
    }
    if (!a.w4) return;
    __syncthreads();
    const int row = lane & 15, kq = lane >> 4;
#pragma unroll 1
    for (int g0 = fk_bid(); g0 < NT / 16; g0 += 2 * nb) {
        const int g1 = g0 + nb; const bool two = g1 < NT / 16;
        const int ks = (wid + (fk_bid() >> 3)) & 7, jrot = 4 * ((fk_bid() >> 6) & 3);
        const float* xp0 = a.xo + (size_t)(g0 * 16 + row) * D + 4 * kq + 256 * ks;
        const float* xp1 = a.xo + (size_t)((two ? g1 : g0) * 16 + row) * D + 4 * kq + 256 * ks;
        const f32x4* wp = a.w4 + (size_t)(ks * 16 * a.ntile) * 64 + lane;
        f32x4 acc[2][3];
#pragma unroll
        for (int g = 0; g < 2; ++g)
#pragma unroll
            for (int n = 0; n < 3; ++n) acc[g][n] = (f32x4){0.f, 0.f, 0.f, 0.f};
        __builtin_amdgcn_s_setprio(1);
#pragma unroll 4
        for (int j0 = 0; j0 < 16; ++j0) { const int j = (j0 + jrot) & 15;
            const f32x4 a0 = *(const f32x4*)(xp0 + 16 * j), a1 = *(const f32x4*)(xp1 + 16 * j);
#pragma unroll
            for (int n = 0; n < 3; ++n) if (n < a.ntile) { const f32x4 bv = wp[(size_t)(j * a.ntile + n) * 64];
#pragma unroll
                for (int i = 0; i < 4; ++i) { acc[0][n] = __builtin_amdgcn_mfma_f32_16x16x4f32(a0[i], bv[i], acc[0][n], 0, 0, 0); acc[1][n] = __builtin_amdgcn_mfma_f32_16x16x4f32(a1[i], bv[i], acc[1][n], 0, 0, 0); } } }
        __builtin_amdgcn_s_setprio(0);
#pragma unroll
        for (int g = 0; g < 2; ++g)
#pragma unroll
            for (int n = 0; n < 3; ++n) if (n < a.ntile) {
#pragma unroll
                for (int r = 0; r < 4; ++r) part[(wid * 32 + 16 * g + 4 * kq + r) * 48 + 16 * n + row] = acc[g][n][r]; }
        __syncthreads();
        for (int i = tid; i < 32 * 16 * a.ntile; i += NTHR) { const int n = i % (16 * a.ntile), r = i / (16 * a.ntile); float s = 0.f;
#pragma unroll
            for (int w = 0; w < 8; ++w) s += part[(w * 32 + r) * 48 + n]; logit[r * 48 + n] = s; }
        __syncthreads();
        if (a.ntile == 1) { const int r = tid & 31, n = tid >> 5; if (r < 16 || two) { const int t = (r < 16 ? g0 : g1) * 16 + (r & 15); const float x = logit[r * 48 + n] + a.fbias[n]; const float ls = fminf(x, 0.f) - 0.6931471805599453f * __builtin_amdgcn_logf(1.0f + __builtin_amdgcn_exp2f(-fabsf(x) * LOG2E));     a.flog[((size_t)((t >> 11) * 16 + n)) * S + (t & (S - 1))] = ls; } }
        else if (tid < 16 || (tid < 32 && two)) { const int t = (tid < 16 ? g0 : g1) * 16 + (tid & 15); FK_LAS const float* lg = logit + tid * 48;
            float g4[4]; float mx = -3e38f; int gs = 0;
            for (int i = 0; i < 4; ++i) { g4[i] = lg[i] + a.bgrp[i]; if (g4[i] > mx) { mx = g4[i]; gs = i; } }
            float den = 0.f; for (int i = 0; i < 4; ++i) den += expf(g4[i] - mx); const float pg = 1.f / den;
            float e[8]; for (int i = 0; i < 8; ++i) e[i] = lg[4 + gs * 8 + i] + a.brt[gs * 8 + i];
            int i1 = 0; for (int i = 1; i < 8; ++i) if (e[i] > e[i1]) i1 = i;
            int i2 = -1; for (int i = 0; i < 8; ++i) if (i != i1 && (i2 < 0 || e[i] > e[i2])) i2 = i;
            const float w1 = 1.f / (1.f + expf(e[i2] - e[i1])), w2 = 1.f - w1;
            const int ea = gs * 8 + i1, eb = gs * 8 + i2;
            const int pa = atomicAdd(a.rcnt + ea * 32, 1), pb = atomicAdd(a.rcnt + eb * 32, 1);
            a.ote[t * 2] = ea; a.ote[t * 2 + 1] = eb; a.otpos[t * 2] = pa; a.otpos[t * 2 + 1] = pb; a.otw[t * 2] = w1 * pg; a.otw[t * 2 + 1] = w2 * pg;
            a.list[ea * NT + pa] = t; a.list[eb * NT + pb] = t; a.sw[ea * NT + pa] = w1 * pg; a.sw[eb * NT + pb] = w2 * pg; }
        __syncthreads();
    }
}

__device__ __forceinline__ void moe_tables(const int* cnt, FK_LAS int* tab) {
    const int tid = fk_tid(), lane = tid & 63;
    __syncthreads();
    if (tid < 64) { const int c = lane < 32 ? cnt[lane * 32] : 0; const int nt = (c + 255) >> 8; int incl = nt;
#pragma unroll
        for (int o = 1; o < 32; o <<= 1) { const int v = __shfl_up(incl, o); if (lane >= o) incl += v; }
        if (lane < 32) { tab[lane] = incl - nt; tab[40 + lane] = (incl - nt) * 256; tab[80 + lane] = c; }
        if (lane == 31) tab[32] = incl; }
    __syncthreads();
}
struct MoeSched1 {
    const char* xb; const char* Bt; const int* list; FK_LAS const int* tab; int G, c;
    __device__ __forceinline__ bool next(int i, GUnit& u) const {
        const int L = i * G + c; const int tot = tab[32] * 4; if (L >= tot) return false;
        int e = 0;
#pragma unroll 1
        for (int q = 1; q < 32; ++q) if (L >= tab[q] * 4) e = q;
        const int r = L - tab[e] * 4, nte = tab[e + 1] - tab[e]; const int mt = r % nte, pn = r / nte;
        u.e = e; u.pm = mt; u.pn = pn; u.nrows = min(256, tab[80 + e] - 256 * mt); u.A = xb; u.B = Bt + ((size_t)e * 1024 + (size_t)pn * 256) * D * 2; return true; }
    __device__ __forceinline__ void a_offs(const GUnit& u, int tid, unsigned (&o)[2][2]) const { int R0, C0, R1, C1; stage_rc(tid * 16, R0, C0); stage_rc(tid * 16 + 8192, R1, C1);
        const int* l = list + (size_t)u.e * NT + u.pm * 256;
        const int r00 = R0 < u.nrows ? R0 : 0, r01 = R1 < u.nrows ? R1 : 0, r10 = R0 + HALF < u.nrows ? R0 + HALF : 0, r11 = R1 + HALF < u.nrows ? R1 + HALF : 0;
        o[0][0] = (unsigned)(l[r00] * D + C0) * 2u; o[0][1] = (unsigned)(l[r01] * D + C1) * 2u; o[1][0] = (unsigned)(l[r10] * D + C0) * 2u; o[1][1] = (unsigned)(l[r11] * D + C1) * 2u; }
};
struct MoeSched2 {
    const char* H; const char* Bt; FK_LAS const int* tab; int G, c;
    __device__ __forceinline__ bool next(int i, GUnit& u) const {
        const int L = i * G + c; const int tot = tab[32] * 8; if (L >= tot) return false;
        int e = 0;
#pragma unroll 1
        for (int q = 1; q < 32; ++q) if (L >= tab[q] * 8) e = q;
        const int r = L - tab[e] * 8, nte = tab[e + 1] - tab[e]; const int mt = r % nte, pn = r / nte;
        u.e = e; u.pm = mt; u.pn = pn; u.nrows = min(256, tab[80 + e] - 256 * mt); u.A = H + (size_t)(tab[40 + e] + 256 * mt) * 512 * 2; u.B = Bt + ((size_t)e * 2048 + (size_t)pn * 256) * 512 * 2; return true; }
    __device__ __forceinline__ void a_offs(const GUnit&, int tid, unsigned (&o)[2][2]) const { int R0, C0, R1, C1; stage_rc(tid * 16, R0, C0); stage_rc(tid * 16 + 8192, R1, C1);
        o[0][0] = (unsigned)(R0 * 512 + C0) * 2u; o[0][1] = (unsigned)(R1 * 512 + C1) * 2u; o[1][0] = o[0][0] + (unsigned)(HALF * 512 * 2); o[1][1] = o[0][1] + (unsigned)(HALF * 512 * 2); }
};
struct EpiMoe1 {
    static constexpr bool PERM = false;
    bf16_t* H; const float* sw; FK_LAS const int* tab;
    __device__ __forceinline__ void operator()(const f32x4 (&acc)[2][2][4][2], const GUnit& u, int wr, int wc, int fr, int fq) const {
        const int hrow0 = tab[40 + u.e] + 256 * u.pm; const float* swe = sw + (size_t)u.e * NT + 256 * u.pm;
#pragma unroll
        for (int ai = 0; ai < 2; ++ai)
#pragma unroll
            for (int m = 0; m < 4; ++m) { const int r = ai * HALF + wr * 64 + m * 16 + fr; if (r < u.nrows) { const float wgt = swe[r];
#pragma unroll
                for (int bj = 0; bj < 2; ++bj) { const f32x4 g = acc[ai][bj][m][0], up = acc[ai][bj][m][1]; f32x4 h;
#pragma unroll
                    for (int j = 0; j < 4; ++j) h[j] = g[j] * __builtin_amdgcn_rcpf(1.0f + __builtin_amdgcn_exp2f(-g[j] * LOG2E)) * up[j] * wgt;
                    u32x2 p; p.x = cvt_pk_bf16(h[0], h[1]); p.y = cvt_pk_bf16(h[2], h[3]);
                    *(u32x2*)(H + (size_t)(hrow0 + r) * 512 + u.pn * 128 + bj * 64 + wc * 16 + 4 * fq) = p; } } }
    }
};
struct EpiMoe2 {
    static constexpr bool PERM = true;
    bf16_t* Y2; FK_LAS const int* tab;
    __device__ __forceinline__ void operator()(const f32x4 (&acc)[2][2][4][2], const GUnit& u, int wr, int wc, int fr, int fq) const {
        const int hrow0 = tab[40 + u.e] + 256 * u.pm;
#pragma unroll
        for (int ai = 0; ai < 2; ++ai)
#pragma unroll
            for (int m = 0; m < 4; ++m) { const int r = ai * HALF + wr * 64 + m * 16 + fr; if (r < u.nrows) {
#pragma unroll
                for (int bj = 0; bj < 2; ++bj) *(u32x4*)(Y2 + (size_t)(hrow0 + r) * D + u.pn * BM + bj * HALF + wc * 32 + 8 * fq) = pack8(acc[ai][bj][m][0], acc[ai][bj][m][1]); } }
    }
};
}
namespace fk {
constexpr int SG_ROWS = 640, SG_ASTG = SG_ROWS * 64, SG_BPIT = 528, SG_BSTG = 16 * SG_BPIT, SG_A = 0, SG_B = 3 * SG_ASTG;
struct SgArgs {
    const char* A; const int* rowlist; int arow0, lda_bytes, nr;
    const float* B0; const float* B1; int ldn, K;
    bf16_t* out; int out_row0, out_ld, out_col0; const float* roww; int var;
};
template <int MF>
__device__ __forceinline__ void sg_loop(FK_LAS unsigned char* lds, f32x4 (&acc)[10][4], const char* const (&ap)[5], const float* bpt, const int ldn, const int nt, const unsigned a_rd, const unsigned b_rd, const unsigned b_wr, const int wid) {
    f32x4 br0[2], br1[2];
#define SG_ISSUE(t, sA, R) do { const int t_ = (t) < nt ? (t) : nt - 1; \
        _Pragma("unroll") for (int i = 0; i < 5; ++i) __builtin_amdgcn_global_load_lds((const unsigned*)(ap[i] + (size_t)t_ * 64), (FK_LAS unsigned*)(lds + SG_A + (sA) * SG_ASTG + (5 * wid + i) * 1024), 16, 0, 0); \
        const float* bq_ = bpt + (size_t)t_ * 32 * ldn; \
        R[0] = __builtin_nontemporal_load((const f32x4*)bq_); R[1] = __builtin_nontemporal_load((const f32x4*)(bq_ + ldn)); } while (0)
#define SG_CONV(R, sB) do { u32x4 w_; w_.x = cvt_pk_bf16(R[0][0], R[1][0]); w_.y = cvt_pk_bf16(R[0][1], R[1][1]); w_.z = cvt_pk_bf16(R[0][2], R[1][2]); w_.w = cvt_pk_bf16(R[0][3], R[1][3]); \
        *(FK_LAS u32x4*)(lds + SG_B + (sB) * SG_BSTG + b_wr) = w_; } while (0)
#define SG_DSR(dst, addr, off) asm volatile("ds_read_b128 %0, %1 offset:%2" : "=v"(dst) : "v"(addr), "n"(off))
#define SG_DSR2(dst, addr, o0, o1) asm volatile("ds_read2_b32 %0, %1 offset0:%2 offset1:%3" : "=v"(dst) : "v"(addr), "n"(o0), "n"(o1))
#define SG_BFRAG(dst, j) do { u32x2 lo_, hi_; SG_DSR2(lo_, ba_, (j) * 16, (j) * 16 + SG_BPIT / 4); SG_DSR2(hi_, ba2_, (j) * 16, (j) * 16 + SG_BPIT / 4); u32x4 w_ = {lo_.x, lo_.y, hi_.x, hi_.y}; dst = *reinterpret_cast<bf16x8*>(&w_); } while (0)
#define SG_STEP(t, RI, RC) do { \
        asm volatile("s_waitcnt lgkmcnt(0)\n\ts_barrier" ::: "memory");                \
        { const int s2_ = sa == 0 ? 2 : sa - 1; SG_ISSUE((t) + 2, s2_, RI); }          \
        __builtin_amdgcn_sched_barrier(0); \
        const unsigned aa_ = a_rd + (unsigned)(sa * SG_ASTG), ba_ = b_rd + (unsigned)(((t) & 1) * SG_BSTG); \
        const unsigned ba2_ = ba_ + 2 * SG_BPIT; bf16x8 b0_, b1_, b2_, b3_, a0_, a1_; \
        SG_BFRAG(b0_, 0); SG_BFRAG(b1_, 1); SG_BFRAG(b2_, 2); SG_BFRAG(b3_, 3);         \
        SG_DSR(a0_, aa_, 0); SG_DSR(a1_, aa_, 1024);                                    \
        asm volatile("s_waitcnt lgkmcnt(1)" : "+v"(b0_), "+v"(b1_), "+v"(b2_), "+v"(b3_), "+v"(a0_)); \
        __builtin_amdgcn_s_setprio(1);                                                 \
        _Pragma("unroll") for (int i = 0; i < MF; i += 2) { \
            if (i > 0) asm volatile("s_waitcnt lgkmcnt(1)" : "+v"(a0_)); \
            acc[i][0] = __builtin_amdgcn_mfma_f32_16x16x32_bf16(b0_, a0_, acc[i][0], 0, 0, 0); acc[i][1] = __builtin_amdgcn_mfma_f32_16x16x32_bf16(b1_, a0_, acc[i][1], 0, 0, 0); \
            acc[i][2] = __builtin_amdgcn_mfma_f32_16x16x32_bf16(b2_, a0_, acc[i][2], 0, 0, 0); acc[i][3] = __builtin_amdgcn_mfma_f32_16x16x32_bf16(b3_, a0_, acc[i][3], 0, 0, 0); \
            if (i + 2 < MF) { SG_DSR(a0_, aa_, (i + 2) * 1024); asm volatile("s_waitcnt lgkmcnt(1)" : "+v"(a1_)); } else asm volatile("s_waitcnt lgkmcnt(0)" : "+v"(a1_)); \
            acc[i + 1][0] = __builtin_amdgcn_mfma_f32_16x16x32_bf16(b0_, a1_, acc[i + 1][0], 0, 0, 0); acc[i + 1][1] = __builtin_amdgcn_mfma_f32_16x16x32_bf16(b1_, a1_, acc[i + 1][1], 0, 0, 0); \
            acc[i + 1][2] = __builtin_amdgcn_mfma_f32_16x16x32_bf16(b2_, a1_, acc[i + 1][2], 0, 0, 0); acc[i + 1][3] = __builtin_amdgcn_mfma_f32_16x16x32_bf16(b3_, a1_, acc[i + 1][3], 0, 0, 0); \
            if (i + 3 < MF) SG_DSR(a1_, aa_, (i + 3) * 1024); } \
        __builtin_amdgcn_s_setprio(0); \
        asm volatile("s_waitcnt vmcnt(7)" ::: "memory");                              \
        SG_CONV(RC, ((t) + 1) & 1); \
        sa = sa == 2 ? 0 : sa + 1; } while (0)
    SG_ISSUE(0, 0, br0); SG_ISSUE(1, 1, br1);
    asm volatile("s_waitcnt vmcnt(7)" ::: "memory");
    SG_CONV(br0, 0);
    int sa = 0;
#pragma unroll 1
    for (int t = 0; t < nt; t += 2) { SG_STEP(t, br0, br1); SG_STEP(t + 1, br1, br0); }
#undef SG_ISSUE
#undef SG_CONV
#undef SG_STEP
#undef SG_DSR
#undef SG_DSR2
#undef SG_BFRAG
}
template <int MODE>
__device__ __forceinline__ void sg_unit(FK_LAS unsigned char* lds, const SgArgs a) {
    const int tid = fk_tid(), wid = __builtin_amdgcn_readfirstlane(tid >> 6), lane = tid & 63, r16 = lane & 15, kq = lane >> 4, wm = wid >> 1, wn = wid & 1;
    const int rpw = ((a.nr + 63) >> 6) << 4, mf = rpw >> 4;
    const int nt = a.K >> 5;
    const char* ap[5];
    { const int kc = (lane & 3) ^ ((lane >> 4) & 3);
#pragma unroll
      for (int i = 0; i < 5; ++i) { int r = 16 * (5 * wid + i) + (lane >> 2); r = r < a.nr ? r : a.nr - 1; const int gr = a.rowlist ? a.rowlist[r] : a.arow0 + r; ap[i] = a.A + (size_t)gr * a.lda_bytes + kc * 16; } }
    const int kp = tid >> 5, c4 = tid & 31;
    const float* bpt;
    if (MODE == 1) { const int blk = c4 >> 3; bpt = ((blk & 1) ? a.B1 : a.B0) + 32 * (blk >> 1) + 4 * (c4 & 7) + (size_t)(2 * kp) * a.ldn; }
    else bpt = a.B0 + 4 * c4 + (size_t)(2 * kp) * a.ldn;
    const unsigned b_wr = (unsigned)(kp * SG_BPIT + c4 * 16);
    const unsigned a_rd = (unsigned)(SG_A + (wm * rpw + r16) * 64 + ((kq ^ ((r16 >> 2) & 3)) << 4));
    const unsigned b_rd = (unsigned)(SG_B + 4 * kq * SG_BPIT + (wn * 64 + r16) * 4);
    f32x4 acc[10][4];
#pragma unroll
    for (int i = 0; i < 10; ++i)
#pragma unroll
        for (int j = 0; j < 4; ++j) acc[i][j] = (f32x4){0.f, 0.f, 0.f, 0.f};
    switch ((mf + 1) >> 1) {
        case 1: sg_loop<2>(lds, acc, ap, bpt, a.ldn, nt, a_rd, b_rd, b_wr, wid); break;
        case 2: sg_loop<4>(lds, acc, ap, bpt, a.ldn, nt, a_rd, b_rd, b_wr, wid); break;
        case 3: sg_loop<6>(lds, acc, ap, bpt, a.ldn, nt, a_rd, b_rd, b_wr, wid); break;
        case 4: sg_loop<8>(lds, acc, ap, bpt, a.ldn, nt, a_rd, b_rd, b_wr, wid); break;
        default: sg_loop<10>(lds, acc, ap, bpt, a.ldn, nt, a_rd, b_rd, b_wr, wid); break;
    }
    float wgts[10];
#pragma unroll
    for (int i = 0; i < 10; ++i) { const int r = wm * rpw + 16 * i + r16; wgts[i] = (MODE == 1 && i < mf && r < a.nr) ? a.roww[r] : 0.f; }
#pragma unroll
    for (int i = 0; i < 10; ++i) if (i < mf) { const int r = wm * rpw + 16 * i + r16; if (r < a.nr) {
        if (MODE == 1) { const float wgt = wgts[i]; bf16_t* orow = a.out + (size_t)(a.out_row0 + r) * a.out_ld + a.out_col0 + 32 * wn + 4 * kq;
#pragma unroll
            for (int j = 0; j < 2; ++j) { const f32x4 g = acc[i][j], up = acc[i][j + 2]; f32x4 h;
#pragma unroll
                for (int q = 0; q < 4; ++q) h[q] = g[q] * __builtin_amdgcn_rcpf(1.0f + __builtin_amdgcn_exp2f(-g[q] * LOG2E)) * up[q] * wgt;
                u32x2 p; p.x = cvt_pk_bf16(h[0], h[1]); p.y = cvt_pk_bf16(h[2], h[3]); *(u32x2*)(orow + 16 * j) = p; } }
        else { bf16_t* orow = a.out + (size_t)(a.out_row0 + r) * a.out_ld + a.out_col0 + 64 * wn + 4 * kq;
#pragma unroll
            for (int j = 0; j < 4; ++j) { const f32x4 v = acc[i][j]; u32x2 p; p.x = cvt_pk_bf16(v[0], v[1]); p.y = cvt_pk_bf16(v[2], v[3]); *(u32x2*)(orow + 16 * j) = p; } } } }
    asm volatile("s_waitcnt lgkmcnt(0)\n\ts_barrier" ::: "memory");
}
__device__ __forceinline__ void phase_moe1(FK_LAS unsigned char* lds, FK_LAS const int* tab, const bf16_t* xb, const int* list, const float* sw, const float* wgate, const float* wup, bf16_t* H, int var) {
#pragma unroll 1
    for (int u = fk_bid(), nb = fk_nblk(); u < 256; u += nb) { const int xcd = u & 7, q = u >> 3, e = xcd + 8 * (q >> 3), s = q & 7; const int ne = tab[80 + e], hrow0 = tab[40 + e];
        const int rbeg = 0, rend = ne;
#pragma unroll 1
        for (int r0 = rbeg; r0 < rend; r0 += SG_ROWS) { SgArgs a; a.A = (const char*)xb; a.rowlist = list + (size_t)e * NT + r0; a.arow0 = 0; a.lda_bytes = D * 2; a.nr = min(SG_ROWS, rend - r0);
            a.B0 = wgate + (size_t)e * D * 512 + 64 * s; a.B1 = wup + (size_t)e * D * 512 + 64 * s; a.ldn = 512; a.K = D;
            a.out = H; a.out_row0 = hrow0 + r0; a.out_ld = 512; a.out_col0 = 64 * s; a.roww = sw + (size_t)e * NT + r0; a.var = var; sg_unit<1>(lds, a); } }
}
__device__ __forceinline__ void phase_moe2(FK_LAS unsigned char* lds, FK_LAS const int* tab, const bf16_t* H, const float* wdown, bf16_t* Y2, int var) {
#pragma unroll 1
    for (int u = fk_bid(), nb = fk_nblk(); u < 512; u += nb) { const int xcd = u & 7, q = u >> 3, e = xcd + 8 * (q >> 4), s = q & 15; const int ne = tab[80 + e], hrow0 = tab[40 + e];
        const int rbeg = 0, rend = ne;
#pragma unroll 1
        for (int r0 = rbeg; r0 < rend; r0 += SG_ROWS) { SgArgs a; a.A = (const char*)H; a.rowlist = nullptr; a.arow0 = hrow0 + r0; a.lda_bytes = 512 * 2; a.nr = min(SG_ROWS, rend - r0);
            a.B0 = wdown + (size_t)e * 512 * D + 128 * s; a.B1 = nullptr; a.ldn = D; a.K = 512;
            a.out = Y2; a.out_row0 = hrow0 + r0; a.out_ld = D; a.out_col0 = 128 * s; a.roww = nullptr; a.var = var; sg_unit<2>(lds, a); } }
}
}
namespace fk {
struct EpiBf16Q {
    static constexpr bool PERM = true;
    bf16_t* O; int ldc, qcols; float qscale;
    __device__ __forceinline__ void operator()(const f32x4 (&acc)[2][2][4][2], const GUnit& u, int wr, int wc, int fr, int fq) const {
        const int row0 = u.pm * BM + wr * 64 + fr;
#pragma unroll
        for (int bj = 0; bj < 2; ++bj) { const int gc = u.pn * BM + bj * HALF + wc * 32 + 8 * fq; const float sc = gc < qcols ? qscale : 1.0f;
#pragma unroll
            for (int ai = 0; ai < 2; ++ai)
#pragma unroll
                for (int m = 0; m < 4; ++m) *(u32x4*)(O + (size_t)(row0 + ai * HALF + m * 16) * ldc + gc) = pack8(acc[ai][bj][m][0] * sc, acc[ai][bj][m][1] * sc); }
    }
};
__device__ __forceinline__ void fox_cumsum_lds(const float* lsig, FK_LAS float* cfl, FK_LAS double* wtot, const int b, const int h) {
    const int tid = fk_tid(), lane = tid & 63, wid = tid >> 6;
    __syncthreads();
    const f32x4 v = *(const f32x4*)(lsig + (size_t)(b * 16 + h) * S + 4 * tid);
    const double s0 = (double)v[0], s1 = s0 + (double)v[1], s2 = s1 + (double)v[2], s3 = s2 + (double)v[3];
    double incl = s3;
#pragma unroll
    for (int o = 1; o < 64; o <<= 1) { const double u = __shfl_up(incl, o); if (lane >= o) incl += u; }
    if (lane == 63) wtot[wid] = incl;
    __syncthreads();
    double off = incl - s3;
#pragma unroll
    for (int w = 0; w < 7; ++w) if (w < wid) off += wtot[w];
    f32x4 o4; o4[0] = (float)((off + s0) * 1.4426950408889634); o4[1] = (float)((off + s1) * 1.4426950408889634); o4[2] = (float)((off + s2) * 1.4426950408889634); o4[3] = (float)((off + s3) * 1.4426950408889634);
    *(FK_LAS f32x4*)(cfl + 4 * tid) = o4;
    __syncthreads();
}
struct EpiDsaIn {
    static constexpr bool PERM = true;
    bf16_t *q, *k, *v, *qidx, *kidx; float* widx;
    __device__ __forceinline__ void operator()(const f32x4 (&acc)[2][2][4][2], const GUnit& u, int wr, int wc, int fr, int fq) const {
        const int row0 = u.pm * BM + wr * 64 + fr;
#pragma unroll
        for (int bj = 0; bj < 2; ++bj) { const int gc = u.pn * BM + bj * HALF + wc * 32 + 8 * fq;
            bf16_t* dst; int ld, c; float sc = 1.0f;
            if (gc < 2048) { dst = q; ld = 2048; c = gc; sc = QSCALE_128; } else if (gc < 2176) { dst = k; ld = 128; c = gc - 2048; } else if (gc < 2304) { dst = v; ld = 128; c = gc - 2176; }
            else if (gc < 3328) { dst = qidx; ld = 1024; c = gc - 2304; } else if (gc < 3392) { dst = kidx; ld = 64; c = gc - 3328; } else { dst = nullptr; ld = 0; c = gc - 3392; }
#pragma unroll
            for (int ai = 0; ai < 2; ++ai)
#pragma unroll
                for (int m = 0; m < 4; ++m) { const int row = row0 + ai * HALF + m * 16;
                    if (dst) *(u32x4*)(dst + (size_t)row * ld + c) = pack8(acc[ai][bj][m][0] * sc, acc[ai][bj][m][1] * sc);
                    else if (c < 16) { *(f32x4*)(widx + (size_t)row * 16 + c) = acc[ai][bj][m][0] * 0.03125f; *(f32x4*)(widx + (size_t)row * 16 + c + 4) = acc[ai][bj][m][1] * 0.03125f; } } }
    }
};

__device__ __forceinline__ unsigned ord_u32(float f) { const unsigned b = __float_as_uint(f); return b ^ ((b >> 31) ? 0xFFFFFFFFu : 0x80000000u); }
__device__ __forceinline__ int half_sum(int v) {
    v += __shfl_xor(v, 1); v += __shfl_xor(v, 2); v += __shfl_xor(v, 4); v += __shfl_xor(v, 8); v += __shfl_xor(v, 16); return v; }
__device__ __forceinline__ void dsa_index_unit(FK_LAS unsigned char* lds, const bf16_t* qidx, const bf16_t* kidx, const float* widx, unsigned short* sel, int* nsel, const int b, const int g, const int var = 0) {
    const int tid = fk_tid(), wid = __builtin_amdgcn_readfirstlane(tid >> 6), lane = tid & 63, r32 = lane & 31, hi = lane >> 5;
    const int t0 = 16 * g, ntile = (t0 >> 6) + 1, nk = 64 * ntile;
    const int tq = t0 + 2 * wid;
    bf16x8 qa[4]; float wv[16];
    { const int row = r32, q = row >> 4, h = row & 15; const bf16_t* p = qidx + ((size_t)(b * S + tq + q)) * 1024 + h * 64 + hi * 8;
#pragma unroll
      for (int ks = 0; ks < 4; ++ks) qa[ks] = *(const bf16x8*)(p + ks * 16);
#pragma unroll
      for (int r = 0; r < 16; ++r) { const int rw = crow(r, hi); wv[r] = widx[((size_t)(b * S + tq + (rw >> 4))) * 16 + (rw & 15)]; } }
    const int krr = tid >> 3, krc = tid & 7, krw = FK_KRSWZ(krr, krc);
    unsigned uk[64];
    bf16x8 stg[4];
#define DI_LOAD(T) do { _Pragma("unroll") for (int q_ = 0; q_ < 4; ++q_) stg[q_] = *(const bf16x8*)(kidx + ((size_t)(b * S + (T) * 256 + q_ * 64 + krr)) * 64 + krc * 8); } while (0)
#define DI_WRITE(bf) do { _Pragma("unroll") for (int q_ = 0; q_ < 4; ++q_) *(FK_LAS bf16x8*)(lds + (bf) * 32768 + q_ * 8192 + krw) = stg[q_]; } while (0)
    const int nt256 = (nk + 255) >> 8;
    DI_LOAD(0); DI_WRITE(0); __syncthreads();
#pragma unroll
    for (int ks = 0; ks < 4; ++ks) asm volatile("" :: "v"(qa[ks]));
#pragma unroll
    for (int r = 0; r < 16; ++r) asm volatile("" :: "v"(wv[r]));
#pragma unroll
    for (int i = 0; i < 64; ++i) uk[i] = 0u;
#pragma unroll 1
    for (int it = 0; it < 8; ++it) {
#pragma unroll
        for (int i = 0; i < 56; ++i) uk[i] = uk[i + 8];
        if (it < nt256 && !(var & 16)) {
            if (it + 1 < nt256) DI_LOAD(it + 1);
#pragma unroll
            for (int jj = 0; jj < 4; ++jj) { const int j = 4 * it + jj;
                if (j < ntile) {
                    FK_LAS const unsigned char* kb = lds + (it & 1) * 32768 + jj * 8192;
                    bf16x8 kfr[2][4];
#pragma unroll
                    for (int sub = 0; sub < 2; ++sub)
#pragma unroll
                        for (int ks = 0; ks < 4; ++ks) kfr[sub][ks] = *(FK_LAS const bf16x8*)(kb + FK_KRSWZ(32 * sub + r32, 2 * ks + hi));
#pragma unroll
                    for (int sub = 0; sub < 2; ++sub) {
                        f32x16 acc;
#pragma unroll
                        for (int r = 0; r < 16; ++r) acc[r] = 0.f;
#pragma unroll
                        for (int ks = 0; ks < 4; ++ks) acc = __builtin_amdgcn_mfma_f32_32x32x16_bf16(qa[ks], kfr[sub][ks], acc, 0, 0, 0);
                        float s0 = 0.f, s1 = 0.f;
#pragma unroll
                        for (int r = 0; r < 8; ++r) { s0 += fmaxf(acc[r], 0.f) * wv[r]; s1 += fmaxf(acc[8 + r], 0.f) * wv[8 + r]; }
                        auto rr = __builtin_amdgcn_permlane32_swap(__float_as_uint(s0), __float_as_uint(s1), false, false);
                        uk[56 + 2 * jj + sub] = ord_u32(__uint_as_float(rr[0]) + __uint_as_float(rr[1]));
                    }
                } else { uk[56 + 2 * jj] = 0u; uk[56 + 2 * jj + 1] = 0u; }
            }
            if (it + 1 < nt256) DI_WRITE((it + 1) & 1);
            __syncthreads();
        } else {
#pragma unroll
            for (int q_ = 0; q_ < 8; ++q_) uk[56 + q_] = 0u; }
    }
#undef DI_LOAD
#undef DI_WRITE
    const int t = tq + hi;
    unsigned short* so = sel + ((size_t)(b * S + t)) * 256;
    int base = 0;
    if (nk <= 256 || (var & 8)) {
#pragma unroll
        for (int s = 0; s < 8; ++s) { const int key = 32 * s + r32; so[key] = (unsigned short)(key < nk ? key : 0); }
        base = nk;
    } else {
        unsigned T = 0u; bool done = false;
#pragma unroll 1
        for (int bit = 31; bit >= 0; --bit) { const unsigned cand = T | (1u << bit); int c = 0;
#pragma unroll
            for (int s = 0; s < 64; ++s) c += (uk[s] >= cand) ? 1 : 0;
            c = half_sum(c); if (!done && c >= 256) { T = cand; done = (c == 256); }
            if (__all(done)) break; }
        int cgt = 0;
#pragma unroll
        for (int s = 0; s < 64; ++s) cgt += (uk[s] > T) ? 1 : 0;
        cgt = half_sum(cgt);
        const int need = 256 - cgt; int eqb = 0;
#pragma unroll
        for (int s = 0; s < 64; ++s) { const int key = 32 * s + r32; const unsigned u = uk[s];
            const bool iseq = (u == T);
            const unsigned long long em = __ballot(iseq); const unsigned eh = hi ? (unsigned)(em >> 32) : (unsigned)em; const int erank = eqb + __popc(eh & ((1u << r32) - 1u)); eqb += __popc(eh);
            const bool take = (u > T) || (iseq && erank < need);
            const unsigned long long tm = __ballot(take); const unsigned th = hi ? (unsigned)(tm >> 32) : (unsigned)tm; const int pos = base + __popc(th & ((1u << r32) - 1u)); base += __popc(th);
            if (take) so[pos] = (unsigned short)key; }
    }
    if (r32 == 0) nsel[b * S + t] = base;
}

constexpr int DS_T5 = 131072, DS_LUT = 133120, DS_SEL = 135168;
#define DS_RD_U16(dst, base, off) asm volatile("ds_read_u16 %0, %1 offset:%2" : "=v"(dst) : "v"(base), "n"(off))
#define DS_RD_U8(dst, addr)  asm volatile("ds_read_u8 %0, %1" : "=v"(dst) : "v"(addr))
#define DS_RD_B32(dst, addr) asm volatile("ds_read_b32 %0, %1" : "=v"(dst) : "v"(addr))
#define DS_RD_B64(dst, base, off) asm volatile("ds_read_b64 %0, %1 offset:%2" : "=v"(dst) : "v"(base), "n"(off))
#define DS_L4(a, o) "+v"(a[o]), "+v"(a[o + 1]), "+v"(a[o + 2]), "+v"(a[o + 3])
#define DS_L8(a, o) DS_L4(a, o), DS_L4(a, o + 4)
#define DS_L16(a, o) DS_L8(a, o), DS_L8(a, o + 8)
#define DS_WAIT4(a)  asm volatile("s_waitcnt lgkmcnt(0)" : DS_L4(a, 0))
#define DS_WAIT8(a)  asm volatile("s_waitcnt lgkmcnt(0)" : DS_L8(a, 0))
#define DS_WAIT32(a) do { asm volatile("s_waitcnt lgkmcnt(0)" : DS_L16(a, 0)); asm volatile("" : DS_L16(a, 16)); } while (0)
__device__ __forceinline__ void phase_dsa_attn(FK_LAS unsigned char* lds, const bf16_t* dq, const bf16_t* dk, const bf16_t* dv, const unsigned short* sel, const int* nsel, const float* t5, bf16_t* o) {
    const int tid = fk_tid(), wid = __builtin_amdgcn_readfirstlane(tid >> 6), lane = tid & 63, c16 = lane & 15, g = lane >> 4;
    FK_LAS float* t5l = (FK_LAS float*)(lds + DS_T5); FK_LAS unsigned char* lut = lds + DS_LUT;
    for (int i = tid; i < 512; i += NTHR) t5l[i] = t5[i] * LOG2E;
    for (int n = tid; n < 2048; n += NTHR) { int bk; if (n < 8) bk = n; else { bk = 8 + (int)(logf((float)n / 8.0f) / 2.772588722239781f * 8.0f); if (bk > 15) bk = 15; } lut[n] = (unsigned char)bk; }
    __syncthreads();
    FK_LAS unsigned char* vst = lds + wid * 16384;
    FK_LAS unsigned short* sell = (FK_LAS unsigned short*)(lds + DS_SEL + wid * 512);
    const unsigned vbase = (unsigned)(size_t)vst, sellb = (unsigned)(size_t)sell, lutb = (unsigned)(size_t)lut, t5b = (unsigned)(size_t)t5l;
    const unsigned sellk = sellb + (unsigned)(c16 * 2), sellg = sellb + (unsigned)(g * 8), sellv = sellb + (unsigned)((lane >> 4) * 2);
#pragma unroll 1
    for (int tg = fk_bid() * 8 + wid; tg < NT; tg += fk_nblk() * 8) {
        const int b = tg >> 11, t = tg & (S - 1); const int cnt = nsel[tg];
        const bf16_t* kb = dk + (size_t)b * S * 128; const bf16_t* vb = dv + (size_t)b * S * 128;
        { const u32x2 s4 = *(const u32x2*)(sel + (size_t)tg * 256 + lane * 4); *(FK_LAS u32x2*)(sell + lane * 4) = s4; }
        bf16x8 qf[4];
#pragma unroll
        for (int ks = 0; ks < 4; ++ks) qf[ks] = *(const bf16x8*)(dq + (size_t)tg * 2048 + c16 * 128 + ks * 32 + g * 8);
        asm volatile("s_waitcnt lgkmcnt(0)" ::: "memory");
        f32x4 sc[16];
        bf16x8 kf[2][4][4];
#define DS_KLOAD(ib, B) do { unsigned kq4[4]; _Pragma("unroll") for (int u = 0; u < 4; ++u) DS_RD_U16(kq4[u], sellk, 32 * (4 * (ib) + u)); DS_WAIT4(kq4); \
            _Pragma("unroll") for (int u = 0; u < 4; ++u) { const bf16_t* kr = kb + (size_t)kq4[u] * 128 + g * 8; \
                _Pragma("unroll") for (int ks = 0; ks < 4; ++ks) kf[B][u][ks] = *(const bf16x8*)(kr + ks * 32); } } while (0)
        DS_KLOAD(0, 0); DS_KLOAD(1, 1);
#pragma unroll
        for (int ib = 0; ib < 4; ++ib) {
#pragma unroll
            for (int u = 0; u < 4; ++u) { f32x4 a = {0.f, 0.f, 0.f, 0.f};
#pragma unroll
                for (int ks = 0; ks < 4; ++ks) a = __builtin_amdgcn_mfma_f32_16x16x32_bf16(kf[ib & 1][u][ks], qf[ks], a, 0, 0, 0);
                sc[4 * ib + u] = a; }
            if (ib + 2 < 4) DS_KLOAD(ib + 2, ib & 1);
        }
#undef DS_KLOAD
        float mx = -3.0e38f;
#pragma unroll
        for (int h = 0; h < 4; ++h) {
            u32x2 k4[4];
#pragma unroll
            for (int q = 0; q < 4; ++q) DS_RD_B64(k4[q], sellg, 32 * (4 * h + q));
            DS_WAIT4(k4);
            unsigned la[16]; unsigned sgn = 0u;
#pragma unroll
            for (int q = 0; q < 4; ++q)
#pragma unroll
                for (int r = 0; r < 4; ++r) { const int kk = (int)((r < 2 ? (k4[q].x >> (16 * r)) : (k4[q].y >> (16 * (r - 2)))) & 0xffffu); const int rel = kk - t; const int n = rel < 0 ? -rel : rel; sgn |= (rel > 0 ? 1u : 0u) << (4 * q + r); la[4 * q + r] = lutb + (unsigned)n; }
            unsigned lb[16];
#pragma unroll
            for (int k = 0; k < 16; ++k) DS_RD_U8(lb[k], la[k]);
            asm volatile("s_waitcnt lgkmcnt(0)" : DS_L16(lb, 0));
#pragma unroll
            for (int k = 0; k < 16; ++k) la[k] = t5b + ((((sgn >> k) & 1u) * 16u + lb[k]) * 16u + (unsigned)c16) * 4u;
#pragma unroll
            for (int k = 0; k < 16; ++k) DS_RD_B32(lb[k], la[k]);
            asm volatile("s_waitcnt lgkmcnt(0)" : DS_L16(lb, 0));
#pragma unroll
            for (int q = 0; q < 4; ++q)
#pragma unroll
                for (int r = 0; r < 4; ++r) { const int i = 4 * h + q; float v = sc[i][r] + __uint_as_float(lb[4 * q + r]); v = (16 * i + 4 * g + r < cnt) ? v : -__builtin_inff(); sc[i][r] = v; mx = fmaxf(mx, v); }
        }
        mx = fmaxf(mx, __shfl_xor(mx, 16)); mx = fmaxf(mx, __shfl_xor(mx, 32));
        float sum = 0.f;
#pragma unroll
        for (int i = 0; i < 16; ++i)
#pragma unroll
            for (int r = 0; r < 4; ++r) { const float p = __builtin_amdgcn_exp2f(sc[i][r] - mx); sc[i][r] = p; sum += p; }
        sum += __shfl_xor(sum, 16); sum += __shfl_xor(sum, 32);
        const float inv = __builtin_amdgcn_rcpf(sum);
        u32x4 pw[8];
#pragma unroll
        for (int c = 0; c < 8; ++c) pw[c] = pack8(sc[2 * c], sc[2 * c + 1]);
        f32x4 oa[8];
#pragma unroll
        for (int d = 0; d < 8; ++d) oa[d] = (f32x4){0.f, 0.f, 0.f, 0.f};
        bf16x8 vv[2][8];
#define DS_VLOAD(c, B) do { unsigned kv8_[8]; _Pragma("unroll") for (int it = 0; it < 8; ++it) DS_RD_U16(kv8_[it], sellv, 64 * (c) + 8 * it); DS_WAIT8(kv8_); \
        _Pragma("unroll") for (int it = 0; it < 8; ++it) { const int ch = lane & 15; vv[B][it] = *(const bf16x8*)(vb + (size_t)kv8_[it] * 128 + ch * 8); } } while (0)
        DS_VLOAD(0, 0);
#pragma unroll
        for (int c = 0; c < 8; ++c) {
            if (32 * c < cnt) {
                if (c + 1 < 8 && 32 * (c + 1) < cnt) DS_VLOAD(c + 1, (c + 1) & 1);
#pragma unroll
                for (int it = 0; it < 8; ++it) { const int idx = lane + 64 * it, lr = idx >> 4, ch = idx & 15; *(FK_LAS bf16x8*)(vst + lr * 256 + ((ch ^ ((lr & 7) << 1)) << 4)) = vv[c & 1][it]; }
                const bf16x8 pf = *reinterpret_cast<const bf16x8*>(&pw[c]);
                asm volatile("s_waitcnt lgkmcnt(0)" ::: "memory");
                const int q4 = c16 >> 2, p4 = c16 & 3; const int rowA = 4 * g + q4, rowB = 16 + 4 * g + q4;
                s16x4 lo8[8], hi8[8];
#pragma unroll
                for (int d = 0; d < 8; ++d) {
                    const unsigned aA = vbase + rowA * 256 + (((2 * d + (p4 >> 1)) ^ ((rowA & 7) << 1)) << 4) + (p4 & 1) * 8;
                    const unsigned aB = vbase + rowB * 256 + (((2 * d + (p4 >> 1)) ^ ((rowB & 7) << 1)) << 4) + (p4 & 1) * 8;
                    asm volatile("ds_read_b64_tr_b16 %0, %1" : "=&v"(lo8[d]) : "v"(aA) : "memory");
                    asm volatile("ds_read_b64_tr_b16 %0, %1" : "=&v"(hi8[d]) : "v"(aB) : "memory"); }
#define DS_PV(d, n) do { asm volatile("s_waitcnt lgkmcnt(" #n ")" : "+v"(lo8[d]), "+v"(hi8[d])); \
                    oa[d] = __builtin_amdgcn_mfma_f32_16x16x32_bf16((bf16x8){lo8[d][0], lo8[d][1], lo8[d][2], lo8[d][3], hi8[d][0], hi8[d][1], hi8[d][2], hi8[d][3]}, pf, oa[d], 0, 0, 0); } while (0)
                DS_PV(0, 14); DS_PV(1, 12); DS_PV(2, 10); DS_PV(3, 8); DS_PV(4, 6); DS_PV(5, 4); DS_PV(6, 2); DS_PV(7, 0);
#undef DS_PV
                __builtin_amdgcn_sched_barrier(0);
            }
        }
#undef DS_VLOAD
#pragma unroll
        for (int d = 0; d < 8; ++d) { u32x2 p; p.x = cvt_pk_bf16(oa[d][0] * inv, oa[d][1] * inv); p.y = cvt_pk_bf16(oa[d][2] * inv, oa[d][3] * inv);
            *(u32x2*)(o + (size_t)tg * 2048 + c16 * 128 + 16 * d + 4 * g) = p; }
    }
}
}
#define XB_TMO      128
#define XB_XCNT(j)  (256  + 64 * (j))
#define XB_XSUB(j)  (1280 + 64 * (j))
#define XB_XGEN(j)  (2304 + 64 * (j))
#define XB_TOP      3328
#define XB_TOPGEN   3392
#define XCD_BAR_WORDS 3456
#define XB_SPIN_CAP (1u << 18)
#define LAS __attribute__((address_space(3)))

__device__ __forceinline__ unsigned xb_ld(unsigned* p)              { return __hip_atomic_load(p, __ATOMIC_RELAXED, __HIP_MEMORY_SCOPE_AGENT); }
__device__ __forceinline__ unsigned xb_add(unsigned* p, unsigned v) { return __hip_atomic_fetch_add(p, v, __ATOMIC_RELAXED, __HIP_MEMORY_SCOPE_AGENT); }
__device__ __forceinline__ unsigned xb_xcc_id() { return (unsigned)__builtin_amdgcn_s_getreg((3 << 11) | 20) & 0xFu; }
#define XB_SPIN(cond, bar) do { unsigned _sp = 0; while (cond) { __builtin_amdgcn_s_sleep(1); \
    if ((++_sp & 255u) == 0u) { if (xb_ld(&(bar)[XB_TMO])) break; if (_sp > XB_SPIN_CAP) { atomicAdd(&(bar)[XB_TMO], 1u); break; } } } } while (0)

struct XcdBarrier {
    unsigned* bar; unsigned x;
    volatile LAS unsigned* st;
};

__device__ __forceinline__ XcdBarrier xcd_barrier_post(unsigned* bar, volatile LAS unsigned* st) {
    XcdBarrier b; b.bar = bar; b.x = xb_xcc_id(); b.st = st;
    if (threadIdx.x == 0) (void)xb_add(&bar[XB_XCNT(b.x)], 1u);
    return b;
}
__device__ __forceinline__ void xcd_barrier_complete(unsigned* bar, unsigned x, unsigned& nloc, unsigned& nx) {
    const unsigned G = gridDim.x * gridDim.y * gridDim.z;
    unsigned sum, cnt, mine, sp = 0u;
    for (;;) {
        sum = 0u; cnt = 0u; mine = 0u;
#pragma unroll
        for (unsigned j = 0; j < 16; ++j) { const unsigned c = xb_ld(&bar[XB_XCNT(j)]); sum += c; cnt += (c > 0u) ? 1u : 0u; mine = (j == x) ? c : mine; }
        if (sum == G) break;
        __builtin_amdgcn_s_sleep(1);
        if ((++sp & 255u) == 0u) { if (xb_ld(&bar[XB_TMO])) break; if (sp > XB_SPIN_CAP) { atomicAdd(&bar[XB_TMO], 1u); break; } }
    }
    nloc = mine > 0u ? mine : 1u; nx = cnt > 0u ? cnt : 1u;
}

__device__ __forceinline__ void xcd_barrier(const XcdBarrier& b) {
    asm volatile("s_waitcnt vmcnt(0)" ::: "memory");
    __syncthreads();
    if (threadIdx.x == 0) {
        unsigned* bar = b.bar;
        __builtin_amdgcn_s_waitcnt(0);
        unsigned nloc = b.st[0], nx = b.st[1];
        if (nloc == 0u) { xcd_barrier_complete(bar, b.x, nloc, nx); b.st[0] = nloc; b.st[1] = nx; }
        const unsigned old = xb_add(&bar[XB_XSUB(b.x)], 1u);
        const unsigned gen = old / nloc;
        if (old + 1u == (gen + 1u) * nloc) {
            __builtin_amdgcn_fence(__ATOMIC_RELEASE, "agent");
            asm volatile("s_waitcnt vmcnt(0)" ::: "memory");
            const unsigned og = xb_add(&bar[XB_TOP], 1u);
            const unsigned tg = og / nx;
            if (og + 1u == (tg + 1u) * nx) xb_add(&bar[XB_TOPGEN], 1u);
            else XB_SPIN(xb_ld(&bar[XB_TOPGEN]) == tg, bar);
            __builtin_amdgcn_fence(__ATOMIC_ACQUIRE, "agent");
            xb_add(&bar[XB_XGEN(b.x)], 1u);
            asm volatile("s_waitcnt vmcnt(0)" ::: "memory");
        } else {
            XB_SPIN(xb_ld(&bar[XB_XGEN(b.x)]) == gen, bar);
            __builtin_amdgcn_fence(__ATOMIC_ACQUIRE, "agent");
            asm volatile("s_waitcnt vmcnt(0)" ::: "memory");
        }
    }
    __syncthreads();
}


__device__ __forceinline__ void xcd_barrier_slim(const XcdBarrier& b) {
    asm volatile("s_waitcnt vmcnt(0)" ::: "memory");
    __syncthreads();
    if (threadIdx.x == 0) {
        unsigned* bar = b.bar;
        __builtin_amdgcn_s_waitcnt(0);
        unsigned nloc = b.st[0], nx = b.st[1];
        if (nloc == 0u) { nloc = 1u; nx = 1u; }
        const unsigned old = xb_add(&bar[XB_XSUB(b.x)], 1u);
        const unsigned gen = old / nloc;
        if (old + 1u == (gen + 1u) * nloc) {
            __builtin_amdgcn_fence(__ATOMIC_RELEASE, "agent");
            asm volatile("s_waitcnt vmcnt(0)" ::: "memory");
            const unsigned og = xb_add(&bar[XB_TOP], 1u);
            const unsigned tg = og / nx;
            if (og + 1u == (tg + 1u) * nx) xb_add(&bar[XB_TOPGEN], 1u);
            else XB_SPIN(xb_ld(&bar[XB_TOPGEN]) == tg, bar);
            __builtin_amdgcn_fence(__ATOMIC_ACQUIRE, "agent");
            xb_add(&bar[XB_XGEN(b.x)], 1u);
            asm volatile("s_waitcnt vmcnt(0)" ::: "memory");
        } else {
            XB_SPIN(xb_ld(&bar[XB_XGEN(b.x)]) == gen, bar);
            __builtin_amdgcn_fence(__ATOMIC_ACQUIRE, "agent");
            asm volatile("s_waitcnt vmcnt(0)" ::: "memory");
        }
    }
    __syncthreads();
}

namespace fk {
template <int FK_PHASE_MASK_, int ML>
__global__ void __launch_bounds__(NTHR, 2) fk_fwd(const FWK kw, const CvtTable T, const int p_lo, const int p_hi) {
    extern __shared__ __attribute__((aligned(16))) unsigned char shm_[];
    FK_LAS unsigned char* lds = (FK_LAS unsigned char*)shm_;
    FK_LAS unsigned* xbw = (FK_LAS unsigned*)(lds + LDS_BYTES - 16);
    if (threadIdx.x == 0) { xbw[0] = 0u; xbw[1] = 0u; xbw[2] = 0u; xbw[3] = 0u; }
    __syncthreads();
#define FWK_FIELDS(X) X(x_in) X(t5) X(mla_w_in) X(mla_qn) X(mla_kvn) X(mla_wq) X(mla_wkv) X(mla_wo) X(fox_w_in) X(fox_bf) X(fox_wo) X(dsa_w_in) X(dsa_wo) X(ln_g) X(ln_b) X(wgrp) X(bgrp) X(wrt) X(brt) X(wgate) X(wup) X(wdown) X(out) X(ws) X(moe_bias_gu) X(moe_bias_d) X(var)
    FK_LAS unsigned long long* kl = (FK_LAS unsigned long long*)(lds + 146944);
    if (threadIdx.x == 0) { int i_ = 0;
#define FWK_PUT(f) kl[i_++] = (unsigned long long)kw.f;
        FWK_FIELDS(FWK_PUT)
#undef FWK_PUT
    }
    __syncthreads();
    XcdBarrier bar = xcd_barrier_post((unsigned*)(kw.ws + WsMap<ML>::CTL), (volatile LAS unsigned*)xbw);
    FK_LAS int* tab = (FK_LAS int*)(lds + TAB_OFF);
    if (p_hi - p_lo > 1) xcd_barrier(bar);
#define PH_ON(k) (((FK_PHASE_MASK_) >> (k)) & 1)
#ifndef FK_REP_MASK
#define FK_REP_MASK 0
#endif
#define PH_REP(k) ((((FK_REP_MASK) >> (k)) & 1) ? 2 : 1)
#define FWK_GET(f) { const unsigned long long v_ = kl[i_++]; const unsigned lo_ = __builtin_amdgcn_readfirstlane((unsigned)v_), hi_ = __builtin_amdgcn_readfirstlane((unsigned)(v_ >> 32)); kq_.f = FkCvt<decltype(kq_.f)>::get(((unsigned long long)hi_ << 32) | lo_); }
#define PH_BEGIN(id) if ((id) >= p_lo && (id) < p_hi) { if ((id) > p_lo) xcd_barrier_slim(bar); FWK kq_; { int i_ = 0; FWK_FIELDS(FWK_GET) } const FW w = make_fw<ML>(kq_, kq_.ws);
#define PH_END }
#define PH_BEGINR(id, bit) PH_BEGIN(id) for (int rep_ = 0; rep_ < PH_REP(bit); ++rep_)
    if constexpr (PH_ON(8)) { PH_BEGINR(0, 8) phase_prologue(w, T, lds); PH_END }
#pragma unroll 1
    for (int layer = 0; layer < 4; ++layer) {
        const int kind = layer % 3, j = layer / 3, pb = 1 + 8 * layer;
        if (kind == 0) {
#define MLA_PTRS bf16_t* cq = (bf16_t*)w.arena; bf16_t* ckv = cq + (size_t)NT * 512; bf16_t* kr = ckv + (size_t)NT * 512; bf16_t* q = kr + (size_t)NT * 64; bf16_t* kv = q + (size_t)NT * 3072; (void)cq; (void)ckv; (void)kr; (void)q; (void)kv;
            if constexpr (PH_ON(0)) PH_BEGINR(pb + 0, 0) { MLA_PTRS RectSched s; s.init(w.xb0, D, w.mla_win_t + (size_t)j * 1280 * D, D, NT, 1280); EpiMlaIn e{cq, ckv, kr, w.ss, w.rope_cs}; gemm_phase(lds, D, D, s, e);
                if (layer == 0 && T.late0 < T.ntiles) { const int busy = (NT / BM) * (1280 / BM); if (fk_bid() >= busy) cvt_wide_range<true>(T, lds, T.late0 + fk_bid() - busy, T.late1, fk_nblk() - busy); } }
            PH_END
            if constexpr (PH_ON(1)) PH_BEGINR(pb + 1, 1) { MLA_PTRS Rect2Sched s; s.s0.init(cq, 512, w.mla_wq_t + (size_t)j * 3072 * 512, 512, NT, 3072); s.s1.init(ckv, 512, w.mla_wkv_t + (size_t)j * 4096 * 512, 512, NT, 4096); s.n0 = 0;
                EpiMlaQKV e{q, kv, w.ss, w.rope_cs, nullptr, false, 0}; e.prepass(lds, s); gemm_phase(lds, 512, 512, s, e);
                if (layer == 0 && T.late1 < T.late2) { const int rem = ((NT / BM) * (7168 / BM)) % fk_nblk(); if (rem > 0 && fk_bid() >= rem) cvt_wide_range<true>(T, lds, T.late1 + fk_bid() - rem, T.late2, fk_nblk() - rem); } }
            PH_END
            if constexpr (PH_ON(2)) PH_BEGINR(pb + 2, 2) { MLA_PTRS
#pragma unroll 1
                for (int p = fk_bid(), np_ = fk_nblk(); p < 256; p += np_) { const int bh = p >> 2, x = p & 3, b = bh >> 4, h = bh & 15;
                    AttnPtrs P; P.Q = q + (size_t)b * S * 3072 + h * 192; P.K = kv + (size_t)b * S * 4096 + h * 256; P.V = P.K + 128; P.KR = kr + (size_t)b * S * 64; P.CF = nullptr; P.O = w.o + (size_t)b * S * D + h * 128; P.qld = 3072; P.kld = 4096;
                    attn_block<0>(lds, P, 7 - x); attn_block<0>(lds, P, x); } } PH_END
        }
        if (kind == 1) {
#define FOX_PTRS bf16_t* qkv = (bf16_t*)w.arena;
            if constexpr (PH_ON(9)) PH_BEGINR(pb + 0, 9) { FOX_PTRS RectSched s; s.init(w.xb0, D, w.fox_win_t, D, NT, 6144); EpiBf16Q e{qkv, 6144, 2048, QSCALE_128}; gemm_phase(lds, D, D, s, e); } PH_END
            if constexpr (PH_ON(10)) PH_BEGINR(pb + 2, 10) { FOX_PTRS
#pragma unroll 1
                for (int p = fk_bid(), np_ = fk_nblk(); p < 256; p += np_) { const int bh = p >> 2, x = p & 3, b = bh >> 4, h = bh & 15;
                    AttnPtrs P; P.Q = qkv + (size_t)b * S * 6144 + h * 128; P.K = P.Q + 2048; P.V = P.Q + 4096; P.KR = nullptr; P.CF = nullptr; P.O = w.o + (size_t)b * S * D + h * 128; P.qld = 6144; P.kld = 6144;
                    fox_cumsum_lds(w.flog, (FK_LAS float*)(lds + AT_CF), (FK_LAS double*)(lds + AT_WS), b, h);
                    attn_block<1>(lds, P, 7 - x); attn_block<1>(lds, P, x); } } PH_END
        }
        if (kind == 2) {
#define DSA_PTRS bf16_t* dq = (bf16_t*)w.arena; bf16_t* dk = dq + (size_t)NT * 2048; bf16_t* dv = dk + (size_t)NT * 128; bf16_t* qidx = dv + (size_t)NT * 128; bf16_t* kidx = qidx + (size_t)NT * 1024; \
            float* widx = (float*)(kidx + (size_t)NT * 64); unsigned short* sel = (unsigned short*)(widx + (size_t)NT * 16); int* nsel = (int*)(sel + (size_t)NT * 256); (void)dq; (void)dk; (void)dv; (void)qidx; (void)kidx; (void)widx; (void)sel; (void)nsel;
            if constexpr (PH_ON(11)) PH_BEGINR(pb + 0, 11) { DSA_PTRS RectSched s; s.init(w.xb0, D, w.dsa_win_t, D, NT, 3584); EpiDsaIn e{dq, dk, dv, qidx, kidx, widx}; gemm_phase(lds, D, D, s, e);
                if (T.late2 < T.ntiles) { const int rem = ((NT / BM) * (3584 / BM)) % fk_nblk(); if (rem > 0 && fk_bid() >= rem) cvt_wide_range<true>(T, lds, T.late2 + fk_bid() - rem, T.ntiles, fk_nblk() - rem); } }
            PH_END
            if constexpr (PH_ON(12)) PH_BEGINR(pb + 1, 12) { DSA_PTRS
#pragma unroll 1
                for (int p = fk_bid(), np_ = fk_nblk(); p < 256; p += np_) { const int b = p >> 6, x = p & 63;
                    dsa_index_unit(lds, qidx, kidx, widx, sel, nsel, b, 127 - x, (int)kq_.var); dsa_index_unit(lds, qidx, kidx, widx, sel, nsel, b, x, (int)kq_.var); } } PH_END
            if constexpr (PH_ON(13)) PH_BEGINR(pb + 2, 13) { DSA_PTRS phase_dsa_attn(lds, dq, dk, dv, sel, nsel, w.t5, w.o); } PH_END
        }
        if constexpr (PH_ON(3)) PH_BEGINR(pb + 3, 3) { const bf16_t* wo_t = kind == 0 ? w.mla_wo_t + (size_t)j * D * D : (kind == 1 ? w.fox_wo_t : w.dsa_wo_t); RectSched s; s.init(w.o, D, wo_t, D, NT, D); EpiBf16Q e{(bf16_t*)w.y, D, 0, 1.0f}; gemm_phase(lds, D, D, s, e); } PH_END
        if constexpr (PH_ON(4)) PH_BEGIN(pb + 4) { LnArgs a; a.x = (layer == 0) ? w.x_in : w.xA; a.yb = (const bf16_t*)w.y; a.Y2 = nullptr; a.te = nullptr; a.tpos = nullptr; a.cnt = nullptr; a.g = w.ln_g + (size_t)(layer * 2) * D; a.b = w.ln_b + (size_t)(layer * 2) * D; a.xo = w.xB; a.xbo = w.xb1; a.out2 = nullptr; a.xqo = nullptr;
            a.w4 = (const f32x4*)w.wr4 + (size_t)layer * 128 * 3 * 64; a.ntile = 3; a.bgrp = w.bgrp + layer * 4; a.brt = w.brt + layer * 32; a.rcnt = w.moe_cnt + layer * 1024; a.ote = w.te; a.otpos = w.tpos; a.otw = w.tw; a.list = w.list; a.sw = w.sw; a.flog = nullptr; a.fbias = nullptr;
            phase_ln(a, lds);
            } PH_END
        if constexpr (PH_ON(5)) PH_BEGINR(pb + 5, 5) { moe_tables(w.moe_cnt + layer * 1024, tab); phase_moe1(lds, tab, w.xb1, w.list, w.sw, w.wgate + (size_t)layer * 32 * D * 512, w.wup + (size_t)layer * 32 * D * 512, w.H, (int)kq_.var); } PH_END
        if constexpr (PH_ON(6)) PH_BEGINR(pb + 6, 6) { moe_tables(w.moe_cnt + layer * 1024, tab); phase_moe2(lds, tab, w.H, w.wdown + (size_t)layer * 32 * 512 * D, w.Y2, (int)kq_.var); } PH_END
        if constexpr (PH_ON(7)) PH_BEGINR(pb + 7, 7) { LnArgs a; a.x = w.xB; a.yb = nullptr; a.Y2 = w.Y2; a.te = w.te; a.tpos = w.tpos; a.cnt = w.moe_cnt + layer * 1024; a.g = w.ln_g + (size_t)(layer * 2 + 1) * D; a.b = w.ln_b + (size_t)(layer * 2 + 1) * D; a.xo = w.xA; a.xbo = w.xb0; a.xqo = nullptr;
            a.out2 = (layer == 3) ? w.out : nullptr; a.w4 = (layer == 0) ? (const f32x4*)w.fox_wf4 : nullptr; a.ntile = (layer == 0) ? 1 : 0; a.bgrp = nullptr; a.brt = nullptr; a.rcnt = nullptr; a.ote = nullptr; a.otpos = nullptr; a.otw = nullptr; a.list = nullptr; a.sw = nullptr; a.flog = w.flog; a.fbias = w.fox_bf;
            phase_ln(a, lds); } PH_END
    }
#undef PH_BEGIN
#undef PH_END
}

constexpr size_t CTL_BYTES = 65536;
static FWK make_fwk(void* const* d_in, void* d_out, char* ws) {
    FWK k; memset(&k, 0, sizeof(k));
    k.x_in = (const float*)d_in[0]; k.t5 = (const float*)d_in[1]; k.mla_w_in = (const float*)d_in[2]; k.mla_qn = (const float*)d_in[3]; k.mla_kvn = (const float*)d_in[4]; k.mla_wq = (const float*)d_in[5];
    k.mla_wkv = (const float*)d_in[6]; k.mla_wo = (const float*)d_in[7]; k.fox_w_in = (const float*)d_in[8]; k.fox_bf = (const float*)d_in[9]; k.fox_wo = (const float*)d_in[10]; k.dsa_w_in = (const float*)d_in[11];
    k.dsa_wo = (const float*)d_in[12]; k.ln_g = (const float*)d_in[13]; k.ln_b = (const float*)d_in[14]; k.wgrp = (const float*)d_in[15]; k.bgrp = (const float*)d_in[16]; k.wrt = (const float*)d_in[17];
    k.brt = (const float*)d_in[18]; k.wgate = (const float*)d_in[19]; k.wup = (const float*)d_in[20]; k.wdown = (const float*)d_in[21]; k.out = (float*)d_out; k.ws = ws;
    return k;
}
static void add_job(CvtTable& T, const float* s0, const float* s1, const float* scale, bf16_t* dst, long sbs, long dbs, int K, int N, int Np, int map, int nbatch) {
    CvtJob& J = T.j[T.njobs++]; J.src0 = s0; J.src1 = s1; J.scale = scale; J.dst = dst; J.src_bstride = sbs; J.dst_bstride = dbs; J.K = K; J.N = N; J.Np = Np; J.map = map; J.nbatch = nbatch; J.tile0 = T.ntiles;
    J.wide = ((K % 128 == 0) && (Np % 256 == 0) && (N % 4 == 0)) ? 1 : 0;
    T.ntiles += J.wide ? nbatch * (K / 128) * (Np / 256) : nbatch * (K / 64) * (Np / 64);
}
static void build_table(CvtTable& T, const FW& w, int moe_l0, int moe_l1, bool base) {
    memset(&T, 0, sizeof(T)); T.misc = base ? 1 : 0;
    if (base) {
#define FK_MLA_JOBS(j) do { \
        add_job(T, w.mla_w_in + (size_t)(j) * D * 1088, nullptr, nullptr, w.mla_win_t + (size_t)(j) * 1280 * D, 0, 0, D, 1088, 1280, MAP_MLA_IN, 1); \
        add_job(T, w.mla_wq + (size_t)(j) * 512 * 3072, nullptr, w.mla_qn + (j) * 512, w.mla_wq_t + (size_t)(j) * 3072 * 512, 0, 0, 512, 3072, 3072, MAP_MLA_Q, 1); \
        add_job(T, w.mla_wkv + (size_t)(j) * 512 * 4096, nullptr, w.mla_kvn + (j) * 512, w.mla_wkv_t + (size_t)(j) * 4096 * 512, 0, 0, 512, 4096, 4096, MAP_ID, 1); \
        add_job(T, w.mla_wo + (size_t)(j) * D * D, nullptr, nullptr, w.mla_wo_t + (size_t)(j) * D * D, 0, 0, D, D, D, MAP_ID, 1); } while (0)
    FK_MLA_JOBS(0);
    T.late0 = T.ntiles;
    add_job(T, w.fox_w_in, nullptr, nullptr, w.fox_win_t, 0, 0, D, 6160, 6144, MAP_ID, 1);
    add_job(T, w.fox_wo, nullptr, nullptr, w.fox_wo_t, 0, 0, D, D, D, MAP_ID, 1);
    add_job(T, w.dsa_w_in, nullptr, nullptr, w.dsa_win_t, 0, 0, D, 3408, 3584, MAP_ID, 1);
    T.late1 = T.ntiles;
    T.late2 = T.ntiles;
    add_job(T, w.dsa_wo, nullptr, nullptr, w.dsa_wo_t, 0, 0, D, D, D, MAP_ID, 1);
    FK_MLA_JOBS(1);
#undef FK_MLA_JOBS
    }
    for (int l = moe_l0; l < moe_l1; ++l) {
        add_job(T, w.wgate + (size_t)l * 32 * D * 512, w.wup + (size_t)l * 32 * D * 512, nullptr, w.moe_gu_t + (size_t)l * 32 * 1024 * D, (long)D * 512, (long)1024 * D, D, 512, 1024, MAP_MOE_GU, 32);
        add_job(T, w.wdown + (size_t)l * 32 * 512 * D, nullptr, nullptr, w.moe_d_t + (size_t)l * 32 * D * 512, (long)512 * D, (long)D * 512, 512, D, D, MAP_ID, 32);
    }
}
static int g_grid = 0;
static void finish_table(CvtTable& T) { int all = 1; for (int i = 0; i < T.njobs; ++i) if (!T.j[i].wide) all = 0; T.pad = all;
    if (!all || T.late0 <= 0 || g_grid != 256) { T.late0 = T.ntiles; T.late1 = T.ntiles; T.late2 = T.ntiles; } }
static void setup_once() {
    if (g_grid) return;
    int dev = 0, cus = 0, per_cu = 0;
    (void)hipGetDevice(&dev); (void)hipDeviceGetAttribute(&cus, hipDeviceAttributeMultiprocessorCount, dev);
    (void)per_cu;
    if (cus <= 0) cus = 256;
    g_grid = cus;
}
template <int MASK, int ML> static void launch_mask(const FWK& w, const CvtTable& T, int lo, int hi, hipStream_t st) {
    static bool attr = false; if (!attr) { (void)hipFuncSetAttribute((const void*)fk_fwd<MASK, ML>, hipFuncAttributeMaxDynamicSharedMemorySize, LDS_BYTES); attr = true; }
    hipLaunchKernelGGL((fk_fwd<MASK, ML>), dim3(g_grid), dim3(NTHR), LDS_BYTES, st, w, T, lo, hi);
}
#ifdef FK_DEBUG_BUILD
static void launch_phase(const FWK& w, const CvtTable& T, int p, hipStream_t st) {
    if (p == 0) { launch_mask<(1 << 8), 1>(w, T, p, p + 1, st); return; }
    const int layer = (p - 1) >> 3, k = (p - 1) & 7, kind = layer % 3;
    if (k >= 3) { switch (k) { case 3: launch_mask<(1 << 3), 1>(w, T, p, p + 1, st); break; case 4: launch_mask<(1 << 4), 1>(w, T, p, p + 1, st); break; case 5: launch_mask<(1 << 5), 1>(w, T, p, p + 1, st); break;
                               case 6: launch_mask<(1 << 6), 1>(w, T, p, p + 1, st); break; default: launch_mask<(1 << 7), 1>(w, T, p, p + 1, st); break; } return; }
    if (kind == 0) { if (k == 0) launch_mask<(1 << 0), 1>(w, T, p, p + 1, st); else if (k == 1) launch_mask<(1 << 1), 1>(w, T, p, p + 1, st); else launch_mask<(1 << 2), 1>(w, T, p, p + 1, st); }
    else if (kind == 1) { if (k == 0) launch_mask<(1 << 9), 1>(w, T, p, p + 1, st); else if (k == 2) launch_mask<(1 << 10), 1>(w, T, p, p + 1, st); }
    else { if (k == 0) launch_mask<(1 << 11), 1>(w, T, p, p + 1, st); else if (k == 1) launch_mask<(1 << 12), 1>(w, T, p, p + 1, st); else launch_mask<(1 << 13), 1>(w, T, p, p + 1, st); }
}
#endif
}
#ifndef FK_EXTRA
#define FK_EXTRA {}
#endif
extern "C" void kernel_launch(void* const* d_in, const int* in_sizes, int n_in, void* d_out, int out_size, void* d_ws, size_t ws_size, hipStream_t stream) {
    using namespace fk;
    setup_once();
    const FWK k = make_fwk(d_in, d_out, (char*)d_ws);
    const FW w = make_fw<0>(k, k.ws);
    static CvtTable T; build_table(T, w, 0, 0, true); finish_table(T);
    (void)hipMemsetAsync(w.bar, 0, CTL_BYTES, stream);
    launch_mask<0x3FFF, 0>(k, T, 0, 33, stream);
    { static const int extra[] = FK_EXTRA; (void)extra; FWK kv = k;
#ifdef FK_VAR
      kv.var = FK_VAR;
#endif
      for (unsigned i = 0; i < sizeof(extra) / sizeof(int); ++i) launch_mask<0x3FFF, 0>(kv, T, extra[i], extra[i] + 1, stream); }
}
```
